# Optimizing an MI355X kernel written in HIP

```python
import jax, jax.numpy as jnp
from jax import lax
import numpy as np

D_MODEL = 1024
BATCH = 2
SEQ = 16384
DEPTH = 1

PLE_DIM = 256
POOL_GROUPS = 4
POOL_GROUP_W = 128
POOL_WINDOWS = (2, 4, 8, 16)
POOL_W = POOL_GROUPS * POOL_GROUP_W
N_HEADS = 8
N_KV_HEADS = 2
HEAD_DIM = 64
ATTN_W = N_HEADS * HEAD_DIM
KV_W = N_KV_HEADS * HEAD_DIM
IDX_HEADS = 8
IDX_DIM = 64
TOPK_MAX = 256
Q_BLOCK = 128
N_EXPERTS = 32
TOP_K = 4
D_FF = D_MODEL
SWIGLU_LIMIT = 7.0
SWIGLU_ALPHA = 1.702
RMS_EPS = 1e-6
IN_SIZES = (POOL_W, ATTN_W, KV_W, KV_W, IDX_HEADS * IDX_DIM, IDX_DIM, IDX_HEADS, 2 * D_MODEL)
IN_COLS = sum(IN_SIZES)
IN_SPLITS = tuple(int(c) for c in np.cumsum(IN_SIZES)[:-1])

kernel_name = "hybrid_pool_dsa_moe_ple_block"


def _rmsnorm(x, g):
    xf = x.astype(jnp.float32)
    y = xf * lax.rsqrt(jnp.mean(xf * xf, axis=-1, keepdims=True) + RMS_EPS)
    return (y * g.astype(jnp.float32)).astype(x.dtype)


def _pool_mixer(u, pool_w, pool_scale):
    b, s, _ = u.shape
    ug = u.reshape(b, s, POOL_GROUPS, POOL_GROUP_W).astype(jnp.float32)
    csum = jnp.cumsum(ug, axis=1)
    count = jnp.arange(1, s + 1, dtype=jnp.float32)
    mixed = []
    for g, w in enumerate(POOL_WINDOWS):
        c = csum[:, :, g]
        lagged = jnp.pad(c, ((0, 0), (w, 0), (0, 0)))[:, :s]
        mean = (c - lagged) / jnp.minimum(count, float(w))[None, :, None]
        mixed.append(mean - ug[:, :, g])
    mixed = jnp.stack(mixed, axis=2).astype(u.dtype)
    y = jnp.einsum('bsgc,gcd->bsgd', mixed, pool_w)
    return y.reshape(b, s, POOL_W) * pool_scale


def _dsa_attention(q, k, v, q_idx, k_idx, w_idx):
    b, s = q.shape[:2]
    n_sel = min(TOPK_MAX, s // 4)
    nb = s // Q_BLOCK
    group = N_HEADS // N_KV_HEADS
    key_pos = jnp.arange(s)
    k_idx32 = k_idx.astype(jnp.float32)

    def to_blocks(a):
        return jnp.moveaxis(a.reshape(b, nb, Q_BLOCK, *a.shape[2:]), 1, 0)

    def block_fn(args):
        qb, qib, wib, start = args
        qpos = start + jnp.arange(Q_BLOCK)
        logit = jnp.einsum('bthd,bsd->bths', qib.astype(jnp.float32), k_idx32) * (IDX_DIM ** -0.5)
        score = jnp.einsum('bths,bth->bts', jax.nn.relu(logit),
                           wib.astype(jnp.float32) * (IDX_HEADS ** -0.5))
        causal = key_pos[None, :] <= qpos[:, None]
        score = jnp.where(causal[None], score, -jnp.inf)
        _, idx = lax.top_k(score, n_sel)
        k_sel = jax.vmap(lambda kb, ib: kb[ib])(k, idx)
        v_sel = jax.vmap(lambda vb, ib: vb[ib])(v, idx)
        qg = qb.reshape(b, Q_BLOCK, N_KV_HEADS, group, HEAD_DIM)
        att = jnp.einsum('btkgd,btnkd->btkgn', qg, k_sel).astype(jnp.float32) * (HEAD_DIM ** -0.5)
        valid = (idx <= qpos[None, :, None])[:, :, None, None, :]
        att = jnp.where(valid, att, -jnp.inf)
        prob = jax.nn.softmax(att, axis=-1).astype(v.dtype)
        o = jnp.einsum('btkgn,btnkd->btkgd', prob, v_sel)
        return o.reshape(b, Q_BLOCK, ATTN_W)

    starts = jnp.arange(nb) * Q_BLOCK
    out = lax.map(block_fn, (to_blocks(q), to_blocks(q_idx), to_blocks(w_idx), starts))
    return jnp.moveaxis(out, 0, 1).reshape(b, s, ATTN_W)


def _moe(h, router_w, router_b, w1, b1, w2, b2):
    logits = (h @ router_w + router_b).astype(jnp.float32)
    top_val, top_idx = lax.top_k(logits, TOP_K)
    gate = jax.nn.softmax(top_val, axis=-1)
    comb = jnp.sum(jax.nn.one_hot(top_idx, N_EXPERTS, dtype=jnp.float32) * gate[..., None],
                   axis=-2).astype(h.dtype)
    out = jnp.zeros_like(h)
    for e in range(N_EXPERTS):
        gu = h @ w1[e] + b1[e]
        g_lin, up = jnp.split(gu, 2, axis=-1)
        g_lin = jnp.minimum(g_lin, SWIGLU_LIMIT)
        up = jnp.clip(up, -SWIGLU_LIMIT, SWIGLU_LIMIT)
        act = (up + 1.0) * (g_lin * jax.nn.sigmoid(SWIGLU_ALPHA * g_lin))
        out = out + comb[..., e:e + 1] * (act @ w2[e] + b2[e])
    return out


def setup_inputs(seed: int = 0) -> dict:
    key = jax.random.key(seed)
    ks = jax.random.split(key, 24)
    f32 = jnp.float32

    def nrm(k, shape, scale):
        return jax.random.normal(k, shape, f32) * scale

    def gain(k, shape):
        return 1.0 + 0.05 * jax.random.normal(k, shape, f32)

    L, D, E = DEPTH, D_MODEL, N_EXPERTS
    return {
        "x": nrm(ks[0], (BATCH, SEQ, D), 1.0),
        "p": nrm(ks[1], (DEPTH, BATCH, SEQ, PLE_DIM), 1.0),
        "norm1_g": gain(ks[2], (L, D)),
        "w_in": nrm(ks[3], (L, D, IN_COLS), D ** -0.5),
        "pool_w": nrm(ks[4], (L, POOL_GROUPS, POOL_GROUP_W, POOL_GROUP_W), POOL_GROUP_W ** -0.5),
        "pool_scale": gain(ks[5], (L, POOL_W)),
        "w_branch_pool": nrm(ks[6], (L, POOL_W, D), POOL_W ** -0.5),
        "w_branch_attn": nrm(ks[7], (L, ATTN_W, D), ATTN_W ** -0.5),
        "w_out": nrm(ks[8], (L, D, D), D ** -0.5),
        "norm2_g": gain(ks[9], (L, D)),
        "router_w": nrm(ks[10], (L, D, E), D ** -0.5),
        "router_b": nrm(ks[11], (L, E), 0.01),
        "exp_w1": nrm(ks[12], (L, E, D, 2 * D_FF), D ** -0.5),
        "exp_b1": nrm(ks[13], (L, E, 2 * D_FF), 0.02),
        "exp_w2": nrm(ks[14], (L, E, D_FF, D), D_FF ** -0.5),
        "exp_b2": nrm(ks[15], (L, E, D), 0.02),
        "ple_norm_g": gain(ks[16], (L, D)),
        "ple_gate_w": nrm(ks[17], (L, D, D), D ** -0.5),
        "ple_proj_w": nrm(ks[18], (L, PLE_DIM, D), PLE_DIM ** -0.5),
        "final_g": gain(ks[19], (D,)),
    }


def reference(x, p, norm1_g, w_in, pool_w, pool_scale, w_branch_pool, w_branch_attn, w_out,
              norm2_g, router_w, router_b, exp_w1, exp_b1, exp_w2, exp_b2,
              ple_norm_g, ple_gate_w, ple_proj_w, final_g):
    b, s, _ = x.shape
    for i in range(DEPTH):
        h = _rmsnorm(x, norm1_g[i])
        proj = h @ w_in[i]
        u, q, k, v, qi, ki, wi, gates = jnp.split(proj, IN_SPLITS, axis=-1)
        y_pool = _pool_mixer(u, pool_w[i], pool_scale[i]) @ w_branch_pool[i]
        y_attn = _dsa_attention(
            q.reshape(b, s, N_HEADS, HEAD_DIM),
            k.reshape(b, s, N_KV_HEADS, HEAD_DIM),
            v.reshape(b, s, N_KV_HEADS, HEAD_DIM),
            qi.reshape(b, s, IDX_HEADS, IDX_DIM), ki, wi) @ w_branch_attn[i]
        g_pool, g_attn = jnp.split(jax.nn.sigmoid(gates), 2, axis=-1)
        x = x + (g_pool * y_pool + g_attn * y_attn) @ w_out[i]
        h2 = _rmsnorm(x, norm2_g[i])
        x = x + _moe(h2, router_w[i], router_b[i], exp_w1[i], exp_b1[i], exp_w2[i], exp_b2[i])
        hp = _rmsnorm(x, ple_norm_g[i])
        x = x + jax.nn.sigmoid(hp @ ple_gate_w[i]) * (p[i].astype(x.dtype) @ ple_proj_w[i])
    return _rmsnorm(x, final_g)
```

```cpp
#include <hip/hip_runtime.h>
#include <cstdio>
#include <cstdint>

#ifndef DBG
#define DBG 0
#endif

#define LAS __attribute__((address_space(3)))
#define GAS __attribute__((address_space(1)))
typedef unsigned short bf16_t;
typedef short bf16x8 __attribute__((ext_vector_type(8)));
typedef float f32x4 __attribute__((ext_vector_type(4)));
typedef float f32x16 __attribute__((ext_vector_type(16)));
typedef unsigned u32x4 __attribute__((ext_vector_type(4)));
typedef unsigned u32x2 __attribute__((ext_vector_type(2)));

constexpr int M = 32768, SEQ = 16384, D = 1024, NP = 4096, NE = 32, DFF = 1024, PLE = 256;
constexpr int IN_COLS = 3912;
constexpr int C_U = 0, C_Q = 512, C_K = 1024, C_V = 1152, C_QI = 1280, C_KI = 1792, C_WI = 1856, C_GP = 2048, C_GA = 3072;
constexpr int MOE_ROWS = M * 4 + NE * 256;
constexpr float RMS_EPS = 1e-6f;
constexpr int NWAVES = 8, NTHREADS = 512;

constexpr size_t MiB = 1u << 20;
constexpr size_t WS_CTL = 0, CTL_ZERO_BYTES = 1 * MiB;
constexpr size_t CTLB_BAR = 16384;
constexpr size_t CTLB_QUEUE = 65536;
constexpr size_t CTLB_META = 65536 + 256;
constexpr size_t CTLB_DBG = 131072;
constexpr size_t CTLB_SS2 = 262144;
constexpr size_t CTLB_SS4 = 393216;
constexpr size_t CTLB_CNTWG = 524288;
constexpr size_t CTLB_TILEE = 589824;
constexpr size_t WS_WIN = 1 * MiB, WS_WPC = 9 * MiB, WS_WBA = 10 * MiB, WS_WOUT = 11 * MiB, WS_WR = 13 * MiB, WS_WPG = 14 * MiB, WS_WPP = 16 * MiB;
constexpr size_t WS_RS1 = 17 * MiB, WS_RS3 = 17 * MiB + 131072;
constexpr size_t WS_TOPI = 18 * MiB, WS_TOPG = 18 * MiB + 524288, WS_LRANK = 19 * MiB, WS_POSOF = 19 * MiB + 524288;
constexpr size_t WS_ROWMAP = 20 * MiB, WS_ROWGATE = 21 * MiB, WS_ROWSCALE = 17 * MiB + 262144;
constexpr size_t WS_W1 = 22 * MiB, WS_W2 = 150 * MiB, WS_PB = 214 * MiB, WS_X1B = 230 * MiB;
constexpr size_t WS_R1 = 294 * MiB;
constexpr size_t WS_R2 = 566 * MiB;
constexpr size_t PJ_U = 0, PJ_Q = 32 * MiB, PJ_KV = 64 * MiB, PJ_QI = 80 * MiB, PJ_KW = 112 * MiB, PJ_G = 120 * MiB;
constexpr size_t WS_SEL = 838 * MiB;
constexpr size_t WS_PP = 870 * MiB;
constexpr size_t WS_END = 934 * MiB;

constexpr int LDS_MAIN = 0;
constexpr int LDS_KT = 131072;
constexpr int LDS_HIST = 147456;
constexpr int LDS_ATM = 155648;
constexpr int LDS_MISC = 156672;
constexpr int LDS_BYTES = 157696;

__device__ __forceinline__ unsigned f2bf(float f) { unsigned u = __builtin_bit_cast(unsigned, f); return (u + 0x7fffu + ((u >> 16) & 1u)) >> 16; }
__device__ __forceinline__ unsigned pk2(float lo, float hi) { return f2bf(lo) | (f2bf(hi) << 16); }
__device__ __forceinline__ float bf_lo(unsigned w) { return __builtin_bit_cast(float, w << 16); }
__device__ __forceinline__ float bf_hi(unsigned w) { return __builtin_bit_cast(float, w & 0xffff0000u); }
__device__ __forceinline__ float bf1(bf16_t b) { return __builtin_bit_cast(float, ((unsigned)b) << 16); }
typedef float f32x2_ __attribute__((ext_vector_type(2)));
__device__ __forceinline__ u32x2 fp8x4_to_bf16x4(unsigned w) {
    const f32x2_ a = __builtin_amdgcn_cvt_pk_f32_fp8((int)w, false), b = __builtin_amdgcn_cvt_pk_f32_fp8((int)w, true);
    const float ax = a.x, ay = a.y, bx = b.x, by = b.y;
    u32x2 r; r.x = __builtin_amdgcn_perm(__float_as_uint(ay), __float_as_uint(ax), 0x07060302u);
    r.y = __builtin_amdgcn_perm(__float_as_uint(by), __float_as_uint(bx), 0x07060302u); return r;
}
__device__ __forceinline__ bf16x8 fp8x8_to_bf16x8(unsigned w0, unsigned w1) { const u32x2 a = fp8x4_to_bf16x4(w0), b = fp8x4_to_bf16x4(w1); return __builtin_bit_cast(bf16x8, (u32x4){a.x, a.y, b.x, b.y}); }
__device__ __forceinline__ float clamp_e4m3(float v) { return __builtin_amdgcn_fmed3f(v, -448.0f, 448.0f); }
__device__ __forceinline__ unsigned pk4_fp8(float a, float b, float c, float d) { int w = __builtin_amdgcn_cvt_pk_fp8_f32(clamp_e4m3(a), clamp_e4m3(b), 0, false); w = __builtin_amdgcn_cvt_pk_fp8_f32(clamp_e4m3(c), clamp_e4m3(d), w, true); return (unsigned)w; }
__device__ __forceinline__ float sigmoidf_(float x) { return __builtin_amdgcn_rcpf(1.0f + __expf(-x)); }
#define LDS_WAIT() asm volatile("s_waitcnt lgkmcnt(0)" ::: "memory")
#define VM_WAIT() asm volatile("s_waitcnt vmcnt(0)" ::: "memory")
__device__ __forceinline__ float wave_sum(float v) {
#pragma unroll
    for (int o = 1; o < 64; o <<= 1) v += __shfl_xor(v, o);
    return v;
}

#define XB_TMO      128
#define XB_XCNT(j)  (256  + 64 * (j))
#define XB_XSUB(j)  (1280 + 64 * (j))
#define XB_XGEN(j)  (2304 + 64 * (j))
#define XB_TOP      3328
#define XB_TOPGEN   3392
#define XCD_BAR_WORDS 3456
#define XB_SPIN_CAP (1u << 22)
__device__ __forceinline__ unsigned xb_ld(unsigned* p)              { return __hip_atomic_load(p, __ATOMIC_RELAXED, __HIP_MEMORY_SCOPE_AGENT); }
__device__ __forceinline__ unsigned xb_add(unsigned* p, unsigned v) { return __hip_atomic_fetch_add(p, v, __ATOMIC_RELAXED, __HIP_MEMORY_SCOPE_AGENT); }
__device__ __forceinline__ unsigned xb_xcc_id() { return (unsigned)__builtin_amdgcn_s_getreg((3 << 11) | 20) & 0xFu; }
#define XB_SPIN(cond, bar) do { unsigned _sp = 0; while (cond) { __builtin_amdgcn_s_sleep(1); \
    if ((++_sp & 255u) == 0u) { if (xb_ld(&(bar)[XB_TMO])) break; if (_sp > XB_SPIN_CAP) { atomicAdd(&(bar)[XB_TMO], 1u); break; } } } } while (0)
struct XcdBarrier { unsigned* bar; unsigned x; volatile LAS unsigned* st; };
__device__ __forceinline__ XcdBarrier xcd_barrier_post(unsigned* bar, volatile LAS unsigned* st) {
    XcdBarrier b; b.bar = bar; b.x = xb_xcc_id(); b.st = st;
    if (threadIdx.x == 0) (void)xb_add(&bar[XB_XCNT(b.x)], 1u);
    return b;
}
__device__ __forceinline__ void xcd_barrier_complete(unsigned* bar, unsigned x, unsigned& nloc, unsigned& nx) {
    const unsigned G = gridDim.x * gridDim.y * gridDim.z;
    unsigned sum, cnt, mine, sp = 0u;
    for (;;) {
        sum = 0u; cnt = 0u; mine = 0u;
#pragma unroll
        for (unsigned j = 0; j < 16; ++j) { const unsigned c = xb_ld(&bar[XB_XCNT(j)]); sum += c; cnt += (c > 0u) ? 1u : 0u; mine = (j == x) ? c : mine; }
        if (sum == G) break;
        __builtin_amdgcn_s_sleep(1);
        if ((++sp & 255u) == 0u) { if (xb_ld(&bar[XB_TMO])) break; if (sp > XB_SPIN_CAP) { atomicAdd(&bar[XB_TMO], 1u); break; } }
    }
    nloc = mine > 0u ? mine : 1u; nx = cnt > 0u ? cnt : 1u;
}
__device__ __forceinline__ void xcd_barrier(const XcdBarrier& b) {
    asm volatile("s_waitcnt vmcnt(0)" ::: "memory");
    __syncthreads();
    if (threadIdx.x == 0) {
        unsigned* bar = b.bar;
        __builtin_amdgcn_s_waitcnt(0);
        unsigned nloc = b.st[0], nx = b.st[1];
        if (nloc == 0u) { xcd_barrier_complete(bar, b.x, nloc, nx); b.st[0] = nloc; b.st[1] = nx; }
        const unsigned old = xb_add(&bar[XB_XSUB(b.x)], 1u);
        const unsigned gen = old / nloc;
        if (old + 1u == (gen + 1u) * nloc) {
            __builtin_amdgcn_fence(__ATOMIC_RELEASE, "agent");
            asm volatile("s_waitcnt vmcnt(0)" ::: "memory");
            const unsigned og = xb_add(&bar[XB_TOP], 1u);
            const unsigned tg = og / nx;
            if (og + 1u == (tg + 1u) * nx) xb_add(&bar[XB_TOPGEN], 1u);
            else XB_SPIN(xb_ld(&bar[XB_TOPGEN]) == tg, bar);
            __builtin_amdgcn_fence(__ATOMIC_ACQUIRE, "agent");
            xb_add(&bar[XB_XGEN(b.x)], 1u);
            asm volatile("s_waitcnt vmcnt(0)" ::: "memory");
        } else {
            XB_SPIN(xb_ld(&bar[XB_XGEN(b.x)]) == gen, bar);
            __builtin_amdgcn_fence(__ATOMIC_ACQUIRE, "agent");
            asm volatile("s_waitcnt vmcnt(0)" ::: "memory");
        }
    }
    __syncthreads();
}

namespace pg8 {
constexpr int BM = 256, BK = 64, HALF = 128, HTB = HALF * BK * 2, STAGE_BYTES = 8 * HTB, NXCD = 8, WGM = 8;
__host__ __device__ __forceinline__ int lds_byte(int r, int c) { const int st = (r >> 4) * 2 + (c >> 5), rr = r & 15, cc = c & 31, ob = rr * 64 + cc * 2; return st * 1024 + (ob ^ (((ob >> 9) & 1) << 5)); }
__host__ __device__ __forceinline__ void stage_rc(int b, int& R, int& C) { const int st = b / 1024, sb = b % 1024, swz = sb ^ (((sb >> 9) & 1) << 5); R = (st >> 1) * 16 + swz / 64; C = (st & 1) * 32 + (swz % 64) / 2; }
__host__ __device__ __forceinline__ int perm32(int rho) { const int n = rho >> 4, i = rho & 15; return 8 * (i >> 2) + 4 * n + (i & 3); }

struct Unit { int pm, pn, e; };
struct Gemm { const bf16_t* A; const bf16_t* Bt; int M, N, K; size_t bstride; const int* rowmap; };

struct StaticOrder {
    int nM, nN, nwg, G, c;
    __device__ void init(int M_, int N_, int G_, int c_) { nM = M_ / BM; nN = N_ / BM; nwg = nM * nN; G = G_; c = c_; }
    __device__ bool next(int i, Unit& u) const {
        const long L = (long)i * G + c; if (L >= nwg) return false;
        int wgid = (int)L; { const int q = nwg / NXCD, r = nwg % NXCD, xcd = wgid % NXCD, off = wgid / NXCD; wgid = (xcd < r ? xcd * (q + 1) : r * (q + 1) + (xcd - r) * q) + off; }
        const int nig = WGM * nN, gid = wgid / nig, fm = gid * WGM, gsz = (nM - fm) < WGM ? (nM - fm) : WGM;
        u.pm = fm + ((wgid % nig) % gsz); u.pn = (wgid % nig) / gsz; u.e = 0; return true;
    }
};
struct MoeOrder {
    const LAS int* tile_e; int ntiles, nct, G, c;
    __device__ bool next(int i, Unit& u) const {
        const int v = (G % 8 == 0) ? (c % 8) * (G / 8) + c / 8 : c;
        const long L = (long)i * G + v; if (L >= (long)ntiles * nct) return false;
        u.pm = (int)(L / nct); u.pn = (int)(L % nct); u.e = tile_e[u.pm]; return true;
    }
};

struct PPOrder {
    int S, r;
    __device__ __forceinline__ bool next(int i, Unit& u) const { if (r < 0) return false; const int L = r + i * S; if (L >= 512) return false; u.pm = L >> 2; u.pn = L & 3; u.e = 0; return true; }
};
__device__ __forceinline__ unsigned cvt_pk_bf16(float lo, float hi) { unsigned r; asm volatile("v_cvt_pk_bf16_f32 %0, %1, %2" : "=v"(r) : "v"(lo), "v"(hi)); return r; }

struct NoHook { static constexpr bool ACTIVE = false; };
typedef long i64x2 __attribute__((ext_vector_type(2)));
template <class Epi, class Sched, bool GATHER, class Hook = NoHook, bool FP8 = false>
__device__ __forceinline__ void gemm_phase(LAS unsigned char* lds, const Gemm g, const Sched& S, const Epi& E, const Hook& Hk = Hook()) {
    const int tid = threadIdx.x, wid = __builtin_amdgcn_readfirstlane(tid >> 6), lane = tid & 63, wr = wid >> 2, wc = wid & 3, fr = lane & 15, fq = lane >> 4;
    const int K = g.K, nt = K / BK;
    unsigned voffA[2][2], nvoffA[2][2], voffB[2]; int RA[2], CA[2];
#pragma unroll
    for (int i = 0; i < 2; ++i) { int R, C; stage_rc(tid * 16 + i * 8192, R, C); const int Rb = Epi::PERM ? ((R & ~31) + perm32(R & 31)) : R;
        RA[i] = R; CA[i] = C; voffB[i] = (unsigned)(Rb * K + C) * 2u; }
    const size_t kstep = (size_t)(BK * 2);
    const size_t hstep = (size_t)HALF * K * 2;
    const size_t tstep = 2 * hstep;
    const unsigned ldsw = (unsigned)wid * 1024u;
    const int aoff = lds_byte(wr * 64 + fr, fq * 8), boff = lds_byte(wc * 32 + fr, fq * 8);
#define PG8_SA(b, h) (((b) * 2 + (h)) * HTB)
#define PG8_SB(b, h) ((4 + (b) * 2 + (h)) * HTB)
#define PG8_STAGE2(bufoff, gbase, v0, v1) do { \
        __builtin_amdgcn_global_load_lds((const unsigned*)((const char*)(gbase) + (v0)), (LAS unsigned*)(lds + (bufoff) + ldsw), 16, 0, 0); \
        __builtin_amdgcn_global_load_lds((const unsigned*)((const char*)(gbase) + (v1)), (LAS unsigned*)(lds + (bufoff) + ldsw + 8192), 16, 0, 0); } while (0)
#define PG8_STAGEB(bufoff, gbase) PG8_STAGE2(bufoff, gbase, voffB[0], voffB[1])
#define PG8_LDA(dst, b, h) do { _Pragma("unroll") for (int m = 0; m < 4; ++m) _Pragma("unroll") for (int k = 0; k < 2; ++k) dst[m][k] = *(const LAS bf16x8*)(lds + PG8_SA(b, h) + aoff + m * 2048 + k * 1024); } while (0)
#define PG8_LDB(dst, b, h) do { _Pragma("unroll") for (int n = 0; n < 2; ++n) _Pragma("unroll") for (int k = 0; k < 2; ++k) dst[n][k] = *(const LAS bf16x8*)(lds + PG8_SB(b, h) + boff + n * 2048 + k * 1024); } while (0)
#define PG8_MMA(ai, bj, At, Bt) do { __builtin_amdgcn_s_setprio(1); _Pragma("unroll") for (int m = 0; m < 4; ++m) _Pragma("unroll") for (int n = 0; n < 2; ++n) _Pragma("unroll") for (int k = 0; k < 2; ++k) \
        { if constexpr (FP8) { const i64x2 b_ = __builtin_bit_cast(i64x2, Bt[n][k]), a_ = __builtin_bit_cast(i64x2, At[m][k]); \
            acc[ai][bj][m][n] = __builtin_amdgcn_mfma_f32_16x16x32_fp8_fp8(b_.x, a_.x, acc[ai][bj][m][n], 0, 0, 0); acc[ai][bj][m][n] = __builtin_amdgcn_mfma_f32_16x16x32_fp8_fp8(b_.y, a_.y, acc[ai][bj][m][n], 0, 0, 0); } \
          else acc[ai][bj][m][n] = __builtin_amdgcn_mfma_f32_16x16x32_bf16(Bt[n][k], At[m][k], acc[ai][bj][m][n], 0, 0, 0); } __builtin_amdgcn_s_setprio(0); } while (0)
#define PG8_WAIT_V(n) asm volatile("s_waitcnt vmcnt(" #n ")" ::: "memory")
#define PG8_WAIT_L(n) asm volatile("s_waitcnt lgkmcnt(" #n ")" ::: "memory")
#define PG8_BAR __builtin_amdgcn_s_barrier()
#define PG8_SCHED __builtin_amdgcn_sched_barrier(0)
    Unit cur, nxt; int ui = 0;
    if (!S.next(0, cur)) return;
    f32x4 acc[2][2][4][2];
#pragma unroll
    for (int a = 0; a < 2; ++a)
#pragma unroll
        for (int b = 0; b < 2; ++b)
#pragma unroll
            for (int m = 0; m < 4; ++m)
#pragma unroll
                for (int n = 0; n < 2; ++n) acc[a][b][m][n] = (f32x4){0.f, 0.f, 0.f, 0.f};
    bf16x8 At[4][2], B0[2][2], B1[2][2];
#pragma unroll
    for (int h = 0; h < 2; ++h)
#pragma unroll
        for (int i = 0; i < 2; ++i) {
            if constexpr (GATHER) voffA[h][i] = ((unsigned)g.rowmap[cur.pm * BM + h * HALF + RA[i]] * (unsigned)K + (unsigned)CA[i]) * 2u;
            else voffA[h][i] = (unsigned)((h * HALF + RA[i]) * K + CA[i]) * 2u;
            if constexpr (GATHER) nvoffA[h][i] = voffA[h][i];
        }
    const char* cA = GATHER ? (const char*)g.A : (const char*)g.A + (size_t)cur.pm * tstep;
    const char* cB = (const char*)g.Bt + (size_t)cur.e * g.bstride + (size_t)cur.pn * tstep;
    PG8_STAGEB(PG8_SB(0, 0), cB); PG8_STAGE2(PG8_SA(0, 0), cA, voffA[0][0], voffA[0][1]); PG8_STAGEB(PG8_SB(0, 1), cB + hstep); PG8_STAGE2(PG8_SA(0, 1), cA, voffA[1][0], voffA[1][1]);
    if (wr == 1) PG8_BAR;
    PG8_WAIT_V(4); PG8_BAR;
    PG8_STAGEB(PG8_SB(1, 0), cB + kstep); PG8_STAGE2(PG8_SA(1, 0), cA + kstep, voffA[0][0], voffA[0][1]); PG8_STAGEB(PG8_SB(1, 1), cB + hstep + kstep);
    PG8_WAIT_V(6); PG8_BAR;
    for (;;) {
        const bool has_next = S.next(ui + 1, nxt);
        const char* nA = has_next ? (GATHER ? (const char*)g.A : (const char*)g.A + (size_t)nxt.pm * tstep) : cA;
        const char* nB = has_next ? (const char*)g.Bt + (size_t)nxt.e * g.bstride + (size_t)nxt.pn * tstep : cB;
        if constexpr (GATHER) {
            if (has_next) {
#pragma unroll
                for (int h = 0; h < 2; ++h)
#pragma unroll
                    for (int i = 0; i < 2; ++i) nvoffA[h][i] = ((unsigned)g.rowmap[nxt.pm * BM + h * HALF + RA[i]] * (unsigned)K + (unsigned)CA[i]) * 2u;
            }
        }
        for (int t = 0; t < nt; t += 2) {
            const bool last = (t == nt - 2);
            if constexpr (Hook::ACTIVE) { if (t == nt / 2) Hk.mid(acc, cur); }
            const char* a1 = cA + (size_t)(t + 1) * kstep;
            const char* a2 = last ? nA : cA + (size_t)(t + 2) * kstep; const char* b2 = last ? nB : cB + (size_t)(t + 2) * kstep;
            const char* a3 = a2 + kstep; const char* b3 = b2 + kstep;
            unsigned w00 = voffA[0][0], w01 = voffA[0][1], w10 = voffA[1][0], w11 = voffA[1][1];
            if constexpr (GATHER) { if (last) { w00 = nvoffA[0][0]; w01 = nvoffA[0][1]; w10 = nvoffA[1][0]; w11 = nvoffA[1][1]; } }
            PG8_LDB(B0, 0, 0); PG8_SCHED; PG8_LDA(At, 0, 0); PG8_STAGE2(PG8_SA(1, 1), a1, voffA[1][0], voffA[1][1]);
            PG8_WAIT_L(8); PG8_BAR; PG8_WAIT_L(0); PG8_MMA(0, 0, At, B0); PG8_BAR; PG8_SCHED;
            PG8_LDB(B1, 0, 1); PG8_STAGEB(PG8_SB(0, 0), b2);
            PG8_BAR; PG8_WAIT_L(0); PG8_MMA(0, 1, At, B1); PG8_BAR;
            PG8_LDA(At, 0, 1); PG8_STAGE2(PG8_SA(0, 0), a2, w00, w01);
            PG8_BAR; PG8_WAIT_L(0); PG8_MMA(1, 0, At, B0); PG8_BAR; PG8_SCHED;
            PG8_STAGEB(PG8_SB(0, 1), b2 + hstep);
            PG8_WAIT_V(6); PG8_BAR; PG8_MMA(1, 1, At, B1); PG8_BAR;
            PG8_LDB(B0, 1, 0); PG8_SCHED; PG8_LDA(At, 1, 0); PG8_STAGE2(PG8_SA(0, 1), a2, w10, w11);
            PG8_WAIT_L(8); PG8_BAR; PG8_WAIT_L(0); PG8_MMA(0, 0, At, B0); PG8_BAR; PG8_SCHED;
            PG8_LDB(B1, 1, 1); PG8_STAGEB(PG8_SB(1, 0), b3);
            PG8_BAR; PG8_WAIT_L(0); PG8_MMA(0, 1, At, B1); PG8_BAR;
            PG8_LDA(At, 1, 1); PG8_STAGE2(PG8_SA(1, 0), a3, w00, w01);
            PG8_BAR; PG8_WAIT_L(0); PG8_MMA(1, 0, At, B0); PG8_BAR; PG8_SCHED;
            PG8_STAGEB(PG8_SB(1, 1), b3 + hstep);
            PG8_WAIT_V(6); PG8_BAR; PG8_MMA(1, 1, At, B1); PG8_BAR;
        }
        E(acc, cur, wr, wc, fr, fq);
        if (!has_next) break;
#pragma unroll
        for (int a = 0; a < 2; ++a)
#pragma unroll
            for (int b = 0; b < 2; ++b)
#pragma unroll
                for (int m = 0; m < 4; ++m)
#pragma unroll
                    for (int n = 0; n < 2; ++n) acc[a][b][m][n] = (f32x4){0.f, 0.f, 0.f, 0.f};
        cur = nxt; cA = nA; cB = nB; ++ui;
        if constexpr (GATHER) {
#pragma unroll
            for (int h = 0; h < 2; ++h)
#pragma unroll
                for (int i = 0; i < 2; ++i) voffA[h][i] = nvoffA[h][i];
        }
    }
    PG8_WAIT_V(0);
    if (wr == 0) PG8_BAR;
    PG8_BAR;
#undef PG8_SA
#undef PG8_SB
#undef PG8_STAGE2
#undef PG8_STAGEB
#undef PG8_LDA
#undef PG8_LDB
#undef PG8_MMA
#undef PG8_WAIT_V
#undef PG8_WAIT_L
#undef PG8_BAR
#undef PG8_SCHED
}
}
using pg8::Unit;

typedef f32x4 AccT[2][2][4][2];
struct EpiProj {
    static constexpr bool PERM = true;
    unsigned char* pj; const float* rs;
    __device__ __forceinline__ void operator()(const AccT& acc, const Unit& u, int wr, int wc, int fr, int fq) const {
        const int pn = u.pn; const bool sig = pn >= 8;
        bf16_t* base; int ld, nbj = 2;
        if (pn < 2)       { base = (bf16_t*)(pj + PJ_U) + pn * 256; ld = 512; }
        else if (pn < 4)  { base = (bf16_t*)(pj + PJ_Q) + (pn - 2) * 256; ld = 512; }
        else if (pn == 4) {
            unsigned char* kv8 = pj + PJ_KV; const int row0 = u.pm * 256 + wr * 64 + fr, cb = wc * 32 + 8 * fq;
            float sv[8];
#pragma unroll
            for (int g = 0; g < 8; ++g) sv[g] = rs[row0 + (g >> 2) * 128 + (g & 3) * 16];
#pragma unroll
            for (int ai = 0; ai < 2; ++ai)
#pragma unroll
                for (int m = 0; m < 4; ++m) { const int row = row0 + ai * 128 + m * 16; const float s = sv[ai * 4 + m];
#pragma unroll
                    for (int bj = 0; bj < 2; ++bj) { const f32x4 v0 = acc[ai][bj][m][0] * s, v1 = acc[ai][bj][m][1] * s;
                        u32x2 w; w.x = pk4_fp8(v0[0], v0[1], v0[2], v0[3]); w.y = pk4_fp8(v1[0], v1[1], v1[2], v1[3]);
                        *(u32x2*)(kv8 + (size_t)row * 256 + bj * 128 + cb) = w; } }
            return; }
        else if (pn < 7)  { base = (bf16_t*)(pj + PJ_QI) + (pn - 5) * 256; ld = 512; }
        else if (pn == 7) { base = (bf16_t*)(pj + PJ_KW); ld = 128; nbj = 1; }
        else              { base = (bf16_t*)(pj + PJ_G) + (pn - 8) * 256; ld = 2048; }
        const int row0 = u.pm * 256 + wr * 64 + fr, col0 = wc * 32 + 8 * fq;
        float sv[8];
#pragma unroll
        for (int g = 0; g < 8; ++g) sv[g] = rs[row0 + (g >> 2) * 128 + (g & 3) * 16];
#pragma unroll
        for (int ai = 0; ai < 2; ++ai)
#pragma unroll
            for (int m = 0; m < 4; ++m) { const int row = row0 + ai * 128 + m * 16; const float s = sv[ai * 4 + m]; bf16_t* rowp = base + (size_t)row * ld + col0;
#pragma unroll
                for (int bj = 0; bj < 2; ++bj) { if (bj < nbj) { f32x4 v0 = acc[ai][bj][m][0] * s, v1 = acc[ai][bj][m][1] * s;
                    if (sig) {
#pragma unroll
                        for (int j = 0; j < 4; ++j) { v0[j] = sigmoidf_(v0[j]); v1[j] = sigmoidf_(v1[j]); } }
                    u32x4 w; w.x = pk2(v0[0], v0[1]); w.y = pk2(v0[2], v0[3]); w.z = pk2(v1[0], v1[1]); w.w = pk2(v1[2], v1[3]);
                    *(u32x4*)(rowp + bj * 128) = w; } } }
    }
};
__device__ __forceinline__ float ga_clamp(float g) { return fmaxf(g, 8.67361738e-19f); }
struct HookGateRatio {
    static constexpr bool ACTIVE = true;
    const bf16_t* gates;
    __device__ __forceinline__ void mid(AccT& acc, const Unit& u) const {
        int tz = threadIdx.x; asm volatile("" : "+v"(tz));
        const int wid = tz >> 6, ln = tz & 63, wr = wid >> 2, wc = wid & 3, fr = ln & 15, fq = ln >> 4;
        const int row0 = u.pm * 256 + wr * 64 + fr, col0 = u.pn * 256 + wc * 32 + 8 * fq;
        u32x4 gpv[2][2], gav[2][2];
#pragma unroll
        for (int bj = 0; bj < 2; ++bj) { gpv[0][bj] = *(const u32x4*)(gates + (size_t)row0 * 2048 + col0 + bj * 128); gav[0][bj] = *(const u32x4*)(gates + (size_t)row0 * 2048 + 1024 + col0 + bj * 128); }
#pragma unroll
        for (int ai = 0; ai < 2; ++ai)
#pragma unroll
            for (int m = 0; m < 4; ++m) { const int g1 = ai * 4 + m + 1;
                if (g1 < 8) { const int rown = row0 + (g1 >> 2) * 128 + (g1 & 3) * 16;
#pragma unroll
                    for (int bj = 0; bj < 2; ++bj) { gpv[g1 & 1][bj] = *(const u32x4*)(gates + (size_t)rown * 2048 + col0 + bj * 128); gav[g1 & 1][bj] = *(const u32x4*)(gates + (size_t)rown * 2048 + 1024 + col0 + bj * 128); } }
#pragma unroll
                for (int bj = 0; bj < 2; ++bj) {
                    const u32x4 gp = gpv[m & 1][bj], ga = gav[m & 1][bj];
                    acc[ai][bj][m][0][0] *= bf_lo(gp.x) * __builtin_amdgcn_rcpf(ga_clamp(bf_lo(ga.x))); acc[ai][bj][m][0][1] *= bf_hi(gp.x) * __builtin_amdgcn_rcpf(ga_clamp(bf_hi(ga.x)));
                    acc[ai][bj][m][0][2] *= bf_lo(gp.y) * __builtin_amdgcn_rcpf(ga_clamp(bf_lo(ga.y))); acc[ai][bj][m][0][3] *= bf_hi(gp.y) * __builtin_amdgcn_rcpf(ga_clamp(bf_hi(ga.y)));
                    acc[ai][bj][m][1][0] *= bf_lo(gp.z) * __builtin_amdgcn_rcpf(ga_clamp(bf_lo(ga.z))); acc[ai][bj][m][1][1] *= bf_hi(gp.z) * __builtin_amdgcn_rcpf(ga_clamp(bf_hi(ga.z)));
                    acc[ai][bj][m][1][2] *= bf_lo(gp.w) * __builtin_amdgcn_rcpf(ga_clamp(bf_lo(ga.w))); acc[ai][bj][m][1][3] *= bf_hi(gp.w) * __builtin_amdgcn_rcpf(ga_clamp(bf_hi(ga.w)));
                    }
                asm volatile("" ::: "memory"); }
    }
};
template <bool ADD, bool CLAMP = false> struct EpiGate {
    static constexpr bool PERM = true;
    bf16_t* O; const bf16_t* gate; const bf16_t* addsrc;
    __device__ __forceinline__ void operator()(const AccT& acc, const Unit& u, int wr, int wc, int fr, int fq) const {
        const int row0 = u.pm * 256 + wr * 64 + fr, col0 = u.pn * 256 + wc * 32 + 8 * fq;
        u32x4 gb[4][2];
#pragma unroll
        for (int g = 0; g < 4; ++g)
#pragma unroll
            for (int bj = 0; bj < 2; ++bj) gb[g][bj] = *(const u32x4*)(gate + (size_t)(row0 + g * 16) * 2048 + col0 + bj * 128);
#pragma unroll
        for (int ai = 0; ai < 2; ++ai)
#pragma unroll
            for (int m = 0; m < 4; ++m) { const int row = row0 + ai * 128 + m * 16;
#pragma unroll
                for (int bj = 0; bj < 2; ++bj) { const int col = col0 + bj * 128;
                    const u32x4 gw = gb[m][bj];
                    if (ai == 0) gb[m][bj] = *(const u32x4*)(gate + (size_t)(row + 128) * 2048 + col);
                    f32x4 v0 = acc[ai][bj][m][0], v1 = acc[ai][bj][m][1];
                    if (CLAMP) {
                        v0[0] *= ga_clamp(bf_lo(gw.x)); v0[1] *= ga_clamp(bf_hi(gw.x)); v0[2] *= ga_clamp(bf_lo(gw.y)); v0[3] *= ga_clamp(bf_hi(gw.y));
                        v1[0] *= ga_clamp(bf_lo(gw.z)); v1[1] *= ga_clamp(bf_hi(gw.z)); v1[2] *= ga_clamp(bf_lo(gw.w)); v1[3] *= ga_clamp(bf_hi(gw.w));
                    } else {
                    v0[0] *= bf_lo(gw.x); v0[1] *= bf_hi(gw.x); v0[2] *= bf_lo(gw.y); v0[3] *= bf_hi(gw.y);
                    v1[0] *= bf_lo(gw.z); v1[1] *= bf_hi(gw.z); v1[2] *= bf_lo(gw.w); v1[3] *= bf_hi(gw.w); }
                    if (ADD) { const u32x4 aw = *(const u32x4*)(addsrc + (size_t)row * D + col);
                        v0[0] += bf_lo(aw.x); v0[1] += bf_hi(aw.x); v0[2] += bf_lo(aw.y); v0[3] += bf_hi(aw.y);
                        v1[0] += bf_lo(aw.z); v1[1] += bf_hi(aw.z); v1[2] += bf_lo(aw.w); v1[3] += bf_hi(aw.w); }
                    u32x4 w; w.x = pk2(v0[0], v0[1]); w.y = pk2(v0[2], v0[3]); w.z = pk2(v1[0], v1[1]); w.w = pk2(v1[2], v1[3]);
                    *(u32x4*)(O + (size_t)row * D + col) = w; } }
    }
};
struct EpiX1 {
    static constexpr bool PERM = false;
    const float* x; bf16_t* xb; float* ss; unsigned char* x8;
    __device__ __forceinline__ void operator()(const AccT& acc, const Unit& u, int wr, int wc, int fr, int fq) const {
        const int row0 = u.pm * 256 + wr * 64 + fr, col0 = u.pn * 256 + wc * 32 + 4 * fq;
        f32x4 xv[2][4];
#pragma unroll
        for (int g = 0; g < 2; ++g)
#pragma unroll
            for (int q = 0; q < 4; ++q) xv[g][q] = *(const f32x4*)(x + (size_t)(row0 + g * 16) * D + col0 + (q >> 1) * 128 + (q & 1) * 16);
#pragma unroll
        for (int ai = 0; ai < 2; ++ai)
#pragma unroll
            for (int m = 0; m < 4; ++m) { const int row = row0 + ai * 128 + m * 16; float s = 0.f;
                const int g2 = ai * 4 + m + 2, rown = row0 + (g2 >> 2) * 128 + (g2 & 3) * 16;
#pragma unroll
                for (int bj = 0; bj < 2; ++bj)
#pragma unroll
                    for (int n = 0; n < 2; ++n) { const size_t o = (size_t)row * D + col0 + bj * 128 + n * 16;
                        const f32x4 xin = xv[m & 1][bj * 2 + n];
                        if (g2 < 8) xv[m & 1][bj * 2 + n] = *(const f32x4*)(x + (size_t)rown * D + col0 + bj * 128 + n * 16);
                        const f32x4 v = xin + acc[ai][bj][m][n];
                        u32x2 w; w.x = pk2(v[0], v[1]); w.y = pk2(v[2], v[3]); *(u32x2*)(xb + o) = w;
                        *(unsigned*)(x8 + o) = pk4_fp8(v[0], v[1], v[2], v[3]);
                        s += (v[0] * v[0] + v[1] * v[1]) + (v[2] * v[2] + v[3] * v[3]); }
                s += __shfl_xor(s, 16); s += __shfl_xor(s, 32);
                if (fq == 0) atomicAdd(ss + row, s); }
    }
};
struct EpiMoe1 {
    static constexpr bool PERM = true;
    unsigned char* act; const float* rowscale; const float* b1;
    __device__ __forceinline__ void operator()(const AccT& acc, const Unit& u, int wr, int wc, int fr, int fq) const {
        const int row0 = u.pm * 256 + wr * 64 + fr, colj = u.pn * 128 + wc * 32 + 8 * fq;
        const float* bg = b1 + (size_t)u.e * 2048 + colj; const float* bu = bg + 1024;
        const f32x4 bg0 = *(const f32x4*)bg, bg1 = *(const f32x4*)(bg + 4), bu0 = *(const f32x4*)bu, bu1 = *(const f32x4*)(bu + 4);
        float sv[8];
#pragma unroll
        for (int g = 0; g < 8; ++g) sv[g] = rowscale[row0 + (g >> 2) * 128 + (g & 3) * 16] * (1.0f / 64.0f);
#pragma unroll
        for (int ai = 0; ai < 2; ++ai)
#pragma unroll
            for (int m = 0; m < 4; ++m) { const int row = row0 + ai * 128 + m * 16;
                const float rs = sv[ai * 4 + m];
                float r[8];
#pragma unroll
                for (int n = 0; n < 2; ++n)
#pragma unroll
                    for (int j = 0; j < 4; ++j) { float gl = acc[ai][0][m][n][j] * rs + (n ? bg1[j] : bg0[j]); float up = acc[ai][1][m][n][j] * rs + (n ? bu1[j] : bu0[j]);
                        gl = fminf(gl, 7.0f); up = fminf(fmaxf(up, -7.0f), 7.0f);
                        r[n * 4 + j] = 8.0f * ((up + 1.0f) * (gl * sigmoidf_(1.702f * gl))); }
                u32x2 w; w.x = pk4_fp8(r[0], r[1], r[2], r[3]); w.y = pk4_fp8(r[4], r[5], r[6], r[7]);
                *(u32x2*)(act + (size_t)row * DFF + colj) = w; }
    }
};
struct EpiMoe2 {
    static constexpr bool PERM = true;
    unsigned char* Y; const float* rowgate; const float* b2;
    __device__ __forceinline__ void operator()(const AccT& acc, const Unit& u, int wr, int wc, int fr, int fq) const {
        const int row0 = u.pm * 256 + wr * 64 + fr, col0 = u.pn * 256 + wc * 32 + 8 * fq;
        f32x4 cb[2][2]; float sv[8];
#pragma unroll
        for (int bj = 0; bj < 2; ++bj) { const float* bb = b2 + (size_t)u.e * D + col0 + bj * 128; cb[bj][0] = *(const f32x4*)bb; cb[bj][1] = *(const f32x4*)(bb + 4); }
#pragma unroll
        for (int g = 0; g < 8; ++g) sv[g] = rowgate[row0 + (g >> 2) * 128 + (g & 3) * 16];
#pragma unroll
        for (int ai = 0; ai < 2; ++ai)
#pragma unroll
            for (int m = 0; m < 4; ++m) { const int row = row0 + ai * 128 + m * 16; const float gt = sv[ai * 4 + m];
#pragma unroll
                for (int bj = 0; bj < 2; ++bj) { const int col = col0 + bj * 128;
                    const f32x4 c0 = cb[bj][0], c1 = cb[bj][1];
                    const f32x4 v0 = (acc[ai][bj][m][0] * (1.0f / 512.0f) + c0) * gt, v1 = (acc[ai][bj][m][1] * (1.0f / 512.0f) + c1) * gt;
                    u32x2 w; w.x = pk4_fp8(v0[0], v0[1], v0[2], v0[3]); w.y = pk4_fp8(v1[0], v1[1], v1[2], v1[3]);
                    *(u32x2*)(Y + (size_t)row * D + col) = w; } }
    }
};
struct EpiPP {
    static constexpr bool PERM = true;
    bf16_t* PP;
    __device__ __forceinline__ void operator()(const AccT& acc, const Unit& u, int wr, int wc, int fr, int fq) const {
        const int row0 = u.pm * 256 + wr * 64 + fr, col0 = u.pn * 256 + wc * 32 + 8 * fq;
#pragma unroll
        for (int ai = 0; ai < 2; ++ai)
#pragma unroll
            for (int m = 0; m < 4; ++m) { const int row = row0 + ai * 128 + m * 16;
#pragma unroll
                for (int bj = 0; bj < 2; ++bj) { const f32x4 v0 = acc[ai][bj][m][0], v1 = acc[ai][bj][m][1];
                    u32x4 w; w.x = pk2(v0[0], v0[1]); w.y = pk2(v0[2], v0[3]); w.z = pk2(v1[0], v1[1]); w.w = pk2(v1[2], v1[3]);
                    *(u32x4*)(PP + (size_t)row * D + col0 + bj * 128) = w; } }
    }
};
struct EpiPleGX {
    static constexpr bool PERM = true;
    bf16_t* x3b; const bf16_t* x2b; const bf16_t* PP; const float* rs; float* ss;
    __device__ __forceinline__ void operator()(const AccT& acc, const Unit& u, int wr, int wc, int fr, int fq) const {
        const int row0 = u.pm * 256 + wr * 64 + fr, col0 = u.pn * 256 + wc * 32 + 8 * fq;
        float sv[8]; u32x4 pb[2][2], xq[2][2];
#pragma unroll
        for (int g = 0; g < 8; ++g) sv[g] = rs[row0 + (g >> 2) * 128 + (g & 3) * 16];
#pragma unroll
        for (int g = 0; g < 2; ++g)
#pragma unroll
            for (int bj = 0; bj < 2; ++bj) { const size_t o = (size_t)(row0 + g * 16) * D + col0 + bj * 128; pb[g][bj] = *(const u32x4*)(PP + o); xq[g][bj] = *(const u32x4*)(x2b + o); }
#pragma unroll
        for (int ai = 0; ai < 2; ++ai)
#pragma unroll
            for (int m = 0; m < 4; ++m) { const int row = row0 + ai * 128 + m * 16; const float rsv = sv[ai * 4 + m]; float s = 0.f;
                const int g2 = ai * 4 + m + 2, rown = row0 + (g2 >> 2) * 128 + (g2 & 3) * 16;
#pragma unroll
                for (int bj = 0; bj < 2; ++bj) { const size_t o = (size_t)row * D + col0 + bj * 128;
                    const u32x4 pw = pb[m & 1][bj], xw = xq[m & 1][bj];
                    if (g2 < 8) { const size_t on = (size_t)rown * D + col0 + bj * 128; pb[m & 1][bj] = *(const u32x4*)(PP + on); xq[m & 1][bj] = *(const u32x4*)(x2b + on); }
                    const f32x4 a0 = acc[ai][bj][m][0] * rsv, a1 = acc[ai][bj][m][1] * rsv;
                    f32x4 x0, x1;
                    x0[0] = bf_lo(xw.x) + sigmoidf_(a0[0]) * bf_lo(pw.x); x0[1] = bf_hi(xw.x) + sigmoidf_(a0[1]) * bf_hi(pw.x);
                    x0[2] = bf_lo(xw.y) + sigmoidf_(a0[2]) * bf_lo(pw.y); x0[3] = bf_hi(xw.y) + sigmoidf_(a0[3]) * bf_hi(pw.y);
                    x1[0] = bf_lo(xw.z) + sigmoidf_(a1[0]) * bf_lo(pw.z); x1[1] = bf_hi(xw.z) + sigmoidf_(a1[1]) * bf_hi(pw.z);
                    x1[2] = bf_lo(xw.w) + sigmoidf_(a1[2]) * bf_lo(pw.w); x1[3] = bf_hi(xw.w) + sigmoidf_(a1[3]) * bf_hi(pw.w);
                    { u32x4 w; w.x = pk2(x0[0], x0[1]); w.y = pk2(x0[2], x0[3]); w.z = pk2(x1[0], x1[1]); w.w = pk2(x1[2], x1[3]); *(u32x4*)(x3b + o) = w; }
                    s += (x0[0] * x0[0] + x0[1] * x0[1]) + (x0[2] * x0[2] + x0[3] * x0[3]) + (x1[0] * x1[0] + x1[1] * x1[1]) + (x1[2] * x1[2] + x1[3] * x1[3]); }
                s += __shfl_xor(s, 16); s += __shfl_xor(s, 32);
                if (fq == 0) atomicAdd(ss + row, s); }
    }
};

struct Args { const float* in[20]; float* out; unsigned char* ws; int ph_lo, ph_hi; };
enum { I_X = 0, I_P, I_N1G, I_WIN, I_POOLW, I_POOLS, I_WBP, I_WBA, I_WOUT, I_N2G, I_RW, I_RB, I_W1, I_B1, I_W2, I_B2, I_PNG, I_PGW, I_PPW, I_FG };
enum { PH_PRO = 0, PH_INPROJ, PH_MIXED, PH_POOL, PH_ATT, PH_Z, PH_X1, PH_ROUTER, PH_SCATTER, PH_MOE1, PH_MOE2, PH_COMBINE, PH_PLE, PH_FINAL, NPH };

__device__ __forceinline__ int tr_dst_row(int mode, int n) {
    if (mode == 1) { if (n >= 1152 && n < 1280) { const int d = (n - 1152) & 63; return 1152 + ((n - 1152) & 64) + 16 * (d & 3) + (d >> 2); }
                     return n < 1864 ? n : n + 184; }
    if (mode == 2) return n < 1024 ? (((n >> 7) << 8) + (n & 127)) : ((((n - 1024) >> 7) << 8) + 128 + ((n - 1024) & 127));
    return n;
}
__device__ __forceinline__ float tr_col_scale(int mode, int n) {
    if (mode == 1) { if ((n >= 512 && n < 1024) || (n >= 1280 && n < 1792)) return 0.125f; if (n >= 1856 && n < 1864) return 0.35355339059327373f; }
    return 1.0f;
}
__device__ __forceinline__ void transpose_item(const float* W, int ldw, int Nvalid, int K, bf16_t* WT, const float* kgain, int mode, LAS float* scr, int kb, int nb, int lane, int ldt = 0, float f8scale = 0.f) {
    if (ldt == 0) ldt = K;
    const int k0 = 64 * kb, n0 = 64 * nb, c4 = lane & 15, kr = lane >> 4, nl = n0 + 4 * c4; const bool nok = nl < Nvalid;
    const f32x4 cs = (f32x4){tr_col_scale(mode, nl), tr_col_scale(mode, nl + 1), tr_col_scale(mode, nl + 2), tr_col_scale(mode, nl + 3)};
    f32x4 v[16];
#pragma unroll
    for (int i = 0; i < 16; ++i) { const int kk = 4 * i + kr; v[i] = nok ? *(const f32x4*)(W + (size_t)(k0 + kk) * ldw + nl) : (f32x4){0.f, 0.f, 0.f, 0.f}; }
    float kgv[16];
#pragma unroll
    for (int i = 0; i < 16; ++i) kgv[i] = kgain ? kgain[k0 + 4 * i + kr] : 1.0f;
#pragma unroll
    for (int i = 0; i < 16; ++i) asm volatile("" : "+v"(kgv[i]));
#pragma unroll
    for (int i = 0; i < 16; ++i) { const int kk = 4 * i + kr; *(LAS f32x4*)(scr + kk * 68 + 4 * c4) = v[i] * cs * kgv[i]; }
    LDS_WAIT(); asm volatile("" ::: "memory");
    const int c = lane & 7;
#pragma unroll
    for (int j = 0; j < 8; ++j) { const int n = (lane >> 3) + 8 * j; const LAS float* s = scr + (8 * c) * 68 + n;
        if (f8scale != 0.f) {
            u32x2 o8; o8.x = pk4_fp8(s[0 * 68] * f8scale, s[1 * 68] * f8scale, s[2 * 68] * f8scale, s[3 * 68] * f8scale); o8.y = pk4_fp8(s[4 * 68] * f8scale, s[5 * 68] * f8scale, s[6 * 68] * f8scale, s[7 * 68] * f8scale);
            if (n0 + n < Nvalid) *(u32x2*)((unsigned char*)WT + (size_t)tr_dst_row(mode, n0 + n) * ldt + k0 + 8 * c) = o8;
        } else {
        u32x4 o; o.x = pk2(s[0 * 68], s[1 * 68]); o.y = pk2(s[2 * 68], s[3 * 68]); o.z = pk2(s[4 * 68], s[5 * 68]); o.w = pk2(s[6 * 68], s[7 * 68]);
        if (n0 + n < Nvalid) *(u32x4*)(WT + (size_t)tr_dst_row(mode, n0 + n) * ldt + k0 + 8 * c) = o; } }
    LDS_WAIT(); asm volatile("" ::: "memory");
}
constexpr int I_E1 = 32 * 16 * 32, I_E2 = 32 * 16 * 16, N_EXPERT_ITEMS = I_E1 + I_E2;
constexpr int I_BA = 8 * 16, I_OUT = 16 * 16, I_R = 16, I_PG = 16 * 16, I_PP = 4 * 16, N_SMALL_ITEMS = I_BA + I_OUT + I_R + I_PG + I_PP;
constexpr int DC_EXPERT = N_EXPERT_ITEMS / 8, DC_SMALL = N_SMALL_ITEMS / 8, DC_WPC = 2048 / 8, DC_PB = M * PLE / 8 / 4096, DC_TOTAL = DC_EXPERT + DC_SMALL + DC_WPC + DC_PB;
__device__ __forceinline__ void deferred_chunk(const Args& a, LAS unsigned char* lds, int c, int wave, int lane) {
    unsigned char* ws = a.ws; LAS float* scr = (LAS float*)(lds + wave * 17408);
    if (c < DC_EXPERT) { int r = c * 8 + wave;
        if (r < I_E1) { const int e = r / (16 * 32), q = r % (16 * 32);
            transpose_item(a.in[I_W1] + (size_t)e * D * 2048, 2048, 2048, D, (bf16_t*)(ws + WS_W1 + (size_t)e * 2048 * D), a.in[I_N2G], 2, scr, q / 32, q % 32, lane, D, 64.0f); return; }
        r -= I_E1; { const int e = r / (16 * 16), q = r % (16 * 16);
            transpose_item(a.in[I_W2] + (size_t)e * DFF * D, D, D, DFF, (bf16_t*)(ws + WS_W2 + (size_t)e * D * DFF), nullptr, 0, scr, q / 16, q % 16, lane, DFF, 64.0f); }
        return; }
    c -= DC_EXPERT;
    if (c < DC_SMALL) { int r = c * 8 + wave;
        if (r < I_BA) { transpose_item(a.in[I_WBA], D, D, 512, (bf16_t*)(ws + WS_WPC) + 512, nullptr, 0, scr, r / 16, r % 16, lane, 1024); return; } r -= I_BA;
        if (r < I_OUT) { transpose_item(a.in[I_WOUT], D, D, D, (bf16_t*)(ws + WS_WOUT), nullptr, 0, scr, r / 16, r % 16, lane); return; } r -= I_OUT;
        if (r < I_R) { transpose_item(a.in[I_RW], NE, NE, D, (bf16_t*)(ws + WS_WR), a.in[I_N2G], 0, scr, r, 0, lane); return; } r -= I_R;
        if (r < I_PG) { transpose_item(a.in[I_PGW], D, D, D, (bf16_t*)(ws + WS_WPG), a.in[I_PNG], 0, scr, r / 16, r % 16, lane); return; } r -= I_PG;
        transpose_item(a.in[I_PPW], D, D, PLE, (bf16_t*)(ws + WS_WPP), nullptr, 0, scr, r / 16, r % 16, lane); return; }
    c -= DC_SMALL;
    if (c < DC_WPC) {
        const float* pw = a.in[I_POOLW]; const float* ps = a.in[I_POOLS]; const float* wbp = a.in[I_WBP]; bf16_t* wpc = (bf16_t*)(ws + WS_WPC);
        const int it = c * 8 + wave, gc = it >> 2, n0 = (it & 3) * 256 + lane * 4, g = gc >> 7;
        f32x4 acc = (f32x4){0.f, 0.f, 0.f, 0.f};
        const float* pwr = pw + (size_t)gc * 128; const float* psr = ps + g * 128; const float* wr_ = wbp + (size_t)(g * 128) * D + n0;
#pragma unroll 8
        for (int d = 0; d < 128; ++d) { const float av = pwr[d] * psr[d]; const f32x4 wv = *(const f32x4*)(wr_ + (size_t)d * D); acc += wv * av; }
#pragma unroll
        for (int j = 0; j < 4; ++j) wpc[(size_t)(n0 + j) * 1024 + gc] = (bf16_t)f2bf(acc[j]);
        return; }
    c -= DC_WPC;
    {
        const f32x4* p = (const f32x4*)a.in[I_P]; u32x4* pb = (u32x4*)(ws + WS_PB);
        f32x4 pv[8][2];
#pragma unroll
        for (int k = 0; k < 8; ++k) { const int i = c * 4096 + k * 512 + (int)threadIdx.x; pv[k][0] = p[2 * i]; pv[k][1] = p[2 * i + 1]; }
#pragma unroll
        for (int k = 0; k < 8; ++k) { const int i = c * 4096 + k * 512 + (int)threadIdx.x; const f32x4 v0 = pv[k][0], v1 = pv[k][1];
            u32x4 w; w.x = pk2(v0[0], v0[1]); w.y = pk2(v0[2], v0[3]); w.z = pk2(v1[0], v1[1]); w.w = pk2(v1[2], v1[3]); pb[i] = w; } }
}
__device__ __forceinline__ void p0_prologue(const Args& a, LAS unsigned char* lds, int wave, int lane, int G) {
    unsigned char* ws = a.ws;
    LAS float* scr = (LAS float*)(lds + wave * 17408);
    const int gw = blockIdx.x * NWAVES + wave, NGW = G * NWAVES;
    for (int it = gw; it < 16 * 62; it += NGW) transpose_item(a.in[I_WIN], IN_COLS, IN_COLS, D, (bf16_t*)(ws + WS_WIN), a.in[I_N1G], 1, scr, it / 62, it % 62, lane);
    for (int c = DC_EXPERT + (int)blockIdx.x; c < DC_TOTAL; c += G) { deferred_chunk(a, lds, c, wave, lane); __syncthreads(); }
    { const int gt = blockIdx.x * NTHREADS + threadIdx.x, NT = G * NTHREADS; u32x4* z = (u32x4*)((bf16_t*)(ws + WS_WIN) + (size_t)1864 * D);
      for (int i = gt; i < 184 * D * 2 / 16; i += NT) z[i] = (u32x4){0u, 0u, 0u, 0u}; }
    { const float* x = a.in[I_X]; bf16_t* xb = (bf16_t*)(ws + WS_R2); float* rs1 = (float*)(ws + WS_RS1);
      for (int m0 = gw; m0 < M; m0 += 2 * NGW) { f32x4 v[2][4];
#pragma unroll
        for (int r = 0; r < 2; ++r) { const int m = m0 + r * NGW; if (m < M) { const f32x4* xr = (const f32x4*)(x + (size_t)m * D) + lane;
#pragma unroll
            for (int j = 0; j < 4; ++j) v[r][j] = xr[64 * j]; } }
#pragma unroll
        for (int r = 0; r < 2; ++r) { const int m = m0 + r * NGW; if (m < M) { float s = 0.f;
#pragma unroll
            for (int j = 0; j < 4; ++j) s += (v[r][j][0] * v[r][j][0] + v[r][j][1] * v[r][j][1]) + (v[r][j][2] * v[r][j][2] + v[r][j][3] * v[r][j][3]);
            s = wave_sum(s); if (lane == 0) rs1[m] = rsqrtf(s * (1.0f / D) + RMS_EPS);
            u32x2* o = (u32x2*)(xb + (size_t)m * D) + lane;
#pragma unroll
            for (int j = 0; j < 4; ++j) { u32x2 w; w.x = pk2(v[r][j][0], v[r][j][1]); w.y = pk2(v[r][j][2], v[r][j][3]); o[64 * j] = w; } } } } }
}

template <int W>
__device__ __forceinline__ void mixed_item(const bf16_t* ub, bf16_t* mixed, int tok, int c8) {
    const int t = tok & (SEQ - 1); const int nw = (t + 1) < W ? (t + 1) : W;
    u32x4 v[W];
#pragma unroll
    for (int i = 0; i < W; ++i) { const int ii = i < nw ? i : 0; v[i] = *(const u32x4*)(ub + (size_t)(tok - ii) * 512 + c8 * 8); }
    float s[8], cur[8];
#pragma unroll
    for (int j = 0; j < 8; ++j) { s[j] = 0.f; cur[j] = 0.f; }
#pragma unroll
    for (int i = 0; i < W; ++i) { const float mk = i < nw ? 1.0f : 0.0f;
        const float f[8] = {bf_lo(v[i].x), bf_hi(v[i].x), bf_lo(v[i].y), bf_hi(v[i].y), bf_lo(v[i].z), bf_hi(v[i].z), bf_lo(v[i].w), bf_hi(v[i].w)};
#pragma unroll
        for (int j = 0; j < 8; ++j) { s[j] = fmaf(f[j], mk, s[j]); if (i == 0) cur[j] = f[j]; } }
    const float inv = 1.0f / (float)nw;
    u32x4 o; o.x = pk2(s[0] * inv - cur[0], s[1] * inv - cur[1]); o.y = pk2(s[2] * inv - cur[2], s[3] * inv - cur[3]);
    o.z = pk2(s[4] * inv - cur[4], s[5] * inv - cur[5]); o.w = pk2(s[6] * inv - cur[6], s[7] * inv - cur[7]);
    *(u32x4*)(mixed + (size_t)tok * 1024 + c8 * 8) = o;
}
__device__ __forceinline__ void p2_mixed(const bf16_t* ub, bf16_t* mixed, int G) {
    const int ln = threadIdx.x & 63, gw = blockIdx.x * NWAVES + (int)(threadIdx.x >> 6), NGW = G * NWAVES;
    int k = 0;
    for (int P = gw; P < M; P += NGW, ++k) {
        const int g = __builtin_amdgcn_readfirstlane((P + k) & 3), tok = (P >> 2) * 4 + (ln >> 4), c8 = g * 16 + (ln & 15);
        if (g == 0) mixed_item<2>(ub, mixed, tok, c8); else if (g == 1) mixed_item<4>(ub, mixed, tok, c8); else if (g == 2) mixed_item<8>(ub, mixed, tok, c8); else mixed_item<16>(ub, mixed, tok, c8);
    }
}

__device__ __forceinline__ unsigned lds_atomic_inc(LAS unsigned* p) { return __hip_atomic_fetch_add(p, 1u, __ATOMIC_RELAXED, __HIP_MEMORY_SCOPE_WORKGROUP); }
__device__ __forceinline__ void prune_token(LAS unsigned* L, LAS unsigned* H, const LAS unsigned* cntin, LAS unsigned* cntp, LAS unsigned* thrp, int lane) {
    const int n = __builtin_amdgcn_readfirstlane((int)*cntin);
    unsigned prefix = 0u; unsigned want = 256u;
#pragma unroll
    for (int p = 0; p < 4; ++p) {
        const int shift = 24 - 8 * p;
        *(LAS u32x4*)(H + 4 * lane) = (u32x4){0u, 0u, 0u, 0u};
        for (int i = lane; i < n; i += 64) { const unsigned e = L[i];
            bool match = true; if (p > 0) match = ((e ^ prefix) >> ((shift + 8) & 31)) == 0u;
            if (match) (void)lds_atomic_inc(H + ((e >> shift) & 255u)); }
        const u32x4 c = *(LAS u32x4*)(H + 4 * lane);
        const unsigned T = c.x + c.y + c.z + c.w; unsigned suf = T;
#pragma unroll
        for (int off = 1; off < 64; off <<= 1) { const unsigned v = (unsigned)__shfl_down((int)suf, off); if (lane + off < 64) suf += v; }
        const unsigned sufex = suf - T;
        const bool found = (sufex < want) && (want <= suf);
        unsigned run = sufex; int d = 0; unsigned nw = 0u; bool got = false;
        if (!got && run + c.w >= want) { d = 4 * lane + 3; nw = want - run; got = true; } run += c.w;
        if (!got && run + c.z >= want) { d = 4 * lane + 2; nw = want - run; got = true; } run += c.z;
        if (!got && run + c.y >= want) { d = 4 * lane + 1; nw = want - run; got = true; } run += c.y;
        if (!got && run + c.x >= want) { d = 4 * lane + 0; nw = want - run; got = true; }
        const unsigned long long fm = __ballot(found);
        const int src = fm ? (__ffsll((long long)fm) - 1) : 0;
        d = __shfl(d, src); want = (unsigned)__shfl((int)nw, src);
        prefix |= (unsigned)d << shift;
    }
    int newn = 0;
    for (int base = 0; base < n; base += 64) { const int i = base + lane; const unsigned e = (i < n) ? L[i] : 0u; const bool keep = (i < n) && (e >= prefix);
        const unsigned long long mk = __ballot(keep);
        const int pos = newn + (int)__builtin_amdgcn_mbcnt_hi((unsigned)(mk >> 32), __builtin_amdgcn_mbcnt_lo((unsigned)mk, 0u));
        if (keep) L[pos] = e;
        newn += __popcll(mk); }
    if (lane == 0) { *cntp = (unsigned)newn; *thrp = prefix; }
}

template <int CTRL> __device__ __forceinline__ unsigned dpp0(unsigned v) { return (unsigned)__builtin_amdgcn_update_dpp(0, (int)v, CTRL, 0xf, 0xf, true); }
__device__ __forceinline__ unsigned wave_min_u32(unsigned v) {
    v = min(v, (unsigned)__builtin_amdgcn_update_dpp((int)v, (int)v, 0x128, 0xf, 0xf, false)); v = min(v, (unsigned)__builtin_amdgcn_update_dpp((int)v, (int)v, 0x124, 0xf, 0xf, false));
    v = min(v, (unsigned)__builtin_amdgcn_update_dpp((int)v, (int)v, 0x122, 0xf, 0xf, false)); v = min(v, (unsigned)__builtin_amdgcn_update_dpp((int)v, (int)v, 0x121, 0xf, 0xf, false));
    const unsigned a = __builtin_amdgcn_readlane((int)v, 0), b = __builtin_amdgcn_readlane((int)v, 16), c = __builtin_amdgcn_readlane((int)v, 32), d = __builtin_amdgcn_readlane((int)v, 48);
    return min(min(a, b), min(c, d));
}
__device__ __forceinline__ unsigned wave_max_u32(unsigned v) { return ~wave_min_u32(~v); }
__device__ __forceinline__ unsigned wave_prefix_incl(unsigned v, int lane) {
    v += dpp0<0x111>(v); v += dpp0<0x112>(v); v += dpp0<0x114>(v); v += dpp0<0x118>(v);
    const unsigned r0 = __builtin_amdgcn_readlane((int)v, 15), r1 = __builtin_amdgcn_readlane((int)v, 31), r2 = __builtin_amdgcn_readlane((int)v, 47);
    const int row = lane >> 4;
    return v + (row >= 1 ? r0 : 0u) + (row >= 2 ? r1 : 0u) + (row >= 3 ? r2 : 0u);
}
template <int FULLROWS>
__device__ __forceinline__ void prune_approx(LAS unsigned* L, LAS unsigned* H, const LAS unsigned* cntin, LAS unsigned* cntp, LAS unsigned* thrp, int lane) {
    const int n = __builtin_amdgcn_readfirstlane((int)*cntin);
    const unsigned tlo = (unsigned)__builtin_amdgcn_readfirstlane((int)*thrp);
    unsigned e[8]; unsigned mxv = 0u;
#pragma unroll
    for (int k = 0; k < 8; ++k) { unsigned v = L[lane + 64 * k]; if (k >= FULLROWS) v = (lane + 64 * k < n) ? v : 0u; e[k] = v; mxv = max(mxv, v); }
    mxv = wave_max_u32(mxv);
    unsigned mn = tlo;
    if (tlo == 0u) {
        unsigned m = 0xFFFFFFFFu;
#pragma unroll
        for (int k = 0; k < 8; ++k) m = (k >= FULLROWS && e[k] == 0u) ? m : min(m, e[k]);
        mn = wave_min_u32(m);
    }
    const unsigned range = mxv - mn;
    const int hb = 31 - __builtin_clz(range | 1u);
    const int shift = hb > 7 ? hb - 7 : 0;
    *(LAS u32x4*)(H + 4 * lane) = (u32x4){0u, 0u, 0u, 0u};
#pragma unroll
    for (int k = 0; k < 8; ++k) if (k < FULLROWS || e[k] != 0u) (void)lds_atomic_inc(H + ((e[k] - mn) >> shift));
    const u32x4 c = *(LAS u32x4*)(H + 4 * lane);
    const unsigned T = c.x + c.y + c.z + c.w;
    const unsigned pin = wave_prefix_incl(T, lane);
    const unsigned tot = (unsigned)__builtin_amdgcn_readlane((int)pin, 63);
    const unsigned sufex = tot - pin;
    const unsigned suf = sufex + T;
    const bool found = (sufex < 256u) && (256u <= suf);
    unsigned run = sufex; int d = 0; bool got = false;
    if (!got && run + c.w >= 256u) { d = 4 * lane + 3; got = true; } run += c.w;
    if (!got && run + c.z >= 256u) { d = 4 * lane + 2; got = true; } run += c.z;
    if (!got && run + c.y >= 256u) { d = 4 * lane + 1; got = true; } run += c.y;
    if (!got && run + c.x >= 256u) { d = 4 * lane + 0; got = true; }
    const unsigned long long fm = __ballot(found);
    const int src = fm ? (__ffsll((long long)fm) - 1) : 0;
    d = __builtin_amdgcn_readlane(d, src);
    unsigned thr = mn + ((unsigned)d << shift);
    thr = thr ? thr : 1u;
    int newn = 0;
#pragma unroll
    for (int k = 0; k < 8; ++k) { const bool keep = e[k] >= thr;
        const unsigned long long mk = __ballot(keep);
        const int pos = newn + (int)__builtin_amdgcn_mbcnt_hi((unsigned)(mk >> 32), __builtin_amdgcn_mbcnt_lo((unsigned)mk, 0u));
        if (keep) L[pos] = e[k];
        newn += __popcll(mk); }
    if (lane == 0) { *cntp = (unsigned)newn; *thrp = thr - 1u; }
}

__device__ __forceinline__ void prune_excess(LAS unsigned* L, LAS unsigned* cntp, int lane) {
    const int n = __builtin_amdgcn_readfirstlane((int)*cntp);
    unsigned e[5];
#pragma unroll
    for (int k = 0; k < 5; ++k) { const int i = lane + 64 * k; const unsigned v = L[i]; e[k] = (i < n) ? v : 0xFFFFFFFFu; }
    for (int r = n - 256; r > 0; --r) {
        unsigned m = min(min(e[0], e[1]), min(min(e[2], e[3]), e[4]));
        m = wave_min_u32(m);
#pragma unroll
        for (int k = 0; k < 5; ++k) e[k] = (e[k] == m) ? 0xFFFFFFFFu : e[k];
    }
    int newn = 0;
#pragma unroll
    for (int k = 0; k < 5; ++k) { const bool keep = e[k] != 0xFFFFFFFFu;
        const unsigned long long mk = __ballot(keep);
        const int pos = newn + (int)__builtin_amdgcn_mbcnt_hi((unsigned)(mk >> 32), __builtin_amdgcn_mbcnt_lo((unsigned)mk, 0u));
        if (keep) L[pos] = e[k];
        newn += __popcll(mk); }
    if (lane == 0) *cntp = (unsigned)newn;
}

template <bool DIAG>
__device__ __forceinline__ void score_tile(LAS unsigned char* lds, const LAS unsigned char* kbuf, const bf16x8 (&afr)[2][4], const float (&wq)[2][16], unsigned (&cn)[2][2], const unsigned (&th)[2][2],
                                           int kt, int t0, int wave, int hf, int l31, unsigned lmask, unsigned trash) {
    bf16x8 bfr[2][4];
#pragma unroll
    for (int kh = 0; kh < 2; ++kh) { const int keyrow = kh * 32 + l31;
#pragma unroll
        for (int ks = 0; ks < 4; ++ks) bfr[kh][ks] = *(const LAS bf16x8*)(kbuf + keyrow * 128 + (((ks * 2 + hf) ^ ((keyrow >> 1) & 7)) * 16)); }
    f32x16 accs[2][2];
#pragma unroll
    for (int kh = 0; kh < 2; ++kh)
#pragma unroll
        for (int rt = 0; rt < 2; ++rt) {
#pragma unroll
            for (int j = 0; j < 16; ++j) accs[kh][rt][j] = 0.f;
#pragma unroll
            for (int ks = 0; ks < 4; ++ks) accs[kh][rt] = __builtin_amdgcn_mfma_f32_32x32x16_bf16(afr[rt][ks], bfr[kh][ks], accs[kh][rt], 0, 0, 0);
        }
#pragma unroll
    for (int kh = 0; kh < 2; ++kh) {
        const int keypos = kt * 64 + kh * 32 + l31;
        const unsigned idxbits = (unsigned)(16383 - keypos);
#pragma unroll
        for (int rt = 0; rt < 2; ++rt) {
#pragma unroll
            for (int ts = 0; ts < 2; ++ts) {
                float s = 0.f;
#pragma unroll
                for (int hd = 0; hd < 8; ++hd) s = fmaf(__builtin_amdgcn_fmed3f(accs[kh][rt][8 * ts + hd], 0.f, 3.0e38f), wq[rt][8 * ts + hd], s);
                const unsigned ub = __builtin_bit_cast(unsigned, s);
                const unsigned srt = ub ^ ((unsigned)((int)ub >> 31) | 0x80000000u);
                const unsigned packed = (srt & 0xFFFFC000u) | idxbits;
                const int tl = 4 * rt + 2 * hf + ts;
                bool pass = packed > th[rt][ts];
                if (DIAG) pass = pass && (keypos <= t0 + wave * 8 + tl);
                const unsigned long long mk = __builtin_amdgcn_ballot_w64(pass);
                const unsigned mine = hf ? (unsigned)(mk >> 32) : (unsigned)mk;
                const unsigned pre = __popc(mine & lmask);
                const unsigned addr = pass ? (unsigned)((wave * 8 + tl) * 2048) + (cn[rt][ts] + pre) * 4u : trash;
                *(LAS unsigned*)(lds + addr) = packed;
                cn[rt][ts] += __popc(mine);
            }
        }
    }
}

__device__ __forceinline__ void p4_attention(const unsigned char* pj, bf16_t* attn_out, unsigned* queue, int* seldbg, LAS unsigned char* lds, int wave, int lane) {
    const bf16_t* qb_ = (const bf16_t*)(pj + PJ_Q); const unsigned char* kv8 = pj + PJ_KV; const bf16_t* qib = (const bf16_t*)(pj + PJ_QI); const bf16_t* kwb = (const bf16_t*)(pj + PJ_KW);
    LAS unsigned* cnt_l = (LAS unsigned*)(lds + LDS_ATM);
    LAS unsigned* thr_l = cnt_l + 64;
    LAS unsigned* unit_l = cnt_l + 128;
    LAS unsigned* pflag = cnt_l + 132;
    LAS unsigned* wl_ctl = cnt_l + 136;
    LAS unsigned* cnt2 = cnt_l + 144;
    LAS unsigned* H = (LAS unsigned*)(lds + LDS_HIST) + wave * 256;
    const int tid = threadIdx.x, hf = lane >> 5, l31 = lane & 31;
    for (;;) {
        if (tid == 0) { const unsigned pref = xb_xcc_id() & 1u;
            unsigned uu = atomicAdd(queue + 64 * pref, 1u), bb = pref;
            if (uu >= 256u) { uu = atomicAdd(queue + 64 * (pref ^ 1u), 1u); bb = pref ^ 1u; }
            *unit_l = (uu >= 256u) ? 0xFFFFu : (uu * 2u + bb); pflag[0] = 0u; pflag[1] = 0u; wl_ctl[0] = 0u; wl_ctl[1] = 0u; }
        __syncthreads();
        const int u = __builtin_amdgcn_readfirstlane((int)*unit_l);
        __syncthreads();
        if (u >= 512) break;
        const int qb = 255 - (u >> 1), b = u & 1, t0 = qb * 64, rowbase = b * SEQ;
        if (lane < 8) { cnt_l[wave * 8 + lane] = 0u; thr_l[wave * 8 + lane] = 0u; }
        bf16x8 afr[2][4]; float wq[2][16];
#pragma unroll
        for (int rt = 0; rt < 2; ++rt) {
            const int m = l31, hd = (m & 3) + 4 * ((m >> 3) & 1), tl = 4 * rt + 2 * ((m >> 2) & 1) + (m >> 4);
            const bf16_t* qp = qib + (size_t)(rowbase + t0 + wave * 8 + tl) * 512 + hd * 64 + hf * 8;
#pragma unroll
            for (int ks = 0; ks < 4; ++ks) afr[rt][ks] = *(const bf16x8*)(qp + ks * 16);
#pragma unroll
            for (int ts = 0; ts < 2; ++ts) { const int tl2 = 4 * rt + 2 * hf + ts;
                const u32x4 wv = *(const u32x4*)(kwb + (size_t)(rowbase + t0 + wave * 8 + tl2) * 128 + 64);
                wq[rt][8 * ts + 0] = bf_lo(wv.x); wq[rt][8 * ts + 1] = bf_hi(wv.x); wq[rt][8 * ts + 2] = bf_lo(wv.y); wq[rt][8 * ts + 3] = bf_hi(wv.y);
                wq[rt][8 * ts + 4] = bf_lo(wv.z); wq[rt][8 * ts + 5] = bf_hi(wv.z); wq[rt][8 * ts + 6] = bf_lo(wv.w); wq[rt][8 * ts + 7] = bf_hi(wv.w); }
        }
#pragma unroll
        for (int rt = 0; rt < 2; ++rt) {
#pragma unroll
            for (int ks = 0; ks < 4; ++ks) asm volatile("" : "+v"(afr[rt][ks]));
#pragma unroll
            for (int j = 0; j < 16; ++j) asm volatile("" : "+v"(wq[rt][j]));
        }
        const int ntile = qb + 1;
        const int skey = tid >> 3, sch = tid & 7;
        const int sdst = skey * 128 + ((sch ^ ((skey >> 1) & 7)) * 16);
        u32x4 stg = *(const u32x4*)(kwb + (size_t)(rowbase + skey) * 128 + sch * 8);
        unsigned cn[2][2], th[2][2];
        const unsigned lmask = (1u << l31) - 1u, trash = (unsigned)(LDS_HIST + wave * 1024 + lane * 4);
#pragma unroll
        for (int rt = 0; rt < 2; ++rt)
#pragma unroll
            for (int ts = 0; ts < 2; ++ts) { cn[rt][ts] = 0u; th[rt][ts] = 0u; }
        for (int kt = 0; kt < ntile; ++kt) {
            LAS unsigned char* kbuf = lds + LDS_KT + (kt & 1) * 8192;
            *(LAS u32x4*)(kbuf + sdst) = stg;
            __syncthreads();
            if (kt + 1 < ntile) stg = *(const u32x4*)(kwb + (size_t)(rowbase + (kt + 1) * 64 + skey) * 128 + sch * 8);
            if (kt > 0 && __builtin_amdgcn_readfirstlane((int)pflag[(kt - 1) & 1]) == kt) {
                const unsigned long long jm = __ballot(cnt_l[lane] > 400u);
                { unsigned long long m = jm;
                  for (int ti = 0; m != 0ull; ++ti) { const int id = __ffsll((long long)m) - 1; m &= m - 1ull;
                    if ((ti & 7) == wave) {
                        prune_approx<6>((LAS unsigned*)(lds + id * 2048), H, cnt_l + id, cnt2 + id, thr_l + id, lane);
                        if (__builtin_amdgcn_readfirstlane((int)cnt2[id]) > 320) prune_token((LAS unsigned*)(lds + id * 2048), H, cnt2 + id, cnt2 + id, thr_l + id, lane);
                    } } }
                __syncthreads();
#pragma unroll
                for (int rt = 0; rt < 2; ++rt)
#pragma unroll
                    for (int ts = 0; ts < 2; ++ts) { const int tl = 4 * rt + 2 * hf + ts;
                        if ((jm >> (wave * 8 + tl)) & 1ull) { cn[rt][ts] = cnt2[wave * 8 + tl]; th[rt][ts] = thr_l[wave * 8 + tl]; } }
            }
            if (kt + 1 < ntile) score_tile<false>(lds, kbuf, afr, wq, cn, th, kt, t0, wave, hf, l31, lmask, trash);
            else                score_tile<true>(lds, kbuf, afr, wq, cn, th, kt, t0, wave, hf, l31, lmask, trash);
            bool need = false;
#pragma unroll
            for (int rt = 0; rt < 2; ++rt)
#pragma unroll
                for (int ts = 0; ts < 2; ++ts) { const int tl = 4 * rt + 2 * hf + ts; if (l31 == 0) cnt_l[wave * 8 + tl] = cn[rt][ts]; need |= cn[rt][ts] > 448u; }
            if (__ballot(need) != 0ull) { if (lane == 0) pflag[kt & 1] = (unsigned)(kt + 1); }
        }
        for (int tl = 0; tl < 8; ++tl) {
            const unsigned c = cnt_l[wave * 8 + tl];
            if (__builtin_amdgcn_readfirstlane((int)c) > 256) {
                LAS unsigned* Lt = (LAS unsigned*)(lds + (wave * 8 + tl) * 2048);
                prune_approx<4>(Lt, H, cnt_l + wave * 8 + tl, cnt_l + wave * 8 + tl, thr_l + wave * 8 + tl, lane);
                const int n2 = __builtin_amdgcn_readfirstlane((int)cnt_l[wave * 8 + tl]);
                if (n2 > 304) prune_token(Lt, H, cnt_l + wave * 8 + tl, cnt_l + wave * 8 + tl, thr_l + wave * 8 + tl, lane);
                else if (n2 > 256) prune_excess(Lt, cnt_l + wave * 8 + tl, lane);
            }
        }
        const int c15 = lane & 15, g4 = lane >> 4;
        for (int tl = 0; tl < 8; ++tl) {
            const int n = __builtin_amdgcn_readfirstlane((int)cnt_l[wave * 8 + tl]);
            const LAS unsigned* L = (const LAS unsigned*)(lds + (wave * 8 + tl) * 2048);
            const int tokrow = rowbase + t0 + wave * 8 + tl;
            const LAS unsigned* Lc = L + c15; const int nc = n - c15, n4 = n - 4 * g4;
#if DBG
            if (seldbg) for (int i = lane; i < 256; i += 64) seldbg[(size_t)tokrow * 256 + i] = (i < n) ? (int)(16383u - (L[i] & 16383u)) : -1;
#endif
            long bq[4];
#pragma unroll
            for (int ks = 0; ks < 4; ++ks) { const bool ok = (c15 < 8) && ((c15 >> 2) == (g4 >> 1));
                const u32x4 v = *(const u32x4*)(qb_ + (size_t)tokrow * 512 + (c15 & 7) * 64 + (g4 & 1) * 32 + ks * 8);
                const unsigned w0 = pk4_fp8(bf_lo(v.x), bf_hi(v.x), bf_lo(v.y), bf_hi(v.y)), w1 = pk4_fp8(bf_lo(v.z), bf_hi(v.z), bf_lo(v.w), bf_hi(v.w));
                bq[ks] = ok ? (long)(((unsigned long long)w1 << 32) | w0) : 0l; }
            f32x4 S[16];
            u32x4 kq[2][4][2];
#define LOAD_KGROUP(buf, grp) do { _Pragma("unroll") for (int tt = 0; tt < 4; ++tt) { const int T_ = (grp) * 4 + tt; const unsigned e_ = Lc[T_ * 16]; \
                const int kp_ = (T_ * 16 < nc) ? (int)(16383u - (e_ & 16383u)) : 0; \
                const unsigned char* kr_ = kv8 + (size_t)(rowbase + kp_) * 256 + g4 * 32;     \
                kq[buf][tt][0] = *(const u32x4*)kr_; kq[buf][tt][1] = *(const u32x4*)(kr_ + 16); } } while (0)
            LOAD_KGROUP(0, 0); LOAD_KGROUP(1, 1);
#pragma unroll
            for (int grp = 0; grp < 4; ++grp) {
#pragma unroll
                for (int tt = 0; tt < 4; ++tt) { const int T = grp * 4 + tt; const u32x4 k0 = kq[grp & 1][tt][0], k1 = kq[grp & 1][tt][1];
                    f32x4 sacc = (f32x4){0.f, 0.f, 0.f, 0.f};
                    sacc = __builtin_amdgcn_mfma_f32_16x16x32_fp8_fp8((long)(((unsigned long long)k0.y << 32) | k0.x), bq[0], sacc, 0, 0, 0);
                    sacc = __builtin_amdgcn_mfma_f32_16x16x32_fp8_fp8((long)(((unsigned long long)k0.w << 32) | k0.z), bq[1], sacc, 0, 0, 0);
                    sacc = __builtin_amdgcn_mfma_f32_16x16x32_fp8_fp8((long)(((unsigned long long)k1.y << 32) | k1.x), bq[2], sacc, 0, 0, 0);
                    sacc = __builtin_amdgcn_mfma_f32_16x16x32_fp8_fp8((long)(((unsigned long long)k1.w << 32) | k1.z), bq[3], sacc, 0, 0, 0);
                    if (n < 256) {
#pragma unroll
                        for (int j = 0; j < 4; ++j) if (T * 16 + j >= n4) sacc[j] = -1e30f; }
                    S[T] = sacc; }
                if (grp < 2) { if (grp == 0) LOAD_KGROUP(0, 2); else LOAD_KGROUP(1, 3); }
                asm volatile("" ::: "memory");
            }
#undef LOAD_KGROUP
            const LAS unsigned* Lh = L + (lane >> 3); const int nh = n - (lane >> 3);
            const int vwr = (wave * 8 + (lane >> 5)) * 2048 + 1024 + ((lane >> 3) & 3) * 160 + (lane >> 5) * 16 + (lane & 7) * 16;
            u32x4 vvA[4], vvB[4];
#pragma unroll
            for (int q = 0; q < 4; ++q) { const unsigned e = Lh[8 * q];
                const int kp = (8 * q < nh) ? (int)(16383u - (e & 16383u)) : 0;
                vvA[q] = *(const u32x4*)(kv8 + (size_t)(rowbase + kp) * 256 + 128 + (lane & 7) * 16); }
#pragma unroll
            for (int q = 0; q < 4; ++q) { const unsigned e = Lh[32 + 8 * q];
                const int kp = (32 + 8 * q < nh) ? (int)(16383u - (e & 16383u)) : 0;
                vvB[q] = *(const u32x4*)(kv8 + (size_t)(rowbase + kp) * 256 + 128 + (lane & 7) * 16); }
            float mx = -1e30f;
#pragma unroll
            for (int T = 0; T < 16; ++T)
#pragma unroll
                for (int j = 0; j < 4; ++j) mx = fmaxf(mx, S[T][j]);
            mx = fmaxf(mx, __shfl_xor(mx, 16)); mx = fmaxf(mx, __shfl_xor(mx, 32));
            float sum = 0.f; unsigned P8[16];
            const float mxl = (mx - 5.545177444f) * 1.44269504089f;
#pragma unroll
            for (int T = 0; T < 16; ++T) { f32x4 pv;
#pragma unroll
                for (int j = 0; j < 4; ++j) { pv[j] = __builtin_amdgcn_exp2f(fmaf(S[T][j], 1.44269504089f, -mxl)); sum += pv[j]; }
                int w = __builtin_amdgcn_cvt_pk_fp8_f32(pv[0], pv[1], 0, false); w = __builtin_amdgcn_cvt_pk_fp8_f32(pv[2], pv[3], w, true); P8[T] = (unsigned)w; }
            sum += __shfl_xor(sum, 16); sum += __shfl_xor(sum, 32);
            const float inv = 1.0f / sum;
            float invh[4];
#pragma unroll
            for (int j = 0; j < 4; ++j) invh[j] = __shfl(inv, 4 * (g4 & 1) + j);
            f32x4 O[8];
#pragma unroll
            for (int dt = 0; dt < 8; ++dt) O[dt] = (f32x4){0.f, 0.f, 0.f, 0.f};
            typedef int i2v __attribute__((ext_vector_type(2)));
            const LAS unsigned char* vtr = lds + (wave * 8 + g4 + 4 * ((lane & 15) >> 3)) * 2048 + 1024 + (((lane & 15) >> 1) & 3) * 160 + ((lane & 15) >> 3) * 128 + (g4 & 1) * 16 + (lane & 1) * 8;
#pragma unroll
            for (int ch = 0; ch < 8; ++ch) {
                u32x4 (&vv)[4] = (ch & 1) ? vvB : vvA;
#pragma unroll
                for (int q = 0; q < 4; ++q) *(LAS u32x4*)(lds + vwr + q * 4096 + (q >> 1) * 128) = vv[q];
                if (ch < 6) {
#pragma unroll
                    for (int q = 0; q < 4; ++q) { const unsigned e = Lh[(ch + 2) * 32 + 8 * q];
                        const int kp = ((ch + 2) * 32 + 8 * q < nh) ? (int)(16383u - (e & 16383u)) : 0;
                        vv[q] = *(const u32x4*)(kv8 + (size_t)(rowbase + kp) * 256 + 128 + (lane & 7) * 16); }
                }
                const long pf = (long)(((unsigned long long)P8[2 * ch + 1] << 32) | P8[2 * ch]);
#pragma unroll
                for (int dt = 0; dt < 8; ++dt) {
                    const i2v vt = __builtin_amdgcn_ds_read_tr8_b64_v2i32((LAS i2v*)(vtr + dt * 16));
                    O[dt] = __builtin_amdgcn_mfma_f32_16x16x32_fp8_fp8(pf, __builtin_bit_cast(long, vt), O[dt], 0, 0, 0);
                }
                asm volatile("" ::: "memory");
            }
            if (g4 < 2) {
#pragma unroll
                for (int j = 0; j < 4; ++j) {
                    const f32x4 o4 = g4 ? (f32x4){O[4][j], O[5][j], O[6][j], O[7][j]} : (f32x4){O[0][j], O[1][j], O[2][j], O[3][j]};
                    u32x2 w; w.x = pk2(o4[0] * invh[j], o4[1] * invh[j]); w.y = pk2(o4[2] * invh[j], o4[3] * invh[j]);
                    *(u32x2*)(attn_out + (size_t)tokrow * 1024 + (4 * g4 + j) * 64 + 4 * c15) = w;
                }
            }
        }
    }
}

__device__ __forceinline__ void p7_router(const Args& a, LAS unsigned char* lds, int wave, int lane, int G) {
    unsigned char* ws = a.ws;
    const bf16_t* x1b = (const bf16_t*)(ws + WS_X1B); const bf16_t* wr = (const bf16_t*)(ws + WS_WR);
    const float* ss2 = (const float*)(ws + CTLB_SS2); const float* rb = a.in[I_RB];
    int* topi = (int*)(ws + WS_TOPI); float* topg = (float*)(ws + WS_TOPG); int* lrank = (int*)(ws + WS_LRANK); int* cntwg = (int*)(ws + CTLB_CNTWG);
    LAS unsigned* wcnt = (LAS unsigned*)(lds + LDS_MISC + 64);
    if (threadIdx.x < 32) wcnt[threadIdx.x] = 0u;
    __syncthreads();
    LAS float* lg = (LAS float*)(lds + wave * 4096);
    const int c15 = lane & 15, g4 = lane >> 4;
    for (int tile = blockIdx.x * NWAVES + wave; tile < M / 16; tile += G * NWAVES) {
        const int tok0 = tile * 16;
        f32x4 a0 = (f32x4){0.f, 0.f, 0.f, 0.f}, a1 = a0;
        const bf16_t* ap = x1b + (size_t)(tok0 + c15) * D + g4 * 8; const bf16_t* bp0 = wr + (size_t)c15 * D + g4 * 8; const bf16_t* bp1 = bp0 + 16 * D;
#pragma unroll 8
        for (int ks = 0; ks < 32; ++ks) { const bf16x8 av = *(const bf16x8*)(ap + ks * 32), b0 = *(const bf16x8*)(bp0 + ks * 32), b1 = *(const bf16x8*)(bp1 + ks * 32);
            a0 = __builtin_amdgcn_mfma_f32_16x16x32_bf16(av, b0, a0, 0, 0, 0); a1 = __builtin_amdgcn_mfma_f32_16x16x32_bf16(av, b1, a1, 0, 0, 0); }
#pragma unroll
        for (int j = 0; j < 4; ++j) { lg[(4 * g4 + j) * 33 + c15] = a0[j]; lg[(4 * g4 + j) * 33 + 16 + c15] = a1[j]; }
        LDS_WAIT(); asm volatile("" ::: "memory");
        if (lane < 16) {
            const int tok = tok0 + lane; const float rs = rsqrtf(ss2[tok] * (1.0f / D) + RMS_EPS);
            float v[32];
#pragma unroll
            for (int e = 0; e < 32; ++e) v[e] = lg[lane * 33 + e] * rs + rb[e];
            int bi[4]; float bv[4];
#pragma unroll
            for (int r = 0; r < 4; ++r) { float best = -3.0e38f; int bidx = 0;
#pragma unroll
                for (int e = 0; e < 32; ++e) { bool used = false;
#pragma unroll
                    for (int q = 0; q < 4; ++q) if (q < r && bi[q] == e) used = true;
                    if (!used && v[e] > best) { best = v[e]; bidx = e; } }
                bi[r] = bidx; bv[r] = best; }
            float ex[4], se = 0.f;
#pragma unroll
            for (int r = 0; r < 4; ++r) { ex[r] = __expf(bv[r] - bv[0]); se += ex[r]; }
            const float inv = 1.0f / se;
#pragma unroll
            for (int r = 0; r < 4; ++r) { topi[tok * 4 + r] = bi[r]; topg[tok * 4 + r] = ex[r] * inv; lrank[tok * 4 + r] = (int)lds_atomic_inc(wcnt + bi[r]); }
        }
        LDS_WAIT(); asm volatile("" ::: "memory");
    }
    __syncthreads();
    if (threadIdx.x < 32) cntwg[blockIdx.x * 32 + threadIdx.x] = (int)wcnt[threadIdx.x];
}

__device__ __forceinline__ void p8_scatter(const Args& a, LAS unsigned char* lds, int wave, int lane, int G) {
    unsigned char* ws = a.ws;
    const int* cntwg = (const int*)(ws + CTLB_CNTWG); const int* topi = (const int*)(ws + WS_TOPI); const float* topg = (const float*)(ws + WS_TOPG);
    const int* lrank = (const int*)(ws + WS_LRANK); int* posof = (int*)(ws + WS_POSOF); int* rowmap = (int*)(ws + WS_ROWMAP); float* rowgate = (float*)(ws + WS_ROWGATE);
    int* tile_e = (int*)(ws + CTLB_TILEE); int* meta = (int*)(ws + CTLB_META); float* rowscale = (float*)(ws + WS_ROWSCALE);
    LAS int* part = (LAS int*)(lds);
    LAS int* tot = (LAS int*)(lds + 8192);
    LAS int* pre = tot + 32;
    LAS int* base = tot + 64;
    const int tid = threadIdx.x, e = tid & 31, pt = tid >> 5, myw = blockIdx.x;
    int sall = 0, spre = 0;
#pragma unroll 8
    for (int w = pt; w < G; w += 16) { const int v = cntwg[w * 32 + e]; sall += v; spre += (w < myw) ? v : 0; }
    part[pt * 32 + e] = sall; part[512 + pt * 32 + e] = spre;
    __syncthreads();
    if (tid < 32) { int s0 = 0, s1 = 0;
#pragma unroll
        for (int q = 0; q < 16; ++q) { s0 += part[q * 32 + tid]; s1 += part[512 + q * 32 + tid]; }
        tot[tid] = s0; pre[tid] = s1; }
    __syncthreads();
    if (tid == 0) { int bsum = 0; for (int q = 0; q < 32; ++q) { base[q] = bsum; bsum += (tot[q] + 255) & ~255; } base[32] = bsum; }
    __syncthreads();
    for (int tile = blockIdx.x * NWAVES + wave; tile < M / 16; tile += G * NWAVES) {
        const int idx = tile * 64 + lane; const int ex = topi[idx];
        const int pos = base[ex] + pre[ex] + lrank[idx];
        rowmap[pos] = idx >> 2; rowgate[pos] = topg[idx]; posof[idx] = pos;
        rowscale[pos] = rsqrtf(((const float*)(ws + CTLB_SS2))[idx >> 2] * (1.0f / D) + RMS_EPS);
    }
    for (int ex = blockIdx.x; ex < 32; ex += G) { const int t_ = tot[ex], pe = (t_ + 255) & ~255;
        for (int r = t_ + tid; r < pe; r += NTHREADS) { rowmap[base[ex] + r] = 0; rowgate[base[ex] + r] = 0.f; rowscale[base[ex] + r] = 0.f; } }
    if (blockIdx.x == 0) {
        const int ntl = base[32] >> 8;
        for (int t = tid; t < 544; t += NTHREADS) { int ex = 0;
            for (int q = 0; q < 32; ++q) if (base[q] <= t * 256) ex = q;
            tile_e[t] = (t < ntl) ? ex : 0; }
        if (tid == 0) meta[0] = ntl;
    }
}

__device__ __forceinline__ void p11_combine(const Args& a, int wave, int lane, int G) {
    unsigned char* ws = a.ws;
    const int* posof = (const int*)(ws + WS_POSOF); const unsigned char* Y = ws + WS_R2; const bf16_t* x1b = (const bf16_t*)(ws + WS_X1B); bf16_t* x2b = (bf16_t*)(ws + WS_R1); float* rs3 = (float*)(ws + WS_RS3);
    const int gw = blockIdx.x * NWAVES + wave, NGW = G * NWAVES;
    typedef int i4v __attribute__((ext_vector_type(4)));
    i4v pnx = (gw < M) ? *(const i4v*)(posof + (size_t)gw * 4) : (i4v){0, 0, 0, 0};
    for (int m = gw; m < M; m += NGW) {
        const i4v pcur = pnx;
        if (m + NGW < M) pnx = *(const i4v*)(posof + (size_t)(m + NGW) * 4);
        const u32x2* xr = (const u32x2*)(x1b + (size_t)m * D) + lane; f32x4 v[4]; u32x2 xw[4]; unsigned yw[4][4];
#pragma unroll
        for (int j = 0; j < 4; ++j) xw[j] = xr[64 * j];
#pragma unroll
        for (int s = 0; s < 4; ++s) { const unsigned* yr = (const unsigned*)(Y + (size_t)pcur[s] * D) + lane;
#pragma unroll
            for (int j = 0; j < 4; ++j) yw[s][j] = yr[64 * j]; }
#pragma unroll
        for (int j = 0; j < 4; ++j) { const u32x2 w = xw[j]; v[j] = (f32x4){bf_lo(w.x), bf_hi(w.x), bf_lo(w.y), bf_hi(w.y)}; }
#pragma unroll
        for (int s = 0; s < 4; ++s) {
#pragma unroll
            for (int j = 0; j < 4; ++j) { const f32x2_ lo = __builtin_amdgcn_cvt_pk_f32_fp8((int)yw[s][j], false), hi = __builtin_amdgcn_cvt_pk_f32_fp8((int)yw[s][j], true);
                v[j][0] += lo.x; v[j][1] += lo.y; v[j][2] += hi.x; v[j][3] += hi.y; } }
        float s = 0.f;
#pragma unroll
        for (int j = 0; j < 4; ++j) s += (v[j][0] * v[j][0] + v[j][1] * v[j][1]) + (v[j][2] * v[j][2] + v[j][3] * v[j][3]);
        s = wave_sum(s); if (lane == 0) rs3[m] = rsqrtf(s * (1.0f / D) + RMS_EPS);
        u32x2* o = (u32x2*)(x2b + (size_t)m * D) + lane;
#pragma unroll
        for (int j = 0; j < 4; ++j) { u32x2 w; w.x = pk2(v[j][0], v[j][1]); w.y = pk2(v[j][2], v[j][3]); o[64 * j] = w; }
    }
}
__device__ __forceinline__ void p13_final(const Args& a, int wave, int lane, int G) {
    const float* ss4 = (const float*)(a.ws + CTLB_SS4); const float* fg = a.in[I_FG]; const bf16_t* x3b = (const bf16_t*)(a.ws + WS_R1 + 128 * MiB);
    const int gw = blockIdx.x * NWAVES + wave, NGW = G * NWAVES;
    f32x4 gq[4];
#pragma unroll
    for (int j = 0; j < 4; ++j) gq[j] = ((const f32x4*)fg)[lane + 64 * j];
    for (int m0 = gw; m0 < M; m0 += 4 * NGW) { u32x2 xw[4][4]; float sv[4];
#pragma unroll
        for (int r = 0; r < 4; ++r) { const int m = m0 + r * NGW; if (m < M) { sv[r] = ss4[m]; const u32x2* xr = (const u32x2*)(x3b + (size_t)m * D) + lane;
#pragma unroll
            for (int j = 0; j < 4; ++j) xw[r][j] = xr[64 * j]; } }
#pragma unroll
        for (int r = 0; r < 4; ++r) { const int m = m0 + r * NGW; if (m < M) { const float rs = rsqrtf(sv[r] * (1.0f / D) + RMS_EPS); f32x4* orow = (f32x4*)(a.out + (size_t)m * D) + lane;
#pragma unroll
            for (int j = 0; j < 4; ++j) { const u32x2 w = xw[r][j]; orow[64 * j] = (f32x4){bf_lo(w.x), bf_hi(w.x), bf_lo(w.y), bf_hi(w.y)} * rs * gq[j]; } } } }
}

__global__ void __launch_bounds__(NTHREADS, 2) fwd(Args args) {
    extern __shared__ __attribute__((aligned(16))) unsigned char lds_raw[];
    LAS unsigned char* lds = (LAS unsigned char*)lds_raw;
    const int G = gridDim.x;
#define tid ((int)threadIdx.x)
#define lane ((int)(threadIdx.x & 63))
#define wave (__builtin_amdgcn_readfirstlane((int)(threadIdx.x >> 6)))
    unsigned char* ws = args.ws;
    volatile LAS unsigned* MISC = (volatile LAS unsigned*)(lds + LDS_MISC);
    if (tid < 64) MISC[tid] = 0u;
    __syncthreads();
    XcdBarrier bar = xcd_barrier_post((unsigned*)(ws + CTLB_BAR), MISC);
    const int lo = args.ph_lo, hi = args.ph_hi;
#define IN(k) (lo <= (k) && (k) < hi)
#define SEAM(k) do { if (IN(k) && IN((k) + 1)) xcd_barrier(bar); } while (0)
    unsigned char* pj = ws + WS_R1;
    bf16_t* xb = (bf16_t*)(ws + WS_R2); bf16_t* cat = (bf16_t*)(ws + WS_R2 + 64 * MiB);
    bf16_t* mixed = cat; bf16_t* attn = cat + 512; bf16_t* zb = (bf16_t*)(ws + WS_R2 + 192 * MiB);

    if (IN(PH_PRO)) { p0_prologue(args, lds, wave, lane, G); }
    SEAM(PH_PRO);
    if (IN(PH_INPROJ)) {
        pg8::Gemm g{xb, (const bf16_t*)(ws + WS_WIN), M, NP, D, 0, nullptr}; pg8::StaticOrder S; S.init(M, NP, G, (int)blockIdx.x);
        EpiProj E{pj, (const float*)(ws + WS_RS1)};
        pg8::gemm_phase<EpiProj, pg8::StaticOrder, false>(lds, g, S, E);
    }
    SEAM(PH_INPROJ);
    if (IN(PH_MIXED)) { p2_mixed((const bf16_t*)(pj + PJ_U), mixed, G); }
    if (IN(PH_ATT)) {
        __syncthreads();
        p4_attention(pj, attn, (unsigned*)(ws + CTLB_QUEUE), DBG ? (int*)(ws + WS_SEL) : nullptr, lds, wave, lane);
        for (;;) {
            __syncthreads();
            if (tid == 0) MISC[4] = atomicAdd((unsigned*)(ws + CTLB_QUEUE) + 128, 1u);
            __syncthreads();
            const int c = __builtin_amdgcn_readfirstlane((int)MISC[4]);
            if (c >= I_E1 / 8) break;
            deferred_chunk(args, lds, c, wave, lane);
        }
    }
    SEAM(PH_ATT);
    if (IN(PH_Z)) {
        pg8::Gemm g{cat, (const bf16_t*)(ws + WS_WPC), M, D, 1024, 0, nullptr}; pg8::StaticOrder S; S.init(M, D, G, (int)blockIdx.x);
        EpiGate<false, true> E{zb, (const bf16_t*)(pj + PJ_G) + 1024, nullptr};
        HookGateRatio Hk{(const bf16_t*)(pj + PJ_G)};
        pg8::gemm_phase<EpiGate<false, true>, pg8::StaticOrder, false, HookGateRatio>(lds, g, S, E, Hk);
    }
    SEAM(PH_Z);
    if (IN(PH_X1)) {
        pg8::Gemm g{zb, (const bf16_t*)(ws + WS_WOUT), M, D, D, 0, nullptr}; pg8::StaticOrder S; S.init(M, D, G, (int)blockIdx.x);
        EpiX1 E{args.in[I_X], (bf16_t*)(ws + WS_X1B), (float*)(ws + CTLB_SS2), ws + WS_R1 + 144 * MiB};
        pg8::gemm_phase<EpiX1, pg8::StaticOrder, false>(lds, g, S, E);
    }
    SEAM(PH_X1);
    if (IN(PH_ROUTER)) { p7_router(args, lds, wave, lane, G); }
    SEAM(PH_ROUTER);
    if (IN(PH_SCATTER)) { __syncthreads(); p8_scatter(args, lds, wave, lane, G); }
    SEAM(PH_SCATTER);
    if (IN(PH_MOE1)) {
        __syncthreads();
        pg8::Gemm g{(const bf16_t*)(ws + WS_R1 + 144 * MiB), (const bf16_t*)(ws + WS_W1), M, 2048, D / 2, (size_t)2048 * D, (const int*)(ws + WS_ROWMAP)};
        LAS int* te_l = (LAS int*)(lds + LDS_KT); for (int i = tid; i < 544; i += NTHREADS) te_l[i] = ((const int*)(ws + CTLB_TILEE))[i];
        __syncthreads();
        pg8::MoeOrder S{te_l, *(const int*)(ws + CTLB_META), 8, G, (int)blockIdx.x};
        EpiMoe1 E{ws + WS_R1, (const float*)(ws + WS_ROWSCALE), args.in[I_B1]};
        pg8::gemm_phase<EpiMoe1, pg8::MoeOrder, true, pg8::NoHook, true>(lds, g, S, E);
        for (;;) {
            __syncthreads();
            if (tid == 0) MISC[4] = atomicAdd((unsigned*)(ws + CTLB_QUEUE) + 192, 1u);
            __syncthreads();
            const int c = I_E1 / 8 + __builtin_amdgcn_readfirstlane((int)MISC[4]);
            if (c >= DC_EXPERT) break;
            deferred_chunk(args, lds, c, wave, lane);
        }
    }
    SEAM(PH_MOE1);
    if (IN(PH_MOE2)) {
        pg8::Gemm g{(const bf16_t*)(ws + WS_R1), (const bf16_t*)(ws + WS_W2), MOE_ROWS, D, DFF / 2, (size_t)D * DFF, nullptr};
        LAS int* te_l = (LAS int*)(lds + LDS_KT); for (int i = tid; i < 544; i += NTHREADS) te_l[i] = ((const int*)(ws + CTLB_TILEE))[i];
        __syncthreads();
        pg8::MoeOrder S{te_l, *(const int*)(ws + CTLB_META), 4, G, (int)blockIdx.x};
        EpiMoe2 E{ws + WS_R2, (const float*)(ws + WS_ROWGATE), args.in[I_B2]};
        pg8::gemm_phase<EpiMoe2, pg8::MoeOrder, false, pg8::NoHook, true>(lds, g, S, E);
        { const int nunits = S.ntiles * 4, rem = nunits % G, vwg = (G % 8 == 0) ? ((int)blockIdx.x % 8) * (G / 8) + (int)blockIdx.x / 8 : (int)blockIdx.x;
          pg8::PPOrder SP{rem ? G - rem : G, rem ? vwg - rem : vwg};
          pg8::Gemm gp{(const bf16_t*)(ws + WS_PB), (const bf16_t*)(ws + WS_WPP), M, D, PLE, 0, nullptr};
          EpiPP EP{(bf16_t*)(ws + WS_PP)};
          pg8::gemm_phase<EpiPP, pg8::PPOrder, false>(lds, gp, SP, EP); }
    }
    SEAM(PH_MOE2);
    if (IN(PH_COMBINE)) { p11_combine(args, wave, lane, G); }
    SEAM(PH_COMBINE);
    if (IN(PH_PLE)) {
        pg8::Gemm g{(const bf16_t*)(ws + WS_R1), (const bf16_t*)(ws + WS_WPG), M, D, D, 0, nullptr}; pg8::StaticOrder S; S.init(M, D, G, (int)blockIdx.x);
        EpiPleGX E{(bf16_t*)(ws + WS_R1 + 128 * MiB), (const bf16_t*)(ws + WS_R1), (const bf16_t*)(ws + WS_PP), (const float*)(ws + WS_RS3), (float*)(ws + CTLB_SS4)};
        pg8::gemm_phase<EpiPleGX, pg8::StaticOrder, false>(lds, g, S, E);
    }
    SEAM(PH_PLE);
    if (IN(PH_FINAL)) { p13_final(args, wave, lane, G); }
#undef IN
#undef SEAM
#undef tid
#undef lane
#undef wave
}

#if DBG
__device__ __forceinline__ unsigned hash_u(unsigned x) { x ^= x >> 16; x *= 0x7feb352dU; x ^= x >> 15; x *= 0x846ca68bU; x ^= x >> 16; return x; }
__device__ __forceinline__ bool closef(float got, float ref, float rtol, float atol) { return fabsf(got - ref) <= atol + rtol * fabsf(ref); }
__device__ float dotbf(const bf16_t* a, const bf16_t* b, int K) { float s = 0.f; for (int k = 0; k < K; ++k) s += bf1(a[k]) * bf1(b[k]); return s; }
__device__ __forceinline__ void dbg_fail(unsigned* dbg, int code) { atomicAdd(dbg + code, 1u); }
__device__ float f2bf_f(float v) { return __builtin_bit_cast(float, f2bf(v) << 16); }

__device__ float pjv(const unsigned char* pj, int m, int c) {
    const bf16_t* b; int ld, cc;
    if (c < 512) { b = (const bf16_t*)(pj + PJ_U); ld = 512; cc = c; }
    else if (c < 1024) { b = (const bf16_t*)(pj + PJ_Q); ld = 512; cc = c - 512; }
    else if (c < 1280) { const unsigned v = (pj + PJ_KV)[(size_t)m * 256 + (c - 1024)]; const int e = (v >> 3) & 15, mt = v & 7;
        const float mag = e ? ldexpf(1.0f + mt * 0.125f, e - 7) : ldexpf(mt * 0.125f, -6); return (v & 128) ? -mag : mag; }
    else if (c < 1792) { b = (const bf16_t*)(pj + PJ_QI); ld = 512; cc = c - 1280; }
    else if (c < 2048) { b = (const bf16_t*)(pj + PJ_KW); ld = 128; cc = c - 1792; if (cc >= 128) return 0.f; }
    else { b = (const bf16_t*)(pj + PJ_G); ld = 2048; cc = c - 2048; }
    return bf1(b[(size_t)m * ld + cc]);
}
__global__ void __launch_bounds__(256) chk(Args a, int phase) {
    unsigned char* ws = a.ws; unsigned* dbg = (unsigned*)(ws + CTLB_DBG);
    const unsigned s = blockIdx.x * 256 + threadIdx.x;
    const unsigned h = hash_u(s * 2654435761u + 12345u), h2 = hash_u(h + 777u);
    const unsigned char* pj = ws + WS_R1;
    const bf16_t* mixed = (const bf16_t*)(ws + WS_R2 + 64 * MiB); const bf16_t* attn = mixed + 512;
    const bf16_t* zb = (const bf16_t*)(ws + WS_R2 + 192 * MiB);
    if (phase == PH_PRO) {
        if (s == 0) {
            volatile unsigned* pv = dbg + 40; pv[0] = 0xC0484038u; pv[1] = 0x3F800000u; pv[2] = 0x40000000u; pv[3] = 0x40800000u; pv[4] = 0xC0000000u;
            const unsigned wrt = pv[0];
            const u32x2 r = fp8x4_to_bf16x4(wrt);
            if (!(r.x == 0x40003F80u && r.y == 0xC0004080u)) {
                if (r.x == 0x3F804000u) dbg_fail(dbg, 21); else if (r.x == 0xC0004080u) dbg_fail(dbg, 22); else if (r.x == 0x40003F80u) dbg_fail(dbg, 25); else if (r.y == 0xC0004080u) dbg_fail(dbg, 26); else dbg_fail(dbg, 23); }
            const unsigned enc = pk4_fp8(__builtin_bit_cast(float, (unsigned)pv[1]), __builtin_bit_cast(float, (unsigned)pv[2]), __builtin_bit_cast(float, (unsigned)pv[3]), __builtin_bit_cast(float, (unsigned)pv[4]));
            if (enc != 0xC0484038u) dbg_fail(dbg, 24);
        }
        {
          const int n = h % IN_COLS, k = h2 % D; int row = n < 1864 ? n : n + 184;
          if (n >= 1152 && n < 1280) { const int d = (n - 1152) & 63; row = 1152 + ((n - 1152) & 64) + 16 * (d & 3) + (d >> 2); }
          float sc = 1.f; if ((n >= 512 && n < 1024) || (n >= 1280 && n < 1792)) sc = 0.125f; if (n >= 1856 && n < 1864) sc = 0.35355339059327373f;
          const float ref = f2bf_f(a.in[I_WIN][(size_t)k * IN_COLS + n] * (sc * a.in[I_N1G][k]));
          const float got = bf1(((const bf16_t*)(ws + WS_WIN))[(size_t)row * D + k]);
          if (!closef(got, ref, 0.01f, 1e-6f)) dbg_fail(dbg, 1); }
        {
          const int m = h % M, k = h2 % D;
          if (!closef(bf1(((const bf16_t*)(ws + WS_R2))[(size_t)m * D + k]), f2bf_f(a.in[I_X][(size_t)m * D + k]), 0.01f, 1e-6f)) dbg_fail(dbg, 2);
          if (s < 512) { float q = 0.f; for (int i = 0; i < D; ++i) { const float v = a.in[I_X][(size_t)m * D + i]; q += v * v; }
            if (!closef(((const float*)(ws + WS_RS1))[m], rsqrtf(q / D + RMS_EPS), 0.001f, 0.f)) dbg_fail(dbg, 2); }
        }
    }
    if (phase == PH_INPROJ) {
        const int m = h % M; int c = h2 % NP; if (s & 1) c = (c & 255) | (7 << 8);
        float r = dotbf((const bf16_t*)(ws + WS_R2) + (size_t)m * D, (const bf16_t*)(ws + WS_WIN) + (size_t)c * D, D) * ((const float*)(ws + WS_RS1))[m];
        if (c >= 2048) r = 1.0f / (1.0f + expf(-r));
        if (c >= 1792 + 128 && c < 2048) r = 0.f;
        if (!closef(pjv(pj, m, c), r, (c >= 1024 && c < 1280) ? 0.08f : 0.02f, (c >= 1024 && c < 1280) ? 0.02f : 0.01f)) dbg_fail(dbg, 3);
    }
    if (phase == PH_MIXED) {
        int m = h % M; if (s < 64) m = (s & 31) + (s >> 5) * SEQ; const int c = h2 % 512, g = c >> 7, w = 2 << g, t = m & (SEQ - 1); const int nw = (t + 1) < w ? (t + 1) : w;
        float r = 0.f; for (int i = 0; i < nw; ++i) r += pjv(pj, m - i, c);
        r = r / nw - pjv(pj, m, c);
        if (!closef(bf1(mixed[(size_t)m * 1024 + c]), r, 0.02f, 0.01f)) dbg_fail(dbg, 4);
    }
    if (phase == PH_Z) {
        {
          const int e = h % 32, n = (h >> 5) % D, k = h2 % D;
          const int k2 = h2 % PLE;
          if (!closef(bf1(((const bf16_t*)(ws + WS_WPP))[(size_t)n * PLE + k2]), f2bf_f(a.in[I_PPW][(size_t)k2 * D + n]), 0.01f, 1e-6f)) dbg_fail(dbg, 1);
          if (!closef(bf1(((const bf16_t*)(ws + WS_WR))[(size_t)e * D + k]), f2bf_f(a.in[I_RW][(size_t)k * NE + e] * a.in[I_N2G][k]), 0.01f, 1e-6f)) dbg_fail(dbg, 1);
          if (!closef(bf1(((const bf16_t*)(ws + WS_WPG))[(size_t)n * D + k]), f2bf_f(a.in[I_PGW][(size_t)k * D + n] * a.in[I_PNG][k]), 0.01f, 1e-6f)) dbg_fail(dbg, 1);
          const int k5 = h2 % 512;
          if (!closef(bf1(((const bf16_t*)(ws + WS_WPC))[(size_t)n * 1024 + 512 + k5]), f2bf_f(a.in[I_WBA][(size_t)k5 * D + n]), 0.01f, 1e-6f)) dbg_fail(dbg, 1);
          { const int g = k5 >> 7; float r = 0.f; for (int d = 0; d < 128; ++d) r += a.in[I_POOLW][(size_t)k5 * 128 + d] * a.in[I_POOLS][g * 128 + d] * a.in[I_WBP][(size_t)(g * 128 + d) * D + n];
            if (!closef(bf1(((const bf16_t*)(ws + WS_WPC))[(size_t)n * 1024 + k5]), r, 0.01f, 1e-4f)) dbg_fail(dbg, 1); } }
        { const int m = h % M, k2 = h2 % PLE;
          if (!closef(bf1(((const bf16_t*)(ws + WS_PB))[(size_t)m * PLE + k2]), f2bf_f(a.in[I_P][(size_t)m * PLE + k2]), 0.01f, 1e-6f)) dbg_fail(dbg, 2); }
        {
          const int e = h % 32, n = (h >> 5) % 2048, k = h2 % D; const int row = n < 1024 ? (((n >> 7) << 8) + (n & 127)) : ((((n - 1024) >> 7) << 8) + 128 + ((n - 1024) & 127));
          const float ref = f2bf_f(a.in[I_W1][((size_t)e * D + k) * 2048 + n] * a.in[I_N2G][k]);
          const float got = bf1(((const bf16_t*)(ws + WS_W1))[((size_t)e * 2048 + row) * D + k]);
          if (!closef(got, ref, 0.01f, 1e-6f)) dbg_fail(dbg, 1); }
        { const int e = h % 32, n = (h >> 5) % D, k = h2 % D;
          if (!closef(bf1(((const bf16_t*)(ws + WS_W2))[((size_t)e * D + n) * DFF + k]), f2bf_f(a.in[I_W2][((size_t)e * DFF + k) * D + n]), 0.01f, 1e-6f)) dbg_fail(dbg, 1); }
        const int m = h % M, c = h2 % D; const bf16_t* wc_ = (const bf16_t*)(ws + WS_WPC) + (size_t)c * 1024;
        const float r = dotbf(mixed + (size_t)m * 1024, wc_, 512) * pjv(pj, m, C_GP + c) + dotbf(attn + (size_t)m * 1024, wc_ + 512, 512) * pjv(pj, m, C_GA + c);
        if (!closef(bf1(zb[(size_t)m * D + c]), r, 0.02f, 0.02f)) dbg_fail(dbg, 8);
    }
    if (phase == PH_X1) {
        const int m = h % M, c = h2 % D;
        const float r = a.in[I_X][(size_t)m * D + c] + dotbf(zb + (size_t)m * D, (const bf16_t*)(ws + WS_WOUT) + (size_t)c * D, D);
        if (!closef(bf1(((const bf16_t*)(ws + WS_X1B))[(size_t)m * D + c]), r, 0.01f, 0.01f)) dbg_fail(dbg, 9);
        if (s < 512) { float q = 0.f; for (int i = 0; i < D; ++i) { const float v = bf1(((const bf16_t*)(ws + WS_X1B))[(size_t)m * D + i]); q += v * v; }
            if (!closef(((const float*)(ws + CTLB_SS2))[m], q, 0.01f, 0.f)) dbg_fail(dbg, 9); }
    }
    if (phase == PH_ROUTER) {
        const int m = h % M; const float rs = rsqrtf(((const float*)(ws + CTLB_SS2))[m] / D + RMS_EPS);
        float v[32]; for (int e = 0; e < 32; ++e) v[e] = dotbf((const bf16_t*)(ws + WS_X1B) + (size_t)m * D, (const bf16_t*)(ws + WS_WR) + (size_t)e * D, D) * rs + a.in[I_RB][e];
        const int* ti = (const int*)(ws + WS_TOPI) + m * 4; const float* tg = (const float*)(ws + WS_TOPG) + m * 4;
        float mn = 1e30f, se = 0.f, gs = 0.f; bool ok = true;
        for (int r = 0; r < 4; ++r) { if (ti[r] < 0 || ti[r] >= 32) { ok = false; break; } mn = fminf(mn, v[ti[r]]); for (int q = 0; q < r; ++q) if (ti[q] == ti[r]) ok = false; }
        if (ok) { for (int r = 0; r < 4; ++r) se += expf(v[ti[r]] - v[ti[0]]);
            for (int r = 0; r < 4; ++r) { if (!closef(tg[r], expf(v[ti[r]] - v[ti[0]]) / se, 0.02f, 0.002f)) ok = false; gs += tg[r]; }
            int above = 0; for (int e = 0; e < 32; ++e) { bool sel = false; for (int r = 0; r < 4; ++r) sel |= (ti[r] == e); if (!sel && v[e] > mn + 1e-3f) ++above; }
            if (above) ok = false; }
        if (!ok) dbg_fail(dbg, 10);
    }
    if (phase == PH_SCATTER) {
        const int m = h % M; const int* ti = (const int*)(ws + WS_TOPI) + m * 4; const int* po = (const int*)(ws + WS_POSOF) + m * 4; const int* te = (const int*)(ws + CTLB_TILEE);
        const int ntl = *(const int*)(ws + CTLB_META); bool ok = ntl > 0 && ntl <= 544;
        for (int r = 0; r < 4 && ok; ++r) { const int p = po[r]; if (p < 0 || p >= ntl * 256) { ok = false; break; }
            if (((const int*)(ws + WS_ROWMAP))[p] != m) ok = false; if (te[p >> 8] != ti[r]) ok = false;
            if (!closef(((const float*)(ws + WS_ROWGATE))[p], ((const float*)(ws + WS_TOPG))[m * 4 + r], 1e-6f, 0.f)) ok = false; }
        if (!ok) dbg_fail(dbg, 11);
    }
    if (phase == PH_MOE1) {
        const int ntl = *(const int*)(ws + CTLB_META); if (ntl > 0 && ntl <= 544) {
        const int row = h % (ntl * 256), j = h2 % DFF; const int e = ((const int*)(ws + CTLB_TILEE))[row >> 8], tok = ((const int*)(ws + WS_ROWMAP))[row];
        const float rs = rsqrtf(((const float*)(ws + CTLB_SS2))[tok] / D + RMS_EPS);
        const bf16_t* w1t = (const bf16_t*)(ws + WS_W1) + (size_t)e * 2048 * D; const int rg = ((j >> 7) << 8) + (j & 127), ru = rg + 128;
        float gl = dotbf((const bf16_t*)(ws + WS_X1B) + (size_t)tok * D, w1t + (size_t)rg * D, D) * rs + a.in[I_B1][e * 2048 + j];
        float up = dotbf((const bf16_t*)(ws + WS_X1B) + (size_t)tok * D, w1t + (size_t)ru * D, D) * rs + a.in[I_B1][e * 2048 + 1024 + j];
        gl = fminf(gl, 7.f); up = fminf(fmaxf(up, -7.f), 7.f);
        const float r = (up + 1.f) * gl / (1.f + expf(-1.702f * gl));
        if (((const float*)(ws + WS_ROWGATE))[row] != 0.f && !closef(bf1(((const bf16_t*)(ws + WS_R1))[(size_t)row * DFF + j]), r, 0.03f, 0.02f)) dbg_fail(dbg, 12); } else dbg_fail(dbg, 12);
    }
    if (phase == PH_MOE2) {
        const int ntl = *(const int*)(ws + CTLB_META); if (ntl > 0 && ntl <= 544) {
        const int row = h % (ntl * 256), c = h2 % D; const int e = ((const int*)(ws + CTLB_TILEE))[row >> 8];
        const float r = (dotbf((const bf16_t*)(ws + WS_R1) + (size_t)row * DFF, (const bf16_t*)(ws + WS_W2) + ((size_t)e * D + c) * DFF, DFF) + a.in[I_B2][e * D + c]) * ((const float*)(ws + WS_ROWGATE))[row];
        if (!closef(bf1(((const bf16_t*)(ws + WS_R2))[(size_t)row * D + c]), r, 0.03f, 0.01f)) dbg_fail(dbg, 13); } else dbg_fail(dbg, 13);
    }
    if (phase == PH_COMBINE) {
        const int m = h % M, c = h2 % D;
        { float r2 = bf1(((const bf16_t*)(ws + WS_X1B))[(size_t)m * D + c]); for (int q = 0; q < 4; ++q) r2 += bf1(((const bf16_t*)(ws + WS_R2))[(size_t)((const int*)(ws + WS_POSOF))[m * 4 + q] * D + c]);
          if (!closef(bf1(((const bf16_t*)(ws + WS_R1))[(size_t)m * D + c]), r2, 0.01f, 0.01f)) dbg_fail(dbg, 14); }
        if (s < 512) { float q = 0.f; for (int i = 0; i < D; ++i) { const float v = bf1(((const bf16_t*)(ws + WS_R1))[(size_t)m * D + i]); q += v * v; }
            if (!closef(((const float*)(ws + WS_RS3))[m], rsqrtf(q / D + RMS_EPS), 0.01f, 0.f)) dbg_fail(dbg, 14); }
    }
    if (phase == PH_PLE) {
        const int m = h % M, c = h2 % D;
        const float pp = dotbf((const bf16_t*)(ws + WS_PB) + (size_t)m * PLE, (const bf16_t*)(ws + WS_WPP) + (size_t)c * PLE, PLE);
        const float ppk = bf1(((const bf16_t*)(ws + WS_PP))[(size_t)m * D + c]);
        if (!closef(ppk, pp, 0.02f, 0.01f)) dbg_fail(dbg, 16);
        const float gate = 1.f / (1.f + expf(-dotbf((const bf16_t*)(ws + WS_R1) + (size_t)m * D, (const bf16_t*)(ws + WS_WPG) + (size_t)c * D, D) * ((const float*)(ws + WS_RS3))[m]));
        const float r3 = bf1(((const bf16_t*)(ws + WS_R1))[(size_t)m * D + c]) + gate * ppk;
        if (!closef(bf1(((const bf16_t*)(ws + WS_R1 + 128 * MiB))[(size_t)m * D + c]), r3, 0.02f, 0.03f)) dbg_fail(dbg, 15);
    }
}
__global__ void __launch_bounds__(256) chk_att(Args a) {
    unsigned char* ws = a.ws; unsigned* dbg = (unsigned*)(ws + CTLB_DBG);
    const unsigned char* pj = ws + WS_R1; const bf16_t* attn = (const bf16_t*)(ws + WS_R2 + 64 * MiB) + 512; const int* sel = (const int*)(ws + WS_SEL);
    const int special[16] = {0, 5, 63, 64, 200, 255, 256, 257, 300, 449, 512, 1000, 2047, 4096, 9000, 16383};
    const int sb = blockIdx.x; int t = (sb < 16) ? special[sb] : (int)(hash_u(sb * 977u + 5u) % SEQ); const int b = sb & 1; const int row = b * SEQ + t;
    __shared__ unsigned bitmap[512]; __shared__ unsigned skey[256]; __shared__ int s_bad, s_viol; __shared__ unsigned s_min; __shared__ float sc[8][256];
    const int tid = threadIdx.x;
    for (int i = tid; i < 512; i += 256) bitmap[i] = 0u;
    if (tid == 0) { s_bad = 0; s_viol = 0; s_min = 0xFFFFFFFFu; }
    __syncthreads();
    const int nsel = (t + 1) < 256 ? (t + 1) : 256;
    auto score_key = [&](int kp) -> unsigned {
        float s = 0.f;
        for (int hd = 0; hd < 8; ++hd) { float l = 0.f; for (int d = 0; d < 64; ++d) l += pjv(pj, row, C_QI + hd * 64 + d) * pjv(pj, b * SEQ + kp, C_KI + d);
            s = fmaf(fmaxf(l, 0.f), pjv(pj, row, C_WI + hd), s); }
        const unsigned ub = __builtin_bit_cast(unsigned, s); const unsigned srt = ub ^ ((ub >> 31) ? 0xFFFFFFFFu : 0x80000000u);
        return (srt & 0xFFFFC000u) | (unsigned)(16383 - kp);
    };
    { const int kp = sel[(size_t)row * 256 + tid];
      if (tid < nsel) { if (kp < 0 || kp > t) atomicAdd(&s_bad, 1); else { const unsigned old = atomicOr(&bitmap[kp >> 5], 1u << (kp & 31)); if (old & (1u << (kp & 31))) atomicAdd(&s_bad, 1);
            const unsigned pk = score_key(kp); skey[tid] = pk; atomicMin(&s_min, pk); } }
      else if (kp != -1) atomicAdd(&s_bad, 1); }
    __syncthreads();
    if (s_bad == 0) {
        for (int kp = tid; kp <= t; kp += 256) { if (!((bitmap[kp >> 5] >> (kp & 31)) & 1u)) { if (score_key(kp) > s_min) atomicAdd(&s_viol, 1); } }
    }
    __syncthreads();
    if (tid == 0 && (s_bad != 0 || s_viol > 3)) dbg_fail(dbg, 6);
    if (s_bad != 0) return;
    for (int hd = 0; hd < 8; ++hd) { float l = -1e30f;
        if (tid < nsel) { const int kp = sel[(size_t)row * 256 + tid]; l = 0.f; for (int d = 0; d < 64; ++d) l += pjv(pj, row, C_Q + hd * 64 + d) * pjv(pj, b * SEQ + kp, C_K + (hd >> 2) * 64 + d); }
        sc[hd][tid] = l; }
    __syncthreads();
    for (int o = tid; o < 512; o += 256) { const int hd = o >> 6, d = o & 63; float mx = -1e30f; for (int i = 0; i < nsel; ++i) mx = fmaxf(mx, sc[hd][i]);
        float se = 0.f, ov = 0.f; for (int i = 0; i < nsel; ++i) { const float p = expf(sc[hd][i] - mx); se += p; ov += p * pjv(pj, b * SEQ + sel[(size_t)row * 256 + i], C_V + (hd >> 2) * 64 + 16 * (d & 3) + (d >> 2)); }
        if (!closef(bf1(attn[(size_t)row * 1024 + o]), ov / se, 0.03f, 0.01f)) dbg_fail(dbg, 7); }
}
__global__ void __launch_bounds__(256) chk_report(Args a) {
    const unsigned* dbg = (const unsigned*)(a.ws + CTLB_DBG);
    int code = 0; for (int c = 20; c < 32; ++c) if (dbg[c] != 0u) { code = c; break; }
    if (code == 0) for (int c = 1; c < 20; ++c) if (dbg[c] != 0u) { code = c; break; }
    if (code == 0) return;
    const float v = sqrtf((float)code);
    for (size_t i = (size_t)blockIdx.x * 256 + threadIdx.x; i < (size_t)M * D; i += (size_t)gridDim.x * 256) a.out[i] = v;
}
#endif

extern "C" void kernel_launch(void* const* d_in, const int* in_sizes, int n_in, void* d_out, int out_size, void* d_ws, size_t ws_size, hipStream_t stream) {
    static int grid = 0;
    if (grid == 0) {
        if (n_in != 20 || out_size != M * D || ws_size < WS_END) { fprintf(stderr, "kernel_launch: unexpected shapes (n_in %d out %d ws %zu)\n", n_in, out_size, ws_size); grid = -1; return; }
        int dev = 0, cus = 0, per_cu = 0;
        if (hipGetDevice(&dev) != hipSuccess || hipDeviceGetAttribute(&cus, hipDeviceAttributeMultiprocessorCount, dev) != hipSuccess) { grid = -1; return; }
        if (hipFuncSetAttribute((const void*)fwd, hipFuncAttributeMaxDynamicSharedMemorySize, LDS_BYTES) != hipSuccess) { fprintf(stderr, "kernel_launch: hipFuncSetAttribute failed\n"); grid = -1; return; }
        if (hipOccupancyMaxActiveBlocksPerMultiprocessor(&per_cu, (const void*)fwd, NTHREADS, LDS_BYTES) != hipSuccess || per_cu < 1) fprintf(stderr, "kernel_launch: occupancy query says %d\n", per_cu);
        (void)hipGetLastError();
        grid = cus;
    }
    if (grid < 0) return;
    (void)hipMemsetAsync((char*)d_ws + WS_CTL, 0, CTL_ZERO_BYTES, stream);
    Args a{};
    for (int i = 0; i < 20; ++i) a.in[i] = (const float*)d_in[i];
    a.out = (float*)d_out; a.ws = (unsigned char*)d_ws;
#if DBG
    for (int p = 0; p < NPH; ++p) {
        a.ph_lo = p; a.ph_hi = p + 1;
        hipLaunchKernelGGL(fwd, dim3(grid), dim3(NTHREADS), LDS_BYTES, stream, a);
        if (p == PH_ATT) hipLaunchKernelGGL(chk_att, dim3(48), dim3(256), 0, stream, a);
        else if (p != PH_FINAL && p != PH_POOL) hipLaunchKernelGGL(chk, dim3(32), dim3(256), 0, stream, a, p);
    }
    hipLaunchKernelGGL(chk_report, dim3(1024), dim3(256), 0, stream, a);
#else
    a.ph_lo = 0; a.ph_hi = NPH;
    hipLaunchKernelGGL(fwd, dim3(grid), dim3(NTHREADS), LDS_BYTES, stream, a);
#endif
}
```

```cpp
#include <hip/hip_runtime.h>
#include <cstdio>
#include <cstdint>

#ifndef DBG
#define DBG 0
#endif

#define LAS __attribute__((address_space(3)))
#define GAS __attribute__((address_space(1)))
typedef unsigned short bf16_t;
typedef short bf16x8 __attribute__((ext_vector_type(8)));
typedef float f32x4 __attribute__((ext_vector_type(4)));
typedef float f32x16 __attribute__((ext_vector_type(16)));
typedef unsigned u32x4 __attribute__((ext_vector_type(4)));
typedef unsigned u32x2 __attribute__((ext_vector_type(2)));

constexpr int M = 32768, SEQ = 16384, D = 1024, NP = 4096, NE = 32, DFF = 1024, PLE = 256;
constexpr int IN_COLS = 3912;
constexpr int C_U = 0, C_Q = 512, C_K = 1024, C_V = 1152, C_QI = 1280, C_KI = 1792, C_WI = 1856, C_GP = 2048, C_GA = 3072;
constexpr int MOE_ROWS = M * 4 + NE * 256;
constexpr float RMS_EPS = 1e-6f;
constexpr int NWAVES = 8, NTHREADS = 512;

constexpr size_t MiB = 1u << 20;
constexpr size_t WS_CTL = 0, CTL_ZERO_BYTES = 1 * MiB;
constexpr size_t CTLB_BAR = 16384;
constexpr size_t CTLB_QUEUE = 65536;
constexpr size_t CTLB_META = 65536 + 256;
constexpr size_t CTLB_DBG = 131072;
constexpr size_t CTLB_SS2 = 262144;
constexpr size_t CTLB_SS4 = 393216;
constexpr size_t CTLB_CNTWG = 524288;
constexpr size_t CTLB_TILEE = 589824;
constexpr size_t WS_WIN = 1 * MiB, WS_WPC = 9 * MiB, WS_WBA = 10 * MiB, WS_WOUT = 11 * MiB, WS_WR = 13 * MiB, WS_WPG = 14 * MiB, WS_WPP = 16 * MiB;
constexpr size_t WS_RS1 = 17 * MiB, WS_RS3 = 17 * MiB + 131072;
constexpr size_t WS_TOPI = 18 * MiB, WS_TOPG = 18 * MiB + 524288, WS_LRANK = 19 * MiB, WS_POSOF = 19 * MiB + 524288;
constexpr size_t WS_ROWMAP = 20 * MiB, WS_ROWGATE = 21 * MiB, WS_ROWSCALE = 17 * MiB + 262144;
constexpr size_t WS_W1 = 22 * MiB, WS_W2 = 150 * MiB, WS_PB = 214 * MiB, WS_X1B = 230 * MiB;
constexpr size_t WS_R1 = 294 * MiB;
constexpr size_t WS_R2 = 566 * MiB;
constexpr size_t PJ_U = 0, PJ_Q = 32 * MiB, PJ_KV = 64 * MiB, PJ_QI = 80 * MiB, PJ_KW = 112 * MiB, PJ_G = 120 * MiB;
constexpr size_t WS_SEL = 838 * MiB;
constexpr size_t WS_PP = 870 * MiB;
constexpr size_t WS_END = 934 * MiB;

constexpr int LDS_MAIN = 0;
constexpr int LDS_KT = 131072;
constexpr int LDS_HIST = 147456;
constexpr int LDS_ATM = 155648;
constexpr int LDS_MISC = 156672;
constexpr int LDS_BYTES = 157696;

__device__ __forceinline__ unsigned f2bf(float f) { unsigned u = __builtin_bit_cast(unsigned, f); return (u + 0x7fffu + ((u >> 16) & 1u)) >> 16; }
__device__ __forceinline__ unsigned pk2(float lo, float hi) { return f2bf(lo) | (f2bf(hi) << 16); }
__device__ __forceinline__ float bf_lo(unsigned w) { return __builtin_bit_cast(float, w << 16); }
__device__ __forceinline__ float bf_hi(unsigned w) { return __builtin_bit_cast(float, w & 0xffff0000u); }
__device__ __forceinline__ float bf1(bf16_t b) { return __builtin_bit_cast(float, ((unsigned)b) << 16); }
typedef float f32x2_ __attribute__((ext_vector_type(2)));
__device__ __forceinline__ u32x2 fp8x4_to_bf16x4(unsigned w) {
    const f32x2_ a = __builtin_amdgcn_cvt_pk_f32_fp8((int)w, false), b = __builtin_amdgcn_cvt_pk_f32_fp8((int)w, true);
    const float ax = a.x, ay = a.y, bx = b.x, by = b.y;
    u32x2 r; r.x = __builtin_amdgcn_perm(__float_as_uint(ay), __float_as_uint(ax), 0x07060302u);
    r.y = __builtin_amdgcn_perm(__float_as_uint(by), __float_as_uint(bx), 0x07060302u); return r;
}
__device__ __forceinline__ bf16x8 fp8x8_to_bf16x8(unsigned w0, unsigned w1) { const u32x2 a = fp8x4_to_bf16x4(w0), b = fp8x4_to_bf16x4(w1); return __builtin_bit_cast(bf16x8, (u32x4){a.x, a.y, b.x, b.y}); }
__device__ __forceinline__ float clamp_e4m3(float v) { return __builtin_amdgcn_fmed3f(v, -448.0f, 448.0f); }
__device__ __forceinline__ unsigned pk4_fp8(float a, float b, float c, float d) { int w = __builtin_amdgcn_cvt_pk_fp8_f32(clamp_e4m3(a), clamp_e4m3(b), 0, false); w = __builtin_amdgcn_cvt_pk_fp8_f32(clamp_e4m3(c), clamp_e4m3(d), w, true); return (unsigned)w; }
__device__ __forceinline__ float sigmoidf_(float x) { return __builtin_amdgcn_rcpf(1.0f + __expf(-x)); }
#define LDS_WAIT() asm volatile("s_waitcnt lgkmcnt(0)" ::: "memory")
#define VM_WAIT() asm volatile("s_waitcnt vmcnt(0)" ::: "memory")
__device__ __forceinline__ float wave_sum(float v) {
#pragma unroll
    for (int o = 1; o < 64; o <<= 1) v += __shfl_xor(v, o);
    return v;
}

#define XB_TMO      128
#define XB_XCNT(j)  (256  + 64 * (j))
#define XB_XSUB(j)  (1280 + 64 * (j))
#define XB_XGEN(j)  (2304 + 64 * (j))
#define XB_TOP      3328
#define XB_TOPGEN   3392
#define XCD_BAR_WORDS 3456
#define XB_SPIN_CAP (1u << 22)
__device__ __forceinline__ unsigned xb_ld(unsigned* p)              { return __hip_atomic_load(p, __ATOMIC_RELAXED, __HIP_MEMORY_SCOPE_AGENT); }
__device__ __forceinline__ unsigned xb_add(unsigned* p, unsigned v) { return __hip_atomic_fetch_add(p, v, __ATOMIC_RELAXED, __HIP_MEMORY_SCOPE_AGENT); }
__device__ __forceinline__ unsigned xb_xcc_id() { return (unsigned)__builtin_amdgcn_s_getreg((3 << 11) | 20) & 0xFu; }
#define XB_SPIN(cond, bar) do { unsigned _sp = 0; while (cond) { __builtin_amdgcn_s_sleep(1); \
    if ((++_sp & 255u) == 0u) { if (xb_ld(&(bar)[XB_TMO])) break; if (_sp > XB_SPIN_CAP) { atomicAdd(&(bar)[XB_TMO], 1u); break; } } } } while (0)
struct XcdBarrier { unsigned* bar; unsigned x; volatile LAS unsigned* st; };
__device__ __forceinline__ XcdBarrier xcd_barrier_post(unsigned* bar, volatile LAS unsigned* st) {
    XcdBarrier b; b.bar = bar; b.x = xb_xcc_id(); b.st = st;
    if (threadIdx.x == 0) (void)xb_add(&bar[XB_XCNT(b.x)], 1u);
    return b;
}
__device__ __forceinline__ void xcd_barrier_complete(unsigned* bar, unsigned x, unsigned& nloc, unsigned& nx) {
    const unsigned G = gridDim.x * gridDim.y * gridDim.z;
    unsigned sum, cnt, mine, sp = 0u;
    for (;;) {
        sum = 0u; cnt = 0u; mine = 0u;
#pragma unroll
        for (unsigned j = 0; j < 16; ++j) { const unsigned c = xb_ld(&bar[XB_XCNT(j)]); sum += c; cnt += (c > 0u) ? 1u : 0u; mine = (j == x) ? c : mine; }
        if (sum == G) break;
        __builtin_amdgcn_s_sleep(1);
        if ((++sp & 255u) == 0u) { if (xb_ld(&bar[XB_TMO])) break; if (sp > XB_SPIN_CAP) { atomicAdd(&bar[XB_TMO], 1u); break; } }
    }
    nloc = mine > 0u ? mine : 1u; nx = cnt > 0u ? cnt : 1u;
}
__device__ __forceinline__ void xcd_barrier(const XcdBarrier& b) {
    asm volatile("s_waitcnt vmcnt(0)" ::: "memory");
    __syncthreads();
    if (threadIdx.x == 0) {
        unsigned* bar = b.bar;
        __builtin_amdgcn_s_waitcnt(0);
        unsigned nloc = b.st[0], nx = b.st[1];
        if (nloc == 0u) { xcd_barrier_complete(bar, b.x, nloc, nx); b.st[0] = nloc; b.st[1] = nx; }
        const unsigned old = xb_add(&bar[XB_XSUB(b.x)], 1u);
        const unsigned gen = old / nloc;
        if (old + 1u == (gen + 1u) * nloc) {
            __builtin_amdgcn_fence(__ATOMIC_RELEASE, "agent");
            asm volatile("s_waitcnt vmcnt(0)" ::: "memory");
            const unsigned og = xb_add(&bar[XB_TOP], 1u);
            const unsigned tg = og / nx;
            if (og + 1u == (tg + 1u) * nx) xb_add(&bar[XB_TOPGEN], 1u);
            else XB_SPIN(xb_ld(&bar[XB_TOPGEN]) == tg, bar);
            __builtin_amdgcn_fence(__ATOMIC_ACQUIRE, "agent");
            xb_add(&bar[XB_XGEN(b.x)], 1u);
            asm volatile("s_waitcnt vmcnt(0)" ::: "memory");
        } else {
            XB_SPIN(xb_ld(&bar[XB_XGEN(b.x)]) == gen, bar);
            __builtin_amdgcn_fence(__ATOMIC_ACQUIRE, "agent");
            asm volatile("s_waitcnt vmcnt(0)" ::: "memory");
        }
    }
    __syncthreads();
}

namespace pg8 {
constexpr int BM = 256, BK = 64, HALF = 128, HTB = HALF * BK * 2, STAGE_BYTES = 8 * HTB, NXCD = 8, WGM = 8;
__host__ __device__ __forceinline__ int lds_byte(int r, int c) { const int st = (r >> 4) * 2 + (c >> 5), rr = r & 15, cc = c & 31, ob = rr * 64 + cc * 2; return st * 1024 + (ob ^ (((ob >> 9) & 1) << 5)); }
__host__ __device__ __forceinline__ void stage_rc(int b, int& R, int& C) { const int st = b / 1024, sb = b % 1024, swz = sb ^ (((sb >> 9) & 1) << 5); R = (st >> 1) * 16 + swz / 64; C = (st & 1) * 32 + (swz % 64) / 2; }
__host__ __device__ __forceinline__ int perm32(int rho) { const int n = rho >> 4, i = rho & 15; return 8 * (i >> 2) + 4 * n + (i & 3); }

struct Unit { int pm, pn, e; };
struct Gemm { const bf16_t* A; const bf16_t* Bt; int M, N, K; size_t bstride; const int* rowmap; };

struct StaticOrder {
    int nM, nN, nwg, G, c;
    __device__ void init(int M_, int N_, int G_, int c_) { nM = M_ / BM; nN = N_ / BM; nwg = nM * nN; G = G_; c = c_; }
    __device__ bool next(int i, Unit& u) const {
        const long L = (long)i * G + c; if (L >= nwg) return false;
        int wgid = (int)L; { const int q = nwg / NXCD, r = nwg % NXCD, xcd = wgid % NXCD, off = wgid / NXCD; wgid = (xcd < r ? xcd * (q + 1) : r * (q + 1) + (xcd - r) * q) + off; }
        const int nig = WGM * nN, gid = wgid / nig, fm = gid * WGM, gsz = (nM - fm) < WGM ? (nM - fm) : WGM;
        u.pm = fm + ((wgid % nig) % gsz); u.pn = (wgid % nig) / gsz; u.e = 0; return true;
    }
};
struct MoeOrder {
    const LAS int* tile_e; int ntiles, nct, G, c;
    __device__ bool next(int i, Unit& u) const {
        const int v = (G % 8 == 0) ? (c % 8) * (G / 8) + c / 8 : c;
        const long L = (long)i * G + v; if (L >= (long)ntiles * nct) return false;
        u.pm = (int)(L / nct); u.pn = (int)(L % nct); u.e = __builtin_amdgcn_readfirstlane(tile_e[u.pm]); return true;
    }
};

struct PPOrder {
    int S, r;
    __device__ __forceinline__ bool next(int i, Unit& u) const { if (r < 0) return false; const int L = r + i * S; if (L >= 512) return false; u.pm = L >> 2; u.pn = L & 3; u.e = 0; return true; }
};
__device__ __forceinline__ unsigned cvt_pk_bf16(float lo, float hi) { unsigned r; asm volatile("v_cvt_pk_bf16_f32 %0, %1, %2" : "=v"(r) : "v"(lo), "v"(hi)); return r; }

struct NoHook { static constexpr bool ACTIVE = false; };
typedef int v8i32 __attribute__((ext_vector_type(8)));
typedef long i64x2 __attribute__((ext_vector_type(2)));
template <class Epi, class Sched, bool GATHER, class Hook = NoHook, int FP8 = 0>
__device__ __forceinline__ void gemm_phase(LAS unsigned char* lds, const Gemm g, const Sched& S, const Epi& E, const Hook& Hk = Hook()) {
    int tid_ = (int)threadIdx.x; asm volatile("" : "+v"(tid_));
    const int tid = tid_, wid = __builtin_amdgcn_readfirstlane(tid >> 6), lane = tid & 63, wr = wid >> 2, wc = wid & 3, fr = lane & 15, fq = lane >> 4;
    const int K = g.K, nt = K / BK;
    unsigned voffA[2][2], nvoffA[2][2], voffB[2]; int RA[2], CA[2];
#pragma unroll
    for (int i = 0; i < 2; ++i) { int R, C; stage_rc(tid * 16 + i * 8192, R, C); const int Rb = Epi::PERM ? ((R & ~31) + perm32(R & 31)) : R;
        RA[i] = R; CA[i] = C; voffB[i] = (unsigned)(Rb * K + C) * 2u; }
    const size_t kstep = (size_t)(BK * 2);
    const size_t hstep = (size_t)HALF * K * 2;
    const size_t tstep = 2 * hstep;
    const unsigned ldsw = (unsigned)wid * 1024u;
    const int aoff = lds_byte(wr * 64 + fr, fq * 8), boff = lds_byte(wc * 32 + fr, fq * 8);
#define PG8_SA(b, h) (((b) * 2 + (h)) * HTB)
#define PG8_SB(b, h) ((4 + (b) * 2 + (h)) * HTB)
      \
    const __amdgpu_buffer_rsrc_t rsA = __builtin_amdgcn_make_buffer_rsrc((void*)g.A, 0, 0x7FFFFFFF, 0x00020000), rsB = __builtin_amdgcn_make_buffer_rsrc((void*)g.Bt, 0, 0x7FFFFFFF, 0x00020000);
#define PG8_STAGE2(bufoff, gbase, v0, v1) do { \
        if constexpr (FP8 == 2) { if ((bufoff) < 4 * HTB) { const int so_ = (int)((const char*)(gbase) - (const char*)g.A); \
                __builtin_amdgcn_raw_ptr_buffer_load_lds(rsA, (LAS void*)(lds + (bufoff) + ldsw), 16, (int)(v0), so_, 0, 0); __builtin_amdgcn_raw_ptr_buffer_load_lds(rsA, (LAS void*)(lds + (bufoff) + ldsw + 8192), 16, (int)(v1), so_, 0, 0); } \
            else { const int so_ = (int)((const char*)(gbase) - (const char*)g.Bt); \
                __builtin_amdgcn_raw_ptr_buffer_load_lds(rsB, (LAS void*)(lds + (bufoff) + ldsw), 16, (int)(v0), so_, 0, 0); __builtin_amdgcn_raw_ptr_buffer_load_lds(rsB, (LAS void*)(lds + (bufoff) + ldsw + 8192), 16, (int)(v1), so_, 0, 0); } } \
        else { \
        __builtin_amdgcn_global_load_lds((const unsigned*)((const char*)(gbase) + (v0)), (LAS unsigned*)(lds + (bufoff) + ldsw), 16, 0, 0); \
        __builtin_amdgcn_global_load_lds((const unsigned*)((const char*)(gbase) + (v1)), (LAS unsigned*)(lds + (bufoff) + ldsw + 8192), 16, 0, 0); } } while (0)
#define PG8_STAGEB(bufoff, gbase) PG8_STAGE2(bufoff, gbase, voffB[0], voffB[1])
#define PG8_LDA(dst, b, h) do { _Pragma("unroll") for (int m = 0; m < 4; ++m) _Pragma("unroll") for (int k = 0; k < 2; ++k) dst[m][k] = *(const LAS bf16x8*)(lds + PG8_SA(b, h) + aoff + m * 2048 + k * 1024); } while (0)
#define PG8_LDB(dst, b, h) do { _Pragma("unroll") for (int n = 0; n < 2; ++n) _Pragma("unroll") for (int k = 0; k < 2; ++k) dst[n][k] = *(const LAS bf16x8*)(lds + PG8_SB(b, h) + boff + n * 2048 + k * 1024); } while (0)
#define PG8_MMA(ai, bj, At, Bt) do { __builtin_amdgcn_s_setprio(1); \
        if constexpr (FP8 == 2) { _Pragma("unroll") for (int m = 0; m < 4; ++m) _Pragma("unroll") for (int n = 0; n < 2; ++n) { \
            const v8i32 b_ = __builtin_bit_cast(v8i32, __builtin_shufflevector(Bt[n][0], Bt[n][1], 0, 1, 2, 3, 4, 5, 6, 7, 8, 9, 10, 11, 12, 13, 14, 15)); \
            const v8i32 a_ = __builtin_bit_cast(v8i32, __builtin_shufflevector(At[m][0], At[m][1], 0, 1, 2, 3, 4, 5, 6, 7, 8, 9, 10, 11, 12, 13, 14, 15)); \
            asm volatile("v_mfma_scale_f32_16x16x128_f8f6f4 %0, %1, %2, %0, %3, %3 op_sel_hi:[0,0,0]" : "+v"(acc[ai][bj][m][n]) : "v"(b_), "v"(a_), "v"(sc1_)); } } \
        else if constexpr (FP8 == 1) { _Pragma("unroll") for (int m = 0; m < 4; ++m) _Pragma("unroll") for (int n = 0; n < 2; ++n) _Pragma("unroll") for (int k = 0; k < 2; ++k) { \
            const i64x2 b_ = __builtin_bit_cast(i64x2, Bt[n][k]), a_ = __builtin_bit_cast(i64x2, At[m][k]); \
            acc[ai][bj][m][n] = __builtin_amdgcn_mfma_f32_16x16x32_fp8_fp8(b_.x, a_.x, acc[ai][bj][m][n], 0, 0, 0); acc[ai][bj][m][n] = __builtin_amdgcn_mfma_f32_16x16x32_fp8_fp8(b_.y, a_.y, acc[ai][bj][m][n], 0, 0, 0); } } \
        else { _Pragma("unroll") for (int m = 0; m < 4; ++m) _Pragma("unroll") for (int n = 0; n < 2; ++n) _Pragma("unroll") for (int k = 0; k < 2; ++k) \
            acc[ai][bj][m][n] = __builtin_amdgcn_mfma_f32_16x16x32_bf16(Bt[n][k], At[m][k], acc[ai][bj][m][n], 0, 0, 0); } \
        __builtin_amdgcn_s_setprio(0); } while (0)
#define PG8_WAIT_V(n) asm volatile("s_waitcnt vmcnt(" #n ")" ::: "memory")
#define PG8_WAIT_L(n) asm volatile("s_waitcnt lgkmcnt(" #n ")" ::: "memory")
#define PG8_BAR __builtin_amdgcn_s_barrier()
#define PG8_SCHED __builtin_amdgcn_sched_barrier(0)
    Unit cur, nxt; int ui = 0;
    if (!S.next(0, cur)) return;
    int sc1_ = 0x7F7F7F7F; if constexpr (FP8 == 2) asm volatile("" : "+v"(sc1_));
    f32x4 acc[2][2][4][2];
#pragma unroll
    for (int a = 0; a < 2; ++a)
#pragma unroll
        for (int b = 0; b < 2; ++b)
#pragma unroll
            for (int m = 0; m < 4; ++m)
#pragma unroll
                for (int n = 0; n < 2; ++n) acc[a][b][m][n] = (f32x4){0.f, 0.f, 0.f, 0.f};
    bf16x8 At[4][2], B0[2][2], B1[2][2];
#pragma unroll
    for (int h = 0; h < 2; ++h)
#pragma unroll
        for (int i = 0; i < 2; ++i) {
            if constexpr (GATHER) voffA[h][i] = ((unsigned)g.rowmap[cur.pm * BM + h * HALF + RA[i]] * (unsigned)K + (unsigned)CA[i]) * 2u;
            else voffA[h][i] = (unsigned)((h * HALF + RA[i]) * K + CA[i]) * 2u;
            if constexpr (GATHER) nvoffA[h][i] = voffA[h][i];
        }
    const char* cA = GATHER ? (const char*)g.A : (const char*)g.A + (size_t)cur.pm * tstep;
    const char* cB = (const char*)g.Bt + (size_t)cur.e * g.bstride + (size_t)cur.pn * tstep;
    PG8_STAGEB(PG8_SB(0, 0), cB); PG8_STAGE2(PG8_SA(0, 0), cA, voffA[0][0], voffA[0][1]); PG8_STAGEB(PG8_SB(0, 1), cB + hstep); PG8_STAGE2(PG8_SA(0, 1), cA, voffA[1][0], voffA[1][1]);
    if (wr == 1) PG8_BAR;
    PG8_WAIT_V(4); PG8_BAR;
    PG8_STAGEB(PG8_SB(1, 0), cB + kstep); PG8_STAGE2(PG8_SA(1, 0), cA + kstep, voffA[0][0], voffA[0][1]); PG8_STAGEB(PG8_SB(1, 1), cB + hstep + kstep);
    PG8_WAIT_V(6); PG8_BAR;
    for (;;) {
        const bool has_next = S.next(ui + 1, nxt);
        const char* nA = has_next ? (GATHER ? (const char*)g.A : (const char*)g.A + (size_t)nxt.pm * tstep) : cA;
        const char* nB = has_next ? (const char*)g.Bt + (size_t)nxt.e * g.bstride + (size_t)nxt.pn * tstep : cB;
        if constexpr (GATHER) {
            if (has_next) {
#pragma unroll
                for (int h = 0; h < 2; ++h)
#pragma unroll
                    for (int i = 0; i < 2; ++i) nvoffA[h][i] = ((unsigned)g.rowmap[nxt.pm * BM + h * HALF + RA[i]] * (unsigned)K + (unsigned)CA[i]) * 2u;
            }
        }
        for (int t = 0; t < nt; t += 2) {
            const bool last = (t == nt - 2);
            if constexpr (Hook::ACTIVE) { if (t == nt / 2) Hk.mid(acc, cur); }
            const char* a1 = cA + (size_t)(t + 1) * kstep;
            const char* a2 = last ? nA : cA + (size_t)(t + 2) * kstep; const char* b2 = last ? nB : cB + (size_t)(t + 2) * kstep;
            const char* a3 = a2 + kstep; const char* b3 = b2 + kstep;
            unsigned w00 = voffA[0][0], w01 = voffA[0][1], w10 = voffA[1][0], w11 = voffA[1][1];
            if constexpr (GATHER) { if (last) { w00 = nvoffA[0][0]; w01 = nvoffA[0][1]; w10 = nvoffA[1][0]; w11 = nvoffA[1][1]; } }
            PG8_LDB(B0, 0, 0); PG8_SCHED; PG8_LDA(At, 0, 0); PG8_STAGE2(PG8_SA(1, 1), a1, voffA[1][0], voffA[1][1]);
            PG8_WAIT_L(8); PG8_BAR; PG8_WAIT_L(0); PG8_MMA(0, 0, At, B0); PG8_BAR; PG8_SCHED;
            PG8_LDB(B1, 0, 1); PG8_STAGEB(PG8_SB(0, 0), b2);
            PG8_BAR; PG8_WAIT_L(0); PG8_MMA(0, 1, At, B1); PG8_BAR;
            PG8_LDA(At, 0, 1); PG8_STAGE2(PG8_SA(0, 0), a2, w00, w01);
            PG8_BAR; PG8_WAIT_L(0); PG8_MMA(1, 0, At, B0); PG8_BAR; PG8_SCHED;
            PG8_STAGEB(PG8_SB(0, 1), b2 + hstep);
            PG8_WAIT_V(6); PG8_BAR; PG8_MMA(1, 1, At, B1); PG8_BAR;
            PG8_LDB(B0, 1, 0); PG8_SCHED; PG8_LDA(At, 1, 0); PG8_STAGE2(PG8_SA(0, 1), a2, w10, w11);
            PG8_WAIT_L(8); PG8_BAR; PG8_WAIT_L(0); PG8_MMA(0, 0, At, B0); PG8_BAR; PG8_SCHED;
            PG8_LDB(B1, 1, 1); PG8_STAGEB(PG8_SB(1, 0), b3);
            PG8_BAR; PG8_WAIT_L(0); PG8_MMA(0, 1, At, B1); PG8_BAR;
            PG8_LDA(At, 1, 1); PG8_STAGE2(PG8_SA(1, 0), a3, w00, w01);
            PG8_BAR; PG8_WAIT_L(0); PG8_MMA(1, 0, At, B0); PG8_BAR; PG8_SCHED;
            PG8_STAGEB(PG8_SB(1, 1), b3 + hstep);
            PG8_WAIT_V(6); PG8_BAR; PG8_MMA(1, 1, At, B1); PG8_BAR;
        }
        if constexpr (FP8 == 2) asm volatile("s_nop 15\n\ts_nop 15" ::: "memory");
        E(acc, cur, wr, wc, fr, fq);
        if (!has_next) break;
#pragma unroll
        for (int a = 0; a < 2; ++a)
#pragma unroll
            for (int b = 0; b < 2; ++b)
#pragma unroll
                for (int m = 0; m < 4; ++m)
#pragma unroll
                    for (int n = 0; n < 2; ++n) acc[a][b][m][n] = (f32x4){0.f, 0.f, 0.f, 0.f};
        cur = nxt; cA = nA; cB = nB; ++ui;
        if constexpr (GATHER) {
#pragma unroll
            for (int h = 0; h < 2; ++h)
#pragma unroll
                for (int i = 0; i < 2; ++i) voffA[h][i] = nvoffA[h][i];
        }
    }
    PG8_WAIT_V(0);
    if (wr == 0) PG8_BAR;
    PG8_BAR;
#undef PG8_SA
#undef PG8_SB
#undef PG8_STAGE2
#undef PG8_STAGEB
#undef PG8_LDA
#undef PG8_LDB
#undef PG8_MMA
#undef PG8_WAIT_V
#undef PG8_WAIT_L
#undef PG8_BAR
#undef PG8_SCHED
}
}
using pg8::Unit;

typedef f32x4 AccT[2][2][4][2];
struct EpiProj {
    static constexpr bool PERM = true;
    unsigned char* pj; const float* rs;
    __device__ __forceinline__ void operator()(const AccT& acc, const Unit& u, int wr, int wc, int fr, int fq) const {
        const int pn = u.pn; const bool sig = pn >= 8;
        bf16_t* base; int ld, nbj = 2;
        if (pn < 2)       { base = (bf16_t*)(pj + PJ_U) + pn * 256; ld = 512; }
        else if (pn < 4)  { base = (bf16_t*)(pj + PJ_Q) + (pn - 2) * 256; ld = 512; }
        else if (pn == 4) {
            unsigned char* kv8 = pj + PJ_KV; const int row0 = u.pm * 256 + wr * 64 + fr, cb = wc * 32 + 8 * fq;
            float sv[8];
#pragma unroll
            for (int g = 0; g < 8; ++g) sv[g] = rs[row0 + (g >> 2) * 128 + (g & 3) * 16];
#pragma unroll
            for (int ai = 0; ai < 2; ++ai)
#pragma unroll
                for (int m = 0; m < 4; ++m) { const int row = row0 + ai * 128 + m * 16; const float s = sv[ai * 4 + m];
#pragma unroll
                    for (int bj = 0; bj < 2; ++bj) { const f32x4 v0 = acc[ai][bj][m][0] * s, v1 = acc[ai][bj][m][1] * s;
                        u32x2 w; w.x = pk4_fp8(v0[0], v0[1], v0[2], v0[3]); w.y = pk4_fp8(v1[0], v1[1], v1[2], v1[3]);
                        *(u32x2*)(kv8 + (size_t)row * 256 + bj * 128 + cb) = w; } }
            return; }
        else if (pn < 7)  { base = (bf16_t*)(pj + PJ_QI) + (pn - 5) * 256; ld = 512; }
        else if (pn == 7) { base = (bf16_t*)(pj + PJ_KW); ld = 128; nbj = 1; }
        else              { base = (bf16_t*)(pj + PJ_G) + (pn - 8) * 256; ld = 2048; }
        const int row0 = u.pm * 256 + wr * 64 + fr, col0 = wc * 32 + 8 * fq;
        float sv[8];
#pragma unroll
        for (int g = 0; g < 8; ++g) sv[g] = rs[row0 + (g >> 2) * 128 + (g & 3) * 16];
#pragma unroll
        for (int ai = 0; ai < 2; ++ai)
#pragma unroll
            for (int m = 0; m < 4; ++m) { const int row = row0 + ai * 128 + m * 16; const float s = sv[ai * 4 + m]; bf16_t* rowp = base + (size_t)row * ld + col0;
#pragma unroll
                for (int bj = 0; bj < 2; ++bj) { if (bj < nbj) { f32x4 v0 = acc[ai][bj][m][0] * s, v1 = acc[ai][bj][m][1] * s;
                    if (sig) {
#pragma unroll
                        for (int j = 0; j < 4; ++j) { v0[j] = sigmoidf_(v0[j]); v1[j] = sigmoidf_(v1[j]); } }
                    u32x4 w; w.x = pk2(v0[0], v0[1]); w.y = pk2(v0[2], v0[3]); w.z = pk2(v1[0], v1[1]); w.w = pk2(v1[2], v1[3]);
                    *(u32x4*)(rowp + bj * 128) = w; } } }
    }
};
__device__ __forceinline__ float ga_clamp(float g) { return fmaxf(g, 8.67361738e-19f); }
struct HookGateRatio {
    static constexpr bool ACTIVE = true;
    const bf16_t* gates;
    __device__ __forceinline__ void mid(AccT& acc, const Unit& u) const {
        int tz = threadIdx.x; asm volatile("" : "+v"(tz));
        const int wid = tz >> 6, ln = tz & 63, wr = wid >> 2, wc = wid & 3, fr = ln & 15, fq = ln >> 4;
        const int row0 = u.pm * 256 + wr * 64 + fr, col0 = u.pn * 256 + wc * 32 + 8 * fq;
        u32x4 gpv[2][2], gav[2][2];
#pragma unroll
        for (int bj = 0; bj < 2; ++bj) { gpv[0][bj] = *(const u32x4*)(gates + (size_t)row0 * 2048 + col0 + bj * 128); gav[0][bj] = *(const u32x4*)(gates + (size_t)row0 * 2048 + 1024 + col0 + bj * 128); }
#pragma unroll
        for (int ai = 0; ai < 2; ++ai)
#pragma unroll
            for (int m = 0; m < 4; ++m) { const int g1 = ai * 4 + m + 1;
                if (g1 < 8) { const int rown = row0 + (g1 >> 2) * 128 + (g1 & 3) * 16;
#pragma unroll
                    for (int bj = 0; bj < 2; ++bj) { gpv[g1 & 1][bj] = *(const u32x4*)(gates + (size_t)rown * 2048 + col0 + bj * 128); gav[g1 & 1][bj] = *(const u32x4*)(gates + (size_t)rown * 2048 + 1024 + col0 + bj * 128); } }
#pragma unroll
                for (int bj = 0; bj < 2; ++bj) {
                    const u32x4 gp = gpv[m & 1][bj], ga = gav[m & 1][bj];
                    acc[ai][bj][m][0][0] *= bf_lo(gp.x) * __builtin_amdgcn_rcpf(ga_clamp(bf_lo(ga.x))); acc[ai][bj][m][0][1] *= bf_hi(gp.x) * __builtin_amdgcn_rcpf(ga_clamp(bf_hi(ga.x)));
                    acc[ai][bj][m][0][2] *= bf_lo(gp.y) * __builtin_amdgcn_rcpf(ga_clamp(bf_lo(ga.y))); acc[ai][bj][m][0][3] *= bf_hi(gp.y) * __builtin_amdgcn_rcpf(ga_clamp(bf_hi(ga.y)));
                    acc[ai][bj][m][1][0] *= bf_lo(gp.z) * __builtin_amdgcn_rcpf(ga_clamp(bf_lo(ga.z))); acc[ai][bj][m][1][1] *= bf_hi(gp.z) * __builtin_amdgcn_rcpf(ga_clamp(bf_hi(ga.z)));
                    acc[ai][bj][m][1][2] *= bf_lo(gp.w) * __builtin_amdgcn_rcpf(ga_clamp(bf_lo(ga.w))); acc[ai][bj][m][1][3] *= bf_hi(gp.w) * __builtin_amdgcn_rcpf(ga_clamp(bf_hi(ga.w)));
                    }
                asm volatile("" ::: "memory"); }
    }
};
template <bool ADD, bool CLAMP = false> struct EpiGate {
    static constexpr bool PERM = true;
    bf16_t* O; const bf16_t* gate; const bf16_t* addsrc;
    __device__ __forceinline__ void operator()(const AccT& acc, const Unit& u, int wr, int wc, int fr, int fq) const {
        const int row0 = u.pm * 256 + wr * 64 + fr, col0 = u.pn * 256 + wc * 32 + 8 * fq;
        u32x4 gb[4][2];
#pragma unroll
        for (int g = 0; g < 4; ++g)
#pragma unroll
            for (int bj = 0; bj < 2; ++bj) gb[g][bj] = *(const u32x4*)(gate + (size_t)(row0 + g * 16) * 2048 + col0 + bj * 128);
#pragma unroll
        for (int ai = 0; ai < 2; ++ai)
#pragma unroll
            for (int m = 0; m < 4; ++m) { const int row = row0 + ai * 128 + m * 16;
#pragma unroll
                for (int bj = 0; bj < 2; ++bj) { const int col = col0 + bj * 128;
                    const u32x4 gw = gb[m][bj];
                    if (ai == 0) gb[m][bj] = *(const u32x4*)(gate + (size_t)(row + 128) * 2048 + col);
                    f32x4 v0 = acc[ai][bj][m][0], v1 = acc[ai][bj][m][1];
                    if (CLAMP) {
                        v0[0] *= ga_clamp(bf_lo(gw.x)); v0[1] *= ga_clamp(bf_hi(gw.x)); v0[2] *= ga_clamp(bf_lo(gw.y)); v0[3] *= ga_clamp(bf_hi(gw.y));
                        v1[0] *= ga_clamp(bf_lo(gw.z)); v1[1] *= ga_clamp(bf_hi(gw.z)); v1[2] *= ga_clamp(bf_lo(gw.w)); v1[3] *= ga_clamp(bf_hi(gw.w));
                    } else {
                    v0[0] *= bf_lo(gw.x); v0[1] *= bf_hi(gw.x); v0[2] *= bf_lo(gw.y); v0[3] *= bf_hi(gw.y);
                    v1[0] *= bf_lo(gw.z); v1[1] *= bf_hi(gw.z); v1[2] *= bf_lo(gw.w); v1[3] *= bf_hi(gw.w); }
                    if (ADD) { const u32x4 aw = *(const u32x4*)(addsrc + (size_t)row * D + col);
                        v0[0] += bf_lo(aw.x); v0[1] += bf_hi(aw.x); v0[2] += bf_lo(aw.y); v0[3] += bf_hi(aw.y);
                        v1[0] += bf_lo(aw.z); v1[1] += bf_hi(aw.z); v1[2] += bf_lo(aw.w); v1[3] += bf_hi(aw.w); }
                    u32x4 w; w.x = pk2(v0[0], v0[1]); w.y = pk2(v0[2], v0[3]); w.z = pk2(v1[0], v1[1]); w.w = pk2(v1[2], v1[3]);
                    *(u32x4*)(O + (size_t)row * D + col) = w; } }
    }
};
struct EpiX1 {
    static constexpr bool PERM = false;
    const float* x; bf16_t* xb; float* ss; unsigned char* x8;
    __device__ __forceinline__ void operator()(const AccT& acc, const Unit& u, int wr, int wc, int fr, int fq) const {
        const int row0 = u.pm * 256 + wr * 64 + fr, col0 = u.pn * 256 + wc * 32 + 4 * fq;
        f32x4 xv[2][4];
#pragma unroll
        for (int g = 0; g < 2; ++g)
#pragma unroll
            for (int q = 0; q < 4; ++q) xv[g][q] = *(const f32x4*)(x + (size_t)(row0 + g * 16) * D + col0 + (q >> 1) * 128 + (q & 1) * 16);
#pragma unroll
        for (int ai = 0; ai < 2; ++ai)
#pragma unroll
            for (int m = 0; m < 4; ++m) { const int row = row0 + ai * 128 + m * 16; float s = 0.f;
                const int g2 = ai * 4 + m + 2, rown = row0 + (g2 >> 2) * 128 + (g2 & 3) * 16;
#pragma unroll
                for (int bj = 0; bj < 2; ++bj)
#pragma unroll
                    for (int n = 0; n < 2; ++n) { const size_t o = (size_t)row * D + col0 + bj * 128 + n * 16;
                        const f32x4 xin = xv[m & 1][bj * 2 + n];
                        if (g2 < 8) xv[m & 1][bj * 2 + n] = *(const f32x4*)(x + (size_t)rown * D + col0 + bj * 128 + n * 16);
                        const f32x4 v = xin + acc[ai][bj][m][n];
                        u32x2 w; w.x = pk2(v[0], v[1]); w.y = pk2(v[2], v[3]); *(u32x2*)(xb + o) = w;
                        *(unsigned*)(x8 + o) = pk4_fp8(v[0], v[1], v[2], v[3]);
                        s += (v[0] * v[0] + v[1] * v[1]) + (v[2] * v[2] + v[3] * v[3]); }
                s += __shfl_xor(s, 16); s += __shfl_xor(s, 32);
                if (fq == 0) atomicAdd(ss + row, s); }
    }
};
struct EpiMoe1 {
    static constexpr bool PERM = true;
    unsigned char* act; const float* rowscale; const float* b1;
    __device__ __forceinline__ void operator()(const AccT& acc, const Unit& u, int wr, int wc, int fr, int fq) const {
        const int row0 = u.pm * 256 + wr * 64 + fr, colj = u.pn * 128 + wc * 32 + 8 * fq;
        const float* bg = b1 + (size_t)u.e * 2048 + colj; const float* bu = bg + 1024;
        const f32x4 bg0 = *(const f32x4*)bg, bg1 = *(const f32x4*)(bg + 4), bu0 = *(const f32x4*)bu, bu1 = *(const f32x4*)(bu + 4);
        float sv[8];
#pragma unroll
        for (int g = 0; g < 8; ++g) sv[g] = rowscale[row0 + (g >> 2) * 128 + (g & 3) * 16] * (1.0f / 64.0f);
#pragma unroll
        for (int ai = 0; ai < 2; ++ai)
#pragma unroll
            for (int m = 0; m < 4; ++m) { const int row = row0 + ai * 128 + m * 16;
                const float rs = sv[ai * 4 + m];
                float r[8];
#pragma unroll
                for (int n = 0; n < 2; ++n)
#pragma unroll
                    for (int j = 0; j < 4; ++j) { float gl = acc[ai][0][m][n][j] * rs + (n ? bg1[j] : bg0[j]); float up = acc[ai][1][m][n][j] * rs + (n ? bu1[j] : bu0[j]);
                        gl = fminf(gl, 7.0f); up = fminf(fmaxf(up, -7.0f), 7.0f);
                        r[n * 4 + j] = 8.0f * ((up + 1.0f) * (gl * sigmoidf_(1.702f * gl))); }
                u32x2 w; w.x = pk4_fp8(r[0], r[1], r[2], r[3]); w.y = pk4_fp8(r[4], r[5], r[6], r[7]);
                *(u32x2*)(act + (size_t)row * DFF + colj) = w; }
    }
};
struct EpiMoe2 {
    static constexpr bool PERM = true;
    unsigned char* Y; const float* rowgate; const float* b2;
    __device__ __forceinline__ void operator()(const AccT& acc, const Unit& u, int wr, int wc, int fr, int fq) const {
        const int row0 = u.pm * 256 + wr * 64 + fr, col0 = u.pn * 256 + wc * 32 + 8 * fq;
        f32x4 cb[2][2]; float sv[8];
#pragma unroll
        for (int bj = 0; bj < 2; ++bj) { const float* bb = b2 + (size_t)u.e * D + col0 + bj * 128; cb[bj][0] = *(const f32x4*)bb; cb[bj][1] = *(const f32x4*)(bb + 4); }
#pragma unroll
        for (int g = 0; g < 8; ++g) sv[g] = rowgate[row0 + (g >> 2) * 128 + (g & 3) * 16];
#pragma unroll
        for (int ai = 0; ai < 2; ++ai)
#pragma unroll
            for (int m = 0; m < 4; ++m) { const int row = row0 + ai * 128 + m * 16; const float gt = sv[ai * 4 + m];
#pragma unroll
                for (int bj = 0; bj < 2; ++bj) { const int col = col0 + bj * 128;
                    const f32x4 c0 = cb[bj][0], c1 = cb[bj][1];
                    const f32x4 v0 = (acc[ai][bj][m][0] * (1.0f / 512.0f) + c0) * gt, v1 = (acc[ai][bj][m][1] * (1.0f / 512.0f) + c1) * gt;
                    u32x2 w; w.x = pk4_fp8(v0[0], v0[1], v0[2], v0[3]); w.y = pk4_fp8(v1[0], v1[1], v1[2], v1[3]);
                    *(u32x2*)(Y + (size_t)row * D + col) = w; } }
    }
};
struct EpiPP {
    static constexpr bool PERM = true;
    bf16_t* PP;
    __device__ __forceinline__ void operator()(const AccT& acc, const Unit& u, int wr, int wc, int fr, int fq) const {
        const int row0 = u.pm * 256 + wr * 64 + fr, col0 = u.pn * 256 + wc * 32 + 8 * fq;
#pragma unroll
        for (int ai = 0; ai < 2; ++ai)
#pragma unroll
            for (int m = 0; m < 4; ++m) { const int row = row0 + ai * 128 + m * 16;
#pragma unroll
                for (int bj = 0; bj < 2; ++bj) { const f32x4 v0 = acc[ai][bj][m][0], v1 = acc[ai][bj][m][1];
                    u32x4 w; w.x = pk2(v0[0], v0[1]); w.y = pk2(v0[2], v0[3]); w.z = pk2(v1[0], v1[1]); w.w = pk2(v1[2], v1[3]);
                    *(u32x4*)(PP + (size_t)row * D + col0 + bj * 128) = w; } }
    }
};
struct EpiPleGX {
    static constexpr bool PERM = true;
    bf16_t* x3b; const bf16_t* x2b; const bf16_t* PP; const float* rs; float* ss;
    __device__ __forceinline__ void operator()(const AccT& acc, const Unit& u, int wr, int wc, int fr, int fq) const {
        const int row0 = u.pm * 256 + wr * 64 + fr, col0 = u.pn * 256 + wc * 32 + 8 * fq;
        float sv[8]; u32x4 pb[2][2], xq[2][2];
#pragma unroll
        for (int g = 0; g < 8; ++g) sv[g] = rs[row0 + (g >> 2) * 128 + (g & 3) * 16];
#pragma unroll
        for (int g = 0; g < 2; ++g)
#pragma unroll
            for (int bj = 0; bj < 2; ++bj) { const size_t o = (size_t)(row0 + g * 16) * D + col0 + bj * 128; pb[g][bj] = *(const u32x4*)(PP + o); xq[g][bj] = *(const u32x4*)(x2b + o); }
#pragma unroll
        for (int ai = 0; ai < 2; ++ai)
#pragma unroll
            for (int m = 0; m < 4; ++m) { const int row = row0 + ai * 128 + m * 16; const float rsv = sv[ai * 4 + m]; float s = 0.f;
                const int g2 = ai * 4 + m + 2, rown = row0 + (g2 >> 2) * 128 + (g2 & 3) * 16;
#pragma unroll
                for (int bj = 0; bj < 2; ++bj) { const size_t o = (size_t)row * D + col0 + bj * 128;
                    const u32x4 pw = pb[m & 1][bj], xw = xq[m & 1][bj];
                    if (g2 < 8) { const size_t on = (size_t)rown * D + col0 + bj * 128; pb[m & 1][bj] = *(const u32x4*)(PP + on); xq[m & 1][bj] = *(const u32x4*)(x2b + on); }
                    const f32x4 a0 = acc[ai][bj][m][0] * rsv, a1 = acc[ai][bj][m][1] * rsv;
                    f32x4 x0, x1;
                    x0[0] = bf_lo(xw.x) + sigmoidf_(a0[0]) * bf_lo(pw.x); x0[1] = bf_hi(xw.x) + sigmoidf_(a0[1]) * bf_hi(pw.x);
                    x0[2] = bf_lo(xw.y) + sigmoidf_(a0[2]) * bf_lo(pw.y); x0[3] = bf_hi(xw.y) + sigmoidf_(a0[3]) * bf_hi(pw.y);
                    x1[0] = bf_lo(xw.z) + sigmoidf_(a1[0]) * bf_lo(pw.z); x1[1] = bf_hi(xw.z) + sigmoidf_(a1[1]) * bf_hi(pw.z);
                    x1[2] = bf_lo(xw.w) + sigmoidf_(a1[2]) * bf_lo(pw.w); x1[3] = bf_hi(xw.w) + sigmoidf_(a1[3]) * bf_hi(pw.w);
                    { u32x4 w; w.x = pk2(x0[0], x0[1]); w.y = pk2(x0[2], x0[3]); w.z = pk2(x1[0], x1[1]); w.w = pk2(x1[2], x1[3]); *(u32x4*)(x3b + o) = w; }
                    s += (x0[0] * x0[0] + x0[1] * x0[1]) + (x0[2] * x0[2] + x0[3] * x0[3]) + (x1[0] * x1[0] + x1[1] * x1[1]) + (x1[2] * x1[2] + x1[3] * x1[3]); }
                s += __shfl_xor(s, 16); s += __shfl_xor(s, 32);
                if (fq == 0) atomicAdd(ss + row, s); }
    }
};

struct Args { const float* in[20]; float* out; unsigned char* ws; int ph_lo, ph_hi; };
enum { I_X = 0, I_P, I_N1G, I_WIN, I_POOLW, I_POOLS, I_WBP, I_WBA, I_WOUT, I_N2G, I_RW, I_RB, I_W1, I_B1, I_W2, I_B2, I_PNG, I_PGW, I_PPW, I_FG };
enum { PH_PRO = 0, PH_INPROJ, PH_MIXED, PH_POOL, PH_ATT, PH_Z, PH_X1, PH_ROUTER, PH_SCATTER, PH_MOE1, PH_MOE2, PH_COMBINE, PH_PLE, PH_FINAL, NPH };

__device__ __forceinline__ int tr_dst_row(int mode, int n) {
    if (mode == 1) { if (n >= 1152 && n < 1280) { const int d = (n - 1152) & 63; return 1152 + ((n - 1152) & 64) + 16 * (d & 3) + (d >> 2); }
                     return n < 1864 ? n : n + 184; }
    if (mode == 2) return n < 1024 ? (((n >> 7) << 8) + (n & 127)) : ((((n - 1024) >> 7) << 8) + 128 + ((n - 1024) & 127));
    return n;
}
__device__ __forceinline__ float tr_col_scale(int mode, int n) {
    if (mode == 1) { if ((n >= 512 && n < 1024) || (n >= 1280 && n < 1792)) return 0.125f; if (n >= 1856 && n < 1864) return 0.35355339059327373f; }
    return 1.0f;
}
__device__ __forceinline__ void transpose_item(const float* W, int ldw, int Nvalid, int K, bf16_t* WT, const float* kgain, int mode, LAS float* scr, int kb, int nb, int lane, int ldt = 0, float f8scale = 0.f) {
    if (ldt == 0) ldt = K;
    const int k0 = 64 * kb, n0 = 64 * nb, c4 = lane & 15, kr = lane >> 4, nl = n0 + 4 * c4; const bool nok = nl < Nvalid;
    const f32x4 cs = (f32x4){tr_col_scale(mode, nl), tr_col_scale(mode, nl + 1), tr_col_scale(mode, nl + 2), tr_col_scale(mode, nl + 3)};
    f32x4 v[16];
#pragma unroll
    for (int i = 0; i < 16; ++i) { const int kk = 4 * i + kr; v[i] = nok ? *(const f32x4*)(W + (size_t)(k0 + kk) * ldw + nl) : (f32x4){0.f, 0.f, 0.f, 0.f}; }
    float kgv[16];
#pragma unroll
    for (int i = 0; i < 16; ++i) kgv[i] = kgain ? kgain[k0 + 4 * i + kr] : 1.0f;
#pragma unroll
    for (int i = 0; i < 16; ++i) asm volatile("" : "+v"(kgv[i]));
#pragma unroll
    for (int i = 0; i < 16; ++i) { const int kk = 4 * i + kr; *(LAS f32x4*)(scr + kk * 68 + 4 * c4) = v[i] * cs * kgv[i]; }
    LDS_WAIT(); asm volatile("" ::: "memory");
    const int c = lane & 7;
#pragma unroll
    for (int j = 0; j < 8; ++j) { const int n = (lane >> 3) + 8 * j; const LAS float* s = scr + (8 * c) * 68 + n;
        if (f8scale != 0.f) {
            u32x2 o8; o8.x = pk4_fp8(s[0 * 68] * f8scale, s[1 * 68] * f8scale, s[2 * 68] * f8scale, s[3 * 68] * f8scale); o8.y = pk4_fp8(s[4 * 68] * f8scale, s[5 * 68] * f8scale, s[6 * 68] * f8scale, s[7 * 68] * f8scale);
            if (n0 + n < Nvalid) *(u32x2*)((unsigned char*)WT + (size_t)tr_dst_row(mode, n0 + n) * ldt + k0 + 8 * c) = o8;
        } else {
        u32x4 o; o.x = pk2(s[0 * 68], s[1 * 68]); o.y = pk2(s[2 * 68], s[3 * 68]); o.z = pk2(s[4 * 68], s[5 * 68]); o.w = pk2(s[6 * 68], s[7 * 68]);
        if (n0 + n < Nvalid) *(u32x4*)(WT + (size_t)tr_dst_row(mode, n0 + n) * ldt + k0 + 8 * c) = o; } }
    LDS_WAIT(); asm volatile("" ::: "memory");
}
constexpr int I_E1 = 32 * 16 * 32, I_E2 = 32 * 16 * 16, N_EXPERT_ITEMS = I_E1 + I_E2;
constexpr int I_BA = 8 * 16, I_OUT = 16 * 16, I_R = 16, I_PG = 16 * 16, I_PP = 4 * 16, N_SMALL_ITEMS = I_BA + I_OUT + I_R + I_PG + I_PP;
constexpr int DC_EXPERT = N_EXPERT_ITEMS / 8, DC_SMALL = N_SMALL_ITEMS / 8, DC_WPC = 2048 / 8, DC_PB = M * PLE / 8 / 4096, DC_TOTAL = DC_EXPERT + DC_SMALL + DC_WPC + DC_PB;
__device__ __forceinline__ void deferred_chunk(const Args& a, LAS unsigned char* lds, int c, int wave, int lane) {
    unsigned char* ws = a.ws; LAS float* scr = (LAS float*)(lds + wave * 17408);
    if (c < DC_EXPERT) { int r = c * 8 + wave;
        if (r < I_E1) { const int e = r / (16 * 32), q = r % (16 * 32);
            transpose_item(a.in[I_W1] + (size_t)e * D * 2048, 2048, 2048, D, (bf16_t*)(ws + WS_W1 + (size_t)e * 2048 * D), a.in[I_N2G], 2, scr, q / 32, q % 32, lane, D, 64.0f); return; }
        r -= I_E1; { const int e = r / (16 * 16), q = r % (16 * 16);
            transpose_item(a.in[I_W2] + (size_t)e * DFF * D, D, D, DFF, (bf16_t*)(ws + WS_W2 + (size_t)e * D * DFF), nullptr, 0, scr, q / 16, q % 16, lane, DFF, 64.0f); }
        return; }
    c -= DC_EXPERT;
    if (c < DC_SMALL) { int r = c * 8 + wave;
        if (r < I_BA) { transpose_item(a.in[I_WBA], D, D, 512, (bf16_t*)(ws + WS_WPC) + 512, nullptr, 0, scr, r / 16, r % 16, lane, 1024); return; } r -= I_BA;
        if (r < I_OUT) { transpose_item(a.in[I_WOUT], D, D, D, (bf16_t*)(ws + WS_WOUT), nullptr, 0, scr, r / 16, r % 16, lane); return; } r -= I_OUT;
        if (r < I_R) { transpose_item(a.in[I_RW], NE, NE, D, (bf16_t*)(ws + WS_WR), a.in[I_N2G], 0, scr, r, 0, lane); return; } r -= I_R;
        if (r < I_PG) { transpose_item(a.in[I_PGW], D, D, D, (bf16_t*)(ws + WS_WPG), a.in[I_PNG], 0, scr, r / 16, r % 16, lane); return; } r -= I_PG;
        transpose_item(a.in[I_PPW], D, D, PLE, (bf16_t*)(ws + WS_WPP), nullptr, 0, scr, r / 16, r % 16, lane); return; }
    c -= DC_SMALL;
    if (c < DC_WPC) {
        const float* pw = a.in[I_POOLW]; const float* ps = a.in[I_POOLS]; const float* wbp = a.in[I_WBP]; bf16_t* wpc = (bf16_t*)(ws + WS_WPC);
        const int it = c * 8 + wave, gc = it >> 2, n0 = (it & 3) * 256 + lane * 4, g = gc >> 7;
        f32x4 acc = (f32x4){0.f, 0.f, 0.f, 0.f};
        const float* pwr = pw + (size_t)gc * 128; const float* psr = ps + g * 128; const float* wr_ = wbp + (size_t)(g * 128) * D + n0;
#pragma unroll 8
        for (int d = 0; d < 128; ++d) { const float av = pwr[d] * psr[d]; const f32x4 wv = *(const f32x4*)(wr_ + (size_t)d * D); acc += wv * av; }
#pragma unroll
        for (int j = 0; j < 4; ++j) wpc[(size_t)(n0 + j) * 1024 + gc] = (bf16_t)f2bf(acc[j]);
        return; }
    c -= DC_WPC;
    {
        const f32x4* p = (const f32x4*)a.in[I_P]; u32x4* pb = (u32x4*)(ws + WS_PB);
        f32x4 pv[8][2];
#pragma unroll
        for (int k = 0; k < 8; ++k) { const int i = c * 4096 + k * 512 + (int)threadIdx.x; pv[k][0] = p[2 * i]; pv[k][1] = p[2 * i + 1]; }
#pragma unroll
        for (int k = 0; k < 8; ++k) { const int i = c * 4096 + k * 512 + (int)threadIdx.x; const f32x4 v0 = pv[k][0], v1 = pv[k][1];
            u32x4 w; w.x = pk2(v0[0], v0[1]); w.y = pk2(v0[2], v0[3]); w.z = pk2(v1[0], v1[1]); w.w = pk2(v1[2], v1[3]); pb[i] = w; } }
}
__device__ __forceinline__ void p0_prologue(const Args& a, LAS unsigned char* lds, int wave, int lane, int G) {
    unsigned char* ws = a.ws;
    LAS float* scr = (LAS float*)(lds + wave * 17408);
    const int gw = blockIdx.x * NWAVES + wave, NGW = G * NWAVES;
    for (int it = gw; it < 16 * 62; it += NGW) transpose_item(a.in[I_WIN], IN_COLS, IN_COLS, D, (bf16_t*)(ws + WS_WIN), a.in[I_N1G], 1, scr, it / 62, it % 62, lane);
    for (int c = DC_EXPERT + (int)blockIdx.x; c < DC_TOTAL; c += G) { deferred_chunk(a, lds, c, wave, lane); __syncthreads(); }
    { const int gt = blockIdx.x * NTHREADS + threadIdx.x, NT = G * NTHREADS; u32x4* z = (u32x4*)((bf16_t*)(ws + WS_WIN) + (size_t)1864 * D);
      for (int i = gt; i < 184 * D * 2 / 16; i += NT) z[i] = (u32x4){0u, 0u, 0u, 0u}; }
    { const float* x = a.in[I_X]; bf16_t* xb = (bf16_t*)(ws + WS_R2); float* rs1 = (float*)(ws + WS_RS1);
      for (int m0 = gw; m0 < M; m0 += 2 * NGW) { f32x4 v[2][4];
#pragma unroll
        for (int r = 0; r < 2; ++r) { const int m = m0 + r * NGW; if (m < M) { const f32x4* xr = (const f32x4*)(x + (size_t)m * D) + lane;
#pragma unroll
            for (int j = 0; j < 4; ++j) v[r][j] = xr[64 * j]; } }
#pragma unroll
        for (int r = 0; r < 2; ++r) { const int m = m0 + r * NGW; if (m < M) { float s = 0.f;
#pragma unroll
            for (int j = 0; j < 4; ++j) s += (v[r][j][0] * v[r][j][0] + v[r][j][1] * v[r][j][1]) + (v[r][j][2] * v[r][j][2] + v[r][j][3] * v[r][j][3]);
            s = wave_sum(s); if (lane == 0) rs1[m] = rsqrtf(s * (1.0f / D) + RMS_EPS);
            u32x2* o = (u32x2*)(xb + (size_t)m * D) + lane;
#pragma unroll
            for (int j = 0; j < 4; ++j) { u32x2 w; w.x = pk2(v[r][j][0], v[r][j][1]); w.y = pk2(v[r][j][2], v[r][j][3]); o[64 * j] = w; } } } } }
}

template <int W>
__device__ __forceinline__ void mixed_item(const bf16_t* ub, bf16_t* mixed, int tok, int c8) {
    const int t = tok & (SEQ - 1); const int nw = (t + 1) < W ? (t + 1) : W;
    u32x4 v[W];
#pragma unroll
    for (int i = 0; i < W; ++i) { const int ii = i < nw ? i : 0; v[i] = *(const u32x4*)(ub + (size_t)(tok - ii) * 512 + c8 * 8); }
    float s[8], cur[8];
#pragma unroll
    for (int j = 0; j < 8; ++j) { s[j] = 0.f; cur[j] = 0.f; }
#pragma unroll
    for (int i = 0; i < W; ++i) { const float mk = i < nw ? 1.0f : 0.0f;
        const float f[8] = {bf_lo(v[i].x), bf_hi(v[i].x), bf_lo(v[i].y), bf_hi(v[i].y), bf_lo(v[i].z), bf_hi(v[i].z), bf_lo(v[i].w), bf_hi(v[i].w)};
#pragma unroll
        for (int j = 0; j < 8; ++j) { s[j] = fmaf(f[j], mk, s[j]); if (i == 0) cur[j] = f[j]; } }
    const float inv = 1.0f / (float)nw;
    u32x4 o; o.x = pk2(s[0] * inv - cur[0], s[1] * inv - cur[1]); o.y = pk2(s[2] * inv - cur[2], s[3] * inv - cur[3]);
    o.z = pk2(s[4] * inv - cur[4], s[5] * inv - cur[5]); o.w = pk2(s[6] * inv - cur[6], s[7] * inv - cur[7]);
    *(u32x4*)(mixed + (size_t)tok * 1024 + c8 * 8) = o;
}
__device__ __forceinline__ void p2_mixed(const bf16_t* ub, bf16_t* mixed, int G) {
    const int ln = threadIdx.x & 63, gw = blockIdx.x * NWAVES + (int)(threadIdx.x >> 6), NGW = G * NWAVES;
    int k = 0;
    for (int P = gw; P < M; P += NGW, ++k) {
        const int g = __builtin_amdgcn_readfirstlane((P + k) & 3), tok = (P >> 2) * 4 + (ln >> 4), c8 = g * 16 + (ln & 15);
        if (g == 0) mixed_item<2>(ub, mixed, tok, c8); else if (g == 1) mixed_item<4>(ub, mixed, tok, c8); else if (g == 2) mixed_item<8>(ub, mixed, tok, c8); else mixed_item<16>(ub, mixed, tok, c8);
    }
}

__device__ __forceinline__ unsigned lds_atomic_inc(LAS unsigned* p) { return __hip_atomic_fetch_add(p, 1u, __ATOMIC_RELAXED, __HIP_MEMORY_SCOPE_WORKGROUP); }
__device__ __forceinline__ void prune_token(LAS unsigned* L, LAS unsigned* H, const LAS unsigned* cntin, LAS unsigned* cntp, LAS unsigned* thrp, int lane) {
    const int n = __builtin_amdgcn_readfirstlane((int)*cntin);
    unsigned prefix = 0u; unsigned want = 256u;
#pragma unroll
    for (int p = 0; p < 4; ++p) {
        const int shift = 24 - 8 * p;
        *(LAS u32x4*)(H + 4 * lane) = (u32x4){0u, 0u, 0u, 0u};
        for (int i = lane; i < n; i += 64) { const unsigned e = L[i];
            bool match = true; if (p > 0) match = ((e ^ prefix) >> ((shift + 8) & 31)) == 0u;
            if (match) (void)lds_atomic_inc(H + ((e >> shift) & 255u)); }
        const u32x4 c = *(LAS u32x4*)(H + 4 * lane);
        const unsigned T = c.x + c.y + c.z + c.w; unsigned suf = T;
#pragma unroll
        for (int off = 1; off < 64; off <<= 1) { const unsigned v = (unsigned)__shfl_down((int)suf, off); if (lane + off < 64) suf += v; }
        const unsigned sufex = suf - T;
        const bool found = (sufex < want) && (want <= suf);
        unsigned run = sufex; int d = 0; unsigned nw = 0u; bool got = false;
        if (!got && run + c.w >= want) { d = 4 * lane + 3; nw = want - run; got = true; } run += c.w;
        if (!got && run + c.z >= want) { d = 4 * lane + 2; nw = want - run; got = true; } run += c.z;
        if (!got && run + c.y >= want) { d = 4 * lane + 1; nw = want - run; got = true; } run += c.y;
        if (!got && run + c.x >= want) { d = 4 * lane + 0; nw = want - run; got = true; }
        const unsigned long long fm = __ballot(found);
        const int src = fm ? (__ffsll((long long)fm) - 1) : 0;
        d = __shfl(d, src); want = (unsigned)__shfl((int)nw, src);
        prefix |= (unsigned)d << shift;
    }
    int newn = 0;
    for (int base = 0; base < n; base += 64) { const int i = base + lane; const unsigned e = (i < n) ? L[i] : 0u; const bool keep = (i < n) && (e >= prefix);
        const unsigned long long mk = __ballot(keep);
        const int pos = newn + (int)__builtin_amdgcn_mbcnt_hi((unsigned)(mk >> 32), __builtin_amdgcn_mbcnt_lo((unsigned)mk, 0u));
        if (keep) L[pos] = e;
        newn += __popcll(mk); }
    if (lane == 0) { *cntp = (unsigned)newn; *thrp = prefix; }
}

template <int CTRL> __device__ __forceinline__ unsigned dpp0(unsigned v) { return (unsigned)__builtin_amdgcn_update_dpp(0, (int)v, CTRL, 0xf, 0xf, true); }
__device__ __forceinline__ unsigned wave_min_u32(unsigned v) {
    v = min(v, (unsigned)__builtin_amdgcn_update_dpp((int)v, (int)v, 0x128, 0xf, 0xf, false)); v = min(v, (unsigned)__builtin_amdgcn_update_dpp((int)v, (int)v, 0x124, 0xf, 0xf, false));
    v = min(v, (unsigned)__builtin_amdgcn_update_dpp((int)v, (int)v, 0x122, 0xf, 0xf, false)); v = min(v, (unsigned)__builtin_amdgcn_update_dpp((int)v, (int)v, 0x121, 0xf, 0xf, false));
    const unsigned a = __builtin_amdgcn_readlane((int)v, 0), b = __builtin_amdgcn_readlane((int)v, 16), c = __builtin_amdgcn_readlane((int)v, 32), d = __builtin_amdgcn_readlane((int)v, 48);
    return min(min(a, b), min(c, d));
}
__device__ __forceinline__ unsigned wave_max_u32(unsigned v) { return ~wave_min_u32(~v); }
__device__ __forceinline__ unsigned wave_prefix_incl(unsigned v, int lane) {
    v += dpp0<0x111>(v); v += dpp0<0x112>(v); v += dpp0<0x114>(v); v += dpp0<0x118>(v);
    const unsigned r0 = __builtin_amdgcn_readlane((int)v, 15), r1 = __builtin_amdgcn_readlane((int)v, 31), r2 = __builtin_amdgcn_readlane((int)v, 47);
    const int row = lane >> 4;
    return v + (row >= 1 ? r0 : 0u) + (row >= 2 ? r1 : 0u) + (row >= 3 ? r2 : 0u);
}
template <int FULLROWS>
__device__ __forceinline__ void prune_approx(LAS unsigned* L, LAS unsigned* H, const LAS unsigned* cntin, LAS unsigned* cntp, LAS unsigned* thrp, int lane) {
    const int n = __builtin_amdgcn_readfirstlane((int)*cntin);
    const unsigned tlo = (unsigned)__builtin_amdgcn_readfirstlane((int)*thrp);
    unsigned e[8]; unsigned mxv = 0u;
#pragma unroll
    for (int k = 0; k < 8; ++k) { unsigned v = L[lane + 64 * k]; if (k >= FULLROWS) v = (lane + 64 * k < n) ? v : 0u; e[k] = v; mxv = max(mxv, v); }
    mxv = wave_max_u32(mxv);
    unsigned mn = tlo;
    if (tlo == 0u) {
        unsigned m = 0xFFFFFFFFu;
#pragma unroll
        for (int k = 0; k < 8; ++k) m = (k >= FULLROWS && e[k] == 0u) ? m : min(m, e[k]);
        mn = wave_min_u32(m);
    }
    const unsigned range = mxv - mn;
    const int hb = 31 - __builtin_clz(range | 1u);
    const int shift = hb > 7 ? hb - 7 : 0;
    *(LAS u32x4*)(H + 4 * lane) = (u32x4){0u, 0u, 0u, 0u};
#pragma unroll
    for (int k = 0; k < 8; ++k) if (k < FULLROWS || e[k] != 0u) (void)lds_atomic_inc(H + ((e[k] - mn) >> shift));
    const u32x4 c = *(LAS u32x4*)(H + 4 * lane);
    const unsigned T = c.x + c.y + c.z + c.w;
    const unsigned pin = wave_prefix_incl(T, lane);
    const unsigned tot = (unsigned)__builtin_amdgcn_readlane((int)pin, 63);
    const unsigned sufex = tot - pin;
    const unsigned suf = sufex + T;
    const bool found = (sufex < 256u) && (256u <= suf);
    unsigned run = sufex; int d = 0; bool got = false;
    if (!got && run + c.w >= 256u) { d = 4 * lane + 3; got = true; } run += c.w;
    if (!got && run + c.z >= 256u) { d = 4 * lane + 2; got = true; } run += c.z;
    if (!got && run + c.y >= 256u) { d = 4 * lane + 1; got = true; } run += c.y;
    if (!got && run + c.x >= 256u) { d = 4 * lane + 0; got = true; }
    const unsigned long long fm = __ballot(found);
    const int src = fm ? (__ffsll((long long)fm) - 1) : 0;
    d = __builtin_amdgcn_readlane(d, src);
    unsigned thr = mn + ((unsigned)d << shift);
    thr = thr ? thr : 1u;
    int newn = 0;
#pragma unroll
    for (int k = 0; k < 8; ++k) { const bool keep = e[k] >= thr;
        const unsigned long long mk = __ballot(keep);
        const int pos = newn + (int)__builtin_amdgcn_mbcnt_hi((unsigned)(mk >> 32), __builtin_amdgcn_mbcnt_lo((unsigned)mk, 0u));
        if (keep) L[pos] = e[k];
        newn += __popcll(mk); }
    if (lane == 0) { *cntp = (unsigned)newn; *thrp = thr - 1u; }
}

__device__ __forceinline__ void prune_excess(LAS unsigned* L, LAS unsigned* cntp, int lane) {
    const int n = __builtin_amdgcn_readfirstlane((int)*cntp);
    unsigned e[5];
#pragma unroll
    for (int k = 0; k < 5; ++k) { const int i = lane + 64 * k; const unsigned v = L[i]; e[k] = (i < n) ? v : 0xFFFFFFFFu; }
    for (int r = n - 256; r > 0; --r) {
        unsigned m = min(min(e[0], e[1]), min(min(e[2], e[3]), e[4]));
        m = wave_min_u32(m);
#pragma unroll
        for (int k = 0; k < 5; ++k) e[k] = (e[k] == m) ? 0xFFFFFFFFu : e[k];
    }
    int newn = 0;
#pragma unroll
    for (int k = 0; k < 5; ++k) { const bool keep = e[k] != 0xFFFFFFFFu;
        const unsigned long long mk = __ballot(keep);
        const int pos = newn + (int)__builtin_amdgcn_mbcnt_hi((unsigned)(mk >> 32), __builtin_amdgcn_mbcnt_lo((unsigned)mk, 0u));
        if (keep) L[pos] = e[k];
        newn += __popcll(mk); }
    if (lane == 0) *cntp = (unsigned)newn;
}

template <bool DIAG>
__device__ __forceinline__ void score_tile(LAS unsigned char* lds, const LAS unsigned char* kbuf, const bf16x8 (&afr)[2][4], const float (&wq)[2][16], unsigned (&cn)[2][2], const unsigned (&th)[2][2],
                                           int kt, int t0, int wave, int hf, int l31, unsigned lmask, unsigned trash) {
    bf16x8 bfr[2][4];
#pragma unroll
    for (int kh = 0; kh < 2; ++kh) { const int keyrow = kh * 32 + l31;
#pragma unroll
        for (int ks = 0; ks < 4; ++ks) bfr[kh][ks] = *(const LAS bf16x8*)(kbuf + keyrow * 128 + (((ks * 2 + hf) ^ ((keyrow >> 1) & 7)) * 16)); }
    f32x16 accs[2][2];
#pragma unroll
    for (int kh = 0; kh < 2; ++kh)
#pragma unroll
        for (int rt = 0; rt < 2; ++rt) {
#pragma unroll
            for (int j = 0; j < 16; ++j) accs[kh][rt][j] = 0.f;
#pragma unroll
            for (int ks = 0; ks < 4; ++ks) accs[kh][rt] = __builtin_amdgcn_mfma_f32_32x32x16_bf16(afr[rt][ks], bfr[kh][ks], accs[kh][rt], 0, 0, 0);
        }
#pragma unroll
    for (int kh = 0; kh < 2; ++kh) {
        const int keypos = kt * 64 + kh * 32 + l31;
        const unsigned idxbits = (unsigned)(16383 - keypos);
#pragma unroll
        for (int rt = 0; rt < 2; ++rt) {
#pragma unroll
            for (int ts = 0; ts < 2; ++ts) {
                float s = 0.f;
#pragma unroll
                for (int hd = 0; hd < 8; ++hd) s = fmaf(__builtin_amdgcn_fmed3f(accs[kh][rt][8 * ts + hd], 0.f, 3.0e38f), wq[rt][8 * ts + hd], s);
                const unsigned ub = __builtin_bit_cast(unsigned, s);
                const unsigned srt = ub ^ ((unsigned)((int)ub >> 31) | 0x80000000u);
                const unsigned packed = (srt & 0xFFFFC000u) | idxbits;
                const int tl = 4 * rt + 2 * hf + ts;
                bool pass = packed > th[rt][ts];
                if (DIAG) pass = pass && (keypos <= t0 + wave * 8 + tl);
                const unsigned long long mk = __builtin_amdgcn_ballot_w64(pass);
                const unsigned mine = hf ? (unsigned)(mk >> 32) : (unsigned)mk;
                const unsigned pre = __popc(mine & lmask);
                const unsigned addr = pass ? (unsigned)((wave * 8 + tl) * 2048) + (cn[rt][ts] + pre) * 4u : trash;
                *(LAS unsigned*)(lds + addr) = packed;
                cn[rt][ts] += __popc(mine);
            }
        }
    }
}

__device__ __forceinline__ void p4_attention(const unsigned char* pj, bf16_t* attn_out, unsigned* queue, int* seldbg, LAS unsigned char* lds, int wave, int lane) {
    const bf16_t* qb_ = (const bf16_t*)(pj + PJ_Q); const unsigned char* kv8 = pj + PJ_KV; const bf16_t* qib = (const bf16_t*)(pj + PJ_QI); const bf16_t* kwb = (const bf16_t*)(pj + PJ_KW);
    LAS unsigned* cnt_l = (LAS unsigned*)(lds + LDS_ATM);
    LAS unsigned* thr_l = cnt_l + 64;
    LAS unsigned* unit_l = cnt_l + 128;
    LAS unsigned* pflag = cnt_l + 132;
    LAS unsigned* wl_ctl = cnt_l + 136;
    LAS unsigned* cnt2 = cnt_l + 144;
    LAS unsigned* H = (LAS unsigned*)(lds + LDS_HIST) + wave * 256;
    const int tid = threadIdx.x, hf = lane >> 5, l31 = lane & 31;
    for (;;) {
        if (tid == 0) { const unsigned pref = xb_xcc_id() & 1u;
            unsigned uu = atomicAdd(queue + 64 * pref, 1u), bb = pref;
            if (uu >= 256u) { uu = atomicAdd(queue + 64 * (pref ^ 1u), 1u); bb = pref ^ 1u; }
            *unit_l = (uu >= 256u) ? 0xFFFFu : (uu * 2u + bb); pflag[0] = 0u; pflag[1] = 0u; wl_ctl[0] = 0u; wl_ctl[1] = 0u; }
        __syncthreads();
        const int u = __builtin_amdgcn_readfirstlane((int)*unit_l);
        __syncthreads();
        if (u >= 512) break;
        const int qb = 255 - (u >> 1), b = u & 1, t0 = qb * 64, rowbase = b * SEQ;
        if (lane < 8) { cnt_l[wave * 8 + lane] = 0u; thr_l[wave * 8 + lane] = 0u; }
        bf16x8 afr[2][4]; float wq[2][16];
#pragma unroll
        for (int rt = 0; rt < 2; ++rt) {
            const int m = l31, hd = (m & 3) + 4 * ((m >> 3) & 1), tl = 4 * rt + 2 * ((m >> 2) & 1) + (m >> 4);
            const bf16_t* qp = qib + (size_t)(rowbase + t0 + wave * 8 + tl) * 512 + hd * 64 + hf * 8;
#pragma unroll
            for (int ks = 0; ks < 4; ++ks) afr[rt][ks] = *(const bf16x8*)(qp + ks * 16);
#pragma unroll
            for (int ts = 0; ts < 2; ++ts) { const int tl2 = 4 * rt + 2 * hf + ts;
                const u32x4 wv = *(const u32x4*)(kwb + (size_t)(rowbase + t0 + wave * 8 + tl2) * 128 + 64);
                wq[rt][8 * ts + 0] = bf_lo(wv.x); wq[rt][8 * ts + 1] = bf_hi(wv.x); wq[rt][8 * ts + 2] = bf_lo(wv.y); wq[rt][8 * ts + 3] = bf_hi(wv.y);
                wq[rt][8 * ts + 4] = bf_lo(wv.z); wq[rt][8 * ts + 5] = bf_hi(wv.z); wq[rt][8 * ts + 6] = bf_lo(wv.w); wq[rt][8 * ts + 7] = bf_hi(wv.w); }
        }
#pragma unroll
        for (int rt = 0; rt < 2; ++rt) {
#pragma unroll
            for (int ks = 0; ks < 4; ++ks) asm volatile("" : "+v"(afr[rt][ks]));
#pragma unroll
            for (int j = 0; j < 16; ++j) asm volatile("" : "+v"(wq[rt][j]));
        }
        const int ntile = qb + 1;
        const int skey = tid >> 3, sch = tid & 7;
        const int sdst = skey * 128 + ((sch ^ ((skey >> 1) & 7)) * 16);
        u32x4 stg = *(const u32x4*)(kwb + (size_t)(rowbase + skey) * 128 + sch * 8);
        unsigned cn[2][2], th[2][2];
        const unsigned lmask = (1u << l31) - 1u, trash = (unsigned)(LDS_HIST + wave * 1024 + lane * 4);
#pragma unroll
        for (int rt = 0; rt < 2; ++rt)
#pragma unroll
            for (int ts = 0; ts < 2; ++ts) { cn[rt][ts] = 0u; th[rt][ts] = 0u; }
        for (int kt = 0; kt < ntile; ++kt) {
            LAS unsigned char* kbuf = lds + LDS_KT + (kt & 1) * 8192;
            *(LAS u32x4*)(kbuf + sdst) = stg;
            __syncthreads();
            if (kt + 1 < ntile) stg = *(const u32x4*)(kwb + (size_t)(rowbase + (kt + 1) * 64 + skey) * 128 + sch * 8);
            if (kt > 0 && __builtin_amdgcn_readfirstlane((int)pflag[(kt - 1) & 1]) == kt) {
                const unsigned long long jm = __ballot(cnt_l[lane] > 400u);
                { unsigned long long m = jm;
                  for (int ti = 0; m != 0ull; ++ti) { const int id = __ffsll((long long)m) - 1; m &= m - 1ull;
                    if ((ti & 7) == wave) {
                        prune_approx<6>((LAS unsigned*)(lds + id * 2048), H, cnt_l + id, cnt2 + id, thr_l + id, lane);
                        if (__builtin_amdgcn_readfirstlane((int)cnt2[id]) > 320) prune_token((LAS unsigned*)(lds + id * 2048), H, cnt2 + id, cnt2 + id, thr_l + id, lane);
                    } } }
                __syncthreads();
#pragma unroll
                for (int rt = 0; rt < 2; ++rt)
#pragma unroll
                    for (int ts = 0; ts < 2; ++ts) { const int tl = 4 * rt + 2 * hf + ts;
                        if ((jm >> (wave * 8 + tl)) & 1ull) { cn[rt][ts] = cnt2[wave * 8 + tl]; th[rt][ts] = thr_l[wave * 8 + tl]; } }
            }
            if (kt + 1 < ntile) score_tile<false>(lds, kbuf, afr, wq, cn, th, kt, t0, wave, hf, l31, lmask, trash);
            else                score_tile<true>(lds, kbuf, afr, wq, cn, th, kt, t0, wave, hf, l31, lmask, trash);
            bool need = false;
#pragma unroll
            for (int rt = 0; rt < 2; ++rt)
#pragma unroll
                for (int ts = 0; ts < 2; ++ts) { const int tl = 4 * rt + 2 * hf + ts; if (l31 == 0) cnt_l[wave * 8 + tl] = cn[rt][ts]; need |= cn[rt][ts] > 448u; }
            if (__ballot(need) != 0ull) { if (lane == 0) pflag[kt & 1] = (unsigned)(kt + 1); }
        }
        for (int tl = 0; tl < 8; ++tl) {
            const unsigned c = cnt_l[wave * 8 + tl];
            if (__builtin_amdgcn_readfirstlane((int)c) > 256) {
                LAS unsigned* Lt = (LAS unsigned*)(lds + (wave * 8 + tl) * 2048);
                prune_approx<4>(Lt, H, cnt_l + wave * 8 + tl, cnt_l + wave * 8 + tl, thr_l + wave * 8 + tl, lane);
                const int n2 = __builtin_amdgcn_readfirstlane((int)cnt_l[wave * 8 + tl]);
                if (n2 > 304) prune_token(Lt, H, cnt_l + wave * 8 + tl, cnt_l + wave * 8 + tl, thr_l + wave * 8 + tl, lane);
                else if (n2 > 256) prune_excess(Lt, cnt_l + wave * 8 + tl, lane);
            }
        }
        const int c15 = lane & 15, g4 = lane >> 4;
        for (int tl = 0; tl < 8; ++tl) {
            const int n = __builtin_amdgcn_readfirstlane((int)cnt_l[wave * 8 + tl]);
            const LAS unsigned* L = (const LAS unsigned*)(lds + (wave * 8 + tl) * 2048);
            const int tokrow = rowbase + t0 + wave * 8 + tl;
            const LAS unsigned* Lc = L + c15; const int nc = n - c15, n4 = n - 4 * g4;
#if DBG
            if (seldbg) for (int i = lane; i < 256; i += 64) seldbg[(size_t)tokrow * 256 + i] = (i < n) ? (int)(16383u - (L[i] & 16383u)) : -1;
#endif
            long bq[4];
#pragma unroll
            for (int ks = 0; ks < 4; ++ks) { const bool ok = (c15 < 8) && ((c15 >> 2) == (g4 >> 1));
                const u32x4 v = *(const u32x4*)(qb_ + (size_t)tokrow * 512 + (c15 & 7) * 64 + (g4 & 1) * 32 + ks * 8);
                const unsigned w0 = pk4_fp8(bf_lo(v.x), bf_hi(v.x), bf_lo(v.y), bf_hi(v.y)), w1 = pk4_fp8(bf_lo(v.z), bf_hi(v.z), bf_lo(v.w), bf_hi(v.w));
                bq[ks] = ok ? (long)(((unsigned long long)w1 << 32) | w0) : 0l; }
            f32x4 S[16];
            u32x4 kq[2][4][2];
#define LOAD_KGROUP(buf, grp) do { _Pragma("unroll") for (int tt = 0; tt < 4; ++tt) { const int T_ = (grp) * 4 + tt; const unsigned e_ = Lc[T_ * 16]; \
                const int kp_ = (T_ * 16 < nc) ? (int)(16383u - (e_ & 16383u)) : 0; \
                const unsigned char* kr_ = kv8 + (size_t)(rowbase + kp_) * 256 + g4 * 32;     \
                kq[buf][tt][0] = *(const u32x4*)kr_; kq[buf][tt][1] = *(const u32x4*)(kr_ + 16); } } while (0)
            LOAD_KGROUP(0, 0); LOAD_KGROUP(1, 1);
#pragma unroll
            for (int grp = 0; grp < 4; ++grp) {
#pragma unroll
                for (int tt = 0; tt < 4; ++tt) { const int T = grp * 4 + tt; const u32x4 k0 = kq[grp & 1][tt][0], k1 = kq[grp & 1][tt][1];
                    f32x4 sacc = (f32x4){0.f, 0.f, 0.f, 0.f};
                    sacc = __builtin_amdgcn_mfma_f32_16x16x32_fp8_fp8((long)(((unsigned long long)k0.y << 32) | k0.x), bq[0], sacc, 0, 0, 0);
                    sacc = __builtin_amdgcn_mfma_f32_16x16x32_fp8_fp8((long)(((unsigned long long)k0.w << 32) | k0.z), bq[1], sacc, 0, 0, 0);
                    sacc = __builtin_amdgcn_mfma_f32_16x16x32_fp8_fp8((long)(((unsigned long long)k1.y << 32) | k1.x), bq[2], sacc, 0, 0, 0);
                    sacc = __builtin_amdgcn_mfma_f32_16x16x32_fp8_fp8((long)(((unsigned long long)k1.w << 32) | k1.z), bq[3], sacc, 0, 0, 0);
                    if (n < 256) {
#pragma unroll
                        for (int j = 0; j < 4; ++j) if (T * 16 + j >= n4) sacc[j] = -1e30f; }
                    S[T] = sacc; }
                if (grp < 2) { if (grp == 0) LOAD_KGROUP(0, 2); else LOAD_KGROUP(1, 3); }
                asm volatile("" ::: "memory");
            }
#undef LOAD_KGROUP
            const LAS unsigned* Lh = L + (lane >> 3); const int nh = n - (lane >> 3);
            const int vwr = (wave * 8 + (lane >> 5)) * 2048 + 1024 + ((lane >> 3) & 3) * 160 + (lane >> 5) * 16 + (lane & 7) * 16;
            u32x4 vvA[4], vvB[4];
#pragma unroll
            for (int q = 0; q < 4; ++q) { const unsigned e = Lh[8 * q];
                const int kp = (8 * q < nh) ? (int)(16383u - (e & 16383u)) : 0;
                vvA[q] = *(const u32x4*)(kv8 + (size_t)(rowbase + kp) * 256 + 128 + (lane & 7) * 16); }
#pragma unroll
            for (int q = 0; q < 4; ++q) { const unsigned e = Lh[32 + 8 * q];
                const int kp = (32 + 8 * q < nh) ? (int)(16383u - (e & 16383u)) : 0;
                vvB[q] = *(const u32x4*)(kv8 + (size_t)(rowbase + kp) * 256 + 128 + (lane & 7) * 16); }
            float mx = -1e30f;
#pragma unroll
            for (int T = 0; T < 16; ++T)
#pragma unroll
                for (int j = 0; j < 4; ++j) mx = fmaxf(mx, S[T][j]);
            mx = fmaxf(mx, __shfl_xor(mx, 16)); mx = fmaxf(mx, __shfl_xor(mx, 32));
            float sum = 0.f; unsigned P8[16];
            const float mxl = (mx - 5.545177444f) * 1.44269504089f;
#pragma unroll
            for (int T = 0; T < 16; ++T) { f32x4 pv;
#pragma unroll
                for (int j = 0; j < 4; ++j) { pv[j] = __builtin_amdgcn_exp2f(fmaf(S[T][j], 1.44269504089f, -mxl)); sum += pv[j]; }
                int w = __builtin_amdgcn_cvt_pk_fp8_f32(pv[0], pv[1], 0, false); w = __builtin_amdgcn_cvt_pk_fp8_f32(pv[2], pv[3], w, true); P8[T] = (unsigned)w; }
            sum += __shfl_xor(sum, 16); sum += __shfl_xor(sum, 32);
            const float inv = 1.0f / sum;
            float invh[4];
#pragma unroll
            for (int j = 0; j < 4; ++j) invh[j] = __shfl(inv, 4 * (g4 & 1) + j);
            f32x4 O[8];
#pragma unroll
            for (int dt = 0; dt < 8; ++dt) O[dt] = (f32x4){0.f, 0.f, 0.f, 0.f};
            typedef int i2v __attribute__((ext_vector_type(2)));
            const LAS unsigned char* vtr = lds + (wave * 8 + g4 + 4 * ((lane & 15) >> 3)) * 2048 + 1024 + (((lane & 15) >> 1) & 3) * 160 + ((lane & 15) >> 3) * 128 + (g4 & 1) * 16 + (lane & 1) * 8;
#pragma unroll
            for (int ch = 0; ch < 8; ++ch) {
                u32x4 (&vv)[4] = (ch & 1) ? vvB : vvA;
#pragma unroll
                for (int q = 0; q < 4; ++q) *(LAS u32x4*)(lds + vwr + q * 4096 + (q >> 1) * 128) = vv[q];
                if (ch < 6) {
#pragma unroll
                    for (int q = 0; q < 4; ++q) { const unsigned e = Lh[(ch + 2) * 32 + 8 * q];
                        const int kp = ((ch + 2) * 32 + 8 * q < nh) ? (int)(16383u - (e & 16383u)) : 0;
                        vv[q] = *(const u32x4*)(kv8 + (size_t)(rowbase + kp) * 256 + 128 + (lane & 7) * 16); }
                }
                const long pf = (long)(((unsigned long long)P8[2 * ch + 1] << 32) | P8[2 * ch]);
#pragma unroll
                for (int dt = 0; dt < 8; ++dt) {
                    const i2v vt = __builtin_amdgcn_ds_read_tr8_b64_v2i32((LAS i2v*)(vtr + dt * 16));
                    O[dt] = __builtin_amdgcn_mfma_f32_16x16x32_fp8_fp8(pf, __builtin_bit_cast(long, vt), O[dt], 0, 0, 0);
                }
                asm volatile("" ::: "memory");
            }
            if (g4 < 2) {
#pragma unroll
                for (int j = 0; j < 4; ++j) {
                    const f32x4 o4 = g4 ? (f32x4){O[4][j], O[5][j], O[6][j], O[7][j]} : (f32x4){O[0][j], O[1][j], O[2][j], O[3][j]};
                    u32x2 w; w.x = pk2(o4[0] * invh[j], o4[1] * invh[j]); w.y = pk2(o4[2] * invh[j], o4[3] * invh[j]);
                    *(u32x2*)(attn_out + (size_t)tokrow * 1024 + (4 * g4 + j) * 64 + 4 * c15) = w;
                }
            }
        }
    }
}

__device__ __forceinline__ void p7_router(const Args& a, LAS unsigned char* lds, int wave, int lane, int G) {
    unsigned char* ws = a.ws;
    const bf16_t* x1b = (const bf16_t*)(ws + WS_X1B); const bf16_t* wr = (const bf16_t*)(ws + WS_WR);
    const float* ss2 = (const float*)(ws + CTLB_SS2); const float* rb = a.in[I_RB];
    int* topi = (int*)(ws + WS_TOPI); float* topg = (float*)(ws + WS_TOPG); int* lrank = (int*)(ws + WS_LRANK); int* cntwg = (int*)(ws + CTLB_CNTWG);
    LAS unsigned* wcnt = (LAS unsigned*)(lds + LDS_MISC + 64);
    if (threadIdx.x < 32) wcnt[threadIdx.x] = 0u;
    __syncthreads();
    LAS float* lg = (LAS float*)(lds + wave * 4096);
    const int c15 = lane & 15, g4 = lane >> 4;
    for (int tile = blockIdx.x * NWAVES + wave; tile < M / 16; tile += G * NWAVES) {
        const int tok0 = tile * 16;
        f32x4 a0 = (f32x4){0.f, 0.f, 0.f, 0.f}, a1 = a0;
        const bf16_t* ap = x1b + (size_t)(tok0 + c15) * D + g4 * 8; const bf16_t* bp0 = wr + (size_t)c15 * D + g4 * 8; const bf16_t* bp1 = bp0 + 16 * D;
#pragma unroll 8
        for (int ks = 0; ks < 32; ++ks) { const bf16x8 av = *(const bf16x8*)(ap + ks * 32), b0 = *(const bf16x8*)(bp0 + ks * 32), b1 = *(const bf16x8*)(bp1 + ks * 32);
            a0 = __builtin_amdgcn_mfma_f32_16x16x32_bf16(av, b0, a0, 0, 0, 0); a1 = __builtin_amdgcn_mfma_f32_16x16x32_bf16(av, b1, a1, 0, 0, 0); }
#pragma unroll
        for (int j = 0; j < 4; ++j) { lg[(4 * g4 + j) * 33 + c15] = a0[j]; lg[(4 * g4 + j) * 33 + 16 + c15] = a1[j]; }
        LDS_WAIT(); asm volatile("" ::: "memory");
        if (lane < 16) {
            const int tok = tok0 + lane; const float rs = rsqrtf(ss2[tok] * (1.0f / D) + RMS_EPS);
            float v[32];
#pragma unroll
            for (int e = 0; e < 32; ++e) v[e] = lg[lane * 33 + e] * rs + rb[e];
            int bi[4]; float bv[4];
#pragma unroll
            for (int r = 0; r < 4; ++r) { float best = -3.0e38f; int bidx = 0;
#pragma unroll
                for (int e = 0; e < 32; ++e) { bool used = false;
#pragma unroll
                    for (int q = 0; q < 4; ++q) if (q < r && bi[q] == e) used = true;
                    if (!used && v[e] > best) { best = v[e]; bidx = e; } }
                bi[r] = bidx; bv[r] = best; }
            float ex[4], se = 0.f;
#pragma unroll
            for (int r = 0; r < 4; ++r) { ex[r] = __expf(bv[r] - bv[0]); se += ex[r]; }
            const float inv = 1.0f / se;
#pragma unroll
            for (int r = 0; r < 4; ++r) { topi[tok * 4 + r] = bi[r]; topg[tok * 4 + r] = ex[r] * inv; lrank[tok * 4 + r] = (int)lds_atomic_inc(wcnt + bi[r]); }
        }
        LDS_WAIT(); asm volatile("" ::: "memory");
    }
    __syncthreads();
    if (threadIdx.x < 32) cntwg[blockIdx.x * 32 + threadIdx.x] = (int)wcnt[threadIdx.x];
}

__device__ __forceinline__ void p8_scatter(const Args& a, LAS unsigned char* lds, int wave, int lane, int G) {
    unsigned char* ws = a.ws;
    const int* cntwg = (const int*)(ws + CTLB_CNTWG); const int* topi = (const int*)(ws + WS_TOPI); const float* topg = (const float*)(ws + WS_TOPG);
    const int* lrank = (const int*)(ws + WS_LRANK); int* posof = (int*)(ws + WS_POSOF); int* rowmap = (int*)(ws + WS_ROWMAP); float* rowgate = (float*)(ws + WS_ROWGATE);
    int* tile_e = (int*)(ws + CTLB_TILEE); int* meta = (int*)(ws + CTLB_META); float* rowscale = (float*)(ws + WS_ROWSCALE);
    LAS int* part = (LAS int*)(lds);
    LAS int* tot = (LAS int*)(lds + 8192);
    LAS int* pre = tot + 32;
    LAS int* base = tot + 64;
    const int tid = threadIdx.x, e = tid & 31, pt = tid >> 5, myw = blockIdx.x;
    int sall = 0, spre = 0;
#pragma unroll 8
    for (int w = pt; w < G; w += 16) { const int v = cntwg[w * 32 + e]; sall += v; spre += (w < myw) ? v : 0; }
    part[pt * 32 + e] = sall; part[512 + pt * 32 + e] = spre;
    __syncthreads();
    if (tid < 32) { int s0 = 0, s1 = 0;
#pragma unroll
        for (int q = 0; q < 16; ++q) { s0 += part[q * 32 + tid]; s1 += part[512 + q * 32 + tid]; }
        tot[tid] = s0; pre[tid] = s1; }
    __syncthreads();
    if (tid == 0) { int bsum = 0; for (int q = 0; q < 32; ++q) { base[q] = bsum; bsum += (tot[q] + 255) & ~255; } base[32] = bsum; }
    __syncthreads();
    for (int tile = blockIdx.x * NWAVES + wave; tile < M / 16; tile += G * NWAVES) {
        const int idx = tile * 64 + lane; const int ex = topi[idx];
        const int pos = base[ex] + pre[ex] + lrank[idx];
        rowmap[pos] = idx >> 2; rowgate[pos] = topg[idx]; posof[idx] = pos;
        rowscale[pos] = rsqrtf(((const float*)(ws + CTLB_SS2))[idx >> 2] * (1.0f / D) + RMS_EPS);
    }
    for (int ex = blockIdx.x; ex < 32; ex += G) { const int t_ = tot[ex], pe = (t_ + 255) & ~255;
        for (int r = t_ + tid; r < pe; r += NTHREADS) { rowmap[base[ex] + r] = 0; rowgate[base[ex] + r] = 0.f; rowscale[base[ex] + r] = 0.f; } }
    if (blockIdx.x == 0) {
        const int ntl = base[32] >> 8;
        for (int t = tid; t < 544; t += NTHREADS) { int ex = 0;
            for (int q = 0; q < 32; ++q) if (base[q] <= t * 256) ex = q;
            tile_e[t] = (t < ntl) ? ex : 0; }
        if (tid == 0) meta[0] = ntl;
    }
}

__device__ __forceinline__ void p11_combine(const Args& a, int wave, int lane, int G) {
    unsigned char* ws = a.ws;
    const int* posof = (const int*)(ws + WS_POSOF); const unsigned char* Y = ws + WS_R2; const bf16_t* x1b = (const bf16_t*)(ws + WS_X1B); bf16_t* x2b = (bf16_t*)(ws + WS_R1); float* rs3 = (float*)(ws + WS_RS3);
    const int gw = blockIdx.x * NWAVES + wave, NGW = G * NWAVES;
    typedef int i4v __attribute__((ext_vector_type(4)));
    i4v pnx = (gw < M) ? *(const i4v*)(posof + (size_t)gw * 4) : (i4v){0, 0, 0, 0};
    for (int m = gw; m < M; m += NGW) {
        const i4v pcur = pnx;
        if (m + NGW < M) pnx = *(const i4v*)(posof + (size_t)(m + NGW) * 4);
        const u32x2* xr = (const u32x2*)(x1b + (size_t)m * D) + lane; f32x4 v[4]; u32x2 xw[4]; unsigned yw[4][4];
#pragma unroll
        for (int j = 0; j < 4; ++j) xw[j] = xr[64 * j];
#pragma unroll
        for (int s = 0; s < 4; ++s) { const unsigned* yr = (const unsigned*)(Y + (size_t)pcur[s] * D) + lane;
#pragma unroll
            for (int j = 0; j < 4; ++j) yw[s][j] = yr[64 * j]; }
#pragma unroll
        for (int j = 0; j < 4; ++j) { const u32x2 w = xw[j]; v[j] = (f32x4){bf_lo(w.x), bf_hi(w.x), bf_lo(w.y), bf_hi(w.y)}; }
#pragma unroll
        for (int s = 0; s < 4; ++s) {
#pragma unroll
            for (int j = 0; j < 4; ++j) { const f32x2_ lo = __builtin_amdgcn_cvt_pk_f32_fp8((int)yw[s][j], false), hi = __builtin_amdgcn_cvt_pk_f32_fp8((int)yw[s][j], true);
                v[j][0] += lo.x; v[j][1] += lo.y; v[j][2] += hi.x; v[j][3] += hi.y; } }
        float s = 0.f;
#pragma unroll
        for (int j = 0; j < 4; ++j) s += (v[j][0] * v[j][0] + v[j][1] * v[j][1]) + (v[j][2] * v[j][2] + v[j][3] * v[j][3]);
        s = wave_sum(s); if (lane == 0) rs3[m] = rsqrtf(s * (1.0f / D) + RMS_EPS);
        u32x2* o = (u32x2*)(x2b + (size_t)m * D) + lane;
#pragma unroll
        for (int j = 0; j < 4; ++j) { u32x2 w; w.x = pk2(v[j][0], v[j][1]); w.y = pk2(v[j][2], v[j][3]); o[64 * j] = w; }
    }
}
__device__ __forceinline__ void p13_final(const Args& a, int wave, int lane, int G) {
    const float* ss4 = (const float*)(a.ws + CTLB_SS4); const float* fg = a.in[I_FG]; const bf16_t* x3b = (const bf16_t*)(a.ws + WS_R1 + 128 * MiB);
    const int gw = blockIdx.x * NWAVES + wave, NGW = G * NWAVES;
    f32x4 gq[4];
#pragma unroll
    for (int j = 0; j < 4; ++j) gq[j] = ((const f32x4*)fg)[lane + 64 * j];
    for (int m0 = gw; m0 < M; m0 += 4 * NGW) { u32x2 xw[4][4]; float sv[4];
#pragma unroll
        for (int r = 0; r < 4; ++r) { const int m = m0 + r * NGW; if (m < M) { sv[r] = ss4[m]; const u32x2* xr = (const u32x2*)(x3b + (size_t)m * D) + lane;
#pragma unroll
            for (int j = 0; j < 4; ++j) xw[r][j] = xr[64 * j]; } }
#pragma unroll
        for (int r = 0; r < 4; ++r) { const int m = m0 + r * NGW; if (m < M) { const float rs = rsqrtf(sv[r] * (1.0f / D) + RMS_EPS); f32x4* orow = (f32x4*)(a.out + (size_t)m * D) + lane;
#pragma unroll
            for (int j = 0; j < 4; ++j) { const u32x2 w = xw[r][j]; orow[64 * j] = (f32x4){bf_lo(w.x), bf_hi(w.x), bf_lo(w.y), bf_hi(w.y)} * rs * gq[j]; } } } }
}

__global__ void __launch_bounds__(NTHREADS, 2) fwd(Args args) {
    extern __shared__ __attribute__((aligned(16))) unsigned char lds_raw[];
    LAS unsigned char* lds = (LAS unsigned char*)lds_raw;
    const int G = gridDim.x;
#define tid ((int)threadIdx.x)
#define lane ((int)(threadIdx.x & 63))
#define wave (__builtin_amdgcn_readfirstlane((int)(threadIdx.x >> 6)))
    unsigned char* ws = args.ws;
    volatile LAS unsigned* MISC = (volatile LAS unsigned*)(lds + LDS_MISC);
    if (tid < 64) MISC[tid] = 0u;
    __syncthreads();
    XcdBarrier bar = xcd_barrier_post((unsigned*)(ws + CTLB_BAR), MISC);
    const int lo = args.ph_lo, hi = args.ph_hi;
#define IN(k) (lo <= (k) && (k) < hi)
#define SEAM(k) do { if (IN(k) && IN((k) + 1)) xcd_barrier(bar); } while (0)
    unsigned char* pj = ws + WS_R1;
    bf16_t* xb = (bf16_t*)(ws + WS_R2); bf16_t* cat = (bf16_t*)(ws + WS_R2 + 64 * MiB);
    bf16_t* mixed = cat; bf16_t* attn = cat + 512; bf16_t* zb = (bf16_t*)(ws + WS_R2 + 192 * MiB);

    if (IN(PH_PRO)) { p0_prologue(args, lds, wave, lane, G); }
    SEAM(PH_PRO);
    if (IN(PH_INPROJ)) {
        pg8::Gemm g{xb, (const bf16_t*)(ws + WS_WIN), M, NP, D, 0, nullptr}; pg8::StaticOrder S; S.init(M, NP, G, (int)blockIdx.x);
        EpiProj E{pj, (const float*)(ws + WS_RS1)};
        pg8::gemm_phase<EpiProj, pg8::StaticOrder, false>(lds, g, S, E);
    }
    SEAM(PH_INPROJ);
    if (IN(PH_MIXED)) { p2_mixed((const bf16_t*)(pj + PJ_U), mixed, G); }
    if (IN(PH_ATT)) {
        __syncthreads();
        p4_attention(pj, attn, (unsigned*)(ws + CTLB_QUEUE), DBG ? (int*)(ws + WS_SEL) : nullptr, lds, wave, lane);
        for (;;) {
            __syncthreads();
            if (tid == 0) MISC[4] = atomicAdd((unsigned*)(ws + CTLB_QUEUE) + 128, 1u);
            __syncthreads();
            const int c = __builtin_amdgcn_readfirstlane((int)MISC[4]);
            if (c >= I_E1 / 8) break;
            deferred_chunk(args, lds, c, wave, lane);
        }
    }
    SEAM(PH_ATT);
    if (IN(PH_Z)) {
        pg8::Gemm g{cat, (const bf16_t*)(ws + WS_WPC), M, D, 1024, 0, nullptr}; pg8::StaticOrder S; S.init(M, D, G, (int)blockIdx.x);
        EpiGate<false, true> E{zb, (const bf16_t*)(pj + PJ_G) + 1024, nullptr};
        HookGateRatio Hk{(const bf16_t*)(pj + PJ_G)};
        pg8::gemm_phase<EpiGate<false, true>, pg8::StaticOrder, false, HookGateRatio>(lds, g, S, E, Hk);
    }
    SEAM(PH_Z);
    if (IN(PH_X1)) {
        pg8::Gemm g{zb, (const bf16_t*)(ws + WS_WOUT), M, D, D, 0, nullptr}; pg8::StaticOrder S; S.init(M, D, G, (int)blockIdx.x);
        EpiX1 E{args.in[I_X], (bf16_t*)(ws + WS_X1B), (float*)(ws + CTLB_SS2), ws + WS_R1 + 144 * MiB};
        pg8::gemm_phase<EpiX1, pg8::StaticOrder, false>(lds, g, S, E);
    }
    SEAM(PH_X1);
    if (IN(PH_ROUTER)) { p7_router(args, lds, wave, lane, G); }
    SEAM(PH_ROUTER);
    if (IN(PH_SCATTER)) { __syncthreads(); p8_scatter(args, lds, wave, lane, G); }
    SEAM(PH_SCATTER);
    if (IN(PH_MOE1)) {
        __syncthreads();
        pg8::Gemm g{(const bf16_t*)(ws + WS_R1 + 144 * MiB), (const bf16_t*)(ws + WS_W1), M, 2048, D / 2, (size_t)2048 * D, (const int*)(ws + WS_ROWMAP)};
        LAS int* te_l = (LAS int*)(lds + LDS_KT); for (int i = tid; i < 544; i += NTHREADS) te_l[i] = ((const int*)(ws + CTLB_TILEE))[i];
        __syncthreads();
        pg8::MoeOrder S{te_l, *(const int*)(ws + CTLB_META), 8, G, (int)blockIdx.x};
        EpiMoe1 E{ws + WS_R1, (const float*)(ws + WS_ROWSCALE), args.in[I_B1]};
        pg8::gemm_phase<EpiMoe1, pg8::MoeOrder, true, pg8::NoHook, 1>(lds, g, S, E);
        for (;;) {
            __syncthreads();
            if (tid == 0) MISC[4] = atomicAdd((unsigned*)(ws + CTLB_QUEUE) + 192, 1u);
            __syncthreads();
            const int c = I_E1 / 8 + __builtin_amdgcn_readfirstlane((int)MISC[4]);
            if (c >= DC_EXPERT) break;
            deferred_chunk(args, lds, c, wave, lane);
        }
    }
    SEAM(PH_MOE1);
    if (IN(PH_MOE2)) {
        pg8::Gemm g{(const bf16_t*)(ws + WS_R1), (const bf16_t*)(ws + WS_W2), MOE_ROWS, D, DFF / 2, (size_t)D * DFF, nullptr};
        LAS int* te_l = (LAS int*)(lds + LDS_KT); for (int i = tid; i < 544; i += NTHREADS) te_l[i] = ((const int*)(ws + CTLB_TILEE))[i];
        __syncthreads();
        pg8::MoeOrder S{te_l, *(const int*)(ws + CTLB_META), 4, G, (int)blockIdx.x};
        EpiMoe2 E{ws + WS_R2, (const float*)(ws + WS_ROWGATE), args.in[I_B2]};
        pg8::gemm_phase<EpiMoe2, pg8::MoeOrder, false, pg8::NoHook, 2>(lds, g, S, E);
        { const int nunits = S.ntiles * 4, rem = nunits % G, vwg = (G % 8 == 0) ? ((int)blockIdx.x % 8) * (G / 8) + (int)blockIdx.x / 8 : (int)blockIdx.x;
          pg8::PPOrder SP{rem ? G - rem : G, rem ? vwg - rem : vwg};
          pg8::Gemm gp{(const bf16_t*)(ws + WS_PB), (const bf16_t*)(ws + WS_WPP), M, D, PLE, 0, nullptr};
          EpiPP EP{(bf16_t*)(ws + WS_PP)};
          pg8::gemm_phase<EpiPP, pg8::PPOrder, false>(lds, gp, SP, EP); }
    }
    SEAM(PH_MOE2);
    if (IN(PH_COMBINE)) { p11_combine(args, wave, lane, G); }
    SEAM(PH_COMBINE);
    if (IN(PH_PLE)) {
        pg8::Gemm g{(const bf16_t*)(ws + WS_R1), (const bf16_t*)(ws + WS_WPG), M, D, D, 0, nullptr}; pg8::StaticOrder S; S.init(M, D, G, (int)blockIdx.x);
        EpiPleGX E{(bf16_t*)(ws + WS_R1 + 128 * MiB), (const bf16_t*)(ws + WS_R1), (const bf16_t*)(ws + WS_PP), (const float*)(ws + WS_RS3), (float*)(ws + CTLB_SS4)};
        pg8::gemm_phase<EpiPleGX, pg8::StaticOrder, false>(lds, g, S, E);
    }
    SEAM(PH_PLE);
    if (IN(PH_FINAL)) { p13_final(args, wave, lane, G); }
#undef IN
#undef SEAM
#undef tid
#undef lane
#undef wave
}

#if DBG
__device__ __forceinline__ unsigned hash_u(unsigned x) { x ^= x >> 16; x *= 0x7feb352dU; x ^= x >> 15; x *= 0x846ca68bU; x ^= x >> 16; return x; }
__device__ __forceinline__ bool closef(float got, float ref, float rtol, float atol) { return fabsf(got - ref) <= atol + rtol * fabsf(ref); }
__device__ float dotbf(const bf16_t* a, const bf16_t* b, int K) { float s = 0.f; for (int k = 0; k < K; ++k) s += bf1(a[k]) * bf1(b[k]); return s; }
__device__ __forceinline__ void dbg_fail(unsigned* dbg, int code) { atomicAdd(dbg + code, 1u); }
__device__ float f2bf_f(float v) { return __builtin_bit_cast(float, f2bf(v) << 16); }

__device__ float pjv(const unsigned char* pj, int m, int c) {
    const bf16_t* b; int ld, cc;
    if (c < 512) { b = (const bf16_t*)(pj + PJ_U); ld = 512; cc = c; }
    else if (c < 1024) { b = (const bf16_t*)(pj + PJ_Q); ld = 512; cc = c - 512; }
    else if (c < 1280) { const unsigned v = (pj + PJ_KV)[(size_t)m * 256 + (c - 1024)]; const int e = (v >> 3) & 15, mt = v & 7;
        const float mag = e ? ldexpf(1.0f + mt * 0.125f, e - 7) : ldexpf(mt * 0.125f, -6); return (v & 128) ? -mag : mag; }
    else if (c < 1792) { b = (const bf16_t*)(pj + PJ_QI); ld = 512; cc = c - 1280; }
    else if (c < 2048) { b = (const bf16_t*)(pj + PJ_KW); ld = 128; cc = c - 1792; if (cc >= 128) return 0.f; }
    else { b = (const bf16_t*)(pj + PJ_G); ld = 2048; cc = c - 2048; }
    return bf1(b[(size_t)m * ld + cc]);
}
__global__ void __launch_bounds__(256) chk(Args a, int phase) {
    unsigned char* ws = a.ws; unsigned* dbg = (unsigned*)(ws + CTLB_DBG);
    const unsigned s = blockIdx.x * 256 + threadIdx.x;
    const unsigned h = hash_u(s * 2654435761u + 12345u), h2 = hash_u(h + 777u);
    const unsigned char* pj = ws + WS_R1;
    const bf16_t* mixed = (const bf16_t*)(ws + WS_R2 + 64 * MiB); const bf16_t* attn = mixed + 512;
    const bf16_t* zb = (const bf16_t*)(ws + WS_R2 + 192 * MiB);
    if (phase == PH_PRO) {
        if (s == 0) {
            volatile unsigned* pv = dbg + 40; pv[0] = 0xC0484038u; pv[1] = 0x3F800000u; pv[2] = 0x40000000u; pv[3] = 0x40800000u; pv[4] = 0xC0000000u;
            const unsigned wrt = pv[0];
            const u32x2 r = fp8x4_to_bf16x4(wrt);
            if (!(r.x == 0x40003F80u && r.y == 0xC0004080u)) {
                if (r.x == 0x3F804000u) dbg_fail(dbg, 21); else if (r.x == 0xC0004080u) dbg_fail(dbg, 22); else if (r.x == 0x40003F80u) dbg_fail(dbg, 25); else if (r.y == 0xC0004080u) dbg_fail(dbg, 26); else dbg_fail(dbg, 23); }
            const unsigned enc = pk4_fp8(__builtin_bit_cast(float, (unsigned)pv[1]), __builtin_bit_cast(float, (unsigned)pv[2]), __builtin_bit_cast(float, (unsigned)pv[3]), __builtin_bit_cast(float, (unsigned)pv[4]));
            if (enc != 0xC0484038u) dbg_fail(dbg, 24);
        }
        {
          const int n = h % IN_COLS, k = h2 % D; int row = n < 1864 ? n : n + 184;
          if (n >= 1152 && n < 1280) { const int d = (n - 1152) & 63; row = 1152 + ((n - 1152) & 64) + 16 * (d & 3) + (d >> 2); }
          float sc = 1.f; if ((n >= 512 && n < 1024) || (n >= 1280 && n < 1792)) sc = 0.125f; if (n >= 1856 && n < 1864) sc = 0.35355339059327373f;
          const float ref = f2bf_f(a.in[I_WIN][(size_t)k * IN_COLS + n] * (sc * a.in[I_N1G][k]));
          const float got = bf1(((const bf16_t*)(ws + WS_WIN))[(size_t)row * D + k]);
          if (!closef(got, ref, 0.01f, 1e-6f)) dbg_fail(dbg, 1); }
        {
          const int m = h % M, k = h2 % D;
          if (!closef(bf1(((const bf16_t*)(ws + WS_R2))[(size_t)m * D + k]), f2bf_f(a.in[I_X][(size_t)m * D + k]), 0.01f, 1e-6f)) dbg_fail(dbg, 2);
          if (s < 512) { float q = 0.f; for (int i = 0; i < D; ++i) { const float v = a.in[I_X][(size_t)m * D + i]; q += v * v; }
            if (!closef(((const float*)(ws + WS_RS1))[m], rsqrtf(q / D + RMS_EPS), 0.001f, 0.f)) dbg_fail(dbg, 2); }
        }
    }
    if (phase == PH_INPROJ) {
        const int m = h % M; int c = h2 % NP; if (s & 1) c = (c & 255) | (7 << 8);
        float r = dotbf((const bf16_t*)(ws + WS_R2) + (size_t)m * D, (const bf16_t*)(ws + WS_WIN) + (size_t)c * D, D) * ((const float*)(ws + WS_RS1))[m];
        if (c >= 2048) r = 1.0f / (1.0f + expf(-r));
        if (c >= 1792 + 128 && c < 2048) r = 0.f;
        if (!closef(pjv(pj, m, c), r, (c >= 1024 && c < 1280) ? 0.08f : 0.02f, (c >= 1024 && c < 1280) ? 0.02f : 0.01f)) dbg_fail(dbg, 3);
    }
    if (phase == PH_MIXED) {
        int m = h % M; if (s < 64) m = (s & 31) + (s >> 5) * SEQ; const int c = h2 % 512, g = c >> 7, w = 2 << g, t = m & (SEQ - 1); const int nw = (t + 1) < w ? (t + 1) : w;
        float r = 0.f; for (int i = 0; i < nw; ++i) r += pjv(pj, m - i, c);
        r = r / nw - pjv(pj, m, c);
        if (!closef(bf1(mixed[(size_t)m * 1024 + c]), r, 0.02f, 0.01f)) dbg_fail(dbg, 4);
    }
    if (phase == PH_Z) {
        {
          const int e = h % 32, n = (h >> 5) % D, k = h2 % D;
          const int k2 = h2 % PLE;
          if (!closef(bf1(((const bf16_t*)(ws + WS_WPP))[(size_t)n * PLE + k2]), f2bf_f(a.in[I_PPW][(size_t)k2 * D + n]), 0.01f, 1e-6f)) dbg_fail(dbg, 1);
          if (!closef(bf1(((const bf16_t*)(ws + WS_WR))[(size_t)e * D + k]), f2bf_f(a.in[I_RW][(size_t)k * NE + e] * a.in[I_N2G][k]), 0.01f, 1e-6f)) dbg_fail(dbg, 1);
          if (!closef(bf1(((const bf16_t*)(ws + WS_WPG))[(size_t)n * D + k]), f2bf_f(a.in[I_PGW][(size_t)k * D + n] * a.in[I_PNG][k]), 0.01f, 1e-6f)) dbg_fail(dbg, 1);
          const int k5 = h2 % 512;
          if (!closef(bf1(((const bf16_t*)(ws + WS_WPC))[(size_t)n * 1024 + 512 + k5]), f2bf_f(a.in[I_WBA][(size_t)k5 * D + n]), 0.01f, 1e-6f)) dbg_fail(dbg, 1);
          { const int g = k5 >> 7; float r = 0.f; for (int d = 0; d < 128; ++d) r += a.in[I_POOLW][(size_t)k5 * 128 + d] * a.in[I_POOLS][g * 128 + d] * a.in[I_WBP][(size_t)(g * 128 + d) * D + n];
            if (!closef(bf1(((const bf16_t*)(ws + WS_WPC))[(size_t)n * 1024 + k5]), r, 0.01f, 1e-4f)) dbg_fail(dbg, 1); } }
        { const int m = h % M, k2 = h2 % PLE;
          if (!closef(bf1(((const bf16_t*)(ws + WS_PB))[(size_t)m * PLE + k2]), f2bf_f(a.in[I_P][(size_t)m * PLE + k2]), 0.01f, 1e-6f)) dbg_fail(dbg, 2); }
        {
          const int e = h % 32, n = (h >> 5) % 2048, k = h2 % D; const int row = n < 1024 ? (((n >> 7) << 8) + (n & 127)) : ((((n - 1024) >> 7) << 8) + 128 + ((n - 1024) & 127));
          const float ref = f2bf_f(a.in[I_W1][((size_t)e * D + k) * 2048 + n] * a.in[I_N2G][k]);
          const float got = bf1(((const bf16_t*)(ws + WS_W1))[((size_t)e * 2048 + row) * D + k]);
          if (!closef(got, ref, 0.01f, 1e-6f)) dbg_fail(dbg, 1); }
        { const int e = h % 32, n = (h >> 5) % D, k = h2 % D;
          if (!closef(bf1(((const bf16_t*)(ws + WS_W2))[((size_t)e * D + n) * DFF + k]), f2bf_f(a.in[I_W2][((size_t)e * DFF + k) * D + n]), 0.01f, 1e-6f)) dbg_fail(dbg, 1); }
        const int m = h % M, c = h2 % D; const bf16_t* wc_ = (const bf16_t*)(ws + WS_WPC) + (size_t)c * 1024;
        const float r = dotbf(mixed + (size_t)m * 1024, wc_, 512) * pjv(pj, m, C_GP + c) + dotbf(attn + (size_t)m * 1024, wc_ + 512, 512) * pjv(pj, m, C_GA + c);
        if (!closef(bf1(zb[(size_t)m * D + c]), r, 0.02f, 0.02f)) dbg_fail(dbg, 8);
    }
    if (phase == PH_X1) {
        const int m = h % M, c = h2 % D;
        const float r = a.in[I_X][(size_t)m * D + c] + dotbf(zb + (size_t)m * D, (const bf16_t*)(ws + WS_WOUT) + (size_t)c * D, D);
        if (!closef(bf1(((const bf16_t*)(ws + WS_X1B))[(size_t)m * D + c]), r, 0.01f, 0.01f)) dbg_fail(dbg, 9);
        if (s < 512) { float q = 0.f; for (int i = 0; i < D; ++i) { const float v = bf1(((const bf16_t*)(ws + WS_X1B))[(size_t)m * D + i]); q += v * v; }
            if (!closef(((const float*)(ws + CTLB_SS2))[m], q, 0.01f, 0.f)) dbg_fail(dbg, 9); }
    }
    if (phase == PH_ROUTER) {
        const int m = h % M; const float rs = rsqrtf(((const float*)(ws + CTLB_SS2))[m] / D + RMS_EPS);
        float v[32]; for (int e = 0; e < 32; ++e) v[e] = dotbf((const bf16_t*)(ws + WS_X1B) + (size_t)m * D, (const bf16_t*)(ws + WS_WR) + (size_t)e * D, D) * rs + a.in[I_RB][e];
        const int* ti = (const int*)(ws + WS_TOPI) + m * 4; const float* tg = (const float*)(ws + WS_TOPG) + m * 4;
        float mn = 1e30f, se = 0.f, gs = 0.f; bool ok = true;
        for (int r = 0; r < 4; ++r) { if (ti[r] < 0 || ti[r] >= 32) { ok = false; break; } mn = fminf(mn, v[ti[r]]); for (int q = 0; q < r; ++q) if (ti[q] == ti[r]) ok = false; }
        if (ok) { for (int r = 0; r < 4; ++r) se += expf(v[ti[r]] - v[ti[0]]);
            for (int r = 0; r < 4; ++r) { if (!closef(tg[r], expf(v[ti[r]] - v[ti[0]]) / se, 0.02f, 0.002f)) ok = false; gs += tg[r]; }
            int above = 0; for (int e = 0; e < 32; ++e) { bool sel = false; for (int r = 0; r < 4; ++r) sel |= (ti[r] == e); if (!sel && v[e] > mn + 1e-3f) ++above; }
            if (above) ok = false; }
        if (!ok) dbg_fail(dbg, 10);
    }
    if (phase == PH_SCATTER) {
        const int m = h % M; const int* ti = (const int*)(ws + WS_TOPI) + m * 4; const int* po = (const int*)(ws + WS_POSOF) + m * 4; const int* te = (const int*)(ws + CTLB_TILEE);
        const int ntl = *(const int*)(ws + CTLB_META); bool ok = ntl > 0 && ntl <= 544;
        for (int r = 0; r < 4 && ok; ++r) { const int p = po[r]; if (p < 0 || p >= ntl * 256) { ok = false; break; }
            if (((const int*)(ws + WS_ROWMAP))[p] != m) ok = false; if (te[p >> 8] != ti[r]) ok = false;
            if (!closef(((const float*)(ws + WS_ROWGATE))[p], ((const float*)(ws + WS_TOPG))[m * 4 + r], 1e-6f, 0.f)) ok = false; }
        if (!ok) dbg_fail(dbg, 11);
    }
    if (phase == PH_MOE1) {
        const int ntl = *(const int*)(ws + CTLB_META); if (ntl > 0 && ntl <= 544) {
        const int row = h % (ntl * 256), j = h2 % DFF; const int e = ((const int*)(ws + CTLB_TILEE))[row >> 8], tok = ((const int*)(ws + WS_ROWMAP))[row];
        const float rs = rsqrtf(((const float*)(ws + CTLB_SS2))[tok] / D + RMS_EPS);
        const bf16_t* w1t = (const bf16_t*)(ws + WS_W1) + (size_t)e * 2048 * D; const int rg = ((j >> 7) << 8) + (j & 127), ru = rg + 128;
        float gl = dotbf((const bf16_t*)(ws + WS_X1B) + (size_t)tok * D, w1t + (size_t)rg * D, D) * rs + a.in[I_B1][e * 2048 + j];
        float up = dotbf((const bf16_t*)(ws + WS_X1B) + (size_t)tok * D, w1t + (size_t)ru * D, D) * rs + a.in[I_B1][e * 2048 + 1024 + j];
        gl = fminf(gl, 7.f); up = fminf(fmaxf(up, -7.f), 7.f);
        const float r = (up + 1.f) * gl / (1.f + expf(-1.702f * gl));
        if (((const float*)(ws + WS_ROWGATE))[row] != 0.f && !closef(bf1(((const bf16_t*)(ws + WS_R1))[(size_t)row * DFF + j]), r, 0.03f, 0.02f)) dbg_fail(dbg, 12); } else dbg_fail(dbg, 12);
    }
    if (phase == PH_MOE2) {
        const int ntl = *(const int*)(ws + CTLB_META); if (ntl > 0 && ntl <= 544) {
        const int row = h % (ntl * 256), c = h2 % D; const int e = ((const int*)(ws + CTLB_TILEE))[row >> 8];
        const float r = (dotbf((const bf16_t*)(ws + WS_R1) + (size_t)row * DFF, (const bf16_t*)(ws + WS_W2) + ((size_t)e * D + c) * DFF, DFF) + a.in[I_B2][e * D + c]) * ((const float*)(ws + WS_ROWGATE))[row];
        if (!closef(bf1(((const bf16_t*)(ws + WS_R2))[(size_t)row * D + c]), r, 0.03f, 0.01f)) dbg_fail(dbg, 13); } else dbg_fail(dbg, 13);
    }
    if (phase == PH_COMBINE) {
        const int m = h % M, c = h2 % D;
        { float r2 = bf1(((const bf16_t*)(ws + WS_X1B))[(size_t)m * D + c]); for (int q = 0; q < 4; ++q) r2 += bf1(((const bf16_t*)(ws + WS_R2))[(size_t)((const int*)(ws + WS_POSOF))[m * 4 + q] * D + c]);
          if (!closef(bf1(((const bf16_t*)(ws + WS_R1))[(size_t)m * D + c]), r2, 0.01f, 0.01f)) dbg_fail(dbg, 14); }
        if (s < 512) { float q = 0.f; for (int i = 0; i < D; ++i) { const float v = bf1(((const bf16_t*)(ws + WS_R1))[(size_t)m * D + i]); q += v * v; }
            if (!closef(((const float*)(ws + WS_RS3))[m], rsqrtf(q / D + RMS_EPS), 0.01f, 0.f)) dbg_fail(dbg, 14); }
    }
    if (phase == PH_PLE) {
        const int m = h % M, c = h2 % D;
        const float pp = dotbf((const bf16_t*)(ws + WS_PB) + (size_t)m * PLE, (const bf16_t*)(ws + WS_WPP) + (size_t)c * PLE, PLE);
        const float ppk = bf1(((const bf16_t*)(ws + WS_PP))[(size_t)m * D + c]);
        if (!closef(ppk, pp, 0.02f, 0.01f)) dbg_fail(dbg, 16);
        const float gate = 1.f / (1.f + expf(-dotbf((const bf16_t*)(ws + WS_R1) + (size_t)m * D, (const bf16_t*)(ws + WS_WPG) + (size_t)c * D, D) * ((const float*)(ws + WS_RS3))[m]));
        const float r3 = bf1(((const bf16_t*)(ws + WS_R1))[(size_t)m * D + c]) + gate * ppk;
        if (!closef(bf1(((const bf16_t*)(ws + WS_R1 + 128 * MiB))[(size_t)m * D + c]), r3, 0.02f, 0.03f)) dbg_fail(dbg, 15);
    }
}
__global__ void __launch_bounds__(256) chk_att(Args a) {
    unsigned char* ws = a.ws; unsigned* dbg = (unsigned*)(ws + CTLB_DBG);
    const unsigned char* pj = ws + WS_R1; const bf16_t* attn = (const bf16_t*)(ws + WS_R2 + 64 * MiB) + 512; const int* sel = (const int*)(ws + WS_SEL);
    const int special[16] = {0, 5, 63, 64, 200, 255, 256, 257, 300, 449, 512, 1000, 2047, 4096, 9000, 16383};
    const int sb = blockIdx.x; int t = (sb < 16) ? special[sb] : (int)(hash_u(sb * 977u + 5u) % SEQ); const int b = sb & 1; const int row = b * SEQ + t;
    __shared__ unsigned bitmap[512]; __shared__ unsigned skey[256]; __shared__ int s_bad, s_viol; __shared__ unsigned s_min; __shared__ float sc[8][256];
    const int tid = threadIdx.x;
    for (int i = tid; i < 512; i += 256) bitmap[i] = 0u;
    if (tid == 0) { s_bad = 0; s_viol = 0; s_min = 0xFFFFFFFFu; }
    __syncthreads();
    const int nsel = (t + 1) < 256 ? (t + 1) : 256;
    auto score_key = [&](int kp) -> unsigned {
        float s = 0.f;
        for (int hd = 0; hd < 8; ++hd) { float l = 0.f; for (int d = 0; d < 64; ++d) l += pjv(pj, row, C_QI + hd * 64 + d) * pjv(pj, b * SEQ + kp, C_KI + d);
            s = fmaf(fmaxf(l, 0.f), pjv(pj, row, C_WI + hd), s); }
        const unsigned ub = __builtin_bit_cast(unsigned, s); const unsigned srt = ub ^ ((ub >> 31) ? 0xFFFFFFFFu : 0x80000000u);
        return (srt & 0xFFFFC000u) | (unsigned)(16383 - kp);
    };
    { const int kp = sel[(size_t)row * 256 + tid];
      if (tid < nsel) { if (kp < 0 || kp > t) atomicAdd(&s_bad, 1); else { const unsigned old = atomicOr(&bitmap[kp >> 5], 1u << (kp & 31)); if (old & (1u << (kp & 31))) atomicAdd(&s_bad, 1);
            const unsigned pk = score_key(kp); skey[tid] = pk; atomicMin(&s_min, pk); } }
      else if (kp != -1) atomicAdd(&s_bad, 1); }
    __syncthreads();
    if (s_bad == 0) {
        for (int kp = tid; kp <= t; kp += 256) { if (!((bitmap[kp >> 5] >> (kp & 31)) & 1u)) { if (score_key(kp) > s_min) atomicAdd(&s_viol, 1); } }
    }
    __syncthreads();
    if (tid == 0 && (s_bad != 0 || s_viol > 3)) dbg_fail(dbg, 6);
    if (s_bad != 0) return;
    for (int hd = 0; hd < 8; ++hd) { float l = -1e30f;
        if (tid < nsel) { const int kp = sel[(size_t)row * 256 + tid]; l = 0.f; for (int d = 0; d < 64; ++d) l += pjv(pj, row, C_Q + hd * 64 + d) * pjv(pj, b * SEQ + kp, C_K + (hd >> 2) * 64 + d); }
        sc[hd][tid] = l; }
    __syncthreads();
    for (int o = tid; o < 512; o += 256) { const int hd = o >> 6, d = o & 63; float mx = -1e30f; for (int i = 0; i < nsel; ++i) mx = fmaxf(mx, sc[hd][i]);
        float se = 0.f, ov = 0.f; for (int i = 0; i < nsel; ++i) { const float p = expf(sc[hd][i] - mx); se += p; ov += p * pjv(pj, b * SEQ + sel[(size_t)row * 256 + i], C_V + (hd >> 2) * 64 + 16 * (d & 3) + (d >> 2)); }
        if (!closef(bf1(attn[(size_t)row * 1024 + o]), ov / se, 0.03f, 0.01f)) dbg_fail(dbg, 7); }
}
__global__ void __launch_bounds__(256) chk_report(Args a) {
    const unsigned* dbg = (const unsigned*)(a.ws + CTLB_DBG);
    int code = 0; for (int c = 20; c < 32; ++c) if (dbg[c] != 0u) { code = c; break; }
    if (code == 0) for (int c = 1; c < 20; ++c) if (dbg[c] != 0u) { code = c; break; }
    if (code == 0) return;
    const float v = sqrtf((float)code);
    for (size_t i = (size_t)blockIdx.x * 256 + threadIdx.x; i < (size_t)M * D; i += (size_t)gridDim.x * 256) a.out[i] = v;
}
#endif

extern "C" void kernel_launch(void* const* d_in, const int* in_sizes, int n_in, void* d_out, int out_size, void* d_ws, size_t ws_size, hipStream_t stream) {
    static int grid = 0;
    if (grid == 0) {
        if (n_in != 20 || out_size != M * D || ws_size < WS_END) { fprintf(stderr, "kernel_launch: unexpected shapes (n_in %d out %d ws %zu)\n", n_in, out_size, ws_size); grid = -1; return; }
        int dev = 0, cus = 0, per_cu = 0;
        if (hipGetDevice(&dev) != hipSuccess || hipDeviceGetAttribute(&cus, hipDeviceAttributeMultiprocessorCount, dev) != hipSuccess) { grid = -1; return; }
        if (hipFuncSetAttribute((const void*)fwd, hipFuncAttributeMaxDynamicSharedMemorySize, LDS_BYTES) != hipSuccess) { fprintf(stderr, "kernel_launch: hipFuncSetAttribute failed\n"); grid = -1; return; }
        if (hipOccupancyMaxActiveBlocksPerMultiprocessor(&per_cu, (const void*)fwd, NTHREADS, LDS_BYTES) != hipSuccess || per_cu < 1) fprintf(stderr, "kernel_launch: occupancy query says %d\n", per_cu);
        (void)hipGetLastError();
        grid = cus;
    }
    if (grid < 0) return;
    (void)hipMemsetAsync((char*)d_ws + WS_CTL, 0, CTL_ZERO_BYTES, stream);
    Args a{};
    for (int i = 0; i < 20; ++i) a.in[i] = (const float*)d_in[i];
    a.out = (float*)d_out; a.ws = (unsigned char*)d_ws;
#if DBG
    for (int p = 0; p < NPH; ++p) {
        a.ph_lo = p; a.ph_hi = p + 1;
        hipLaunchKernelGGL(fwd, dim3(grid), dim3(NTHREADS), LDS_BYTES, stream, a);
        if (p == PH_ATT) hipLaunchKernelGGL(chk_att, dim3(48), dim3(256), 0, stream, a);
        else if (p != PH_FINAL && p != PH_POOL) hipLaunchKernelGGL(chk, dim3(32), dim3(256), 0, stream, a, p);
    }
    hipLaunchKernelGGL(chk_report, dim3(1024), dim3(256), 0, stream, a);
#else
    a.ph_lo = 0; a.ph_hi = NPH;
    hipLaunchKernelGGL(fwd, dim3(grid), dim3(NTHREADS), LDS_BYTES, stream, a);
#endif
}
```

```cpp
#include <hip/hip_runtime.h>
#include <cstdio>
#include <cstdint>

#ifndef DBG
#define DBG 0
#endif

#define LAS __attribute__((address_space(3)))
#define GAS __attribute__((address_space(1)))
typedef unsigned short bf16_t;
typedef short bf16x8 __attribute__((ext_vector_type(8)));
typedef float f32x4 __attribute__((ext_vector_type(4)));
typedef float f32x16 __attribute__((ext_vector_type(16)));
typedef unsigned u32x4 __attribute__((ext_vector_type(4)));
typedef unsigned u32x2 __attribute__((ext_vector_type(2)));

constexpr int M = 32768, SEQ = 16384, D = 1024, NP = 4096, NE = 32, DFF = 1024, PLE = 256;
constexpr int IN_COLS = 3912;
constexpr int C_U = 0, C_Q = 512, C_K = 1024, C_V = 1152, C_QI = 1280, C_KI = 1792, C_WI = 1856, C_GP = 2048, C_GA = 3072;
constexpr int MOE_ROWS = M * 4 + NE * 256;
constexpr float RMS_EPS = 1e-6f;
constexpr int NWAVES = 8, NTHREADS = 512;

constexpr size_t MiB = 1u << 20;
constexpr size_t WS_CTL = 0, CTL_ZERO_BYTES = 1 * MiB;
constexpr size_t CTLB_BAR = 16384;
constexpr size_t CTLB_QUEUE = 65536;
constexpr size_t CTLB_META = 65536 + 256;
constexpr size_t CTLB_DBG = 131072;
constexpr size_t CTLB_SS2 = 262144;
constexpr size_t CTLB_SS4 = 393216;
constexpr size_t CTLB_CNTWG = 524288;
constexpr size_t CTLB_TILEE = 589824;
constexpr size_t WS_WIN = 1 * MiB, WS_WPC = 9 * MiB, WS_WBA = 10 * MiB, WS_WOUT = 11 * MiB, WS_WR = 13 * MiB, WS_WPG = 14 * MiB, WS_WPP = 16 * MiB;
constexpr size_t WS_RS1 = 17 * MiB, WS_RS3 = 17 * MiB + 131072;
constexpr size_t WS_TOPI = 18 * MiB, WS_TOPG = 18 * MiB + 524288, WS_LRANK = 19 * MiB, WS_POSOF = 19 * MiB + 524288;
constexpr size_t WS_ROWMAP = 20 * MiB, WS_ROWGATE = 21 * MiB, WS_ROWSCALE = 17 * MiB + 262144;
constexpr size_t WS_W1 = 22 * MiB, WS_W2 = 150 * MiB, WS_PB = 214 * MiB, WS_X1B = 230 * MiB;
constexpr size_t WS_R1 = 294 * MiB;
constexpr size_t WS_R2 = 566 * MiB;
constexpr size_t PJ_U = 0, PJ_Q = 32 * MiB, PJ_KV = 64 * MiB, PJ_QI = 80 * MiB, PJ_KW = 112 * MiB, PJ_G = 120 * MiB;
constexpr size_t WS_SEL = 838 * MiB;
constexpr size_t WS_PP = 870 * MiB;
constexpr size_t WS_END = 934 * MiB;

constexpr int LDS_MAIN = 0;
constexpr int LDS_KT = 131072;
constexpr int LDS_HIST = 147456;
constexpr int LDS_ATM = 155648;
constexpr int LDS_MISC = 156672;
constexpr int LDS_BYTES = 157696;

__device__ __forceinline__ unsigned f2bf(float f) { unsigned u = __builtin_bit_cast(unsigned, f); return (u + 0x7fffu + ((u >> 16) & 1u)) >> 16; }
__device__ __forceinline__ unsigned pk2(float lo, float hi) { return f2bf(lo) | (f2bf(hi) << 16); }
__device__ __forceinline__ float bf_lo(unsigned w) { return __builtin_bit_cast(float, w << 16); }
__device__ __forceinline__ float bf_hi(unsigned w) { return __builtin_bit_cast(float, w & 0xffff0000u); }
__device__ __forceinline__ float bf1(bf16_t b) { return __builtin_bit_cast(float, ((unsigned)b) << 16); }
typedef float f32x2_ __attribute__((ext_vector_type(2)));
__device__ __forceinline__ u32x2 fp8x4_to_bf16x4(unsigned w) {
    const f32x2_ a = __builtin_amdgcn_cvt_pk_f32_fp8((int)w, false), b = __builtin_amdgcn_cvt_pk_f32_fp8((int)w, true);
    const float ax = a.x, ay = a.y, bx = b.x, by = b.y;
    u32x2 r; r.x = __builtin_amdgcn_perm(__float_as_uint(ay), __float_as_uint(ax), 0x07060302u);
    r.y = __builtin_amdgcn_perm(__float_as_uint(by), __float_as_uint(bx), 0x07060302u); return r;
}
__device__ __forceinline__ bf16x8 fp8x8_to_bf16x8(unsigned w0, unsigned w1) { const u32x2 a = fp8x4_to_bf16x4(w0), b = fp8x4_to_bf16x4(w1); return __builtin_bit_cast(bf16x8, (u32x4){a.x, a.y, b.x, b.y}); }
__device__ __forceinline__ float clamp_e4m3(float v) { return __builtin_amdgcn_fmed3f(v, -448.0f, 448.0f); }
__device__ __forceinline__ unsigned pk4_fp8(float a, float b, float c, float d) { int w = __builtin_amdgcn_cvt_pk_fp8_f32(clamp_e4m3(a), clamp_e4m3(b), 0, false); w = __builtin_amdgcn_cvt_pk_fp8_f32(clamp_e4m3(c), clamp_e4m3(d), w, true); return (unsigned)w; }
__device__ __forceinline__ float sigmoidf_(float x) { return __builtin_amdgcn_rcpf(1.0f + __expf(-x)); }
#define LDS_WAIT() asm volatile("s_waitcnt lgkmcnt(0)" ::: "memory")
#define VM_WAIT() asm volatile("s_waitcnt vmcnt(0)" ::: "memory")
__device__ __forceinline__ float wave_sum(float v) {
#pragma unroll
    for (int o = 1; o < 64; o <<= 1) v += __shfl_xor(v, o);
    return v;
}

#define XB_TMO      128
#define XB_XCNT(j)  (256  + 64 * (j))
#define XB_XSUB(j)  (1280 + 64 * (j))
#define XB_XGEN(j)  (2304 + 64 * (j))
#define XB_TOP      3328
#define XB_TOPGEN   3392
#define XCD_BAR_WORDS 3456
#define XB_SPIN_CAP (1u << 22)
__device__ __forceinline__ unsigned xb_ld(unsigned* p)              { return __hip_atomic_load(p, __ATOMIC_RELAXED, __HIP_MEMORY_SCOPE_AGENT); }
__device__ __forceinline__ unsigned xb_add(unsigned* p, unsigned v) { return __hip_atomic_fetch_add(p, v, __ATOMIC_RELAXED, __HIP_MEMORY_SCOPE_AGENT); }
__device__ __forceinline__ unsigned xb_xcc_id() { return (unsigned)__builtin_amdgcn_s_getreg((3 << 11) | 20) & 0xFu; }
#define XB_SPIN(cond, bar) do { unsigned _sp = 0; while (cond) { __builtin_amdgcn_s_sleep(1); \
    if ((++_sp & 255u) == 0u) { if (xb_ld(&(bar)[XB_TMO])) break; if (_sp > XB_SPIN_CAP) { atomicAdd(&(bar)[XB_TMO], 1u); break; } } } } while (0)
struct XcdBarrier { unsigned* bar; unsigned x; volatile LAS unsigned* st; };
__device__ __forceinline__ XcdBarrier xcd_barrier_post(unsigned* bar, volatile LAS unsigned* st) {
    XcdBarrier b; b.bar = bar; b.x = xb_xcc_id(); b.st = st;
    if (threadIdx.x == 0) (void)xb_add(&bar[XB_XCNT(b.x)], 1u);
    return b;
}
__device__ __forceinline__ void xcd_barrier_complete(unsigned* bar, unsigned x, unsigned& nloc, unsigned& nx) {
    const unsigned G = gridDim.x * gridDim.y * gridDim.z;
    unsigned sum, cnt, mine, sp = 0u;
    for (;;) {
        sum = 0u; cnt = 0u; mine = 0u;
#pragma unroll
        for (unsigned j = 0; j < 16; ++j) { const unsigned c = xb_ld(&bar[XB_XCNT(j)]); sum += c; cnt += (c > 0u) ? 1u : 0u; mine = (j == x) ? c : mine; }
        if (sum == G) break;
        __builtin_amdgcn_s_sleep(1);
        if ((++sp & 255u) == 0u) { if (xb_ld(&bar[XB_TMO])) break; if (sp > XB_SPIN_CAP) { atomicAdd(&bar[XB_TMO], 1u); break; } }
    }
    nloc = mine > 0u ? mine : 1u; nx = cnt > 0u ? cnt : 1u;
}
__device__ __forceinline__ void xcd_barrier(const XcdBarrier& b) {
    asm volatile("s_waitcnt vmcnt(0)" ::: "memory");
    __syncthreads();
    if (threadIdx.x == 0) {
        unsigned* bar = b.bar;
        __builtin_amdgcn_s_waitcnt(0);
        unsigned nloc = b.st[0], nx = b.st[1];
        if (nloc == 0u) { xcd_barrier_complete(bar, b.x, nloc, nx); b.st[0] = nloc; b.st[1] = nx; }
        const unsigned old = xb_add(&bar[XB_XSUB(b.x)], 1u);
        const unsigned gen = old / nloc;
        if (old + 1u == (gen + 1u) * nloc) {
            __builtin_amdgcn_fence(__ATOMIC_RELEASE, "agent");
            asm volatile("s_waitcnt vmcnt(0)" ::: "memory");
            const unsigned og = xb_add(&bar[XB_TOP], 1u);
            const unsigned tg = og / nx;
            if (og + 1u == (tg + 1u) * nx) xb_add(&bar[XB_TOPGEN], 1u);
            else XB_SPIN(xb_ld(&bar[XB_TOPGEN]) == tg, bar);
            __builtin_amdgcn_fence(__ATOMIC_ACQUIRE, "agent");
            xb_add(&bar[XB_XGEN(b.x)], 1u);
            asm volatile("s_waitcnt vmcnt(0)" ::: "memory");
        } else {
            XB_SPIN(xb_ld(&bar[XB_XGEN(b.x)]) == gen, bar);
            __builtin_amdgcn_fence(__ATOMIC_ACQUIRE, "agent");
            asm volatile("s_waitcnt vmcnt(0)" ::: "memory");
        }
    }
    __syncthreads();
}

namespace pg8 {
constexpr int BM = 256, BK = 64, HALF = 128, HTB = HALF * BK * 2, STAGE_BYTES = 8 * HTB, NXCD = 8, WGM = 8;
__host__ __device__ __forceinline__ int lds_byte(int r, int c) { const int st = (r >> 4) * 2 + (c >> 5), rr = r & 15, cc = c & 31, ob = rr * 64 + cc * 2; return st * 1024 + (ob ^ (((ob >> 9) & 1) << 5)); }
__host__ __device__ __forceinline__ void stage_rc(int b, int& R, int& C) { const int st = b / 1024, sb = b % 1024, swz = sb ^ (((sb >> 9) & 1) << 5); R = (st >> 1) * 16 + swz / 64; C = (st & 1) * 32 + (swz % 64) / 2; }
__host__ __device__ __forceinline__ int perm32(int rho) { const int n = rho >> 4, i = rho & 15; return 8 * (i >> 2) + 4 * n + (i & 3); }

struct Unit { int pm, pn, e; };
struct Gemm { const bf16_t* A; const bf16_t* Bt; int M, N, K; size_t bstride; const int* rowmap; };

struct StaticOrder {
    int nM, nN, nwg, G, c;
    __device__ void init(int M_, int N_, int G_, int c_) { nM = M_ / BM; nN = N_ / BM; nwg = nM * nN; G = G_; c = c_; }
    __device__ bool next(int i, Unit& u) const {
        const long L = (long)i * G + c; if (L >= nwg) return false;
        int wgid = (int)L; { const int q = nwg / NXCD, r = nwg % NXCD, xcd = wgid % NXCD, off = wgid / NXCD; wgid = (xcd < r ? xcd * (q + 1) : r * (q + 1) + (xcd - r) * q) + off; }
        const int nig = WGM * nN, gid = wgid / nig, fm = gid * WGM, gsz = (nM - fm) < WGM ? (nM - fm) : WGM;
        u.pm = fm + ((wgid % nig) % gsz); u.pn = (wgid % nig) / gsz; u.e = 0; return true;
    }
};
struct MoeOrder {
    const LAS int* tile_e; int ntiles, nct, G, c;
    __device__ bool next(int i, Unit& u) const {
        const int v = (G % 8 == 0) ? (c % 8) * (G / 8) + c / 8 : c;
        const long L = (long)i * G + v; if (L >= (long)ntiles * nct) return false;
        u.pm = (int)(L / nct); u.pn = (int)(L % nct); u.e = __builtin_amdgcn_readfirstlane(tile_e[u.pm]); return true;
    }
};

struct PPOrder {
    int S, r;
    __device__ __forceinline__ bool next(int i, Unit& u) const { if (r < 0) return false; const int L = r + i * S; if (L >= 512) return false; u.pm = L >> 2; u.pn = L & 3; u.e = 0; return true; }
};
__device__ __forceinline__ unsigned cvt_pk_bf16(float lo, float hi) { unsigned r; asm volatile("v_cvt_pk_bf16_f32 %0, %1, %2" : "=v"(r) : "v"(lo), "v"(hi)); return r; }

struct NoHook { static constexpr bool ACTIVE = false; };
typedef int v8i32 __attribute__((ext_vector_type(8)));
typedef long i64x2 __attribute__((ext_vector_type(2)));
template <class Epi, class Sched, bool GATHER, class Hook = NoHook, int FP8 = 0>
__device__ __forceinline__ void gemm_phase(LAS unsigned char* lds, const Gemm g, const Sched& S, const Epi& E, const Hook& Hk = Hook()) {
    int tid_ = (int)threadIdx.x; asm volatile("" : "+v"(tid_));
    const int tid = tid_, wid = __builtin_amdgcn_readfirstlane(tid >> 6), lane = tid & 63, wr = wid >> 2, wc = wid & 3, fr = lane & 15, fq = lane >> 4;
    const int K = g.K, nt = K / BK;
    unsigned voffA[2][2], nvoffA[2][2], voffB[2]; int RA[2], CA[2];
#pragma unroll
    for (int i = 0; i < 2; ++i) { int R, C; stage_rc(tid * 16 + i * 8192, R, C); const int Rb = Epi::PERM ? ((R & ~31) + perm32(R & 31)) : R;
        RA[i] = R; CA[i] = C; voffB[i] = (unsigned)(Rb * K + C) * 2u; }
    const size_t kstep = (size_t)(BK * 2);
    const size_t hstep = (size_t)HALF * K * 2;
    const size_t tstep = 2 * hstep;
    const unsigned ldsw = (unsigned)wid * 1024u;
    const int aoff = lds_byte(wr * 64 + fr, fq * 8), boff = lds_byte(wc * 32 + fr, fq * 8);
#define PG8_SA(b, h) (((b) * 2 + (h)) * HTB)
#define PG8_SB(b, h) ((4 + (b) * 2 + (h)) * HTB)
      \
    const __amdgpu_buffer_rsrc_t rsA = __builtin_amdgcn_make_buffer_rsrc((void*)g.A, 0, 0x7FFFFFFF, 0x00020000), rsB = __builtin_amdgcn_make_buffer_rsrc((void*)g.Bt, 0, 0x7FFFFFFF, 0x00020000);
#define PG8_STAGE2(bufoff, gbase, v0, v1) do { \
        if constexpr (FP8 == 2) { if ((bufoff) < 4 * HTB) { const int so_ = (int)((const char*)(gbase) - (const char*)g.A); \
                __builtin_amdgcn_raw_ptr_buffer_load_lds(rsA, (LAS void*)(lds + (bufoff) + ldsw), 16, (int)(v0), so_, 0, 0); __builtin_amdgcn_raw_ptr_buffer_load_lds(rsA, (LAS void*)(lds + (bufoff) + ldsw + 8192), 16, (int)(v1), so_, 0, 0); } \
            else { const int so_ = (int)((const char*)(gbase) - (const char*)g.Bt); \
                __builtin_amdgcn_raw_ptr_buffer_load_lds(rsB, (LAS void*)(lds + (bufoff) + ldsw), 16, (int)(v0), so_, 0, 0); __builtin_amdgcn_raw_ptr_buffer_load_lds(rsB, (LAS void*)(lds + (bufoff) + ldsw + 8192), 16, (int)(v1), so_, 0, 0); } } \
        else { \
        __builtin_amdgcn_global_load_lds((const unsigned*)((const char*)(gbase) + (v0)), (LAS unsigned*)(lds + (bufoff) + ldsw), 16, 0, 0); \
        __builtin_amdgcn_global_load_lds((const unsigned*)((const char*)(gbase) + (v1)), (LAS unsigned*)(lds + (bufoff) + ldsw + 8192), 16, 0, 0); } } while (0)
#define PG8_STAGEB(bufoff, gbase) PG8_STAGE2(bufoff, gbase, voffB[0], voffB[1])
#define PG8_LDA(dst, b, h) do { _Pragma("unroll") for (int m = 0; m < 4; ++m) _Pragma("unroll") for (int k = 0; k < 2; ++k) dst[m][k] = *(const LAS bf16x8*)(lds + PG8_SA(b, h) + aoff + m * 2048 + k * 1024); } while (0)
#define PG8_LDB(dst, b, h) do { _Pragma("unroll") for (int n = 0; n < 2; ++n) _Pragma("unroll") for (int k = 0; k < 2; ++k) dst[n][k] = *(const LAS bf16x8*)(lds + PG8_SB(b, h) + boff + n * 2048 + k * 1024); } while (0)
#define PG8_MMA(ai, bj, At, Bt) do { __builtin_amdgcn_s_setprio(1); \
        if constexpr (FP8 == 2) { _Pragma("unroll") for (int m = 0; m < 4; ++m) _Pragma("unroll") for (int n = 0; n < 2; ++n) { \
            const v8i32 b_ = __builtin_bit_cast(v8i32, __builtin_shufflevector(Bt[n][0], Bt[n][1], 0, 1, 2, 3, 4, 5, 6, 7, 8, 9, 10, 11, 12, 13, 14, 15)); \
            const v8i32 a_ = __builtin_bit_cast(v8i32, __builtin_shufflevector(At[m][0], At[m][1], 0, 1, 2, 3, 4, 5, 6, 7, 8, 9, 10, 11, 12, 13, 14, 15)); \
            asm volatile("v_mfma_scale_f32_16x16x128_f8f6f4 %0, %1, %2, %0, %3, %3 op_sel_hi:[0,0,0]" : "+v"(acc[ai][bj][m][n]) : "v"(b_), "v"(a_), "v"(sc1_)); } } \
        else if constexpr (FP8 == 1) { _Pragma("unroll") for (int m = 0; m < 4; ++m) _Pragma("unroll") for (int n = 0; n < 2; ++n) _Pragma("unroll") for (int k = 0; k < 2; ++k) { \
            const i64x2 b_ = __builtin_bit_cast(i64x2, Bt[n][k]), a_ = __builtin_bit_cast(i64x2, At[m][k]); \
            acc[ai][bj][m][n] = __builtin_amdgcn_mfma_f32_16x16x32_fp8_fp8(b_.x, a_.x, acc[ai][bj][m][n], 0, 0, 0); acc[ai][bj][m][n] = __builtin_amdgcn_mfma_f32_16x16x32_fp8_fp8(b_.y, a_.y, acc[ai][bj][m][n], 0, 0, 0); } } \
        else { _Pragma("unroll") for (int m = 0; m < 4; ++m) _Pragma("unroll") for (int n = 0; n < 2; ++n) _Pragma("unroll") for (int k = 0; k < 2; ++k) \
            acc[ai][bj][m][n] = __builtin_amdgcn_mfma_f32_16x16x32_bf16(Bt[n][k], At[m][k], acc[ai][bj][m][n], 0, 0, 0); } \
        __builtin_amdgcn_s_setprio(0); } while (0)
#define PG8_WAIT_V(n) asm volatile("s_waitcnt vmcnt(" #n ")" ::: "memory")
#define PG8_WAIT_L(n) asm volatile("s_waitcnt lgkmcnt(" #n ")" ::: "memory")
#define PG8_BAR __builtin_amdgcn_s_barrier()
#define PG8_SCHED __builtin_amdgcn_sched_barrier(0)
    Unit cur, nxt; int ui = 0;
    if (!S.next(0, cur)) return;
    int sc1_ = 0x7F7F7F7F; if constexpr (FP8 == 2) asm volatile("" : "+v"(sc1_));
    f32x4 acc[2][2][4][2];
#pragma unroll
    for (int a = 0; a < 2; ++a)
#pragma unroll
        for (int b = 0; b < 2; ++b)
#pragma unroll
            for (int m = 0; m < 4; ++m)
#pragma unroll
                for (int n = 0; n < 2; ++n) acc[a][b][m][n] = (f32x4){0.f, 0.f, 0.f, 0.f};
    bf16x8 At[4][2], B0[2][2], B1[2][2];
#pragma unroll
    for (int h = 0; h < 2; ++h)
#pragma unroll
        for (int i = 0; i < 2; ++i) {
            if constexpr (GATHER) voffA[h][i] = ((unsigned)g.rowmap[cur.pm * BM + h * HALF + RA[i]] * (unsigned)K + (unsigned)CA[i]) * 2u;
            else voffA[h][i] = (unsigned)((h * HALF + RA[i]) * K + CA[i]) * 2u;
            if constexpr (GATHER) nvoffA[h][i] = voffA[h][i];
        }
    const char* cA = GATHER ? (const char*)g.A : (const char*)g.A + (size_t)cur.pm * tstep;
    const char* cB = (const char*)g.Bt + (size_t)cur.e * g.bstride + (size_t)cur.pn * tstep;
    PG8_STAGEB(PG8_SB(0, 0), cB); PG8_STAGE2(PG8_SA(0, 0), cA, voffA[0][0], voffA[0][1]); PG8_STAGEB(PG8_SB(0, 1), cB + hstep); PG8_STAGE2(PG8_SA(0, 1), cA, voffA[1][0], voffA[1][1]);
    if (wr == 1) PG8_BAR;
    PG8_WAIT_V(4); PG8_BAR;
    PG8_STAGEB(PG8_SB(1, 0), cB + kstep); PG8_STAGE2(PG8_SA(1, 0), cA + kstep, voffA[0][0], voffA[0][1]); PG8_STAGEB(PG8_SB(1, 1), cB + hstep + kstep);
    PG8_WAIT_V(6); PG8_BAR;
    for (;;) {
        const bool has_next = S.next(ui + 1, nxt);
        const char* nA = has_next ? (GATHER ? (const char*)g.A : (const char*)g.A + (size_t)nxt.pm * tstep) : cA;
        const char* nB = has_next ? (const char*)g.Bt + (size_t)nxt.e * g.bstride + (size_t)nxt.pn * tstep : cB;
        if constexpr (GATHER) {
            if (has_next) {
#pragma unroll
                for (int h = 0; h < 2; ++h)
#pragma unroll
                    for (int i = 0; i < 2; ++i) nvoffA[h][i] = ((unsigned)g.rowmap[nxt.pm * BM + h * HALF + RA[i]] * (unsigned)K + (unsigned)CA[i]) * 2u;
            }
        }
        for (int t = 0; t < nt; t += 2) {
            const bool last = (t == nt - 2);
            if constexpr (Hook::ACTIVE) { if (t == nt / 2) Hk.mid(acc, cur); }
            const char* a1 = cA + (size_t)(t + 1) * kstep;
            const char* a2 = last ? nA : cA + (size_t)(t + 2) * kstep; const char* b2 = last ? nB : cB + (size_t)(t + 2) * kstep;
            const char* a3 = a2 + kstep; const char* b3 = b2 + kstep;
            unsigned w00 = voffA[0][0], w01 = voffA[0][1], w10 = voffA[1][0], w11 = voffA[1][1];
            if constexpr (GATHER) { if (last) { w00 = nvoffA[0][0]; w01 = nvoffA[0][1]; w10 = nvoffA[1][0]; w11 = nvoffA[1][1]; } }
            PG8_LDB(B0, 0, 0); PG8_SCHED; PG8_LDA(At, 0, 0); PG8_STAGE2(PG8_SA(1, 1), a1, voffA[1][0], voffA[1][1]);
            PG8_WAIT_L(8); PG8_BAR; PG8_WAIT_L(0); PG8_MMA(0, 0, At, B0); PG8_BAR; PG8_SCHED;
            PG8_LDB(B1, 0, 1); PG8_STAGEB(PG8_SB(0, 0), b2);
            PG8_BAR; PG8_WAIT_L(0); PG8_MMA(0, 1, At, B1); PG8_BAR;
            PG8_LDA(At, 0, 1); PG8_STAGE2(PG8_SA(0, 0), a2, w00, w01);
            PG8_BAR; PG8_WAIT_L(0); PG8_MMA(1, 0, At, B0); PG8_BAR; PG8_SCHED;
            PG8_STAGEB(PG8_SB(0, 1), b2 + hstep);
            PG8_WAIT_V(6); PG8_BAR; PG8_MMA(1, 1, At, B1); PG8_BAR;
            PG8_LDB(B0, 1, 0); PG8_SCHED; PG8_LDA(At, 1, 0); PG8_STAGE2(PG8_SA(0, 1), a2, w10, w11);
            PG8_WAIT_L(8); PG8_BAR; PG8_WAIT_L(0); PG8_MMA(0, 0, At, B0); PG8_BAR; PG8_SCHED;
            PG8_LDB(B1, 1, 1); PG8_STAGEB(PG8_SB(1, 0), b3);
            PG8_BAR; PG8_WAIT_L(0); PG8_MMA(0, 1, At, B1); PG8_BAR;
            PG8_LDA(At, 1, 1); PG8_STAGE2(PG8_SA(1, 0), a3, w00, w01);
            PG8_BAR; PG8_WAIT_L(0); PG8_MMA(1, 0, At, B0); PG8_BAR; PG8_SCHED;
            PG8_STAGEB(PG8_SB(1, 1), b3 + hstep);
            PG8_WAIT_V(6); PG8_BAR; PG8_MMA(1, 1, At, B1); PG8_BAR;
        }
        if constexpr (FP8 == 2) asm volatile("s_nop 15\n\ts_nop 15" ::: "memory");
        E(acc, cur, wr, wc, fr, fq);
        if (!has_next) break;
#pragma unroll
        for (int a = 0; a < 2; ++a)
#pragma unroll
            for (int b = 0; b < 2; ++b)
#pragma unroll
                for (int m = 0; m < 4; ++m)
#pragma unroll
                    for (int n = 0; n < 2; ++n) acc[a][b][m][n] = (f32x4){0.f, 0.f, 0.f, 0.f};
        cur = nxt; cA = nA; cB = nB; ++ui;
        if constexpr (GATHER) {
#pragma unroll
            for (int h = 0; h < 2; ++h)
#pragma unroll
                for (int i = 0; i < 2; ++i) voffA[h][i] = nvoffA[h][i];
        }
    }
    PG8_WAIT_V(0);
    if (wr == 0) PG8_BAR;
    PG8_BAR;
#undef PG8_SA
#undef PG8_SB
#undef PG8_STAGE2
#undef PG8_STAGEB
#undef PG8_LDA
#undef PG8_LDB
#undef PG8_MMA
#undef PG8_WAIT_V
#undef PG8_WAIT_L
#undef PG8_BAR
#undef PG8_SCHED
}
}
using pg8::Unit;

typedef f32x4 AccT[2][2][4][2];
struct EpiProj {
    static constexpr bool PERM = true;
    unsigned char* pj; const float* rs;
    __device__ __forceinline__ void operator()(const AccT& acc, const Unit& u, int wr, int wc, int fr, int fq) const {
        const int pn = u.pn; const bool sig = pn >= 8;
        bf16_t* base; int ld, nbj = 2;
        if (pn < 2)       { base = (bf16_t*)(pj + PJ_U) + pn * 256; ld = 512; }
        else if (pn < 4)  { base = (bf16_t*)(pj + PJ_Q) + (pn - 2) * 256; ld = 512; }
        else if (pn == 4) {
            unsigned char* kv8 = pj + PJ_KV; const int row0 = u.pm * 256 + wr * 64 + fr, cb = wc * 32 + 8 * fq;
            float sv[8];
#pragma unroll
            for (int g = 0; g < 8; ++g) sv[g] = rs[row0 + (g >> 2) * 128 + (g & 3) * 16];
#pragma unroll
            for (int ai = 0; ai < 2; ++ai)
#pragma unroll
                for (int m = 0; m < 4; ++m) { const int row = row0 + ai * 128 + m * 16; const float s = sv[ai * 4 + m];
#pragma unroll
                    for (int bj = 0; bj < 2; ++bj) { const f32x4 v0 = acc[ai][bj][m][0] * s, v1 = acc[ai][bj][m][1] * s;
                        u32x2 w; w.x = pk4_fp8(v0[0], v0[1], v0[2], v0[3]); w.y = pk4_fp8(v1[0], v1[1], v1[2], v1[3]);
                        *(u32x2*)(kv8 + (size_t)row * 256 + bj * 128 + cb) = w; } }
            return; }
        else if (pn < 7)  { base = (bf16_t*)(pj + PJ_QI) + (pn - 5) * 256; ld = 512; }
        else if (pn == 7) { base = (bf16_t*)(pj + PJ_KW); ld = 128; nbj = 1; }
        else              { base = (bf16_t*)(pj + PJ_G) + (pn - 8) * 256; ld = 2048; }
        const int row0 = u.pm * 256 + wr * 64 + fr, col0 = wc * 32 + 8 * fq;
        float sv[8];
#pragma unroll
        for (int g = 0; g < 8; ++g) sv[g] = rs[row0 + (g >> 2) * 128 + (g & 3) * 16];
#pragma unroll
        for (int ai = 0; ai < 2; ++ai)
#pragma unroll
            for (int m = 0; m < 4; ++m) { const int row = row0 + ai * 128 + m * 16; const float s = sv[ai * 4 + m]; bf16_t* rowp = base + (size_t)row * ld + col0;
#pragma unroll
                for (int bj = 0; bj < 2; ++bj) { if (bj < nbj) { f32x4 v0 = acc[ai][bj][m][0] * s, v1 = acc[ai][bj][m][1] * s;
                    if (sig) {
#pragma unroll
                        for (int j = 0; j < 4; ++j) { v0[j] = sigmoidf_(v0[j]); v1[j] = sigmoidf_(v1[j]); } }
                    u32x4 w; w.x = pk2(v0[0], v0[1]); w.y = pk2(v0[2], v0[3]); w.z = pk2(v1[0], v1[1]); w.w = pk2(v1[2], v1[3]);
                    *(u32x4*)(rowp + bj * 128) = w; } } }
    }
};
__device__ __forceinline__ float ga_clamp(float g) { return fmaxf(g, 8.67361738e-19f); }
struct HookGateRatio {
    static constexpr bool ACTIVE = true;
    const bf16_t* gates;
    __device__ __forceinline__ void mid(AccT& acc, const Unit& u) const {
        int tz = threadIdx.x; asm volatile("" : "+v"(tz));
        const int wid = tz >> 6, ln = tz & 63, wr = wid >> 2, wc = wid & 3, fr = ln & 15, fq = ln >> 4;
        const int row0 = u.pm * 256 + wr * 64 + fr, col0 = u.pn * 256 + wc * 32 + 8 * fq;
        u32x4 gpv[2][2], gav[2][2];
#pragma unroll
        for (int bj = 0; bj < 2; ++bj) { gpv[0][bj] = *(const u32x4*)(gates + (size_t)row0 * 2048 + col0 + bj * 128); gav[0][bj] = *(const u32x4*)(gates + (size_t)row0 * 2048 + 1024 + col0 + bj * 128); }
#pragma unroll
        for (int ai = 0; ai < 2; ++ai)
#pragma unroll
            for (int m = 0; m < 4; ++m) { const int g1 = ai * 4 + m + 1;
                if (g1 < 8) { const int rown = row0 + (g1 >> 2) * 128 + (g1 & 3) * 16;
#pragma unroll
                    for (int bj = 0; bj < 2; ++bj) { gpv[g1 & 1][bj] = *(const u32x4*)(gates + (size_t)rown * 2048 + col0 + bj * 128); gav[g1 & 1][bj] = *(const u32x4*)(gates + (size_t)rown * 2048 + 1024 + col0 + bj * 128); } }
#pragma unroll
                for (int bj = 0; bj < 2; ++bj) {
                    const u32x4 gp = gpv[m & 1][bj], ga = gav[m & 1][bj];
                    acc[ai][bj][m][0][0] *= bf_lo(gp.x) * __builtin_amdgcn_rcpf(ga_clamp(bf_lo(ga.x))); acc[ai][bj][m][0][1] *= bf_hi(gp.x) * __builtin_amdgcn_rcpf(ga_clamp(bf_hi(ga.x)));
                    acc[ai][bj][m][0][2] *= bf_lo(gp.y) * __builtin_amdgcn_rcpf(ga_clamp(bf_lo(ga.y))); acc[ai][bj][m][0][3] *= bf_hi(gp.y) * __builtin_amdgcn_rcpf(ga_clamp(bf_hi(ga.y)));
                    acc[ai][bj][m][1][0] *= bf_lo(gp.z) * __builtin_amdgcn_rcpf(ga_clamp(bf_lo(ga.z))); acc[ai][bj][m][1][1] *= bf_hi(gp.z) * __builtin_amdgcn_rcpf(ga_clamp(bf_hi(ga.z)));
                    acc[ai][bj][m][1][2] *= bf_lo(gp.w) * __builtin_amdgcn_rcpf(ga_clamp(bf_lo(ga.w))); acc[ai][bj][m][1][3] *= bf_hi(gp.w) * __builtin_amdgcn_rcpf(ga_clamp(bf_hi(ga.w)));
                    }
                asm volatile("" ::: "memory"); }
    }
};
template <bool ADD, bool CLAMP = false> struct EpiGate {
    static constexpr bool PERM = true;
    bf16_t* O; const bf16_t* gate; const bf16_t* addsrc;
    __device__ __forceinline__ void operator()(const AccT& acc, const Unit& u, int wr, int wc, int fr, int fq) const {
        const int row0 = u.pm * 256 + wr * 64 + fr, col0 = u.pn * 256 + wc * 32 + 8 * fq;
        u32x4 gb[4][2];
#pragma unroll
        for (int g = 0; g < 4; ++g)
#pragma unroll
            for (int bj = 0; bj < 2; ++bj) gb[g][bj] = *(const u32x4*)(gate + (size_t)(row0 + g * 16) * 2048 + col0 + bj * 128);
#pragma unroll
        for (int ai = 0; ai < 2; ++ai)
#pragma unroll
            for (int m = 0; m < 4; ++m) { const int row = row0 + ai * 128 + m * 16;
#pragma unroll
                for (int bj = 0; bj < 2; ++bj) { const int col = col0 + bj * 128;
                    const u32x4 gw = gb[m][bj];
                    if (ai == 0) gb[m][bj] = *(const u32x4*)(gate + (size_t)(row + 128) * 2048 + col);
                    f32x4 v0 = acc[ai][bj][m][0], v1 = acc[ai][bj][m][1];
                    if (CLAMP) {
                        v0[0] *= ga_clamp(bf_lo(gw.x)); v0[1] *= ga_clamp(bf_hi(gw.x)); v0[2] *= ga_clamp(bf_lo(gw.y)); v0[3] *= ga_clamp(bf_hi(gw.y));
                        v1[0] *= ga_clamp(bf_lo(gw.z)); v1[1] *= ga_clamp(bf_hi(gw.z)); v1[2] *= ga_clamp(bf_lo(gw.w)); v1[3] *= ga_clamp(bf_hi(gw.w));
                    } else {
                    v0[0] *= bf_lo(gw.x); v0[1] *= bf_hi(gw.x); v0[2] *= bf_lo(gw.y); v0[3] *= bf_hi(gw.y);
                    v1[0] *= bf_lo(gw.z); v1[1] *= bf_hi(gw.z); v1[2] *= bf_lo(gw.w); v1[3] *= bf_hi(gw.w); }
                    if (ADD) { const u32x4 aw = *(const u32x4*)(addsrc + (size_t)row * D + col);
                        v0[0] += bf_lo(aw.x); v0[1] += bf_hi(aw.x); v0[2] += bf_lo(aw.y); v0[3] += bf_hi(aw.y);
                        v1[0] += bf_lo(aw.z); v1[1] += bf_hi(aw.z); v1[2] += bf_lo(aw.w); v1[3] += bf_hi(aw.w); }
                    u32x4 w; w.x = pk2(v0[0], v0[1]); w.y = pk2(v0[2], v0[3]); w.z = pk2(v1[0], v1[1]); w.w = pk2(v1[2], v1[3]);
                    *(u32x4*)(O + (size_t)row * D + col) = w; } }
    }
};
struct EpiX1 {
    static constexpr bool PERM = false;
    const float* x; bf16_t* xb; float* ss; unsigned char* x8;
    __device__ __forceinline__ void operator()(const AccT& acc, const Unit& u, int wr, int wc, int fr, int fq) const {
        const int row0 = u.pm * 256 + wr * 64 + fr, col0 = u.pn * 256 + wc * 32 + 4 * fq;
        f32x4 xv[2][4];
#pragma unroll
        for (int g = 0; g < 2; ++g)
#pragma unroll
            for (int q = 0; q < 4; ++q) xv[g][q] = *(const f32x4*)(x + (size_t)(row0 + g * 16) * D + col0 + (q >> 1) * 128 + (q & 1) * 16);
#pragma unroll
        for (int ai = 0; ai < 2; ++ai)
#pragma unroll
            for (int m = 0; m < 4; ++m) { const int row = row0 + ai * 128 + m * 16; float s = 0.f;
                const int g2 = ai * 4 + m + 2, rown = row0 + (g2 >> 2) * 128 + (g2 & 3) * 16;
#pragma unroll
                for (int bj = 0; bj < 2; ++bj)
#pragma unroll
                    for (int n = 0; n < 2; ++n) { const size_t o = (size_t)row * D + col0 + bj * 128 + n * 16;
                        const f32x4 xin = xv[m & 1][bj * 2 + n];
                        if (g2 < 8) xv[m & 1][bj * 2 + n] = *(const f32x4*)(x + (size_t)rown * D + col0 + bj * 128 + n * 16);
                        const f32x4 v = xin + acc[ai][bj][m][n];
                        u32x2 w; w.x = pk2(v[0], v[1]); w.y = pk2(v[2], v[3]); *(u32x2*)(xb + o) = w;
                        *(unsigned*)(x8 + o) = pk4_fp8(v[0], v[1], v[2], v[3]);
                        s += (v[0] * v[0] + v[1] * v[1]) + (v[2] * v[2] + v[3] * v[3]); }
                s += __shfl_xor(s, 16); s += __shfl_xor(s, 32);
                if (fq == 0) atomicAdd(ss + row, s); }
    }
};
struct EpiMoe1 {
    static constexpr bool PERM = true;
    unsigned char* act; const float* rowscale; const float* b1;
    __device__ __forceinline__ void operator()(const AccT& acc, const Unit& u, int wr, int wc, int fr, int fq) const {
        const int row0 = u.pm * 256 + wr * 64 + fr, colj = u.pn * 128 + wc * 32 + 8 * fq;
        const float* bg = b1 + (size_t)u.e * 2048 + colj; const float* bu = bg + 1024;
        const f32x4 bg0 = *(const f32x4*)bg, bg1 = *(const f32x4*)(bg + 4), bu0 = *(const f32x4*)bu, bu1 = *(const f32x4*)(bu + 4);
        float sv[8];
#pragma unroll
        for (int g = 0; g < 8; ++g) sv[g] = rowscale[row0 + (g >> 2) * 128 + (g & 3) * 16] * (1.0f / 64.0f);
#pragma unroll
        for (int ai = 0; ai < 2; ++ai)
#pragma unroll
            for (int m = 0; m < 4; ++m) { const int row = row0 + ai * 128 + m * 16;
                const float rs = sv[ai * 4 + m];
                float r[8];
#pragma unroll
                for (int n = 0; n < 2; ++n)
#pragma unroll
                    for (int j = 0; j < 4; ++j) { float gl = acc[ai][0][m][n][j] * rs + (n ? bg1[j] : bg0[j]); float up = acc[ai][1][m][n][j] * rs + (n ? bu1[j] : bu0[j]);
                        gl = fminf(gl, 7.0f); up = fminf(fmaxf(up, -7.0f), 7.0f);
                        r[n * 4 + j] = 8.0f * ((up + 1.0f) * (gl * sigmoidf_(1.702f * gl))); }
                u32x2 w; w.x = pk4_fp8(r[0], r[1], r[2], r[3]); w.y = pk4_fp8(r[4], r[5], r[6], r[7]);
                *(u32x2*)(act + (size_t)row * DFF + colj) = w; }
    }
};
struct EpiMoe2 {
    static constexpr bool PERM = true;
    unsigned char* Y; const float* rowgate; const float* b2;
    __device__ __forceinline__ void operator()(const AccT& acc, const Unit& u, int wr, int wc, int fr, int fq) const {
        const int row0 = u.pm * 256 + wr * 64 + fr, col0 = u.pn * 256 + wc * 32 + 8 * fq;
        f32x4 cb[2][2]; float sv[8];
#pragma unroll
        for (int bj = 0; bj < 2; ++bj) { const float* bb = b2 + (size_t)u.e * D + col0 + bj * 128; cb[bj][0] = *(const f32x4*)bb; cb[bj][1] = *(const f32x4*)(bb + 4); }
#pragma unroll
        for (int g = 0; g < 8; ++g) sv[g] = rowgate[row0 + (g >> 2) * 128 + (g & 3) * 16];
#pragma unroll
        for (int ai = 0; ai < 2; ++ai)
#pragma unroll
            for (int m = 0; m < 4; ++m) { const int row = row0 + ai * 128 + m * 16; const float gt = sv[ai * 4 + m];
#pragma unroll
                for (int bj = 0; bj < 2; ++bj) { const int col = col0 + bj * 128;
                    const f32x4 c0 = cb[bj][0], c1 = cb[bj][1];
                    const f32x4 v0 = (acc[ai][bj][m][0] * (1.0f / 512.0f) + c0) * gt, v1 = (acc[ai][bj][m][1] * (1.0f / 512.0f) + c1) * gt;
                    u32x2 w; w.x = pk4_fp8(v0[0], v0[1], v0[2], v0[3]); w.y = pk4_fp8(v1[0], v1[1], v1[2], v1[3]);
                    *(u32x2*)(Y + (size_t)row * D + col) = w; } }
    }
};
struct EpiPP {
    static constexpr bool PERM = true;
    bf16_t* PP;
    __device__ __forceinline__ void operator()(const AccT& acc, const Unit& u, int wr, int wc, int fr, int fq) const {
        const int row0 = u.pm * 256 + wr * 64 + fr, col0 = u.pn * 256 + wc * 32 + 8 * fq;
#pragma unroll
        for (int ai = 0; ai < 2; ++ai)
#pragma unroll
            for (int m = 0; m < 4; ++m) { const int row = row0 + ai * 128 + m * 16;
#pragma unroll
                for (int bj = 0; bj < 2; ++bj) { const f32x4 v0 = acc[ai][bj][m][0], v1 = acc[ai][bj][m][1];
                    u32x4 w; w.x = pk2(v0[0], v0[1]); w.y = pk2(v0[2], v0[3]); w.z = pk2(v1[0], v1[1]); w.w = pk2(v1[2], v1[3]);
                    *(u32x4*)(PP + (size_t)row * D + col0 + bj * 128) = w; } }
    }
};
struct EpiPleGX {
    static constexpr bool PERM = true;
    bf16_t* x3b; const bf16_t* x2b; const bf16_t* PP; const float* rs; float* ss;
    __device__ __forceinline__ void operator()(const AccT& acc, const Unit& u, int wr, int wc, int fr, int fq) const {
        const int row0 = u.pm * 256 + wr * 64 + fr, col0 = u.pn * 256 + wc * 32 + 8 * fq;
        float sv[8]; u32x4 pb[2][2], xq[2][2];
#pragma unroll
        for (int g = 0; g < 8; ++g) sv[g] = rs[row0 + (g >> 2) * 128 + (g & 3) * 16];
#pragma unroll
        for (int g = 0; g < 2; ++g)
#pragma unroll
            for (int bj = 0; bj < 2; ++bj) { const size_t o = (size_t)(row0 + g * 16) * D + col0 + bj * 128; pb[g][bj] = *(const u32x4*)(PP + o); xq[g][bj] = *(const u32x4*)(x2b + o); }
#pragma unroll
        for (int ai = 0; ai < 2; ++ai)
#pragma unroll
            for (int m = 0; m < 4; ++m) { const int row = row0 + ai * 128 + m * 16; const float rsv = sv[ai * 4 + m]; float s = 0.f;
                const int g2 = ai * 4 + m + 2, rown = row0 + (g2 >> 2) * 128 + (g2 & 3) * 16;
#pragma unroll
                for (int bj = 0; bj < 2; ++bj) { const size_t o = (size_t)row * D + col0 + bj * 128;
                    const u32x4 pw = pb[m & 1][bj], xw = xq[m & 1][bj];
                    if (g2 < 8) { const size_t on = (size_t)rown * D + col0 + bj * 128; pb[m & 1][bj] = *(const u32x4*)(PP + on); xq[m & 1][bj] = *(const u32x4*)(x2b + on); }
                    const f32x4 a0 = acc[ai][bj][m][0] * rsv, a1 = acc[ai][bj][m][1] * rsv;
                    f32x4 x0, x1;
                    x0[0] = bf_lo(xw.x) + sigmoidf_(a0[0]) * bf_lo(pw.x); x0[1] = bf_hi(xw.x) + sigmoidf_(a0[1]) * bf_hi(pw.x);
                    x0[2] = bf_lo(xw.y) + sigmoidf_(a0[2]) * bf_lo(pw.y); x0[3] = bf_hi(xw.y) + sigmoidf_(a0[3]) * bf_hi(pw.y);
                    x1[0] = bf_lo(xw.z) + sigmoidf_(a1[0]) * bf_lo(pw.z); x1[1] = bf_hi(xw.z) + sigmoidf_(a1[1]) * bf_hi(pw.z);
                    x1[2] = bf_lo(xw.w) + sigmoidf_(a1[2]) * bf_lo(pw.w); x1[3] = bf_hi(xw.w) + sigmoidf_(a1[3]) * bf_hi(pw.w);
                    { u32x4 w; w.x = pk2(x0[0], x0[1]); w.y = pk2(x0[2], x0[3]); w.z = pk2(x1[0], x1[1]); w.w = pk2(x1[2], x1[3]); *(u32x4*)(x3b + o) = w; }
                    s += (x0[0] * x0[0] + x0[1] * x0[1]) + (x0[2] * x0[2] + x0[3] * x0[3]) + (x1[0] * x1[0] + x1[1] * x1[1]) + (x1[2] * x1[2] + x1[3] * x1[3]); }
                s += __shfl_xor(s, 16); s += __shfl_xor(s, 32);
                if (fq == 0) atomicAdd(ss + row, s); }
    }
};

struct Args { const float* in[20]; float* out; unsigned char* ws; int ph_lo, ph_hi; };
enum { I_X = 0, I_P, I_N1G, I_WIN, I_POOLW, I_POOLS, I_WBP, I_WBA, I_WOUT, I_N2G, I_RW, I_RB, I_W1, I_B1, I_W2, I_B2, I_PNG, I_PGW, I_PPW, I_FG };
enum { PH_PRO = 0, PH_INPROJ, PH_MIXED, PH_POOL, PH_ATT, PH_Z, PH_X1, PH_ROUTER, PH_SCATTER, PH_MOE1, PH_MOE2, PH_COMBINE, PH_PLE, PH_FINAL, NPH };

__device__ __forceinline__ int tr_dst_row(int mode, int n) {
    if (mode == 1) { if (n >= 1152 && n < 1280) { const int d = (n - 1152) & 63; return 1152 + ((n - 1152) & 64) + 16 * (d & 3) + (d >> 2); }
                     return n < 1864 ? n : n + 184; }
    if (mode == 2) return n < 1024 ? (((n >> 7) << 8) + (n & 127)) : ((((n - 1024) >> 7) << 8) + 128 + ((n - 1024) & 127));
    return n;
}
__device__ __forceinline__ float tr_col_scale(int mode, int n) {
    if (mode == 1) { if ((n >= 512 && n < 1024) || (n >= 1280 && n < 1792)) return 0.125f; if (n >= 1856 && n < 1864) return 0.35355339059327373f; }
    return 1.0f;
}
__device__ __forceinline__ void transpose_item(const float* W, int ldw, int Nvalid, int K, bf16_t* WT, const float* kgain, int mode, LAS float* scr, int kb, int nb, int lane, int ldt = 0, float f8scale = 0.f) {
    if (ldt == 0) ldt = K;
    const int k0 = 64 * kb, n0 = 64 * nb, c4 = lane & 15, kr = lane >> 4, nl = n0 + 4 * c4; const bool nok = nl < Nvalid;
    const f32x4 cs = (f32x4){tr_col_scale(mode, nl), tr_col_scale(mode, nl + 1), tr_col_scale(mode, nl + 2), tr_col_scale(mode, nl + 3)};
    f32x4 v[16];
#pragma unroll
    for (int i = 0; i < 16; ++i) { const int kk = 4 * i + kr; v[i] = nok ? *(const f32x4*)(W + (size_t)(k0 + kk) * ldw + nl) : (f32x4){0.f, 0.f, 0.f, 0.f}; }
    float kgv[16];
#pragma unroll
    for (int i = 0; i < 16; ++i) kgv[i] = kgain ? kgain[k0 + 4 * i + kr] : 1.0f;
#pragma unroll
    for (int i = 0; i < 16; ++i) asm volatile("" : "+v"(kgv[i]));
#pragma unroll
    for (int i = 0; i < 16; ++i) { const int kk = 4 * i + kr; *(LAS f32x4*)(scr + kk * 68 + 4 * c4) = v[i] * cs * kgv[i]; }
    LDS_WAIT(); asm volatile("" ::: "memory");
    const int c = lane & 7;
#pragma unroll
    for (int j = 0; j < 8; ++j) { const int n = (lane >> 3) + 8 * j; const LAS float* s = scr + (8 * c) * 68 + n;
        if (f8scale != 0.f) {
            u32x2 o8; o8.x = pk4_fp8(s[0 * 68] * f8scale, s[1 * 68] * f8scale, s[2 * 68] * f8scale, s[3 * 68] * f8scale); o8.y = pk4_fp8(s[4 * 68] * f8scale, s[5 * 68] * f8scale, s[6 * 68] * f8scale, s[7 * 68] * f8scale);
            if (n0 + n < Nvalid) *(u32x2*)((unsigned char*)WT + (size_t)tr_dst_row(mode, n0 + n) * ldt + k0 + 8 * c) = o8;
        } else {
        u32x4 o; o.x = pk2(s[0 * 68], s[1 * 68]); o.y = pk2(s[2 * 68], s[3 * 68]); o.z = pk2(s[4 * 68], s[5 * 68]); o.w = pk2(s[6 * 68], s[7 * 68]);
        if (n0 + n < Nvalid) *(u32x4*)(WT + (size_t)tr_dst_row(mode, n0 + n) * ldt + k0 + 8 * c) = o; } }
    LDS_WAIT(); asm volatile("" ::: "memory");
}
constexpr int I_E1 = 32 * 16 * 32, I_E2 = 32 * 16 * 16, N_EXPERT_ITEMS = I_E1 + I_E2;
constexpr int I_BA = 8 * 16, I_OUT = 16 * 16, I_R = 16, I_PG = 16 * 16, I_PP = 4 * 16, N_SMALL_ITEMS = I_BA + I_OUT + I_R + I_PG + I_PP;
constexpr int DC_EXPERT = N_EXPERT_ITEMS / 8, DC_SMALL = N_SMALL_ITEMS / 8, DC_WPC = 2048 / 8, DC_PB = M * PLE / 8 / 4096, DC_TOTAL = DC_EXPERT + DC_SMALL + DC_WPC + DC_PB;
__device__ __forceinline__ void deferred_chunk(const Args& a, LAS unsigned char* lds, int c, int wave, int lane) {
    unsigned char* ws = a.ws; LAS float* scr = (LAS float*)(lds + wave * 17408);
    if (c < DC_EXPERT) { int r = c * 8 + wave;
        if (r < I_E1) { const int e = r / (16 * 32), q = r % (16 * 32);
            transpose_item(a.in[I_W1] + (size_t)e * D * 2048, 2048, 2048, D, (bf16_t*)(ws + WS_W1 + (size_t)e * 2048 * D), a.in[I_N2G], 2, scr, q / 32, q % 32, lane, D, 64.0f); return; }
        r -= I_E1; { const int e = r / (16 * 16), q = r % (16 * 16);
            transpose_item(a.in[I_W2] + (size_t)e * DFF * D, D, D, DFF, (bf16_t*)(ws + WS_W2 + (size_t)e * D * DFF), nullptr, 0, scr, q / 16, q % 16, lane, DFF, 64.0f); }
        return; }
    c -= DC_EXPERT;
    if (c < DC_SMALL) { int r = c * 8 + wave;
        if (r < I_BA) { transpose_item(a.in[I_WBA], D, D, 512, (bf16_t*)(ws + WS_WPC) + 512, nullptr, 0, scr, r / 16, r % 16, lane, 1024); return; } r -= I_BA;
        if (r < I_OUT) { transpose_item(a.in[I_WOUT], D, D, D, (bf16_t*)(ws + WS_WOUT), nullptr, 0, scr, r / 16, r % 16, lane); return; } r -= I_OUT;
        if (r < I_R) { transpose_item(a.in[I_RW], NE, NE, D, (bf16_t*)(ws + WS_WR), a.in[I_N2G], 0, scr, r, 0, lane); return; } r -= I_R;
        if (r < I_PG) { transpose_item(a.in[I_PGW], D, D, D, (bf16_t*)(ws + WS_WPG), a.in[I_PNG], 0, scr, r / 16, r % 16, lane); return; } r -= I_PG;
        transpose_item(a.in[I_PPW], D, D, PLE, (bf16_t*)(ws + WS_WPP), nullptr, 0, scr, r / 16, r % 16, lane); return; }
    c -= DC_SMALL;
    if (c < DC_WPC) {
        const float* pw = a.in[I_POOLW]; const float* ps = a.in[I_POOLS]; const float* wbp = a.in[I_WBP]; bf16_t* wpc = (bf16_t*)(ws + WS_WPC);
        const int it = c * 8 + wave, gc = it >> 2, n0 = (it & 3) * 256 + lane * 4, g = gc >> 7;
        f32x4 acc = (f32x4){0.f, 0.f, 0.f, 0.f};
        const float* pwr = pw + (size_t)gc * 128; const float* psr = ps + g * 128; const float* wr_ = wbp + (size_t)(g * 128) * D + n0;
#pragma unroll 8
        for (int d = 0; d < 128; ++d) { const float av = pwr[d] * psr[d]; const f32x4 wv = *(const f32x4*)(wr_ + (size_t)d * D); acc += wv * av; }
#pragma unroll
        for (int j = 0; j < 4; ++j) wpc[(size_t)(n0 + j) * 1024 + gc] = (bf16_t)f2bf(acc[j]);
        return; }
    c -= DC_WPC;
    {
        const f32x4* p = (const f32x4*)a.in[I_P]; u32x4* pb = (u32x4*)(ws + WS_PB);
        f32x4 pv[8][2];
#pragma unroll
        for (int k = 0; k < 8; ++k) { const int i = c * 4096 + k * 512 + (int)threadIdx.x; pv[k][0] = p[2 * i]; pv[k][1] = p[2 * i + 1]; }
#pragma unroll
        for (int k = 0; k < 8; ++k) { const int i = c * 4096 + k * 512 + (int)threadIdx.x; const f32x4 v0 = pv[k][0], v1 = pv[k][1];
            u32x4 w; w.x = pk2(v0[0], v0[1]); w.y = pk2(v0[2], v0[3]); w.z = pk2(v1[0], v1[1]); w.w = pk2(v1[2], v1[3]); pb[i] = w; } }
}
__device__ __forceinline__ void p0_prologue(const Args& a, LAS unsigned char* lds, int wave, int lane, int G) {
    unsigned char* ws = a.ws;
    LAS float* scr = (LAS float*)(lds + wave * 17408);
    const int gw = blockIdx.x * NWAVES + wave, NGW = G * NWAVES;
    for (int it = gw; it < 16 * 62; it += NGW) transpose_item(a.in[I_WIN], IN_COLS, IN_COLS, D, (bf16_t*)(ws + WS_WIN), a.in[I_N1G], 1, scr, it / 62, it % 62, lane);
    for (int c = DC_EXPERT + (int)blockIdx.x; c < DC_TOTAL; c += G) { deferred_chunk(a, lds, c, wave, lane); __syncthreads(); }
    { const int gt = blockIdx.x * NTHREADS + threadIdx.x, NT = G * NTHREADS; u32x4* z = (u32x4*)((bf16_t*)(ws + WS_WIN) + (size_t)1864 * D);
      for (int i = gt; i < 184 * D * 2 / 16; i += NT) z[i] = (u32x4){0u, 0u, 0u, 0u}; }
    { const float* x = a.in[I_X]; bf16_t* xb = (bf16_t*)(ws + WS_R2); float* rs1 = (float*)(ws + WS_RS1);
      for (int m0 = gw; m0 < M; m0 += 2 * NGW) { f32x4 v[2][4];
#pragma unroll
        for (int r = 0; r < 2; ++r) { const int m = m0 + r * NGW; if (m < M) { const f32x4* xr = (const f32x4*)(x + (size_t)m * D) + lane;
#pragma unroll
            for (int j = 0; j < 4; ++j) v[r][j] = xr[64 * j]; } }
#pragma unroll
        for (int r = 0; r < 2; ++r) { const int m = m0 + r * NGW; if (m < M) { float s = 0.f;
#pragma unroll
            for (int j = 0; j < 4; ++j) s += (v[r][j][0] * v[r][j][0] + v[r][j][1] * v[r][j][1]) + (v[r][j][2] * v[r][j][2] + v[r][j][3] * v[r][j][3]);
            s = wave_sum(s); if (lane == 0) rs1[m] = rsqrtf(s * (1.0f / D) + RMS_EPS);
            u32x2* o = (u32x2*)(xb + (size_t)m * D) + lane;
#pragma unroll
            for (int j = 0; j < 4; ++j) { u32x2 w; w.x = pk2(v[r][j][0], v[r][j][1]); w.y = pk2(v[r][j][2], v[r][j][3]); o[64 * j] = w; } } } } }
}

template <int W>
__device__ __forceinline__ void mixed_item(const bf16_t* ub, bf16_t* mixed, int tok, int c8) {
    const int t = tok & (SEQ - 1); const int nw = (t + 1) < W ? (t + 1) : W;
    u32x4 v[W];
#pragma unroll
    for (int i = 0; i < W; ++i) { const int ii = i < nw ? i : 0; v[i] = *(const u32x4*)(ub + (size_t)(tok - ii) * 512 + c8 * 8); }
    float s[8], cur[8];
#pragma unroll
    for (int j = 0; j < 8; ++j) { s[j] = 0.f; cur[j] = 0.f; }
#pragma unroll
    for (int i = 0; i < W; ++i) { const float mk = i < nw ? 1.0f : 0.0f;
        const float f[8] = {bf_lo(v[i].x), bf_hi(v[i].x), bf_lo(v[i].y), bf_hi(v[i].y), bf_lo(v[i].z), bf_hi(v[i].z), bf_lo(v[i].w), bf_hi(v[i].w)};
#pragma unroll
        for (int j = 0; j < 8; ++j) { s[j] = fmaf(f[j], mk, s[j]); if (i == 0) cur[j] = f[j]; } }
    const float inv = 1.0f / (float)nw;
    u32x4 o; o.x = pk2(s[0] * inv - cur[0], s[1] * inv - cur[1]); o.y = pk2(s[2] * inv - cur[2], s[3] * inv - cur[3]);
    o.z = pk2(s[4] * inv - cur[4], s[5] * inv - cur[5]); o.w = pk2(s[6] * inv - cur[6], s[7] * inv - cur[7]);
    *(u32x4*)(mixed + (size_t)tok * 1024 + c8 * 8) = o;
}
__device__ __forceinline__ void p2_mixed(const bf16_t* ub, bf16_t* mixed, int G) {
    const int ln = threadIdx.x & 63, gw = blockIdx.x * NWAVES + (int)(threadIdx.x >> 6), NGW = G * NWAVES;
    int k = 0;
    for (int P = gw; P < M; P += NGW, ++k) {
        const int g = __builtin_amdgcn_readfirstlane((P + k) & 3), tok = (P >> 2) * 4 + (ln >> 4), c8 = g * 16 + (ln & 15);
        if (g == 0) mixed_item<2>(ub, mixed, tok, c8); else if (g == 1) mixed_item<4>(ub, mixed, tok, c8); else if (g == 2) mixed_item<8>(ub, mixed, tok, c8); else mixed_item<16>(ub, mixed, tok, c8);
    }
}

__device__ __forceinline__ unsigned lds_atomic_inc(LAS unsigned* p) { return __hip_atomic_fetch_add(p, 1u, __ATOMIC_RELAXED, __HIP_MEMORY_SCOPE_WORKGROUP); }
__device__ __forceinline__ void prune_token(LAS unsigned* L, LAS unsigned* H, const LAS unsigned* cntin, LAS unsigned* cntp, LAS unsigned* thrp, int lane) {
    const int n = __builtin_amdgcn_readfirstlane((int)*cntin);
    unsigned prefix = 0u; unsigned want = 256u;
#pragma unroll
    for (int p = 0; p < 4; ++p) {
        const int shift = 24 - 8 * p;
        *(LAS u32x4*)(H + 4 * lane) = (u32x4){0u, 0u, 0u, 0u};
        for (int i = lane; i < n; i += 64) { const unsigned e = L[i];
            bool match = true; if (p > 0) match = ((e ^ prefix) >> ((shift + 8) & 31)) == 0u;
            if (match) (void)lds_atomic_inc(H + ((e >> shift) & 255u)); }
        const u32x4 c = *(LAS u32x4*)(H + 4 * lane);
        const unsigned T = c.x + c.y + c.z + c.w; unsigned suf = T;
#pragma unroll
        for (int off = 1; off < 64; off <<= 1) { const unsigned v = (unsigned)__shfl_down((int)suf, off); if (lane + off < 64) suf += v; }
        const unsigned sufex = suf - T;
        const bool found = (sufex < want) && (want <= suf);
        unsigned run = sufex; int d = 0; unsigned nw = 0u; bool got = false;
        if (!got && run + c.w >= want) { d = 4 * lane + 3; nw = want - run; got = true; } run += c.w;
        if (!got && run + c.z >= want) { d = 4 * lane + 2; nw = want - run; got = true; } run += c.z;
        if (!got && run + c.y >= want) { d = 4 * lane + 1; nw = want - run; got = true; } run += c.y;
        if (!got && run + c.x >= want) { d = 4 * lane + 0; nw = want - run; got = true; }
        const unsigned long long fm = __ballot(found);
        const int src = fm ? (__ffsll((long long)fm) - 1) : 0;
        d = __shfl(d, src); want = (unsigned)__shfl((int)nw, src);
        prefix |= (unsigned)d << shift;
    }
    int newn = 0;
    for (int base = 0; base < n; base += 64) { const int i = base + lane; const unsigned e = (i < n) ? L[i] : 0u; const bool keep = (i < n) && (e >= prefix);
        const unsigned long long mk = __ballot(keep);
        const int pos = newn + (int)__builtin_amdgcn_mbcnt_hi((unsigned)(mk >> 32), __builtin_amdgcn_mbcnt_lo((unsigned)mk, 0u));
        if (keep) L[pos] = e;
        newn += __popcll(mk); }
    if (lane == 0) { *cntp = (unsigned)newn; *thrp = prefix; }
}

template <int CTRL> __device__ __forceinline__ unsigned dpp0(unsigned v) { return (unsigned)__builtin_amdgcn_update_dpp(0, (int)v, CTRL, 0xf, 0xf, true); }
__device__ __forceinline__ unsigned wave_min_u32(unsigned v) {
    v = min(v, (unsigned)__builtin_amdgcn_update_dpp((int)v, (int)v, 0x128, 0xf, 0xf, false)); v = min(v, (unsigned)__builtin_amdgcn_update_dpp((int)v, (int)v, 0x124, 0xf, 0xf, false));
    v = min(v, (unsigned)__builtin_amdgcn_update_dpp((int)v, (int)v, 0x122, 0xf, 0xf, false)); v = min(v, (unsigned)__builtin_amdgcn_update_dpp((int)v, (int)v, 0x121, 0xf, 0xf, false));
    const unsigned a = __builtin_amdgcn_readlane((int)v, 0), b = __builtin_amdgcn_readlane((int)v, 16), c = __builtin_amdgcn_readlane((int)v, 32), d = __builtin_amdgcn_readlane((int)v, 48);
    return min(min(a, b), min(c, d));
}
__device__ __forceinline__ unsigned wave_max_u32(unsigned v) { return ~wave_min_u32(~v); }
__device__ __forceinline__ unsigned wave_prefix_incl(unsigned v, int lane) {
    v += dpp0<0x111>(v); v += dpp0<0x112>(v); v += dpp0<0x114>(v); v += dpp0<0x118>(v);
    const unsigned r0 = __builtin_amdgcn_readlane((int)v, 15), r1 = __builtin_amdgcn_readlane((int)v, 31), r2 = __builtin_amdgcn_readlane((int)v, 47);
    const int row = lane >> 4;
    return v + (row >= 1 ? r0 : 0u) + (row >= 2 ? r1 : 0u) + (row >= 3 ? r2 : 0u);
}
template <int FULLROWS>
__device__ __forceinline__ void prune_approx(LAS unsigned* L, LAS unsigned* H, const LAS unsigned* cntin, LAS unsigned* cntp, LAS unsigned* thrp, int lane) {
    const int n = __builtin_amdgcn_readfirstlane((int)*cntin);
    const unsigned tlo = (unsigned)__builtin_amdgcn_readfirstlane((int)*thrp);
    unsigned e[8]; unsigned mxv = 0u;
#pragma unroll
    for (int k = 0; k < 8; ++k) { unsigned v = L[lane + 64 * k]; if (k >= FULLROWS) v = (lane + 64 * k < n) ? v : 0u; e[k] = v; mxv = max(mxv, v); }
    mxv = wave_max_u32(mxv);
    unsigned mn = tlo;
    if (tlo == 0u) {
        unsigned m = 0xFFFFFFFFu;
#pragma unroll
        for (int k = 0; k < 8; ++k) m = (k >= FULLROWS && e[k] == 0u) ? m : min(m, e[k]);
        mn = wave_min_u32(m);
    }
    const unsigned range = mxv - mn;
    const int hb = 31 - __builtin_clz(range | 1u);
    const int shift = hb > 7 ? hb - 7 : 0;
    *(LAS u32x4*)(H + 4 * lane) = (u32x4){0u, 0u, 0u, 0u};
#pragma unroll
    for (int k = 0; k < 8; ++k) if (k < FULLROWS || e[k] != 0u) (void)lds_atomic_inc(H + ((e[k] - mn) >> shift));
    const u32x4 c = *(LAS u32x4*)(H + 4 * lane);
    const unsigned T = c.x + c.y + c.z + c.w;
    const unsigned pin = wave_prefix_incl(T, lane);
    const unsigned tot = (unsigned)__builtin_amdgcn_readlane((int)pin, 63);
    const unsigned sufex = tot - pin;
    const unsigned suf = sufex + T;
    const bool found = (sufex < 256u) && (256u <= suf);
    unsigned run = sufex; int d = 0; bool got = false;
    if (!got && run + c.w >= 256u) { d = 4 * lane + 3; got = true; } run += c.w;
    if (!got && run + c.z >= 256u) { d = 4 * lane + 2; got = true; } run += c.z;
    if (!got && run + c.y >= 256u) { d = 4 * lane + 1; got = true; } run += c.y;
    if (!got && run + c.x >= 256u) { d = 4 * lane + 0; got = true; }
    const unsigned long long fm = __ballot(found);
    const int src = fm ? (__ffsll((long long)fm) - 1) : 0;
    d = __builtin_amdgcn_readlane(d, src);
    unsigned thr = mn + ((unsigned)d << shift);
    thr = thr ? thr : 1u;
    int newn = 0;
#pragma unroll
    for (int k = 0; k < 8; ++k) { const bool keep = e[k] >= thr;
        const unsigned long long mk = __ballot(keep);
        const int pos = newn + (int)__builtin_amdgcn_mbcnt_hi((unsigned)(mk >> 32), __builtin_amdgcn_mbcnt_lo((unsigned)mk, 0u));
        if (keep) L[pos] = e[k];
        newn += __popcll(mk); }
    if (lane == 0) { *cntp = (unsigned)newn; *thrp = thr - 1u; }
}

__device__ __forceinline__ void prune_excess(LAS unsigned* L, LAS unsigned* cntp, int lane) {
    const int n = __builtin_amdgcn_readfirstlane((int)*cntp);
    unsigned e[5];
#pragma unroll
    for (int k = 0; k < 5; ++k) { const int i = lane + 64 * k; const unsigned v = L[i]; e[k] = (i < n) ? v : 0xFFFFFFFFu; }
    for (int r = n - 256; r > 0; --r) {
        unsigned m = min(min(e[0], e[1]), min(min(e[2], e[3]), e[4]));
        m = wave_min_u32(m);
#pragma unroll
        for (int k = 0; k < 5; ++k) e[k] = (e[k] == m) ? 0xFFFFFFFFu : e[k];
    }
    int newn = 0;
#pragma unroll
    for (int k = 0; k < 5; ++k) { const bool keep = e[k] != 0xFFFFFFFFu;
        const unsigned long long mk = __ballot(keep);
        const int pos = newn + (int)__builtin_amdgcn_mbcnt_hi((unsigned)(mk >> 32), __builtin_amdgcn_mbcnt_lo((unsigned)mk, 0u));
        if (keep) L[pos] = e[k];
        newn += __popcll(mk); }
    if (lane == 0) *cntp = (unsigned)newn;
}

template <bool DIAG>
__device__ __forceinline__ void score_tile(LAS unsigned char* lds, const LAS unsigned char* kbuf, const bf16x8 (&afr)[2][4], const float (&wq)[2][16], unsigned (&cn)[2][2], const unsigned (&th)[2][2],
                                           int kt, int t0, int wave, int hf, int l31, unsigned lmask, unsigned trash) {
    bf16x8 bfr[2][4];
#pragma unroll
    for (int kh = 0; kh < 2; ++kh) { const int keyrow = kh * 32 + l31;
#pragma unroll
        for (int ks = 0; ks < 4; ++ks) bfr[kh][ks] = *(const LAS bf16x8*)(kbuf + keyrow * 128 + (((ks * 2 + hf) ^ ((keyrow >> 1) & 7)) * 16)); }
    f32x16 accs[2][2];
#pragma unroll
    for (int kh = 0; kh < 2; ++kh)
#pragma unroll
        for (int rt = 0; rt < 2; ++rt) {
#pragma unroll
            for (int j = 0; j < 16; ++j) accs[kh][rt][j] = 0.f;
#pragma unroll
            for (int ks = 0; ks < 4; ++ks) accs[kh][rt] = __builtin_amdgcn_mfma_f32_32x32x16_bf16(afr[rt][ks], bfr[kh][ks], accs[kh][rt], 0, 0, 0);
        }
#pragma unroll
    for (int kh = 0; kh < 2; ++kh) {
        const int keypos = kt * 64 + kh * 32 + l31;
        const unsigned idxbits = (unsigned)(16383 - keypos);
#pragma unroll
        for (int rt = 0; rt < 2; ++rt) {
#pragma unroll
            for (int ts = 0; ts < 2; ++ts) {
                float s = 0.f;
#pragma unroll
                for (int hd = 0; hd < 8; ++hd) s = fmaf(__builtin_amdgcn_fmed3f(accs[kh][rt][8 * ts + hd], 0.f, 3.0e38f), wq[rt][8 * ts + hd], s);
                const unsigned ub = __builtin_bit_cast(unsigned, s);
                const unsigned srt = ub ^ ((unsigned)((int)ub >> 31) | 0x80000000u);
                const unsigned packed = (srt & 0xFFFFC000u) | idxbits;
                const int tl = 4 * rt + 2 * hf + ts;
                bool pass = packed > th[rt][ts];
                if (DIAG) pass = pass && (keypos <= t0 + wave * 8 + tl);
                const unsigned long long mk = __builtin_amdgcn_ballot_w64(pass);
                const unsigned mine = hf ? (unsigned)(mk >> 32) : (unsigned)mk;
                const unsigned pre = __popc(mine & lmask);
                const unsigned addr = pass ? (unsigned)((wave * 8 + tl) * 2048) + (cn[rt][ts] + pre) * 4u : trash;
                *(LAS unsigned*)(lds + addr) = packed;
                cn[rt][ts] += __popc(mine);
            }
        }
    }
}

__device__ __forceinline__ void p4_attention(const unsigned char* pj, bf16_t* attn_out, unsigned* queue, int* seldbg, LAS unsigned char* lds, int wave, int lane) {
    const bf16_t* qb_ = (const bf16_t*)(pj + PJ_Q); const unsigned char* kv8 = pj + PJ_KV; const bf16_t* qib = (const bf16_t*)(pj + PJ_QI); const bf16_t* kwb = (const bf16_t*)(pj + PJ_KW);
    LAS unsigned* cnt_l = (LAS unsigned*)(lds + LDS_ATM);
    LAS unsigned* thr_l = cnt_l + 64;
    LAS unsigned* unit_l = cnt_l + 128;
    LAS unsigned* pflag = cnt_l + 132;
    LAS unsigned* wl_ctl = cnt_l + 136;
    LAS unsigned* cnt2 = cnt_l + 144;
    LAS unsigned* H = (LAS unsigned*)(lds + LDS_HIST) + wave * 256;
    const int tid = threadIdx.x, hf = lane >> 5, l31 = lane & 31;
    for (;;) {
        if (tid == 0) { const unsigned pref = xb_xcc_id() & 1u;
            unsigned uu = atomicAdd(queue + 64 * pref, 1u), bb = pref;
            if (uu >= 256u) { uu = atomicAdd(queue + 64 * (pref ^ 1u), 1u); bb = pref ^ 1u; }
            *unit_l = (uu >= 256u) ? 0xFFFFu : (uu * 2u + bb); pflag[0] = 0u; pflag[1] = 0u; wl_ctl[0] = 0u; wl_ctl[1] = 0u; }
        __syncthreads();
        const int u = __builtin_amdgcn_readfirstlane((int)*unit_l);
        __syncthreads();
        if (u >= 512) break;
        const int qb = 255 - (u >> 1), b = u & 1, t0 = qb * 64, rowbase = b * SEQ;
        if (lane < 8) { cnt_l[wave * 8 + lane] = 0u; thr_l[wave * 8 + lane] = 0u; }
        bf16x8 afr[2][4]; float wq[2][16];
#pragma unroll
        for (int rt = 0; rt < 2; ++rt) {
            const int m = l31, hd = (m & 3) + 4 * ((m >> 3) & 1), tl = 4 * rt + 2 * ((m >> 2) & 1) + (m >> 4);
            const bf16_t* qp = qib + (size_t)(rowbase + t0 + wave * 8 + tl) * 512 + hd * 64 + hf * 8;
#pragma unroll
            for (int ks = 0; ks < 4; ++ks) afr[rt][ks] = *(const bf16x8*)(qp + ks * 16);
#pragma unroll
            for (int ts = 0; ts < 2; ++ts) { const int tl2 = 4 * rt + 2 * hf + ts;
                const u32x4 wv = *(const u32x4*)(kwb + (size_t)(rowbase + t0 + wave * 8 + tl2) * 128 + 64);
                wq[rt][8 * ts + 0] = bf_lo(wv.x); wq[rt][8 * ts + 1] = bf_hi(wv.x); wq[rt][8 * ts + 2] = bf_lo(wv.y); wq[rt][8 * ts + 3] = bf_hi(wv.y);
                wq[rt][8 * ts + 4] = bf_lo(wv.z); wq[rt][8 * ts + 5] = bf_hi(wv.z); wq[rt][8 * ts + 6] = bf_lo(wv.w); wq[rt][8 * ts + 7] = bf_hi(wv.w); }
        }
#pragma unroll
        for (int rt = 0; rt < 2; ++rt) {
#pragma unroll
            for (int ks = 0; ks < 4; ++ks) asm volatile("" : "+v"(afr[rt][ks]));
#pragma unroll
            for (int j = 0; j < 16; ++j) asm volatile("" : "+v"(wq[rt][j]));
        }
        const int ntile = qb + 1;
        const int skey = tid >> 3, sch = tid & 7;
        const int sdst = skey * 128 + ((sch ^ ((skey >> 1) & 7)) * 16);
        u32x4 stg = *(const u32x4*)(kwb + (size_t)(rowbase + skey) * 128 + sch * 8);
        unsigned cn[2][2], th[2][2];
        const unsigned lmask = (1u << l31) - 1u, trash = (unsigned)(LDS_HIST + wave * 1024 + lane * 4);
#pragma unroll
        for (int rt = 0; rt < 2; ++rt)
#pragma unroll
            for (int ts = 0; ts < 2; ++ts) { cn[rt][ts] = 0u; th[rt][ts] = 0u; }
        for (int kt = 0; kt < ntile; ++kt) {
            LAS unsigned char* kbuf = lds + LDS_KT + (kt & 1) * 8192;
            *(LAS u32x4*)(kbuf + sdst) = stg;
            __syncthreads();
            if (kt + 1 < ntile) stg = *(const u32x4*)(kwb + (size_t)(rowbase + (kt + 1) * 64 + skey) * 128 + sch * 8);
            if (kt > 0 && __builtin_amdgcn_readfirstlane((int)pflag[(kt - 1) & 1]) == kt) {
                const unsigned long long jm = __ballot(cnt_l[lane] > 400u);
                { unsigned long long m = jm;
                  for (int ti = 0; m != 0ull; ++ti) { const int id = __ffsll((long long)m) - 1; m &= m - 1ull;
                    if ((ti & 7) == wave) {
                        prune_approx<6>((LAS unsigned*)(lds + id * 2048), H, cnt_l + id, cnt2 + id, thr_l + id, lane);
                        if (__builtin_amdgcn_readfirstlane((int)cnt2[id]) > 320) prune_token((LAS unsigned*)(lds + id * 2048), H, cnt2 + id, cnt2 + id, thr_l + id, lane);
                    } } }
                __syncthreads();
#pragma unroll
                for (int rt = 0; rt < 2; ++rt)
#pragma unroll
                    for (int ts = 0; ts < 2; ++ts) { const int tl = 4 * rt + 2 * hf + ts;
                        if ((jm >> (wave * 8 + tl)) & 1ull) { cn[rt][ts] = cnt2[wave * 8 + tl]; th[rt][ts] = thr_l[wave * 8 + tl]; } }
            }
            if (kt + 1 < ntile) score_tile<false>(lds, kbuf, afr, wq, cn, th, kt, t0, wave, hf, l31, lmask, trash);
            else                score_tile<true>(lds, kbuf, afr, wq, cn, th, kt, t0, wave, hf, l31, lmask, trash);
            bool need = false;
#pragma unroll
            for (int rt = 0; rt < 2; ++rt)
#pragma unroll
                for (int ts = 0; ts < 2; ++ts) { const int tl = 4 * rt + 2 * hf + ts; if (l31 == 0) cnt_l[wave * 8 + tl] = cn[rt][ts]; need |= cn[rt][ts] > 448u; }
            if (__ballot(need) != 0ull) { if (lane == 0) pflag[kt & 1] = (unsigned)(kt + 1); }
        }
        for (int tl = 0; tl < 8; ++tl) {
            const unsigned c = cnt_l[wave * 8 + tl];
            if (__builtin_amdgcn_readfirstlane((int)c) > 256) {
                LAS unsigned* Lt = (LAS unsigned*)(lds + (wave * 8 + tl) * 2048);
                prune_approx<4>(Lt, H, cnt_l + wave * 8 + tl, cnt_l + wave * 8 + tl, thr_l + wave * 8 + tl, lane);
                const int n2 = __builtin_amdgcn_readfirstlane((int)cnt_l[wave * 8 + tl]);
                if (n2 > 304) prune_token(Lt, H, cnt_l + wave * 8 + tl, cnt_l + wave * 8 + tl, thr_l + wave * 8 + tl, lane);
                else if (n2 > 256) prune_excess(Lt, cnt_l + wave * 8 + tl, lane);
            }
        }
        const int c15 = lane & 15, g4 = lane >> 4;
        for (int tl = 0; tl < 8; ++tl) {
            const int n = __builtin_amdgcn_readfirstlane((int)cnt_l[wave * 8 + tl]);
            const LAS unsigned* L = (const LAS unsigned*)(lds + (wave * 8 + tl) * 2048);
            const int tokrow = rowbase + t0 + wave * 8 + tl;
            const LAS unsigned* Lc = L + c15; const int nc = n - c15, n4 = n - 4 * g4;
#if DBG
            if (seldbg) for (int i = lane; i < 256; i += 64) seldbg[(size_t)tokrow * 256 + i] = (i < n) ? (int)(16383u - (L[i] & 16383u)) : -1;
#endif
            long bq[4];
#pragma unroll
            for (int ks = 0; ks < 4; ++ks) { const bool ok = (c15 < 8) && ((c15 >> 2) == (g4 >> 1));
                const u32x4 v = *(const u32x4*)(qb_ + (size_t)tokrow * 512 + (c15 & 7) * 64 + (g4 & 1) * 32 + ks * 8);
                const unsigned w0 = pk4_fp8(bf_lo(v.x), bf_hi(v.x), bf_lo(v.y), bf_hi(v.y)), w1 = pk4_fp8(bf_lo(v.z), bf_hi(v.z), bf_lo(v.w), bf_hi(v.w));
                bq[ks] = ok ? (long)(((unsigned long long)w1 << 32) | w0) : 0l; }
            f32x4 S[16];
            u32x4 kq[2][4][2];
#define LOAD_KGROUP(buf, grp) do { _Pragma("unroll") for (int tt = 0; tt < 4; ++tt) { const int T_ = (grp) * 4 + tt; const unsigned e_ = Lc[T_ * 16]; \
                const int kp_ = (T_ * 16 < nc) ? (int)(16383u - (e_ & 16383u)) : 0; \
                const unsigned char* kr_ = kv8 + (size_t)(rowbase + kp_) * 256 + g4 * 32;     \
                kq[buf][tt][0] = *(const u32x4*)kr_; kq[buf][tt][1] = *(const u32x4*)(kr_ + 16); } } while (0)
            LOAD_KGROUP(0, 0); LOAD_KGROUP(1, 1);
#pragma unroll
            for (int grp = 0; grp < 4; ++grp) {
#pragma unroll
                for (int tt = 0; tt < 4; ++tt) { const int T = grp * 4 + tt; const u32x4 k0 = kq[grp & 1][tt][0], k1 = kq[grp & 1][tt][1];
                    f32x4 sacc = (f32x4){0.f, 0.f, 0.f, 0.f};
                    sacc = __builtin_amdgcn_mfma_f32_16x16x32_fp8_fp8((long)(((unsigned long long)k0.y << 32) | k0.x), bq[0], sacc, 0, 0, 0);
                    sacc = __builtin_amdgcn_mfma_f32_16x16x32_fp8_fp8((long)(((unsigned long long)k0.w << 32) | k0.z), bq[1], sacc, 0, 0, 0);
                    sacc = __builtin_amdgcn_mfma_f32_16x16x32_fp8_fp8((long)(((unsigned long long)k1.y << 32) | k1.x), bq[2], sacc, 0, 0, 0);
                    sacc = __builtin_amdgcn_mfma_f32_16x16x32_fp8_fp8((long)(((unsigned long long)k1.w << 32) | k1.z), bq[3], sacc, 0, 0, 0);
                    if (n < 256) {
#pragma unroll
                        for (int j = 0; j < 4; ++j) if (T * 16 + j >= n4) sacc[j] = -1e30f; }
                    S[T] = sacc; }
                if (grp < 2) { if (grp == 0) LOAD_KGROUP(0, 2); else LOAD_KGROUP(1, 3); }
                asm volatile("" ::: "memory");
            }
#undef LOAD_KGROUP
            const LAS unsigned* Lh = L + (lane >> 3); const int nh = n - (lane >> 3);
            const int vwr = (wave * 8 + (lane >> 5)) * 2048 + 1024 + ((lane >> 3) & 3) * 160 + (lane >> 5) * 16 + (lane & 7) * 16;
            u32x4 vvA[4], vvB[4];
#pragma unroll
            for (int q = 0; q < 4; ++q) { const unsigned e = Lh[8 * q];
                const int kp = (8 * q < nh) ? (int)(16383u - (e & 16383u)) : 0;
                vvA[q] = *(const u32x4*)(kv8 + (size_t)(rowbase + kp) * 256 + 128 + (lane & 7) * 16); }
#pragma unroll
            for (int q = 0; q < 4; ++q) { const unsigned e = Lh[32 + 8 * q];
                const int kp = (32 + 8 * q < nh) ? (int)(16383u - (e & 16383u)) : 0;
                vvB[q] = *(const u32x4*)(kv8 + (size_t)(rowbase + kp) * 256 + 128 + (lane & 7) * 16); }
            float mx = -1e30f;
#pragma unroll
            for (int T = 0; T < 16; ++T)
#pragma unroll
                for (int j = 0; j < 4; ++j) mx = fmaxf(mx, S[T][j]);
            mx = fmaxf(mx, __shfl_xor(mx, 16)); mx = fmaxf(mx, __shfl_xor(mx, 32));
            float sum = 0.f; unsigned P8[16];
            const float mxl = (mx - 5.545177444f) * 1.44269504089f;
#pragma unroll
            for (int T = 0; T < 16; ++T) { f32x4 pv;
#pragma unroll
                for (int j = 0; j < 4; ++j) { pv[j] = __builtin_amdgcn_exp2f(fmaf(S[T][j], 1.44269504089f, -mxl)); sum += pv[j]; }
                int w = __builtin_amdgcn_cvt_pk_fp8_f32(pv[0], pv[1], 0, false); w = __builtin_amdgcn_cvt_pk_fp8_f32(pv[2], pv[3], w, true); P8[T] = (unsigned)w; }
            sum += __shfl_xor(sum, 16); sum += __shfl_xor(sum, 32);
            const float inv = 1.0f / sum;
            float invh[4];
#pragma unroll
            for (int j = 0; j < 4; ++j) invh[j] = __shfl(inv, 4 * (g4 & 1) + j);
            f32x4 O[8];
#pragma unroll
            for (int dt = 0; dt < 8; ++dt) O[dt] = (f32x4){0.f, 0.f, 0.f, 0.f};
            typedef int i2v __attribute__((ext_vector_type(2)));
            const LAS unsigned char* vtr = lds + (wave * 8 + g4 + 4 * ((lane & 15) >> 3)) * 2048 + 1024 + (((lane & 15) >> 1) & 3) * 160 + ((lane & 15) >> 3) * 128 + (g4 & 1) * 16 + (lane & 1) * 8;
#pragma unroll
            for (int ch = 0; ch < 8; ++ch) {
                u32x4 (&vv)[4] = (ch & 1) ? vvB : vvA;
#pragma unroll
                for (int q = 0; q < 4; ++q) *(LAS u32x4*)(lds + vwr + q * 4096 + (q >> 1) * 128) = vv[q];
                if (ch < 6) {
#pragma unroll
                    for (int q = 0; q < 4; ++q) { const unsigned e = Lh[(ch + 2) * 32 + 8 * q];
                        const int kp = ((ch + 2) * 32 + 8 * q < nh) ? (int)(16383u - (e & 16383u)) : 0;
                        vv[q] = *(const u32x4*)(kv8 + (size_t)(rowbase + kp) * 256 + 128 + (lane & 7) * 16); }
                }
                const long pf = (long)(((unsigned long long)P8[2 * ch + 1] << 32) | P8[2 * ch]);
#pragma unroll
                for (int dt = 0; dt < 8; ++dt) {
                    const i2v vt = __builtin_amdgcn_ds_read_tr8_b64_v2i32((LAS i2v*)(vtr + dt * 16));
                    O[dt] = __builtin_amdgcn_mfma_f32_16x16x32_fp8_fp8(pf, __builtin_bit_cast(long, vt), O[dt], 0, 0, 0);
                }
                asm volatile("" ::: "memory");
            }
            if (g4 < 2) {
#pragma unroll
                for (int j = 0; j < 4; ++j) {
                    const f32x4 o4 = g4 ? (f32x4){O[4][j], O[5][j], O[6][j], O[7][j]} : (f32x4){O[0][j], O[1][j], O[2][j], O[3][j]};
                    u32x2 w; w.x = pk2(o4[0] * invh[j], o4[1] * invh[j]); w.y = pk2(o4[2] * invh[j], o4[3] * invh[j]);
                    *(u32x2*)(attn_out + (size_t)tokrow * 1024 + (4 * g4 + j) * 64 + 4 * c15) = w;
                }
            }
        }
    }
}

__device__ __forceinline__ void p7_router(const Args& a, LAS unsigned char* lds, int wave, int lane, int G) {
    unsigned char* ws = a.ws;
    const bf16_t* x1b = (const bf16_t*)(ws + WS_X1B); const bf16_t* wr = (const bf16_t*)(ws + WS_WR);
    const float* ss2 = (const float*)(ws + CTLB_SS2); const float* rb = a.in[I_RB];
    int* topi = (int*)(ws + WS_TOPI); float* topg = (float*)(ws + WS_TOPG); int* lrank = (int*)(ws + WS_LRANK); int* cntwg = (int*)(ws + CTLB_CNTWG);
    LAS unsigned* wcnt = (LAS unsigned*)(lds + LDS_MISC + 64);
    if (threadIdx.x < 32) wcnt[threadIdx.x] = 0u;
    __syncthreads();
    LAS float* lg = (LAS float*)(lds + wave * 4096);
    const int c15 = lane & 15, g4 = lane >> 4;
    for (int tile = blockIdx.x * NWAVES + wave; tile < M / 16; tile += G * NWAVES) {
        const int tok0 = tile * 16;
        f32x4 a0 = (f32x4){0.f, 0.f, 0.f, 0.f}, a1 = a0;
        const bf16_t* ap = x1b + (size_t)(tok0 + c15) * D + g4 * 8; const bf16_t* bp0 = wr + (size_t)c15 * D + g4 * 8; const bf16_t* bp1 = bp0 + 16 * D;
#pragma unroll 8
        for (int ks = 0; ks < 32; ++ks) { const bf16x8 av = *(const bf16x8*)(ap + ks * 32), b0 = *(const bf16x8*)(bp0 + ks * 32), b1 = *(const bf16x8*)(bp1 + ks * 32);
            a0 = __builtin_amdgcn_mfma_f32_16x16x32_bf16(av, b0, a0, 0, 0, 0); a1 = __builtin_amdgcn_mfma_f32_16x16x32_bf16(av, b1, a1, 0, 0, 0); }
#pragma unroll
        for (int j = 0; j < 4; ++j) { lg[(4 * g4 + j) * 33 + c15] = a0[j]; lg[(4 * g4 + j) * 33 + 16 + c15] = a1[j]; }
        LDS_WAIT(); asm volatile("" ::: "memory");
        if (lane < 16) {
            const int tok = tok0 + lane; const float rs = rsqrtf(ss2[tok] * (1.0f / D) + RMS_EPS);
            float v[32];
#pragma unroll
            for (int e = 0; e < 32; ++e) v[e] = lg[lane * 33 + e] * rs + rb[e];
            int bi[4]; float bv[4];
#pragma unroll
            for (int r = 0; r < 4; ++r) { float best = -3.0e38f; int bidx = 0;
#pragma unroll
                for (int e = 0; e < 32; ++e) { bool used = false;
#pragma unroll
                    for (int q = 0; q < 4; ++q) if (q < r && bi[q] == e) used = true;
                    if (!used && v[e] > best) { best = v[e]; bidx = e; } }
                bi[r] = bidx; bv[r] = best; }
            float ex[4], se = 0.f;
#pragma unroll
            for (int r = 0; r < 4; ++r) { ex[r] = __expf(bv[r] - bv[0]); se += ex[r]; }
            const float inv = 1.0f / se;
#pragma unroll
            for (int r = 0; r < 4; ++r) { topi[tok * 4 + r] = bi[r]; topg[tok * 4 + r] = ex[r] * inv; lrank[tok * 4 + r] = (int)lds_atomic_inc(wcnt + bi[r]); }
        }
        LDS_WAIT(); asm volatile("" ::: "memory");
    }
    __syncthreads();
    if (threadIdx.x < 32) cntwg[blockIdx.x * 32 + threadIdx.x] = (int)wcnt[threadIdx.x];
}

__device__ __forceinline__ void p8_scatter(const Args& a, LAS unsigned char* lds, int wave, int lane, int G) {
    unsigned char* ws = a.ws;
    const int* cntwg = (const int*)(ws + CTLB_CNTWG); const int* topi = (const int*)(ws + WS_TOPI); const float* topg = (const float*)(ws + WS_TOPG);
    const int* lrank = (const int*)(ws + WS_LRANK); int* posof = (int*)(ws + WS_POSOF); int* rowmap = (int*)(ws + WS_ROWMAP); float* rowgate = (float*)(ws + WS_ROWGATE);
    int* tile_e = (int*)(ws + CTLB_TILEE); int* meta = (int*)(ws + CTLB_META); float* rowscale = (float*)(ws + WS_ROWSCALE);
    LAS int* part = (LAS int*)(lds);
    LAS int* tot = (LAS int*)(lds + 8192);
    LAS int* pre = tot + 32;
    LAS int* base = tot + 64;
    const int tid = threadIdx.x, e = tid & 31, pt = tid >> 5, myw = blockIdx.x;
    int sall = 0, spre = 0;
#pragma unroll 8
    for (int w = pt; w < G; w += 16) { const int v = cntwg[w * 32 + e]; sall += v; spre += (w < myw) ? v : 0; }
    part[pt * 32 + e] = sall; part[512 + pt * 32 + e] = spre;
    __syncthreads();
    if (tid < 32) { int s0 = 0, s1 = 0;
#pragma unroll
        for (int q = 0; q < 16; ++q) { s0 += part[q * 32 + tid]; s1 += part[512 + q * 32 + tid]; }
        tot[tid] = s0; pre[tid] = s1; }
    __syncthreads();
    if (tid == 0) { int bsum = 0; for (int q = 0; q < 32; ++q) { base[q] = bsum; bsum += (tot[q] + 255) & ~255; } base[32] = bsum; }
    __syncthreads();
    for (int tile = blockIdx.x * NWAVES + wave; tile < M / 16; tile += G * NWAVES) {
        const int idx = tile * 64 + lane; const int ex = topi[idx];
        const int pos = base[ex] + pre[ex] + lrank[idx];
        rowmap[pos] = idx >> 2; rowgate[pos] = topg[idx]; posof[idx] = pos;
        rowscale[pos] = rsqrtf(((const float*)(ws + CTLB_SS2))[idx >> 2] * (1.0f / D) + RMS_EPS);
    }
    for (int ex = blockIdx.x; ex < 32; ex += G) { const int t_ = tot[ex], pe = (t_ + 255) & ~255;
        for (int r = t_ + tid; r < pe; r += NTHREADS) { rowmap[base[ex] + r] = 0; rowgate[base[ex] + r] = 0.f; rowscale[base[ex] + r] = 0.f; } }
    if (blockIdx.x == 0) {
        const int ntl = base[32] >> 8;
        for (int t = tid; t < 544; t += NTHREADS) { int ex = 0;
            for (int q = 0; q < 32; ++q) if (base[q] <= t * 256) ex = q;
            tile_e[t] = (t < ntl) ? ex : 0; }
        if (tid == 0) meta[0] = ntl;
    }
}

__device__ __forceinline__ void p11_combine(const Args& a, int wave, int lane, int G) {
    unsigned char* ws = a.ws;
    const int* posof = (const int*)(ws + WS_POSOF); const unsigned char* Y = ws + WS_R2; const bf16_t* x1b = (const bf16_t*)(ws + WS_X1B); bf16_t* x2b = (bf16_t*)(ws + WS_R1); float* rs3 = (float*)(ws + WS_RS3);
    const int gw = blockIdx.x * NWAVES + wave, NGW = G * NWAVES;
    typedef int i4v __attribute__((ext_vector_type(4)));
    i4v pnx = (gw < M) ? *(const i4v*)(posof + (size_t)gw * 4) : (i4v){0, 0, 0, 0};
    for (int m = gw; m < M; m += NGW) {
        const i4v pcur = pnx;
        if (m + NGW < M) pnx = *(const i4v*)(posof + (size_t)(m + NGW) * 4);
        const u32x2* xr = (const u32x2*)(x1b + (size_t)m * D) + lane; f32x4 v[4]; u32x2 xw[4]; unsigned yw[4][4];
#pragma unroll
        for (int j = 0; j < 4; ++j) xw[j] = xr[64 * j];
#pragma unroll
        for (int s = 0; s < 4; ++s) { const unsigned* yr = (const unsigned*)(Y + (size_t)pcur[s] * D) + lane;
#pragma unroll
            for (int j = 0; j < 4; ++j) yw[s][j] = yr[64 * j]; }
#pragma unroll
        for (int j = 0; j < 4; ++j) { const u32x2 w = xw[j]; v[j] = (f32x4){bf_lo(w.x), bf_hi(w.x), bf_lo(w.y), bf_hi(w.y)}; }
#pragma unroll
        for (int s = 0; s < 4; ++s) {
#pragma unroll
            for (int j = 0; j < 4; ++j) { const f32x2_ lo = __builtin_amdgcn_cvt_pk_f32_fp8((int)yw[s][j], false), hi = __builtin_amdgcn_cvt_pk_f32_fp8((int)yw[s][j], true);
                v[j][0] += lo.x; v[j][1] += lo.y; v[j][2] += hi.x; v[j][3] += hi.y; } }
        float s = 0.f;
#pragma unroll
        for (int j = 0; j < 4; ++j) s += (v[j][0] * v[j][0] + v[j][1] * v[j][1]) + (v[j][2] * v[j][2] + v[j][3] * v[j][3]);
        s = wave_sum(s); if (lane == 0) rs3[m] = rsqrtf(s * (1.0f / D) + RMS_EPS);
        u32x2* o = (u32x2*)(x2b + (size_t)m * D) + lane;
#pragma unroll
        for (int j = 0; j < 4; ++j) { u32x2 w; w.x = pk2(v[j][0], v[j][1]); w.y = pk2(v[j][2], v[j][3]); o[64 * j] = w; }
    }
}
__device__ __forceinline__ void p13_final(const Args& a, int wave, int lane, int G) {
    const float* ss4 = (const float*)(a.ws + CTLB_SS4); const float* fg = a.in[I_FG]; const bf16_t* x3b = (const bf16_t*)(a.ws + WS_R1 + 128 * MiB);
    const int gw = blockIdx.x * NWAVES + wave, NGW = G * NWAVES;
    f32x4 gq[4];
#pragma unroll
    for (int j = 0; j < 4; ++j) gq[j] = ((const f32x4*)fg)[lane + 64 * j];
    for (int m0 = gw; m0 < M; m0 += 4 * NGW) { u32x2 xw[4][4]; float sv[4];
#pragma unroll
        for (int r = 0; r < 4; ++r) { const int m = m0 + r * NGW; if (m < M) { sv[r] = ss4[m]; const u32x2* xr = (const u32x2*)(x3b + (size_t)m * D) + lane;
#pragma unroll
            for (int j = 0; j < 4; ++j) xw[r][j] = xr[64 * j]; } }
#pragma unroll
        for (int r = 0; r < 4; ++r) { const int m = m0 + r * NGW; if (m < M) { const float rs = rsqrtf(sv[r] * (1.0f / D) + RMS_EPS); f32x4* orow = (f32x4*)(a.out + (size_t)m * D) + lane;
#pragma unroll
            for (int j = 0; j < 4; ++j) { const u32x2 w = xw[r][j]; orow[64 * j] = (f32x4){bf_lo(w.x), bf_hi(w.x), bf_lo(w.y), bf_hi(w.y)} * rs * gq[j]; } } } }
}

__global__ void __launch_bounds__(NTHREADS, 2) fwd(Args args) {
    extern __shared__ __attribute__((aligned(16))) unsigned char lds_raw[];
    LAS unsigned char* lds = (LAS unsigned char*)lds_raw;
    const int G = gridDim.x;
#define tid ((int)threadIdx.x)
#define lane ((int)(threadIdx.x & 63))
#define wave (__builtin_amdgcn_readfirstlane((int)(threadIdx.x >> 6)))
    unsigned char* ws = args.ws;
    volatile LAS unsigned* MISC = (volatile LAS unsigned*)(lds + LDS_MISC);
    if (tid < 64) MISC[tid] = 0u;
    __syncthreads();
    XcdBarrier bar = xcd_barrier_post((unsigned*)(ws + CTLB_BAR), MISC);
    const int lo = args.ph_lo, hi = args.ph_hi;
#define IN(k) (lo <= (k) && (k) < hi)
#define SEAM(k) do { if (IN(k) && IN((k) + 1)) xcd_barrier(bar); } while (0)
    unsigned char* pj = ws + WS_R1;
    bf16_t* xb = (bf16_t*)(ws + WS_R2); bf16_t* cat = (bf16_t*)(ws + WS_R2 + 64 * MiB);
    bf16_t* mixed = cat; bf16_t* attn = cat + 512; bf16_t* zb = (bf16_t*)(ws + WS_R2 + 192 * MiB);

    if (IN(PH_PRO)) { p0_prologue(args, lds, wave, lane, G); }
    SEAM(PH_PRO);
    if (IN(PH_INPROJ)) {
        pg8::Gemm g{xb, (const bf16_t*)(ws + WS_WIN), M, NP, D, 0, nullptr}; pg8::StaticOrder S; S.init(M, NP, G, (int)blockIdx.x);
        EpiProj E{pj, (const float*)(ws + WS_RS1)};
        pg8::gemm_phase<EpiProj, pg8::StaticOrder, false>(lds, g, S, E);
    }
    SEAM(PH_INPROJ);
    if (IN(PH_MIXED)) { p2_mixed((const bf16_t*)(pj + PJ_U), mixed, G); }
    if (IN(PH_ATT)) {
        __syncthreads();
        p4_attention(pj, attn, (unsigned*)(ws + CTLB_QUEUE), DBG ? (int*)(ws + WS_SEL) : nullptr, lds, wave, lane);
        for (;;) {
            __syncthreads();
            if (tid == 0) MISC[4] = atomicAdd((unsigned*)(ws + CTLB_QUEUE) + 128, 1u);
            __syncthreads();
            const int c = __builtin_amdgcn_readfirstlane((int)MISC[4]);
            if (c >= I_E1 / 8) break;
            deferred_chunk(args, lds, c, wave, lane);
        }
    }
    SEAM(PH_ATT);
    if (IN(PH_Z)) {
        pg8::Gemm g{cat, (const bf16_t*)(ws + WS_WPC), M, D, 1024, 0, nullptr}; pg8::StaticOrder S; S.init(M, D, G, (int)blockIdx.x);
        EpiGate<false, true> E{zb, (const bf16_t*)(pj + PJ_G) + 1024, nullptr};
        HookGateRatio Hk{(const bf16_t*)(pj + PJ_G)};
        pg8::gemm_phase<EpiGate<false, true>, pg8::StaticOrder, false, HookGateRatio>(lds, g, S, E, Hk);
    }
    SEAM(PH_Z);
    if (IN(PH_X1)) {
        pg8::Gemm g{zb, (const bf16_t*)(ws + WS_WOUT), M, D, D, 0, nullptr}; pg8::StaticOrder S; S.init(M, D, G, (int)blockIdx.x);
        EpiX1 E{args.in[I_X], (bf16_t*)(ws + WS_X1B), (float*)(ws + CTLB_SS2), ws + WS_R1 + 144 * MiB};
        pg8::gemm_phase<EpiX1, pg8::StaticOrder, false>(lds, g, S, E);
    }
    SEAM(PH_X1);
    if (IN(PH_ROUTER)) { p7_router(args, lds, wave, lane, G); }
    SEAM(PH_ROUTER);
    if (IN(PH_SCATTER)) { __syncthreads(); p8_scatter(args, lds, wave, lane, G); }
    SEAM(PH_SCATTER);
    if (IN(PH_MOE1)) {
        __syncthreads();
        pg8::Gemm g{(const bf16_t*)(ws + WS_R1 + 144 * MiB), (const bf16_t*)(ws + WS_W1), M, 2048, D / 2, (size_t)2048 * D, (const int*)(ws + WS_ROWMAP)};
        LAS int* te_l = (LAS int*)(lds + LDS_KT); for (int i = tid; i < 544; i += NTHREADS) te_l[i] = ((const int*)(ws + CTLB_TILEE))[i];
        __syncthreads();
        pg8::MoeOrder S{te_l, *(const int*)(ws + CTLB_META), 8, G, (int)blockIdx.x};
        EpiMoe1 E{ws + WS_R1, (const float*)(ws + WS_ROWSCALE), args.in[I_B1]};
        pg8::gemm_phase<EpiMoe1, pg8::MoeOrder, true, pg8::NoHook, 2>(lds, g, S, E);
        for (;;) {
            __syncthreads();
            if (tid == 0) MISC[4] = atomicAdd((unsigned*)(ws + CTLB_QUEUE) + 192, 1u);
            __syncthreads();
            const int c = I_E1 / 8 + __builtin_amdgcn_readfirstlane((int)MISC[4]);
            if (c >= DC_EXPERT) break;
            deferred_chunk(args, lds, c, wave, lane);
        }
    }
    SEAM(PH_MOE1);
    if (IN(PH_MOE2)) {
        pg8::Gemm g{(const bf16_t*)(ws + WS_R1), (const bf16_t*)(ws + WS_W2), MOE_ROWS, D, DFF / 2, (size_t)D * DFF, nullptr};
        LAS int* te_l = (LAS int*)(lds + LDS_KT); for (int i = tid; i < 544; i += NTHREADS) te_l[i] = ((const int*)(ws + CTLB_TILEE))[i];
        __syncthreads();
        pg8::MoeOrder S{te_l, *(const int*)(ws + CTLB_META), 4, G, (int)blockIdx.x};
        EpiMoe2 E{ws + WS_R2, (const float*)(ws + WS_ROWGATE), args.in[I_B2]};
        pg8::gemm_phase<EpiMoe2, pg8::MoeOrder, false, pg8::NoHook, 2>(lds, g, S, E);
        { const int nunits = S.ntiles * 4, rem = nunits % G, vwg = (G % 8 == 0) ? ((int)blockIdx.x % 8) * (G / 8) + (int)blockIdx.x / 8 : (int)blockIdx.x;
          pg8::PPOrder SP{rem ? G - rem : G, rem ? vwg - rem : vwg};
          pg8::Gemm gp{(const bf16_t*)(ws + WS_PB), (const bf16_t*)(ws + WS_WPP), M, D, PLE, 0, nullptr};
          EpiPP EP{(bf16_t*)(ws + WS_PP)};
          pg8::gemm_phase<EpiPP, pg8::PPOrder, false>(lds, gp, SP, EP); }
    }
    SEAM(PH_MOE2);
    if (IN(PH_COMBINE)) { p11_combine(args, wave, lane, G); }
    SEAM(PH_COMBINE);
    if (IN(PH_PLE)) {
        pg8::Gemm g{(const bf16_t*)(ws + WS_R1), (const bf16_t*)(ws + WS_WPG), M, D, D, 0, nullptr}; pg8::StaticOrder S; S.init(M, D, G, (int)blockIdx.x);
        EpiPleGX E{(bf16_t*)(ws + WS_R1 + 128 * MiB), (const bf16_t*)(ws + WS_R1), (const bf16_t*)(ws + WS_PP), (const float*)(ws + WS_RS3), (float*)(ws + CTLB_SS4)};
        pg8::gemm_phase<EpiPleGX, pg8::StaticOrder, false>(lds, g, S, E);
    }
    SEAM(PH_PLE);
    if (IN(PH_FINAL)) { p13_final(args, wave, lane, G); }
#undef IN
#undef SEAM
#undef tid
#undef lane
#undef wave
}

#if DBG
__device__ __forceinline__ unsigned hash_u(unsigned x) { x ^= x >> 16; x *= 0x7feb352dU; x ^= x >> 15; x *= 0x846ca68bU; x ^= x >> 16; return x; }
__device__ __forceinline__ bool closef(float got, float ref, float rtol, float atol) { return fabsf(got - ref) <= atol + rtol * fabsf(ref); }
__device__ float dotbf(const bf16_t* a, const bf16_t* b, int K) { float s = 0.f; for (int k = 0; k < K; ++k) s += bf1(a[k]) * bf1(b[k]); return s; }
__device__ __forceinline__ void dbg_fail(unsigned* dbg, int code) { atomicAdd(dbg + code, 1u); }
__device__ float f2bf_f(float v) { return __builtin_bit_cast(float, f2bf(v) << 16); }

__device__ float pjv(const unsigned char* pj, int m, int c) {
    const bf16_t* b; int ld, cc;
    if (c < 512) { b = (const bf16_t*)(pj + PJ_U); ld = 512; cc = c; }
    else if (c < 1024) { b = (const bf16_t*)(pj + PJ_Q); ld = 512; cc = c - 512; }
    else if (c < 1280) { const unsigned v = (pj + PJ_KV)[(size_t)m * 256 + (c - 1024)]; const int e = (v >> 3) & 15, mt = v & 7;
        const float mag = e ? ldexpf(1.0f + mt * 0.125f, e - 7) : ldexpf(mt * 0.125f, -6); return (v & 128) ? -mag : mag; }
    else if (c < 1792) { b = (const bf16_t*)(pj + PJ_QI); ld = 512; cc = c - 1280; }
    else if (c < 2048) { b = (const bf16_t*)(pj + PJ_KW); ld = 128; cc = c - 1792; if (cc >= 128) return 0.f; }
    else { b = (const bf16_t*)(pj + PJ_G); ld = 2048; cc = c - 2048; }
    return bf1(b[(size_t)m * ld + cc]);
}
__global__ void __launch_bounds__(256) chk(Args a, int phase) {
    unsigned char* ws = a.ws; unsigned* dbg = (unsigned*)(ws + CTLB_DBG);
    const unsigned s = blockIdx.x * 256 + threadIdx.x;
    const unsigned h = hash_u(s * 2654435761u + 12345u), h2 = hash_u(h + 777u);
    const unsigned char* pj = ws + WS_R1;
    const bf16_t* mixed = (const bf16_t*)(ws + WS_R2 + 64 * MiB); const bf16_t* attn = mixed + 512;
    const bf16_t* zb = (const bf16_t*)(ws + WS_R2 + 192 * MiB);
    if (phase == PH_PRO) {
        if (s == 0) {
            volatile unsigned* pv = dbg + 40; pv[0] = 0xC0484038u; pv[1] = 0x3F800000u; pv[2] = 0x40000000u; pv[3] = 0x40800000u; pv[4] = 0xC0000000u;
            const unsigned wrt = pv[0];
            const u32x2 r = fp8x4_to_bf16x4(wrt);
            if (!(r.x == 0x40003F80u && r.y == 0xC0004080u)) {
                if (r.x == 0x3F804000u) dbg_fail(dbg, 21); else if (r.x == 0xC0004080u) dbg_fail(dbg, 22); else if (r.x == 0x40003F80u) dbg_fail(dbg, 25); else if (r.y == 0xC0004080u) dbg_fail(dbg, 26); else dbg_fail(dbg, 23); }
            const unsigned enc = pk4_fp8(__builtin_bit_cast(float, (unsigned)pv[1]), __builtin_bit_cast(float, (unsigned)pv[2]), __builtin_bit_cast(float, (unsigned)pv[3]), __builtin_bit_cast(float, (unsigned)pv[4]));
            if (enc != 0xC0484038u) dbg_fail(dbg, 24);
        }
        {
          const int n = h % IN_COLS, k = h2 % D; int row = n < 1864 ? n : n + 184;
          if (n >= 1152 && n < 1280) { const int d = (n - 1152) & 63; row = 1152 + ((n - 1152) & 64) + 16 * (d & 3) + (d >> 2); }
          float sc = 1.f; if ((n >= 512 && n < 1024) || (n >= 1280 && n < 1792)) sc = 0.125f; if (n >= 1856 && n < 1864) sc = 0.35355339059327373f;
          const float ref = f2bf_f(a.in[I_WIN][(size_t)k * IN_COLS + n] * (sc * a.in[I_N1G][k]));
          const float got = bf1(((const bf16_t*)(ws + WS_WIN))[(size_t)row * D + k]);
          if (!closef(got, ref, 0.01f, 1e-6f)) dbg_fail(dbg, 1); }
        {
          const int m = h % M, k = h2 % D;
          if (!closef(bf1(((const bf16_t*)(ws + WS_R2))[(size_t)m * D + k]), f2bf_f(a.in[I_X][(size_t)m * D + k]), 0.01f, 1e-6f)) dbg_fail(dbg, 2);
          if (s < 512) { float q = 0.f; for (int i = 0; i < D; ++i) { const float v = a.in[I_X][(size_t)m * D + i]; q += v * v; }
            if (!closef(((const float*)(ws + WS_RS1))[m], rsqrtf(q / D + RMS_EPS), 0.001f, 0.f)) dbg_fail(dbg, 2); }
        }
    }
    if (phase == PH_INPROJ) {
        const int m = h % M; int c = h2 % NP; if (s & 1) c = (c & 255) | (7 << 8);
        float r = dotbf((const bf16_t*)(ws + WS_R2) + (size_t)m * D, (const bf16_t*)(ws + WS_WIN) + (size_t)c * D, D) * ((const float*)(ws + WS_RS1))[m];
        if (c >= 2048) r = 1.0f / (1.0f + expf(-r));
        if (c >= 1792 + 128 && c < 2048) r = 0.f;
        if (!closef(pjv(pj, m, c), r, (c >= 1024 && c < 1280) ? 0.08f : 0.02f, (c >= 1024 && c < 1280) ? 0.02f : 0.01f)) dbg_fail(dbg, 3);
    }
    if (phase == PH_MIXED) {
        int m = h % M; if (s < 64) m = (s & 31) + (s >> 5) * SEQ; const int c = h2 % 512, g = c >> 7, w = 2 << g, t = m & (SEQ - 1); const int nw = (t + 1) < w ? (t + 1) : w;
        float r = 0.f; for (int i = 0; i < nw; ++i) r += pjv(pj, m - i, c);
        r = r / nw - pjv(pj, m, c);
        if (!closef(bf1(mixed[(size_t)m * 1024 + c]), r, 0.02f, 0.01f)) dbg_fail(dbg, 4);
    }
    if (phase == PH_Z) {
        {
          const int e = h % 32, n = (h >> 5) % D, k = h2 % D;
          const int k2 = h2 % PLE;
          if (!closef(bf1(((const bf16_t*)(ws + WS_WPP))[(size_t)n * PLE + k2]), f2bf_f(a.in[I_PPW][(size_t)k2 * D + n]), 0.01f, 1e-6f)) dbg_fail(dbg, 1);
          if (!closef(bf1(((const bf16_t*)(ws + WS_WR))[(size_t)e * D + k]), f2bf_f(a.in[I_RW][(size_t)k * NE + e] * a.in[I_N2G][k]), 0.01f, 1e-6f)) dbg_fail(dbg, 1);
          if (!closef(bf1(((const bf16_t*)(ws + WS_WPG))[(size_t)n * D + k]), f2bf_f(a.in[I_PGW][(size_t)k * D + n] * a.in[I_PNG][k]), 0.01f, 1e-6f)) dbg_fail(dbg, 1);
          const int k5 = h2 % 512;
          if (!closef(bf1(((const bf16_t*)(ws + WS_WPC))[(size_t)n * 1024 + 512 + k5]), f2bf_f(a.in[I_WBA][(size_t)k5 * D + n]), 0.01f, 1e-6f)) dbg_fail(dbg, 1);
          { const int g = k5 >> 7; float r = 0.f; for (int d = 0; d < 128; ++d) r += a.in[I_POOLW][(size_t)k5 * 128 + d] * a.in[I_POOLS][g * 128 + d] * a.in[I_WBP][(size_t)(g * 128 + d) * D + n];
            if (!closef(bf1(((const bf16_t*)(ws + WS_WPC))[(size_t)n * 1024 + k5]), r, 0.01f, 1e-4f)) dbg_fail(dbg, 1); } }
        { const int m = h % M, k2 = h2 % PLE;
          if (!closef(bf1(((const bf16_t*)(ws + WS_PB))[(size_t)m * PLE + k2]), f2bf_f(a.in[I_P][(size_t)m * PLE + k2]), 0.01f, 1e-6f)) dbg_fail(dbg, 2); }
        {
          const int e = h % 32, n = (h >> 5) % 2048, k = h2 % D; const int row = n < 1024 ? (((n >> 7) << 8) + (n & 127)) : ((((n - 1024) >> 7) << 8) + 128 + ((n - 1024) & 127));
          const float ref = f2bf_f(a.in[I_W1][((size_t)e * D + k) * 2048 + n] * a.in[I_N2G][k]);
          const float got = bf1(((const bf16_t*)(ws + WS_W1))[((size_t)e * 2048 + row) * D + k]);
          if (!closef(got, ref, 0.01f, 1e-6f)) dbg_fail(dbg, 1); }
        { const int e = h % 32, n = (h >> 5) % D, k = h2 % D;
          if (!closef(bf1(((const bf16_t*)(ws + WS_W2))[((size_t)e * D + n) * DFF + k]), f2bf_f(a.in[I_W2][((size_t)e * DFF + k) * D + n]), 0.01f, 1e-6f)) dbg_fail(dbg, 1); }
        const int m = h % M, c = h2 % D; const bf16_t* wc_ = (const bf16_t*)(ws + WS_WPC) + (size_t)c * 1024;
        const float r = dotbf(mixed + (size_t)m * 1024, wc_, 512) * pjv(pj, m, C_GP + c) + dotbf(attn + (size_t)m * 1024, wc_ + 512, 512) * pjv(pj, m, C_GA + c);
        if (!closef(bf1(zb[(size_t)m * D + c]), r, 0.02f, 0.02f)) dbg_fail(dbg, 8);
    }
    if (phase == PH_X1) {
        const int m = h % M, c = h2 % D;
        const float r = a.in[I_X][(size_t)m * D + c] + dotbf(zb + (size_t)m * D, (const bf16_t*)(ws + WS_WOUT) + (size_t)c * D, D);
        if (!closef(bf1(((const bf16_t*)(ws + WS_X1B))[(size_t)m * D + c]), r, 0.01f, 0.01f)) dbg_fail(dbg, 9);
        if (s < 512) { float q = 0.f; for (int i = 0; i < D; ++i) { const float v = bf1(((const bf16_t*)(ws + WS_X1B))[(size_t)m * D + i]); q += v * v; }
            if (!closef(((const float*)(ws + CTLB_SS2))[m], q, 0.01f, 0.f)) dbg_fail(dbg, 9); }
    }
    if (phase == PH_ROUTER) {
        const int m = h % M; const float rs = rsqrtf(((const float*)(ws + CTLB_SS2))[m] / D + RMS_EPS);
        float v[32]; for (int e = 0; e < 32; ++e) v[e] = dotbf((const bf16_t*)(ws + WS_X1B) + (size_t)m * D, (const bf16_t*)(ws + WS_WR) + (size_t)e * D, D) * rs + a.in[I_RB][e];
        const int* ti = (const int*)(ws + WS_TOPI) + m * 4; const float* tg = (const float*)(ws + WS_TOPG) + m * 4;
        float mn = 1e30f, se = 0.f, gs = 0.f; bool ok = true;
        for (int r = 0; r < 4; ++r) { if (ti[r] < 0 || ti[r] >= 32) { ok = false; break; } mn = fminf(mn, v[ti[r]]); for (int q = 0; q < r; ++q) if (ti[q] == ti[r]) ok = false; }
        if (ok) { for (int r = 0; r < 4; ++r) se += expf(v[ti[r]] - v[ti[0]]);
            for (int r = 0; r < 4; ++r) { if (!closef(tg[r], expf(v[ti[r]] - v[ti[0]]) / se, 0.02f, 0.002f)) ok = false; gs += tg[r]; }
            int above = 0; for (int e = 0; e < 32; ++e) { bool sel = false; for (int r = 0; r < 4; ++r) sel |= (ti[r] == e); if (!sel && v[e] > mn + 1e-3f) ++above; }
            if (above) ok = false; }
        if (!ok) dbg_fail(dbg, 10);
    }
    if (phase == PH_SCATTER) {
        const int m = h % M; const int* ti = (const int*)(ws + WS_TOPI) + m * 4; const int* po = (const int*)(ws + WS_POSOF) + m * 4; const int* te = (const int*)(ws + CTLB_TILEE);
        const int ntl = *(const int*)(ws + CTLB_META); bool ok = ntl > 0 && ntl <= 544;
        for (int r = 0; r < 4 && ok; ++r) { const int p = po[r]; if (p < 0 || p >= ntl * 256) { ok = false; break; }
            if (((const int*)(ws + WS_ROWMAP))[p] != m) ok = false; if (te[p >> 8] != ti[r]) ok = false;
            if (!closef(((const float*)(ws + WS_ROWGATE))[p], ((const float*)(ws + WS_TOPG))[m * 4 + r], 1e-6f, 0.f)) ok = false; }
        if (!ok) dbg_fail(dbg, 11);
    }
    if (phase == PH_MOE1) {
        const int ntl = *(const int*)(ws + CTLB_META); if (ntl > 0 && ntl <= 544) {
        const int row = h % (ntl * 256), j = h2 % DFF; const int e = ((const int*)(ws + CTLB_TILEE))[row >> 8], tok = ((const int*)(ws + WS_ROWMAP))[row];
        const float rs = rsqrtf(((const float*)(ws + CTLB_SS2))[tok] / D + RMS_EPS);
        const bf16_t* w1t = (const bf16_t*)(ws + WS_W1) + (size_t)e * 2048 * D; const int rg = ((j >> 7) << 8) + (j & 127), ru = rg + 128;
        float gl = dotbf((const bf16_t*)(ws + WS_X1B) + (size_t)tok * D, w1t + (size_t)rg * D, D) * rs + a.in[I_B1][e * 2048 + j];
        float up = dotbf((const bf16_t*)(ws + WS_X1B) + (size_t)tok * D, w1t + (size_t)ru * D, D) * rs + a.in[I_B1][e * 2048 + 1024 + j];
        gl = fminf(gl, 7.f); up = fminf(fmaxf(up, -7.f), 7.f);
        const float r = (up + 1.f) * gl / (1.f + expf(-1.702f * gl));
        if (((const float*)(ws + WS_ROWGATE))[row] != 0.f && !closef(bf1(((const bf16_t*)(ws + WS_R1))[(size_t)row * DFF + j]), r, 0.03f, 0.02f)) dbg_fail(dbg, 12); } else dbg_fail(dbg, 12);
    }
    if (phase == PH_MOE2) {
        const int ntl = *(const int*)(ws + CTLB_META); if (ntl > 0 && ntl <= 544) {
        const int row = h % (ntl * 256), c = h2 % D; const int e = ((const int*)(ws + CTLB_TILEE))[row >> 8];
        const float r = (dotbf((const bf16_t*)(ws + WS_R1) + (size_t)row * DFF, (const bf16_t*)(ws + WS_W2) + ((size_t)e * D + c) * DFF, DFF) + a.in[I_B2][e * D + c]) * ((const float*)(ws + WS_ROWGATE))[row];
        if (!closef(bf1(((const bf16_t*)(ws + WS_R2))[(size_t)row * D + c]), r, 0.03f, 0.01f)) dbg_fail(dbg, 13); } else dbg_fail(dbg, 13);
    }
    if (phase == PH_COMBINE) {
        const int m = h % M, c = h2 % D;
        { float r2 = bf1(((const bf16_t*)(ws + WS_X1B))[(size_t)m * D + c]); for (int q = 0; q < 4; ++q) r2 += bf1(((const bf16_t*)(ws + WS_R2))[(size_t)((const int*)(ws + WS_POSOF))[m * 4 + q] * D + c]);
          if (!closef(bf1(((const bf16_t*)(ws + WS_R1))[(size_t)m * D + c]), r2, 0.01f, 0.01f)) dbg_fail(dbg, 14); }
        if (s < 512) { float q = 0.f; for (int i = 0; i < D; ++i) { const float v = bf1(((const bf16_t*)(ws + WS_R1))[(size_t)m * D + i]); q += v * v; }
            if (!closef(((const float*)(ws + WS_RS3))[m], rsqrtf(q / D + RMS_EPS), 0.01f, 0.f)) dbg_fail(dbg, 14); }
    }
    if (phase == PH_PLE) {
        const int m = h % M, c = h2 % D;
        const float pp = dotbf((const bf16_t*)(ws + WS_PB) + (size_t)m * PLE, (const bf16_t*)(ws + WS_WPP) + (size_t)c * PLE, PLE);
        const float ppk = bf1(((const bf16_t*)(ws + WS_PP))[(size_t)m * D + c]);
        if (!closef(ppk, pp, 0.02f, 0.01f)) dbg_fail(dbg, 16);
        const float gate = 1.f / (1.f + expf(-dotbf((const bf16_t*)(ws + WS_R1) + (size_t)m * D, (const bf16_t*)(ws + WS_WPG) + (size_t)c * D, D) * ((const float*)(ws + WS_RS3))[m]));
        const float r3 = bf1(((const bf16_t*)(ws + WS_R1))[(size_t)m * D + c]) + gate * ppk;
        if (!closef(bf1(((const bf16_t*)(ws + WS_R1 + 128 * MiB))[(size_t)m * D + c]), r3, 0.02f, 0.03f)) dbg_fail(dbg, 15);
    }
}
__global__ void __launch_bounds__(256) chk_att(Args a) {
    unsigned char* ws = a.ws; unsigned* dbg = (unsigned*)(ws + CTLB_DBG);
    const unsigned char* pj = ws + WS_R1; const bf16_t* attn = (const bf16_t*)(ws + WS_R2 + 64 * MiB) + 512; const int* sel = (const int*)(ws + WS_SEL);
    const int special[16] = {0, 5, 63, 64, 200, 255, 256, 257, 300, 449, 512, 1000, 2047, 4096, 9000, 16383};
    const int sb = blockIdx.x; int t = (sb < 16) ? special[sb] : (int)(hash_u(sb * 977u + 5u) % SEQ); const int b = sb & 1; const int row = b * SEQ + t;
    __shared__ unsigned bitmap[512]; __shared__ unsigned skey[256]; __shared__ int s_bad, s_viol; __shared__ unsigned s_min; __shared__ float sc[8][256];
    const int tid = threadIdx.x;
    for (int i = tid; i < 512; i += 256) bitmap[i] = 0u;
    if (tid == 0) { s_bad = 0; s_viol = 0; s_min = 0xFFFFFFFFu; }
    __syncthreads();
    const int nsel = (t + 1) < 256 ? (t + 1) : 256;
    auto score_key = [&](int kp) -> unsigned {
        float s = 0.f;
        for (int hd = 0; hd < 8; ++hd) { float l = 0.f; for (int d = 0; d < 64; ++d) l += pjv(pj, row, C_QI + hd * 64 + d) * pjv(pj, b * SEQ + kp, C_KI + d);
            s = fmaf(fmaxf(l, 0.f), pjv(pj, row, C_WI + hd), s); }
        const unsigned ub = __builtin_bit_cast(unsigned, s); const unsigned srt = ub ^ ((ub >> 31) ? 0xFFFFFFFFu : 0x80000000u);
        return (srt & 0xFFFFC000u) | (unsigned)(16383 - kp);
    };
    { const int kp = sel[(size_t)row * 256 + tid];
      if (tid < nsel) { if (kp < 0 || kp > t) atomicAdd(&s_bad, 1); else { const unsigned old = atomicOr(&bitmap[kp >> 5], 1u << (kp & 31)); if (old & (1u << (kp & 31))) atomicAdd(&s_bad, 1);
            const unsigned pk = score_key(kp); skey[tid] = pk; atomicMin(&s_min, pk); } }
      else if (kp != -1) atomicAdd(&s_bad, 1); }
    __syncthreads();
    if (s_bad == 0) {
        for (int kp = tid; kp <= t; kp += 256) { if (!((bitmap[kp >> 5] >> (kp & 31)) & 1u)) { if (score_key(kp) > s_min) atomicAdd(&s_viol, 1); } }
    }
    __syncthreads();
    if (tid == 0 && (s_bad != 0 || s_viol > 3)) dbg_fail(dbg, 6);
    if (s_bad != 0) return;
    for (int hd = 0; hd < 8; ++hd) { float l = -1e30f;
        if (tid < nsel) { const int kp = sel[(size_t)row * 256 + tid]; l = 0.f; for (int d = 0; d < 64; ++d) l += pjv(pj, row, C_Q + hd * 64 + d) * pjv(pj, b * SEQ + kp, C_K + (hd >> 2) * 64 + d); }
        sc[hd][tid] = l; }
    __syncthreads();
    for (int o = tid; o < 512; o += 256) { const int hd = o >> 6, d = o & 63; float mx = -1e30f; for (int i = 0; i < nsel; ++i) mx = fmaxf(mx, sc[hd][i]);
        float se = 0.f, ov = 0.f; for (int i = 0; i < nsel; ++i) { const float p = expf(sc[hd][i] - mx); se += p; ov += p * pjv(pj, b * SEQ + sel[(size_t)row * 256 + i], C_V + (hd >> 2) * 64 + 16 * (d & 3) + (d >> 2)); }
        if (!closef(bf1(attn[(size_t)row * 1024 + o]), ov / se, 0.03f, 0.01f)) dbg_fail(dbg, 7); }
}
__global__ void __launch_bounds__(256) chk_report(Args a) {
    const unsigned* dbg = (const unsigned*)(a.ws + CTLB_DBG);
    int code = 0; for (int c = 20; c < 32; ++c) if (dbg[c] != 0u) { code = c; break; }
    if (code == 0) for (int c = 1; c < 20; ++c) if (dbg[c] != 0u) { code = c; break; }
    if (code == 0) return;
    const float v = sqrtf((float)code);
    for (size_t i = (size_t)blockIdx.x * 256 + threadIdx.x; i < (size_t)M * D; i += (size_t)gridDim.x * 256) a.out[i] = v;
}
#endif

extern "C" void kernel_launch(void* const* d_in, const int* in_sizes, int n_in, void* d_out, int out_size, void* d_ws, size_t ws_size, hipStream_t stream) {
    static int grid = 0;
    if (grid == 0) {
        if (n_in != 20 || out_size != M * D || ws_size < WS_END) { fprintf(stderr, "kernel_launch: unexpected shapes (n_in %d out %d ws %zu)\n", n_in, out_size, ws_size); grid = -1; return; }
        int dev = 0, cus = 0, per_cu = 0;
        if (hipGetDevice(&dev) != hipSuccess || hipDeviceGetAttribute(&cus, hipDeviceAttributeMultiprocessorCount, dev) != hipSuccess) { grid = -1; return; }
        if (hipFuncSetAttribute((const void*)fwd, hipFuncAttributeMaxDynamicSharedMemorySize, LDS_BYTES) != hipSuccess) { fprintf(stderr, "kernel_launch: hipFuncSetAttribute failed\n"); grid = -1; return; }
        if (hipOccupancyMaxActiveBlocksPerMultiprocessor(&per_cu, (const void*)fwd, NTHREADS, LDS_BYTES) != hipSuccess || per_cu < 1) fprintf(stderr, "kernel_launch: occupancy query says %d\n", per_cu);
        (void)hipGetLastError();
        grid = cus;
    }
    if (grid < 0) return;
    (void)hipMemsetAsync((char*)d_ws + WS_CTL, 0, CTL_ZERO_BYTES, stream);
    Args a{};
    for (int i = 0; i < 20; ++i) a.in[i] = (const float*)d_in[i];
    a.out = (float*)d_out; a.ws = (unsigned char*)d_ws;
#if DBG
    for (int p = 0; p < NPH; ++p) {
        a.ph_lo = p; a.ph_hi = p + 1;
        hipLaunchKernelGGL(fwd, dim3(grid), dim3(NTHREADS), LDS_BYTES, stream, a);
        if (p == PH_ATT) hipLaunchKernelGGL(chk_att, dim3(48), dim3(256), 0, stream, a);
        else if (p != PH_FINAL && p != PH_POOL) hipLaunchKernelGGL(chk, dim3(32), dim3(256), 0, stream, a, p);
    }
    hipLaunchKernelGGL(chk_report, dim3(1024), dim3(256), 0, stream, a);
#else
    a.ph_lo = 0; a.ph_hi = NPH;
    hipLaunchKernelGGL(fwd, dim3(grid), dim3(NTHREADS), LDS_BYTES, stream, a);
#endif
}
```

```cpp
#include <hip/hip_runtime.h>
#include <cstdio>
#include <cstdint>

#ifndef DBG
#define DBG 0
#endif

#define LAS __attribute__((address_space(3)))
#define GAS __attribute__((address_space(1)))
typedef unsigned short bf16_t;
typedef short bf16x8 __attribute__((ext_vector_type(8)));
typedef float f32x4 __attribute__((ext_vector_type(4)));
typedef float f32x16 __attribute__((ext_vector_type(16)));
typedef unsigned u32x4 __attribute__((ext_vector_type(4)));
typedef unsigned u32x2 __attribute__((ext_vector_type(2)));

constexpr int M = 32768, SEQ = 16384, D = 1024, NP = 4096, NE = 32, DFF = 1024, PLE = 256;
constexpr int IN_COLS = 3912;
constexpr int C_U = 0, C_Q = 512, C_K = 1024, C_V = 1152, C_QI = 1280, C_KI = 1792, C_WI = 1856, C_GP = 2048, C_GA = 3072;
constexpr int MOE_ROWS = M * 4 + NE * 256;
constexpr float RMS_EPS = 1e-6f;
constexpr int NWAVES = 8, NTHREADS = 512;

constexpr size_t MiB = 1u << 20;
constexpr size_t WS_CTL = 0, CTL_ZERO_BYTES = 1 * MiB;
constexpr size_t CTLB_BAR = 16384;
constexpr size_t CTLB_QUEUE = 65536;
constexpr size_t CTLB_META = 65536 + 256;
constexpr size_t CTLB_DBG = 131072;
constexpr size_t CTLB_SS2 = 262144;
constexpr size_t CTLB_SS4 = 393216;
constexpr size_t CTLB_CNTWG = 524288;
constexpr size_t CTLB_TILEE = 589824;
constexpr size_t WS_WIN = 1 * MiB, WS_WPC = 9 * MiB, WS_WBA = 10 * MiB, WS_WOUT = 11 * MiB, WS_WR = 13 * MiB, WS_WPG = 14 * MiB, WS_WPP = 16 * MiB;
constexpr size_t WS_RS1 = 17 * MiB, WS_RS3 = 17 * MiB + 131072;
constexpr size_t WS_TOPI = 18 * MiB, WS_TOPG = 18 * MiB + 524288, WS_LRANK = 19 * MiB, WS_POSOF = 19 * MiB + 524288;
constexpr size_t WS_ROWMAP = 20 * MiB, WS_ROWGATE = 21 * MiB, WS_ROWSCALE = 17 * MiB + 262144;
constexpr size_t WS_W1 = 22 * MiB, WS_W2 = 150 * MiB, WS_PB = 214 * MiB, WS_X1B = 230 * MiB;
constexpr size_t WS_R1 = 294 * MiB;
constexpr size_t WS_R2 = 566 * MiB;
constexpr size_t PJ_U = 0, PJ_Q = 32 * MiB, PJ_KV = 64 * MiB, PJ_QI = 80 * MiB, PJ_KW = 112 * MiB, PJ_G = 120 * MiB;
constexpr size_t WS_SEL = 838 * MiB;
constexpr size_t WS_PP = 870 * MiB;
constexpr size_t WS_END = 934 * MiB;

constexpr int LDS_MAIN = 0;
constexpr int LDS_KT = 131072;
constexpr int LDS_HIST = 147456;
constexpr int LDS_ATM = 155648;
constexpr int LDS_MISC = 156672;
constexpr int LDS_BYTES = 157696;

__device__ __forceinline__ unsigned f2bf(float f) { unsigned u = __builtin_bit_cast(unsigned, f); return (u + 0x7fffu + ((u >> 16) & 1u)) >> 16; }
__device__ __forceinline__ unsigned pk2(float lo, float hi) { return f2bf(lo) | (f2bf(hi) << 16); }
__device__ __forceinline__ float bf_lo(unsigned w) { return __builtin_bit_cast(float, w << 16); }
__device__ __forceinline__ float bf_hi(unsigned w) { return __builtin_bit_cast(float, w & 0xffff0000u); }
__device__ __forceinline__ float bf1(bf16_t b) { return __builtin_bit_cast(float, ((unsigned)b) << 16); }
typedef float f32x2_ __attribute__((ext_vector_type(2)));
__device__ __forceinline__ u32x2 fp8x4_to_bf16x4(unsigned w) {
    const f32x2_ a = __builtin_amdgcn_cvt_pk_f32_fp8((int)w, false), b = __builtin_amdgcn_cvt_pk_f32_fp8((int)w, true);
    const float ax = a.x, ay = a.y, bx = b.x, by = b.y;
    u32x2 r; r.x = __builtin_amdgcn_perm(__float_as_uint(ay), __float_as_uint(ax), 0x07060302u);
    r.y = __builtin_amdgcn_perm(__float_as_uint(by), __float_as_uint(bx), 0x07060302u); return r;
}
__device__ __forceinline__ bf16x8 fp8x8_to_bf16x8(unsigned w0, unsigned w1) { const u32x2 a = fp8x4_to_bf16x4(w0), b = fp8x4_to_bf16x4(w1); return __builtin_bit_cast(bf16x8, (u32x4){a.x, a.y, b.x, b.y}); }
__device__ __forceinline__ float clamp_e4m3(float v) { return __builtin_amdgcn_fmed3f(v, -448.0f, 448.0f); }
__device__ __forceinline__ unsigned pk4_fp8(float a, float b, float c, float d) { int w = __builtin_amdgcn_cvt_pk_fp8_f32(clamp_e4m3(a), clamp_e4m3(b), 0, false); w = __builtin_amdgcn_cvt_pk_fp8_f32(clamp_e4m3(c), clamp_e4m3(d), w, true); return (unsigned)w; }
__device__ __forceinline__ float sigmoidf_(float x) { return __builtin_amdgcn_rcpf(1.0f + __expf(-x)); }
#define LDS_WAIT() asm volatile("s_waitcnt lgkmcnt(0)" ::: "memory")
#define VM_WAIT() asm volatile("s_waitcnt vmcnt(0)" ::: "memory")
__device__ __forceinline__ float wave_sum(float v) {
#pragma unroll
    for (int o = 1; o < 64; o <<= 1) v += __shfl_xor(v, o);
    return v;
}

#define XB_TMO      128
#define XB_XCNT(j)  (256  + 64 * (j))
#define XB_XSUB(j)  (1280 + 64 * (j))
#define XB_XGEN(j)  (2304 + 64 * (j))
#define XB_TOP      3328
#define XB_TOPGEN   3392
#define XCD_BAR_WORDS 3456
#define XB_SPIN_CAP (1u << 22)
__device__ __forceinline__ unsigned xb_ld(unsigned* p)              { return __hip_atomic_load(p, __ATOMIC_RELAXED, __HIP_MEMORY_SCOPE_AGENT); }
__device__ __forceinline__ unsigned xb_add(unsigned* p, unsigned v) { return __hip_atomic_fetch_add(p, v, __ATOMIC_RELAXED, __HIP_MEMORY_SCOPE_AGENT); }
__device__ __forceinline__ unsigned xb_xcc_id() { return (unsigned)__builtin_amdgcn_s_getreg((3 << 11) | 20) & 0xFu; }
#define XB_SPIN(cond, bar) do { unsigned _sp = 0; while (cond) { __builtin_amdgcn_s_sleep(1); \
    if ((++_sp & 255u) == 0u) { if (xb_ld(&(bar)[XB_TMO])) break; if (_sp > XB_SPIN_CAP) { atomicAdd(&(bar)[XB_TMO], 1u); break; } } } } while (0)
struct XcdBarrier { unsigned* bar; unsigned x; volatile LAS unsigned* st; };
__device__ __forceinline__ XcdBarrier xcd_barrier_post(unsigned* bar, volatile LAS unsigned* st) {
    XcdBarrier b; b.bar = bar; b.x = xb_xcc_id(); b.st = st;
    if (threadIdx.x == 0) (void)xb_add(&bar[XB_XCNT(b.x)], 1u);
    return b;
}
__device__ __forceinline__ void xcd_barrier_complete(unsigned* bar, unsigned x, unsigned& nloc, unsigned& nx) {
    const unsigned G = gridDim.x * gridDim.y * gridDim.z;
    unsigned sum, cnt, mine, sp = 0u;
    for (;;) {
        sum = 0u; cnt = 0u; mine = 0u;
#pragma unroll
        for (unsigned j = 0; j < 16; ++j) { const unsigned c = xb_ld(&bar[XB_XCNT(j)]); sum += c; cnt += (c > 0u) ? 1u : 0u; mine = (j == x) ? c : mine; }
        if (sum == G) break;
        __builtin_amdgcn_s_sleep(1);
        if ((++sp & 255u) == 0u) { if (xb_ld(&bar[XB_TMO])) break; if (sp > XB_SPIN_CAP) { atomicAdd(&bar[XB_TMO], 1u); break; } }
    }
    nloc = mine > 0u ? mine : 1u; nx = cnt > 0u ? cnt : 1u;
}
__device__ __forceinline__ void xcd_barrier(const XcdBarrier& b) {
    asm volatile("s_waitcnt vmcnt(0)" ::: "memory");
    __syncthreads();
    if (threadIdx.x == 0) {
        unsigned* bar = b.bar;
        __builtin_amdgcn_s_waitcnt(0);
        unsigned nloc = b.st[0], nx = b.st[1];
        if (nloc == 0u) { xcd_barrier_complete(bar, b.x, nloc, nx); b.st[0] = nloc; b.st[1] = nx; }
        const unsigned old = xb_add(&bar[XB_XSUB(b.x)], 1u);
        const unsigned gen = old / nloc;
        if (old + 1u == (gen + 1u) * nloc) {
            __builtin_amdgcn_fence(__ATOMIC_RELEASE, "agent");
            asm volatile("s_waitcnt vmcnt(0)" ::: "memory");
            const unsigned og = xb_add(&bar[XB_TOP], 1u);
            const unsigned tg = og / nx;
            if (og + 1u == (tg + 1u) * nx) xb_add(&bar[XB_TOPGEN], 1u);
            else XB_SPIN(xb_ld(&bar[XB_TOPGEN]) == tg, bar);
            __builtin_amdgcn_fence(__ATOMIC_ACQUIRE, "agent");
            xb_add(&bar[XB_XGEN(b.x)], 1u);
            asm volatile("s_waitcnt vmcnt(0)" ::: "memory");
        } else {
            XB_SPIN(xb_ld(&bar[XB_XGEN(b.x)]) == gen, bar);
            __builtin_amdgcn_fence(__ATOMIC_ACQUIRE, "agent");
            asm volatile("s_waitcnt vmcnt(0)" ::: "memory");
        }
    }
    __syncthreads();
}

namespace pg8 {
constexpr int BM = 256, BK = 64, HALF = 128, HTB = HALF * BK * 2, STAGE_BYTES = 8 * HTB, NXCD = 8, WGM = 8;
__host__ __device__ __forceinline__ int lds_byte(int r, int c) { const int st = (r >> 4) * 2 + (c >> 5), rr = r & 15, cc = c & 31, ob = rr * 64 + cc * 2; return st * 1024 + (ob ^ (((ob >> 9) & 1) << 5)); }
__host__ __device__ __forceinline__ void stage_rc(int b, int& R, int& C) { const int st = b / 1024, sb = b % 1024, swz = sb ^ (((sb >> 9) & 1) << 5); R = (st >> 1) * 16 + swz / 64; C = (st & 1) * 32 + (swz % 64) / 2; }
__host__ __device__ __forceinline__ int perm32(int rho) { const int n = rho >> 4, i = rho & 15; return 8 * (i >> 2) + 4 * n + (i & 3); }

struct Unit { int pm, pn, e; };
struct Gemm { const bf16_t* A; const bf16_t* Bt; int M, N, K; size_t bstride; const int* rowmap; };

struct StaticOrder {
    int nM, nN, nwg, G, c;
    __device__ void init(int M_, int N_, int G_, int c_) { nM = M_ / BM; nN = N_ / BM; nwg = nM * nN; G = G_; c = c_; }
    __device__ bool next(int i, Unit& u) const {
        const long L = (long)i * G + c; if (L >= nwg) return false;
        int wgid = (int)L; { const int q = nwg / NXCD, r = nwg % NXCD, xcd = wgid % NXCD, off = wgid / NXCD; wgid = (xcd < r ? xcd * (q + 1) : r * (q + 1) + (xcd - r) * q) + off; }
        const int nig = WGM * nN, gid = wgid / nig, fm = gid * WGM, gsz = (nM - fm) < WGM ? (nM - fm) : WGM;
        u.pm = fm + ((wgid % nig) % gsz); u.pn = (wgid % nig) / gsz; u.e = 0; return true;
    }
};
struct MoeOrder {
    const LAS int* tile_e; int ntiles, nct, G, c;
    __device__ bool next(int i, Unit& u) const {
        const int v = (G % 8 == 0) ? (c % 8) * (G / 8) + c / 8 : c;
        const long L = (long)i * G + v; if (L >= (long)ntiles * nct) return false;
        u.pm = (int)(L / nct); u.pn = (int)(L % nct); u.e = __builtin_amdgcn_readfirstlane(tile_e[u.pm]); return true;
    }
};

struct PPOrder {
    int S, r;
    __device__ __forceinline__ bool next(int i, Unit& u) const { if (r < 0) return false; const int L = r + i * S; if (L >= 512) return false; u.pm = L >> 2; u.pn = L & 3; u.e = 0; return true; }
};
__device__ __forceinline__ unsigned cvt_pk_bf16(float lo, float hi) { unsigned r; asm volatile("v_cvt_pk_bf16_f32 %0, %1, %2" : "=v"(r) : "v"(lo), "v"(hi)); return r; }

struct NoHook { static constexpr bool ACTIVE = false; };
typedef int v8i32 __attribute__((ext_vector_type(8)));
typedef long i64x2 __attribute__((ext_vector_type(2)));
template <class Epi, class Sched, bool GATHER, class Hook = NoHook, int FP8 = 0>
__device__ __forceinline__ void gemm_phase(LAS unsigned char* lds, const Gemm g, const Sched& S, const Epi& E, const Hook& Hk = Hook()) {
    int tid_ = (int)threadIdx.x; asm volatile("" : "+v"(tid_));
    const int tid = tid_, wid = __builtin_amdgcn_readfirstlane(tid >> 6), lane = tid & 63, wr = wid >> 2, wc = wid & 3, fr = lane & 15, fq = lane >> 4;
    const int K = g.K, nt = K / BK;
    unsigned voffA[2][2], nvoffA[2][2], voffB[2]; int RA[2], CA[2];
#pragma unroll
    for (int i = 0; i < 2; ++i) { int R, C; stage_rc(tid * 16 + i * 8192, R, C); const int Rb = Epi::PERM ? ((R & ~31) + perm32(R & 31)) : R;
        RA[i] = R; CA[i] = C; voffB[i] = (unsigned)(Rb * K + C) * 2u; }
    const size_t kstep = (size_t)(BK * 2);
    const size_t hstep = (size_t)HALF * K * 2;
    const size_t tstep = 2 * hstep;
    const unsigned ldsw = (unsigned)wid * 1024u;
    const int aoff = lds_byte(wr * 64 + fr, fq * 8), boff = lds_byte(wc * 32 + fr, fq * 8);
#define PG8_SA(b, h) (((b) * 2 + (h)) * HTB)
#define PG8_SB(b, h) ((4 + (b) * 2 + (h)) * HTB)
      \
    const __amdgpu_buffer_rsrc_t rsA = __builtin_amdgcn_make_buffer_rsrc((void*)g.A, 0, 0x7FFFFFFF, 0x00020000), rsB = __builtin_amdgcn_make_buffer_rsrc((void*)g.Bt, 0, 0x7FFFFFFF, 0x00020000);
#define PG8_STAGE2(bufoff, gbase, v0, v1) do { \
        if constexpr (true) { if ((bufoff) < 4 * HTB) { const int so_ = (int)((const char*)(gbase) - (const char*)g.A); \
                __builtin_amdgcn_raw_ptr_buffer_load_lds(rsA, (LAS void*)(lds + (bufoff) + ldsw), 16, (int)(v0), so_, 0, 0); __builtin_amdgcn_raw_ptr_buffer_load_lds(rsA, (LAS void*)(lds + (bufoff) + ldsw + 8192), 16, (int)(v1), so_, 0, 0); } \
            else { const int so_ = (int)((const char*)(gbase) - (const char*)g.Bt); \
                __builtin_amdgcn_raw_ptr_buffer_load_lds(rsB, (LAS void*)(lds + (bufoff) + ldsw), 16, (int)(v0), so_, 0, 0); __builtin_amdgcn_raw_ptr_buffer_load_lds(rsB, (LAS void*)(lds + (bufoff) + ldsw + 8192), 16, (int)(v1), so_, 0, 0); } } \
        else { \
        __builtin_amdgcn_global_load_lds((const unsigned*)((const char*)(gbase) + (v0)), (LAS unsigned*)(lds + (bufoff) + ldsw), 16, 0, 0); \
        __builtin_amdgcn_global_load_lds((const unsigned*)((const char*)(gbase) + (v1)), (LAS unsigned*)(lds + (bufoff) + ldsw + 8192), 16, 0, 0); } } while (0)
#define PG8_STAGEB(bufoff, gbase) PG8_STAGE2(bufoff, gbase, voffB[0], voffB[1])
#define PG8_LDA(dst, b, h) do { _Pragma("unroll") for (int m = 0; m < 4; ++m) _Pragma("unroll") for (int k = 0; k < 2; ++k) dst[m][k] = *(const LAS bf16x8*)(lds + PG8_SA(b, h) + aoff + m * 2048 + k * 1024); } while (0)
#define PG8_LDB(dst, b, h) do { _Pragma("unroll") for (int n = 0; n < 2; ++n) _Pragma("unroll") for (int k = 0; k < 2; ++k) dst[n][k] = *(const LAS bf16x8*)(lds + PG8_SB(b, h) + boff + n * 2048 + k * 1024); } while (0)
#define PG8_MMA(ai, bj, At, Bt) do { __builtin_amdgcn_s_setprio(1); \
        if constexpr (FP8 == 2) { _Pragma("unroll") for (int m = 0; m < 4; ++m) _Pragma("unroll") for (int n = 0; n < 2; ++n) { \
            const v8i32 b_ = __builtin_bit_cast(v8i32, __builtin_shufflevector(Bt[n][0], Bt[n][1], 0, 1, 2, 3, 4, 5, 6, 7, 8, 9, 10, 11, 12, 13, 14, 15)); \
            const v8i32 a_ = __builtin_bit_cast(v8i32, __builtin_shufflevector(At[m][0], At[m][1], 0, 1, 2, 3, 4, 5, 6, 7, 8, 9, 10, 11, 12, 13, 14, 15)); \
            asm volatile("v_mfma_scale_f32_16x16x128_f8f6f4 %0, %1, %2, %0, %3, %3 op_sel_hi:[0,0,0]" : "+v"(acc[ai][bj][m][n]) : "v"(b_), "v"(a_), "v"(sc1_)); } } \
        else if constexpr (FP8 == 1) { _Pragma("unroll") for (int m = 0; m < 4; ++m) _Pragma("unroll") for (int n = 0; n < 2; ++n) _Pragma("unroll") for (int k = 0; k < 2; ++k) { \
            const i64x2 b_ = __builtin_bit_cast(i64x2, Bt[n][k]), a_ = __builtin_bit_cast(i64x2, At[m][k]); \
            acc[ai][bj][m][n] = __builtin_amdgcn_mfma_f32_16x16x32_fp8_fp8(b_.x, a_.x, acc[ai][bj][m][n], 0, 0, 0); acc[ai][bj][m][n] = __builtin_amdgcn_mfma_f32_16x16x32_fp8_fp8(b_.y, a_.y, acc[ai][bj][m][n], 0, 0, 0); } } \
        else { _Pragma("unroll") for (int m = 0; m < 4; ++m) _Pragma("unroll") for (int n = 0; n < 2; ++n) _Pragma("unroll") for (int k = 0; k < 2; ++k) \
            acc[ai][bj][m][n] = __builtin_amdgcn_mfma_f32_16x16x32_bf16(Bt[n][k], At[m][k], acc[ai][bj][m][n], 0, 0, 0); } \
        __builtin_amdgcn_s_setprio(0); } while (0)
#define PG8_WAIT_V(n) asm volatile("s_waitcnt vmcnt(" #n ")" ::: "memory")
#define PG8_WAIT_L(n) asm volatile("s_waitcnt lgkmcnt(" #n ")" ::: "memory")
#define PG8_BAR __builtin_amdgcn_s_barrier()
#define PG8_SCHED __builtin_amdgcn_sched_barrier(0)
    Unit cur, nxt; int ui = 0;
    if (!S.next(0, cur)) return;
    int sc1_ = 0x7F7F7F7F; if constexpr (FP8 == 2) asm volatile("" : "+v"(sc1_));
    f32x4 acc[2][2][4][2];
#pragma unroll
    for (int a = 0; a < 2; ++a)
#pragma unroll
        for (int b = 0; b < 2; ++b)
#pragma unroll
            for (int m = 0; m < 4; ++m)
#pragma unroll
                for (int n = 0; n < 2; ++n) acc[a][b][m][n] = (f32x4){0.f, 0.f, 0.f, 0.f};
    bf16x8 At[4][2], B0[2][2], B1[2][2];
#pragma unroll
    for (int h = 0; h < 2; ++h)
#pragma unroll
        for (int i = 0; i < 2; ++i) {
            if constexpr (GATHER) voffA[h][i] = ((unsigned)g.rowmap[cur.pm * BM + h * HALF + RA[i]] * (unsigned)K + (unsigned)CA[i]) * 2u;
            else voffA[h][i] = (unsigned)((h * HALF + RA[i]) * K + CA[i]) * 2u;
            if constexpr (GATHER) nvoffA[h][i] = voffA[h][i];
        }
    const char* cA = GATHER ? (const char*)g.A : (const char*)g.A + (size_t)cur.pm * tstep;
    const char* cB = (const char*)g.Bt + (size_t)cur.e * g.bstride + (size_t)cur.pn * tstep;
    PG8_STAGEB(PG8_SB(0, 0), cB); PG8_STAGE2(PG8_SA(0, 0), cA, voffA[0][0], voffA[0][1]); PG8_STAGEB(PG8_SB(0, 1), cB + hstep); PG8_STAGE2(PG8_SA(0, 1), cA, voffA[1][0], voffA[1][1]);
    if (wr == 1) PG8_BAR;
    PG8_WAIT_V(4); PG8_BAR;
    PG8_STAGEB(PG8_SB(1, 0), cB + kstep); PG8_STAGE2(PG8_SA(1, 0), cA + kstep, voffA[0][0], voffA[0][1]); PG8_STAGEB(PG8_SB(1, 1), cB + hstep + kstep);
    PG8_WAIT_V(6); PG8_BAR;
    for (;;) {
        const bool has_next = S.next(ui + 1, nxt);
        const char* nA = has_next ? (GATHER ? (const char*)g.A : (const char*)g.A + (size_t)nxt.pm * tstep) : cA;
        const char* nB = has_next ? (const char*)g.Bt + (size_t)nxt.e * g.bstride + (size_t)nxt.pn * tstep : cB;
        if constexpr (GATHER) {
            if (has_next) {
#pragma unroll
                for (int h = 0; h < 2; ++h)
#pragma unroll
                    for (int i = 0; i < 2; ++i) nvoffA[h][i] = ((unsigned)g.rowmap[nxt.pm * BM + h * HALF + RA[i]] * (unsigned)K + (unsigned)CA[i]) * 2u;
            }
        }
        for (int t = 0; t < nt; t += 2) {
            const bool last = (t == nt - 2);
            if constexpr (Hook::ACTIVE) { if (t == nt / 2) Hk.mid(acc, cur); }
            const char* a1 = cA + (size_t)(t + 1) * kstep;
            const char* a2 = last ? nA : cA + (size_t)(t + 2) * kstep; const char* b2 = last ? nB : cB + (size_t)(t + 2) * kstep;
            const char* a3 = a2 + kstep; const char* b3 = b2 + kstep;
            unsigned w00 = voffA[0][0], w01 = voffA[0][1], w10 = voffA[1][0], w11 = voffA[1][1];
            if constexpr (GATHER) { if (last) { w00 = nvoffA[0][0]; w01 = nvoffA[0][1]; w10 = nvoffA[1][0]; w11 = nvoffA[1][1]; } }
            PG8_LDB(B0, 0, 0); PG8_SCHED; PG8_LDA(At, 0, 0); PG8_STAGE2(PG8_SA(1, 1), a1, voffA[1][0], voffA[1][1]);
            PG8_WAIT_L(8); PG8_BAR; PG8_WAIT_L(0); PG8_MMA(0, 0, At, B0); PG8_BAR; PG8_SCHED;
            PG8_LDB(B1, 0, 1); PG8_STAGEB(PG8_SB(0, 0), b2);
            PG8_BAR; PG8_WAIT_L(0); PG8_MMA(0, 1, At, B1); PG8_BAR;
            PG8_LDA(At, 0, 1); PG8_STAGE2(PG8_SA(0, 0), a2, w00, w01);
            PG8_BAR; PG8_WAIT_L(0); PG8_MMA(1, 0, At, B0); PG8_BAR; PG8_SCHED;
            PG8_STAGEB(PG8_SB(0, 1), b2 + hstep);
            PG8_WAIT_V(6); PG8_BAR; PG8_MMA(1, 1, At, B1); PG8_BAR;
            PG8_LDB(B0, 1, 0); PG8_SCHED; PG8_LDA(At, 1, 0); PG8_STAGE2(PG8_SA(0, 1), a2, w10, w11);
            PG8_WAIT_L(8); PG8_BAR; PG8_WAIT_L(0); PG8_MMA(0, 0, At, B0); PG8_BAR; PG8_SCHED;
            PG8_LDB(B1, 1, 1); PG8_STAGEB(PG8_SB(1, 0), b3);
            PG8_BAR; PG8_WAIT_L(0); PG8_MMA(0, 1, At, B1); PG8_BAR;
            PG8_LDA(At, 1, 1); PG8_STAGE2(PG8_SA(1, 0), a3, w00, w01);
            PG8_BAR; PG8_WAIT_L(0); PG8_MMA(1, 0, At, B0); PG8_BAR; PG8_SCHED;
            PG8_STAGEB(PG8_SB(1, 1), b3 + hstep);
            PG8_WAIT_V(6); PG8_BAR; PG8_MMA(1, 1, At, B1); PG8_BAR;
        }
        if constexpr (FP8 == 2) asm volatile("s_nop 15\n\ts_nop 15" ::: "memory");
        E(acc, cur, wr, wc, fr, fq);
        if (!has_next) break;
#pragma unroll
        for (int a = 0; a < 2; ++a)
#pragma unroll
            for (int b = 0; b < 2; ++b)
#pragma unroll
                for (int m = 0; m < 4; ++m)
#pragma unroll
                    for (int n = 0; n < 2; ++n) acc[a][b][m][n] = (f32x4){0.f, 0.f, 0.f, 0.f};
        cur = nxt; cA = nA; cB = nB; ++ui;
        if constexpr (GATHER) {
#pragma unroll
            for (int h = 0; h < 2; ++h)
#pragma unroll
                for (int i = 0; i < 2; ++i) voffA[h][i] = nvoffA[h][i];
        }
    }
    PG8_WAIT_V(0);
    if (wr == 0) PG8_BAR;
    PG8_BAR;
#undef PG8_SA
#undef PG8_SB
#undef PG8_STAGE2
#undef PG8_STAGEB
#undef PG8_LDA
#undef PG8_LDB
#undef PG8_MMA
#undef PG8_WAIT_V
#undef PG8_WAIT_L
#undef PG8_BAR
#undef PG8_SCHED
}
}
using pg8::Unit;

typedef f32x4 AccT[2][2][4][2];
struct EpiProj {
    static constexpr bool PERM = true;
    unsigned char* pj; const float* rs;
    __device__ __forceinline__ void operator()(const AccT& acc, const Unit& u, int wr, int wc, int fr, int fq) const {
        const int pn = u.pn; const bool sig = pn >= 8;
        bf16_t* base; int ld, nbj = 2;
        if (pn < 2)       { base = (bf16_t*)(pj + PJ_U) + pn * 256; ld = 512; }
        else if (pn < 4)  { base = (bf16_t*)(pj + PJ_Q) + (pn - 2) * 256; ld = 512; }
        else if (pn == 4) {
            unsigned char* kv8 = pj + PJ_KV; const int row0 = u.pm * 256 + wr * 64 + fr, cb = wc * 32 + 8 * fq;
            float sv[8];
#pragma unroll
            for (int g = 0; g < 8; ++g) sv[g] = rs[row0 + (g >> 2) * 128 + (g & 3) * 16];
#pragma unroll
            for (int ai = 0; ai < 2; ++ai)
#pragma unroll
                for (int m = 0; m < 4; ++m) { const int row = row0 + ai * 128 + m * 16; const float s = sv[ai * 4 + m];
#pragma unroll
                    for (int bj = 0; bj < 2; ++bj) { const f32x4 v0 = acc[ai][bj][m][0] * s, v1 = acc[ai][bj][m][1] * s;
                        u32x2 w; w.x = pk4_fp8(v0[0], v0[1], v0[2], v0[3]); w.y = pk4_fp8(v1[0], v1[1], v1[2], v1[3]);
                        *(u32x2*)(kv8 + (size_t)row * 256 + bj * 128 + cb) = w; } }
            return; }
        else if (pn < 7)  { base = (bf16_t*)(pj + PJ_QI) + (pn - 5) * 256; ld = 512; }
        else if (pn == 7) { base = (bf16_t*)(pj + PJ_KW); ld = 128; nbj = 1; }
        else              { base = (bf16_t*)(pj + PJ_G) + (pn - 8) * 256; ld = 2048; }
        const int row0 = u.pm * 256 + wr * 64 + fr, col0 = wc * 32 + 8 * fq;
        float sv[8];
#pragma unroll
        for (int g = 0; g < 8; ++g) sv[g] = rs[row0 + (g >> 2) * 128 + (g & 3) * 16];
#pragma unroll
        for (int ai = 0; ai < 2; ++ai)
#pragma unroll
            for (int m = 0; m < 4; ++m) { const int row = row0 + ai * 128 + m * 16; const float s = sv[ai * 4 + m]; bf16_t* rowp = base + (size_t)row * ld + col0;
#pragma unroll
                for (int bj = 0; bj < 2; ++bj) { if (bj < nbj) { f32x4 v0 = acc[ai][bj][m][0] * s, v1 = acc[ai][bj][m][1] * s;
                    if (sig) {
#pragma unroll
                        for (int j = 0; j < 4; ++j) { v0[j] = sigmoidf_(v0[j]); v1[j] = sigmoidf_(v1[j]); } }
                    u32x4 w; w.x = pk2(v0[0], v0[1]); w.y = pk2(v0[2], v0[3]); w.z = pk2(v1[0], v1[1]); w.w = pk2(v1[2], v1[3]);
                    *(u32x4*)(rowp + bj * 128) = w; } } }
    }
};
__device__ __forceinline__ float ga_clamp(float g) { return fmaxf(g, 8.67361738e-19f); }
struct HookGateRatio {
    static constexpr bool ACTIVE = true;
    const bf16_t* gates;
    __device__ __forceinline__ void mid(AccT& acc, const Unit& u) const {
        int tz = threadIdx.x; asm volatile("" : "+v"(tz));
        const int wid = tz >> 6, ln = tz & 63, wr = wid >> 2, wc = wid & 3, fr = ln & 15, fq = ln >> 4;
        const int row0 = u.pm * 256 + wr * 64 + fr, col0 = u.pn * 256 + wc * 32 + 8 * fq;
        u32x4 gpv[2][2], gav[2][2];
#pragma unroll
        for (int bj = 0; bj < 2; ++bj) { gpv[0][bj] = *(const u32x4*)(gates + (size_t)row0 * 2048 + col0 + bj * 128); gav[0][bj] = *(const u32x4*)(gates + (size_t)row0 * 2048 + 1024 + col0 + bj * 128); }
#pragma unroll
        for (int ai = 0; ai < 2; ++ai)
#pragma unroll
            for (int m = 0; m < 4; ++m) { const int g1 = ai * 4 + m + 1;
                if (g1 < 8) { const int rown = row0 + (g1 >> 2) * 128 + (g1 & 3) * 16;
#pragma unroll
                    for (int bj = 0; bj < 2; ++bj) { gpv[g1 & 1][bj] = *(const u32x4*)(gates + (size_t)rown * 2048 + col0 + bj * 128); gav[g1 & 1][bj] = *(const u32x4*)(gates + (size_t)rown * 2048 + 1024 + col0 + bj * 128); } }
#pragma unroll
                for (int bj = 0; bj < 2; ++bj) {
                    const u32x4 gp = gpv[m & 1][bj], ga = gav[m & 1][bj];
                    acc[ai][bj][m][0][0] *= bf_lo(gp.x) * __builtin_amdgcn_rcpf(ga_clamp(bf_lo(ga.x))); acc[ai][bj][m][0][1] *= bf_hi(gp.x) * __builtin_amdgcn_rcpf(ga_clamp(bf_hi(ga.x)));
                    acc[ai][bj][m][0][2] *= bf_lo(gp.y) * __builtin_amdgcn_rcpf(ga_clamp(bf_lo(ga.y))); acc[ai][bj][m][0][3] *= bf_hi(gp.y) * __builtin_amdgcn_rcpf(ga_clamp(bf_hi(ga.y)));
                    acc[ai][bj][m][1][0] *= bf_lo(gp.z) * __builtin_amdgcn_rcpf(ga_clamp(bf_lo(ga.z))); acc[ai][bj][m][1][1] *= bf_hi(gp.z) * __builtin_amdgcn_rcpf(ga_clamp(bf_hi(ga.z)));
                    acc[ai][bj][m][1][2] *= bf_lo(gp.w) * __builtin_amdgcn_rcpf(ga_clamp(bf_lo(ga.w))); acc[ai][bj][m][1][3] *= bf_hi(gp.w) * __builtin_amdgcn_rcpf(ga_clamp(bf_hi(ga.w)));
                    }
                asm volatile("" ::: "memory"); }
    }
};
template <bool ADD, bool CLAMP = false> struct EpiGate {
    static constexpr bool PERM = true;
    bf16_t* O; const bf16_t* gate; const bf16_t* addsrc;
    __device__ __forceinline__ void operator()(const AccT& acc, const Unit& u, int wr, int wc, int fr, int fq) const {
        const int row0 = u.pm * 256 + wr * 64 + fr, col0 = u.pn * 256 + wc * 32 + 8 * fq;
        u32x4 gb[4][2];
#pragma unroll
        for (int g = 0; g < 4; ++g)
#pragma unroll
            for (int bj = 0; bj < 2; ++bj) gb[g][bj] = *(const u32x4*)(gate + (size_t)(row0 + g * 16) * 2048 + col0 + bj * 128);
#pragma unroll
        for (int ai = 0; ai < 2; ++ai)
#pragma unroll
            for (int m = 0; m < 4; ++m) { const int row = row0 + ai * 128 + m * 16;
#pragma unroll
                for (int bj = 0; bj < 2; ++bj) { const int col = col0 + bj * 128;
                    const u32x4 gw = gb[m][bj];
                    if (ai == 0) gb[m][bj] = *(const u32x4*)(gate + (size_t)(row + 128) * 2048 + col);
                    f32x4 v0 = acc[ai][bj][m][0], v1 = acc[ai][bj][m][1];
                    if (CLAMP) {
                        v0[0] *= ga_clamp(bf_lo(gw.x)); v0[1] *= ga_clamp(bf_hi(gw.x)); v0[2] *= ga_clamp(bf_lo(gw.y)); v0[3] *= ga_clamp(bf_hi(gw.y));
                        v1[0] *= ga_clamp(bf_lo(gw.z)); v1[1] *= ga_clamp(bf_hi(gw.z)); v1[2] *= ga_clamp(bf_lo(gw.w)); v1[3] *= ga_clamp(bf_hi(gw.w));
                    } else {
                    v0[0] *= bf_lo(gw.x); v0[1] *= bf_hi(gw.x); v0[2] *= bf_lo(gw.y); v0[3] *= bf_hi(gw.y);
                    v1[0] *= bf_lo(gw.z); v1[1] *= bf_hi(gw.z); v1[2] *= bf_lo(gw.w); v1[3] *= bf_hi(gw.w); }
                    if (ADD) { const u32x4 aw = *(const u32x4*)(addsrc + (size_t)row * D + col);
                        v0[0] += bf_lo(aw.x); v0[1] += bf_hi(aw.x); v0[2] += bf_lo(aw.y); v0[3] += bf_hi(aw.y);
                        v1[0] += bf_lo(aw.z); v1[1] += bf_hi(aw.z); v1[2] += bf_lo(aw.w); v1[3] += bf_hi(aw.w); }
                    u32x4 w; w.x = pk2(v0[0], v0[1]); w.y = pk2(v0[2], v0[3]); w.z = pk2(v1[0], v1[1]); w.w = pk2(v1[2], v1[3]);
                    *(u32x4*)(O + (size_t)row * D + col) = w; } }
    }
};
struct EpiX1 {
    static constexpr bool PERM = false;
    const float* x; bf16_t* xb; float* ss; unsigned char* x8;
    __device__ __forceinline__ void operator()(const AccT& acc, const Unit& u, int wr, int wc, int fr, int fq) const {
        const int row0 = u.pm * 256 + wr * 64 + fr, col0 = u.pn * 256 + wc * 32 + 4 * fq;
        f32x4 xv[2][4];
#pragma unroll
        for (int g = 0; g < 2; ++g)
#pragma unroll
            for (int q = 0; q < 4; ++q) xv[g][q] = *(const f32x4*)(x + (size_t)(row0 + g * 16) * D + col0 + (q >> 1) * 128 + (q & 1) * 16);
#pragma unroll
        for (int ai = 0; ai < 2; ++ai)
#pragma unroll
            for (int m = 0; m < 4; ++m) { const int row = row0 + ai * 128 + m * 16; float s = 0.f;
                const int g2 = ai * 4 + m + 2, rown = row0 + (g2 >> 2) * 128 + (g2 & 3) * 16;
#pragma unroll
                for (int bj = 0; bj < 2; ++bj)
#pragma unroll
                    for (int n = 0; n < 2; ++n) { const size_t o = (size_t)row * D + col0 + bj * 128 + n * 16;
                        const f32x4 xin = xv[m & 1][bj * 2 + n];
                        if (g2 < 8) xv[m & 1][bj * 2 + n] = *(const f32x4*)(x + (size_t)rown * D + col0 + bj * 128 + n * 16);
                        const f32x4 v = xin + acc[ai][bj][m][n];
                        u32x2 w; w.x = pk2(v[0], v[1]); w.y = pk2(v[2], v[3]); *(u32x2*)(xb + o) = w;
                        *(unsigned*)(x8 + o) = pk4_fp8(v[0], v[1], v[2], v[3]);
                        s += (v[0] * v[0] + v[1] * v[1]) + (v[2] * v[2] + v[3] * v[3]); }
                s += __shfl_xor(s, 16); s += __shfl_xor(s, 32);
                if (fq == 0) atomicAdd(ss + row, s); }
    }
};
struct EpiMoe1 {
    static constexpr bool PERM = true;
    unsigned char* act; const float* rowscale; const float* b1;
    __device__ __forceinline__ void operator()(const AccT& acc, const Unit& u, int wr, int wc, int fr, int fq) const {
        const int row0 = u.pm * 256 + wr * 64 + fr, colj = u.pn * 128 + wc * 32 + 8 * fq;
        const float* bg = b1 + (size_t)u.e * 2048 + colj; const float* bu = bg + 1024;
        const f32x4 bg0 = *(const f32x4*)bg, bg1 = *(const f32x4*)(bg + 4), bu0 = *(const f32x4*)bu, bu1 = *(const f32x4*)(bu + 4);
        float sv[8];
#pragma unroll
        for (int g = 0; g < 8; ++g) sv[g] = rowscale[row0 + (g >> 2) * 128 + (g & 3) * 16] * (1.0f / 64.0f);
#pragma unroll
        for (int ai = 0; ai < 2; ++ai)
#pragma unroll
            for (int m = 0; m < 4; ++m) { const int row = row0 + ai * 128 + m * 16;
                const float rs = sv[ai * 4 + m];
                float r[8];
#pragma unroll
                for (int n = 0; n < 2; ++n)
#pragma unroll
                    for (int j = 0; j < 4; ++j) { float gl = acc[ai][0][m][n][j] * rs + (n ? bg1[j] : bg0[j]); float up = acc[ai][1][m][n][j] * rs + (n ? bu1[j] : bu0[j]);
                        gl = fminf(gl, 7.0f); up = fminf(fmaxf(up, -7.0f), 7.0f);
                        r[n * 4 + j] = 8.0f * ((up + 1.0f) * (gl * sigmoidf_(1.702f * gl))); }
                u32x2 w; w.x = pk4_fp8(r[0], r[1], r[2], r[3]); w.y = pk4_fp8(r[4], r[5], r[6], r[7]);
                *(u32x2*)(act + (size_t)row * DFF + colj) = w; }
    }
};
struct EpiMoe2 {
    static constexpr bool PERM = true;
    unsigned char* Y; const float* rowgate; const float* b2;
    __device__ __forceinline__ void operator()(const AccT& acc, const Unit& u, int wr, int wc, int fr, int fq) const {
        const int row0 = u.pm * 256 + wr * 64 + fr, col0 = u.pn * 256 + wc * 32 + 8 * fq;
        f32x4 cb[2][2]; float sv[8];
#pragma unroll
        for (int bj = 0; bj < 2; ++bj) { const float* bb = b2 + (size_t)u.e * D + col0 + bj * 128; cb[bj][0] = *(const f32x4*)bb; cb[bj][1] = *(const f32x4*)(bb + 4); }
#pragma unroll
        for (int g = 0; g < 8; ++g) sv[g] = rowgate[row0 + (g >> 2) * 128 + (g & 3) * 16];
#pragma unroll
        for (int ai = 0; ai < 2; ++ai)
#pragma unroll
            for (int m = 0; m < 4; ++m) { const int row = row0 + ai * 128 + m * 16; const float gt = sv[ai * 4 + m];
#pragma unroll
                for (int bj = 0; bj < 2; ++bj) { const int col = col0 + bj * 128;
                    const f32x4 c0 = cb[bj][0], c1 = cb[bj][1];
                    const f32x4 v0 = (acc[ai][bj][m][0] * (1.0f / 512.0f) + c0) * gt, v1 = (acc[ai][bj][m][1] * (1.0f / 512.0f) + c1) * gt;
                    u32x2 w; w.x = pk4_fp8(v0[0], v0[1], v0[2], v0[3]); w.y = pk4_fp8(v1[0], v1[1], v1[2], v1[3]);
                    *(u32x2*)(Y + (size_t)row * D + col) = w; } }
    }
};
struct EpiPP {
    static constexpr bool PERM = true;
    bf16_t* PP;
    __device__ __forceinline__ void operator()(const AccT& acc, const Unit& u, int wr, int wc, int fr, int fq) const {
        const int row0 = u.pm * 256 + wr * 64 + fr, col0 = u.pn * 256 + wc * 32 + 8 * fq;
#pragma unroll
        for (int ai = 0; ai < 2; ++ai)
#pragma unroll
            for (int m = 0; m < 4; ++m) { const int row = row0 + ai * 128 + m * 16;
#pragma unroll
                for (int bj = 0; bj < 2; ++bj) { const f32x4 v0 = acc[ai][bj][m][0], v1 = acc[ai][bj][m][1];
                    u32x4 w; w.x = pk2(v0[0], v0[1]); w.y = pk2(v0[2], v0[3]); w.z = pk2(v1[0], v1[1]); w.w = pk2(v1[2], v1[3]);
                    *(u32x4*)(PP + (size_t)row * D + col0 + bj * 128) = w; } }
    }
};
struct EpiPleGX {
    static constexpr bool PERM = true;
    bf16_t* x3b; const bf16_t* x2b; const bf16_t* PP; const float* rs; float* ss;
    __device__ __forceinline__ void operator()(const AccT& acc, const Unit& u, int wr, int wc, int fr, int fq) const {
        const int row0 = u.pm * 256 + wr * 64 + fr, col0 = u.pn * 256 + wc * 32 + 8 * fq;
        float sv[8]; u32x4 pb[2][2], xq[2][2];
#pragma unroll
        for (int g = 0; g < 8; ++g) sv[g] = rs[row0 + (g >> 2) * 128 + (g & 3) * 16];
#pragma unroll
        for (int g = 0; g < 2; ++g)
#pragma unroll
            for (int bj = 0; bj < 2; ++bj) { const size_t o = (size_t)(row0 + g * 16) * D + col0 + bj * 128; pb[g][bj] = *(const u32x4*)(PP + o); xq[g][bj] = *(const u32x4*)(x2b + o); }
#pragma unroll
        for (int ai = 0; ai < 2; ++ai)
#pragma unroll
            for (int m = 0; m < 4; ++m) { const int row = row0 + ai * 128 + m * 16; const float rsv = sv[ai * 4 + m]; float s = 0.f;
                const int g2 = ai * 4 + m + 2, rown = row0 + (g2 >> 2) * 128 + (g2 & 3) * 16;
#pragma unroll
                for (int bj = 0; bj < 2; ++bj) { const size_t o = (size_t)row * D + col0 + bj * 128;
                    const u32x4 pw = pb[m & 1][bj], xw = xq[m & 1][bj];
                    if (g2 < 8) { const size_t on = (size_t)rown * D + col0 + bj * 128; pb[m & 1][bj] = *(const u32x4*)(PP + on); xq[m & 1][bj] = *(const u32x4*)(x2b + on); }
                    const f32x4 a0 = acc[ai][bj][m][0] * rsv, a1 = acc[ai][bj][m][1] * rsv;
                    f32x4 x0, x1;
                    x0[0] = bf_lo(xw.x) + sigmoidf_(a0[0]) * bf_lo(pw.x); x0[1] = bf_hi(xw.x) + sigmoidf_(a0[1]) * bf_hi(pw.x);
                    x0[2] = bf_lo(xw.y) + sigmoidf_(a0[2]) * bf_lo(pw.y); x0[3] = bf_hi(xw.y) + sigmoidf_(a0[3]) * bf_hi(pw.y);
                    x1[0] = bf_lo(xw.z) + sigmoidf_(a1[0]) * bf_lo(pw.z); x1[1] = bf_hi(xw.z) + sigmoidf_(a1[1]) * bf_hi(pw.z);
                    x1[2] = bf_lo(xw.w) + sigmoidf_(a1[2]) * bf_lo(pw.w); x1[3] = bf_hi(xw.w) + sigmoidf_(a1[3]) * bf_hi(pw.w);
                    { u32x4 w; w.x = pk2(x0[0], x0[1]); w.y = pk2(x0[2], x0[3]); w.z = pk2(x1[0], x1[1]); w.w = pk2(x1[2], x1[3]); *(u32x4*)(x3b + o) = w; }
                    s += (x0[0] * x0[0] + x0[1] * x0[1]) + (x0[2] * x0[2] + x0[3] * x0[3]) + (x1[0] * x1[0] + x1[1] * x1[1]) + (x1[2] * x1[2] + x1[3] * x1[3]); }
                s += __shfl_xor(s, 16); s += __shfl_xor(s, 32);
                if (fq == 0) atomicAdd(ss + row, s); }
    }
};

struct Args { const float* in[20]; float* out; unsigned char* ws; int ph_lo, ph_hi; };
enum { I_X = 0, I_P, I_N1G, I_WIN, I_POOLW, I_POOLS, I_WBP, I_WBA, I_WOUT, I_N2G, I_RW, I_RB, I_W1, I_B1, I_W2, I_B2, I_PNG, I_PGW, I_PPW, I_FG };
enum { PH_PRO = 0, PH_INPROJ, PH_MIXED, PH_POOL, PH_ATT, PH_Z, PH_X1, PH_ROUTER, PH_SCATTER, PH_MOE1, PH_MOE2, PH_COMBINE, PH_PLE, PH_FINAL, NPH };

__device__ __forceinline__ int tr_dst_row(int mode, int n) {
    if (mode == 1) { if (n >= 1152 && n < 1280) { const int d = (n - 1152) & 63; return 1152 + ((n - 1152) & 64) + 16 * (d & 3) + (d >> 2); }
                     return n < 1864 ? n : n + 184; }
    if (mode == 2) return n < 1024 ? (((n >> 7) << 8) + (n & 127)) : ((((n - 1024) >> 7) << 8) + 128 + ((n - 1024) & 127));
    return n;
}
__device__ __forceinline__ float tr_col_scale(int mode, int n) {
    if (mode == 1) { if ((n >= 512 && n < 1024) || (n >= 1280 && n < 1792)) return 0.125f; if (n >= 1856 && n < 1864) return 0.35355339059327373f; }
    return 1.0f;
}
__device__ __forceinline__ void transpose_item(const float* W, int ldw, int Nvalid, int K, bf16_t* WT, const float* kgain, int mode, LAS float* scr, int kb, int nb, int lane, int ldt = 0, float f8scale = 0.f) {
    if (ldt == 0) ldt = K;
    const int k0 = 64 * kb, n0 = 64 * nb, c4 = lane & 15, kr = lane >> 4, nl = n0 + 4 * c4; const bool nok = nl < Nvalid;
    const f32x4 cs = (f32x4){tr_col_scale(mode, nl), tr_col_scale(mode, nl + 1), tr_col_scale(mode, nl + 2), tr_col_scale(mode, nl + 3)};
    f32x4 v[16];
#pragma unroll
    for (int i = 0; i < 16; ++i) { const int kk = 4 * i + kr; v[i] = nok ? *(const f32x4*)(W + (size_t)(k0 + kk) * ldw + nl) : (f32x4){0.f, 0.f, 0.f, 0.f}; }
    float kgv[16];
#pragma unroll
    for (int i = 0; i < 16; ++i) kgv[i] = kgain ? kgain[k0 + 4 * i + kr] : 1.0f;
#pragma unroll
    for (int i = 0; i < 16; ++i) asm volatile("" : "+v"(kgv[i]));
#pragma unroll
    for (int i = 0; i < 16; ++i) { const int kk = 4 * i + kr; *(LAS f32x4*)(scr + kk * 68 + 4 * c4) = v[i] * cs * kgv[i]; }
    LDS_WAIT(); asm volatile("" ::: "memory");
    const int c = lane & 7;
#pragma unroll
    for (int j = 0; j < 8; ++j) { const int n = (lane >> 3) + 8 * j; const LAS float* s = scr + (8 * c) * 68 + n;
        if (f8scale != 0.f) {
            u32x2 o8; o8.x = pk4_fp8(s[0 * 68] * f8scale, s[1 * 68] * f8scale, s[2 * 68] * f8scale, s[3 * 68] * f8scale); o8.y = pk4_fp8(s[4 * 68] * f8scale, s[5 * 68] * f8scale, s[6 * 68] * f8scale, s[7 * 68] * f8scale);
            if (n0 + n < Nvalid) *(u32x2*)((unsigned char*)WT + (size_t)tr_dst_row(mode, n0 + n) * ldt + k0 + 8 * c) = o8;
        } else {
        u32x4 o; o.x = pk2(s[0 * 68], s[1 * 68]); o.y = pk2(s[2 * 68], s[3 * 68]); o.z = pk2(s[4 * 68], s[5 * 68]); o.w = pk2(s[6 * 68], s[7 * 68]);
        if (n0 + n < Nvalid) *(u32x4*)(WT + (size_t)tr_dst_row(mode, n0 + n) * ldt + k0 + 8 * c) = o; } }
    LDS_WAIT(); asm volatile("" ::: "memory");
}
constexpr int I_E1 = 32 * 16 * 32, I_E2 = 32 * 16 * 16, N_EXPERT_ITEMS = I_E1 + I_E2;
constexpr int I_BA = 8 * 16, I_OUT = 16 * 16, I_R = 16, I_PG = 16 * 16, I_PP = 4 * 16, N_SMALL_ITEMS = I_BA + I_OUT + I_R + I_PG + I_PP;
constexpr int DC_EXPERT = N_EXPERT_ITEMS / 8, DC_SMALL = N_SMALL_ITEMS / 8, DC_WPC = 2048 / 8, DC_PB = M * PLE / 8 / 4096, DC_TOTAL = DC_EXPERT + DC_SMALL + DC_WPC + DC_PB;
__device__ __forceinline__ void deferred_chunk(const Args& a, LAS unsigned char* lds, int c, int wave, int lane) {
    unsigned char* ws = a.ws; LAS float* scr = (LAS float*)(lds + wave * 17408);
    if (c < DC_EXPERT) { int r = c * 8 + wave;
        if (r < I_E1) { const int e = r / (16 * 32), q = r % (16 * 32);
            transpose_item(a.in[I_W1] + (size_t)e * D * 2048, 2048, 2048, D, (bf16_t*)(ws + WS_W1 + (size_t)e * 2048 * D), a.in[I_N2G], 2, scr, q / 32, q % 32, lane, D, 64.0f); return; }
        r -= I_E1; { const int e = r / (16 * 16), q = r % (16 * 16);
            transpose_item(a.in[I_W2] + (size_t)e * DFF * D, D, D, DFF, (bf16_t*)(ws + WS_W2 + (size_t)e * D * DFF), nullptr, 0, scr, q / 16, q % 16, lane, DFF, 64.0f); }
        return; }
    c -= DC_EXPERT;
    if (c < DC_SMALL) { int r = c * 8 + wave;
        if (r < I_BA) { transpose_item(a.in[I_WBA], D, D, 512, (bf16_t*)(ws + WS_WPC) + 512, nullptr, 0, scr, r / 16, r % 16, lane, 1024); return; } r -= I_BA;
        if (r < I_OUT) { transpose_item(a.in[I_WOUT], D, D, D, (bf16_t*)(ws + WS_WOUT), nullptr, 0, scr, r / 16, r % 16, lane); return; } r -= I_OUT;
        if (r < I_R) { transpose_item(a.in[I_RW], NE, NE, D, (bf16_t*)(ws + WS_WR), a.in[I_N2G], 0, scr, r, 0, lane); return; } r -= I_R;
        if (r < I_PG) { transpose_item(a.in[I_PGW], D, D, D, (bf16_t*)(ws + WS_WPG), a.in[I_PNG], 0, scr, r / 16, r % 16, lane); return; } r -= I_PG;
        transpose_item(a.in[I_PPW], D, D, PLE, (bf16_t*)(ws + WS_WPP), nullptr, 0, scr, r / 16, r % 16, lane); return; }
    c -= DC_SMALL;
    if (c < DC_WPC) {
        const float* pw = a.in[I_POOLW]; const float* ps = a.in[I_POOLS]; const float* wbp = a.in[I_WBP]; bf16_t* wpc = (bf16_t*)(ws + WS_WPC);
        const int it = c * 8 + wave, gc = it >> 2, n0 = (it & 3) * 256 + lane * 4, g = gc >> 7;
        f32x4 acc = (f32x4){0.f, 0.f, 0.f, 0.f};
        const float* pwr = pw + (size_t)gc * 128; const float* psr = ps + g * 128; const float* wr_ = wbp + (size_t)(g * 128) * D + n0;
#pragma unroll 8
        for (int d = 0; d < 128; ++d) { const float av = pwr[d] * psr[d]; const f32x4 wv = *(const f32x4*)(wr_ + (size_t)d * D); acc += wv * av; }
#pragma unroll
        for (int j = 0; j < 4; ++j) wpc[(size_t)(n0 + j) * 1024 + gc] = (bf16_t)f2bf(acc[j]);
        return; }
    c -= DC_WPC;
    {
        const f32x4* p = (const f32x4*)a.in[I_P]; u32x4* pb = (u32x4*)(ws + WS_PB);
        f32x4 pv[8][2];
#pragma unroll
        for (int k = 0; k < 8; ++k) { const int i = c * 4096 + k * 512 + (int)threadIdx.x; pv[k][0] = p[2 * i]; pv[k][1] = p[2 * i + 1]; }
#pragma unroll
        for (int k = 0; k < 8; ++k) { const int i = c * 4096 + k * 512 + (int)threadIdx.x; const f32x4 v0 = pv[k][0], v1 = pv[k][1];
            u32x4 w; w.x = pk2(v0[0], v0[1]); w.y = pk2(v0[2], v0[3]); w.z = pk2(v1[0], v1[1]); w.w = pk2(v1[2], v1[3]); pb[i] = w; } }
}
__device__ __forceinline__ void p0_prologue(const Args& a, LAS unsigned char* lds, int wave, int lane, int G) {
    unsigned char* ws = a.ws;
    LAS float* scr = (LAS float*)(lds + wave * 17408);
    const int gw = blockIdx.x * NWAVES + wave, NGW = G * NWAVES;
    for (int it = gw; it < 16 * 62; it += NGW) transpose_item(a.in[I_WIN], IN_COLS, IN_COLS, D, (bf16_t*)(ws + WS_WIN), a.in[I_N1G], 1, scr, it / 62, it % 62, lane);
    for (int c = DC_EXPERT + (int)blockIdx.x; c < DC_TOTAL; c += G) { deferred_chunk(a, lds, c, wave, lane); __syncthreads(); }
    { const int gt = blockIdx.x * NTHREADS + threadIdx.x, NT = G * NTHREADS; u32x4* z = (u32x4*)((bf16_t*)(ws + WS_WIN) + (size_t)1864 * D);
      for (int i = gt; i < 184 * D * 2 / 16; i += NT) z[i] = (u32x4){0u, 0u, 0u, 0u}; }
    { const float* x = a.in[I_X]; bf16_t* xb = (bf16_t*)(ws + WS_R2); float* rs1 = (float*)(ws + WS_RS1);
      for (int m0 = gw; m0 < M; m0 += 2 * NGW) { f32x4 v[2][4];
#pragma unroll
        for (int r = 0; r < 2; ++r) { const int m = m0 + r * NGW; if (m < M) { const f32x4* xr = (const f32x4*)(x + (size_t)m * D) + lane;
#pragma unroll
            for (int j = 0; j < 4; ++j) v[r][j] = xr[64 * j]; } }
#pragma unroll
        for (int r = 0; r < 2; ++r) { const int m = m0 + r * NGW; if (m < M) { float s = 0.f;
#pragma unroll
            for (int j = 0; j < 4; ++j) s += (v[r][j][0] * v[r][j][0] + v[r][j][1] * v[r][j][1]) + (v[r][j][2] * v[r][j][2] + v[r][j][3] * v[r][j][3]);
            s = wave_sum(s); if (lane == 0) rs1[m] = rsqrtf(s * (1.0f / D) + RMS_EPS);
            u32x2* o = (u32x2*)(xb + (size_t)m * D) + lane;
#pragma unroll
            for (int j = 0; j < 4; ++j) { u32x2 w; w.x = pk2(v[r][j][0], v[r][j][1]); w.y = pk2(v[r][j][2], v[r][j][3]); o[64 * j] = w; } } } } }
}

template <int W>
__device__ __forceinline__ void mixed_item(const bf16_t* ub, bf16_t* mixed, int tok, int c8) {
    const int t = tok & (SEQ - 1); const int nw = (t + 1) < W ? (t + 1) : W;
    u32x4 v[W];
#pragma unroll
    for (int i = 0; i < W; ++i) { const int ii = i < nw ? i : 0; v[i] = *(const u32x4*)(ub + (size_t)(tok - ii) * 512 + c8 * 8); }
    float s[8], cur[8];
#pragma unroll
    for (int j = 0; j < 8; ++j) { s[j] = 0.f; cur[j] = 0.f; }
#pragma unroll
    for (int i = 0; i < W; ++i) { const float mk = i < nw ? 1.0f : 0.0f;
        const float f[8] = {bf_lo(v[i].x), bf_hi(v[i].x), bf_lo(v[i].y), bf_hi(v[i].y), bf_lo(v[i].z), bf_hi(v[i].z), bf_lo(v[i].w), bf_hi(v[i].w)};
#pragma unroll
        for (int j = 0; j < 8; ++j) { s[j] = fmaf(f[j], mk, s[j]); if (i == 0) cur[j] = f[j]; } }
    const float inv = 1.0f / (float)nw;
    u32x4 o; o.x = pk2(s[0] * inv - cur[0], s[1] * inv - cur[1]); o.y = pk2(s[2] * inv - cur[2], s[3] * inv - cur[3]);
    o.z = pk2(s[4] * inv - cur[4], s[5] * inv - cur[5]); o.w = pk2(s[6] * inv - cur[6], s[7] * inv - cur[7]);
    *(u32x4*)(mixed + (size_t)tok * 1024 + c8 * 8) = o;
}
__device__ __forceinline__ void p2_mixed(const bf16_t* ub, bf16_t* mixed, int G) {
    const int ln = threadIdx.x & 63, gw = blockIdx.x * NWAVES + (int)(threadIdx.x >> 6), NGW = G * NWAVES;
    int k = 0;
    for (int P = gw; P < M; P += NGW, ++k) {
        const int g = __builtin_amdgcn_readfirstlane((P + k) & 3), tok = (P >> 2) * 4 + (ln >> 4), c8 = g * 16 + (ln & 15);
        if (g == 0) mixed_item<2>(ub, mixed, tok, c8); else if (g == 1) mixed_item<4>(ub, mixed, tok, c8); else if (g == 2) mixed_item<8>(ub, mixed, tok, c8); else mixed_item<16>(ub, mixed, tok, c8);
    }
}

__device__ __forceinline__ unsigned lds_atomic_inc(LAS unsigned* p) { return __hip_atomic_fetch_add(p, 1u, __ATOMIC_RELAXED, __HIP_MEMORY_SCOPE_WORKGROUP); }
__device__ __forceinline__ void prune_token(LAS unsigned* L, LAS unsigned* H, const LAS unsigned* cntin, LAS unsigned* cntp, LAS unsigned* thrp, int lane) {
    const int n = __builtin_amdgcn_readfirstlane((int)*cntin);
    unsigned prefix = 0u; unsigned want = 256u;
#pragma unroll
    for (int p = 0; p < 4; ++p) {
        const int shift = 24 - 8 * p;
        *(LAS u32x4*)(H + 4 * lane) = (u32x4){0u, 0u, 0u, 0u};
        for (int i = lane; i < n; i += 64) { const unsigned e = L[i];
            bool match = true; if (p > 0) match = ((e ^ prefix) >> ((shift + 8) & 31)) == 0u;
            if (match) (void)lds_atomic_inc(H + ((e >> shift) & 255u)); }
        const u32x4 c = *(LAS u32x4*)(H + 4 * lane);
        const unsigned T = c.x + c.y + c.z + c.w; unsigned suf = T;
#pragma unroll
        for (int off = 1; off < 64; off <<= 1) { const unsigned v = (unsigned)__shfl_down((int)suf, off); if (lane + off < 64) suf += v; }
        const unsigned sufex = suf - T;
        const bool found = (sufex < want) && (want <= suf);
        unsigned run = sufex; int d = 0; unsigned nw = 0u; bool got = false;
        if (!got && run + c.w >= want) { d = 4 * lane + 3; nw = want - run; got = true; } run += c.w;
        if (!got && run + c.z >= want) { d = 4 * lane + 2; nw = want - run; got = true; } run += c.z;
        if (!got && run + c.y >= want) { d = 4 * lane + 1; nw = want - run; got = true; } run += c.y;
        if (!got && run + c.x >= want) { d = 4 * lane + 0; nw = want - run; got = true; }
        const unsigned long long fm = __ballot(found);
        const int src = fm ? (__ffsll((long long)fm) - 1) : 0;
        d = __shfl(d, src); want = (unsigned)__shfl((int)nw, src);
        prefix |= (unsigned)d << shift;
    }
    int newn = 0;
    for (int base = 0; base < n; base += 64) { const int i = base + lane; const unsigned e = (i < n) ? L[i] : 0u; const bool keep = (i < n) && (e >= prefix);
        const unsigned long long mk = __ballot(keep);
        const int pos = newn + (int)__builtin_amdgcn_mbcnt_hi((unsigned)(mk >> 32), __builtin_amdgcn_mbcnt_lo((unsigned)mk, 0u));
        if (keep) L[pos] = e;
        newn += __popcll(mk); }
    if (lane == 0) { *cntp = (unsigned)newn; *thrp = prefix; }
}

template <int CTRL> __device__ __forceinline__ unsigned dpp0(unsigned v) { return (unsigned)__builtin_amdgcn_update_dpp(0, (int)v, CTRL, 0xf, 0xf, true); }
__device__ __forceinline__ unsigned wave_min_u32(unsigned v) {
    v = min(v, (unsigned)__builtin_amdgcn_update_dpp((int)v, (int)v, 0x128, 0xf, 0xf, false)); v = min(v, (unsigned)__builtin_amdgcn_update_dpp((int)v, (int)v, 0x124, 0xf, 0xf, false));
    v = min(v, (unsigned)__builtin_amdgcn_update_dpp((int)v, (int)v, 0x122, 0xf, 0xf, false)); v = min(v, (unsigned)__builtin_amdgcn_update_dpp((int)v, (int)v, 0x121, 0xf, 0xf, false));
    const unsigned a = __builtin_amdgcn_readlane((int)v, 0), b = __builtin_amdgcn_readlane((int)v, 16), c = __builtin_amdgcn_readlane((int)v, 32), d = __builtin_amdgcn_readlane((int)v, 48);
    return min(min(a, b), min(c, d));
}
__device__ __forceinline__ unsigned wave_max_u32(unsigned v) { return ~wave_min_u32(~v); }
__device__ __forceinline__ unsigned wave_prefix_incl(unsigned v, int lane) {
    v += dpp0<0x111>(v); v += dpp0<0x112>(v); v += dpp0<0x114>(v); v += dpp0<0x118>(v);
    const unsigned r0 = __builtin_amdgcn_readlane((int)v, 15), r1 = __builtin_amdgcn_readlane((int)v, 31), r2 = __builtin_amdgcn_readlane((int)v, 47);
    const int row = lane >> 4;
    return v + (row >= 1 ? r0 : 0u) + (row >= 2 ? r1 : 0u) + (row >= 3 ? r2 : 0u);
}
template <int FULLROWS>
__device__ __forceinline__ void prune_approx(LAS unsigned* L, LAS unsigned* H, const LAS unsigned* cntin, LAS unsigned* cntp, LAS unsigned* thrp, int lane) {
    const int n = __builtin_amdgcn_readfirstlane((int)*cntin);
    const unsigned tlo = (unsigned)__builtin_amdgcn_readfirstlane((int)*thrp);
    unsigned e[8]; unsigned mxv = 0u;
#pragma unroll
    for (int k = 0; k < 8; ++k) { unsigned v = L[lane + 64 * k]; if (k >= FULLROWS) v = (lane + 64 * k < n) ? v : 0u; e[k] = v; mxv = max(mxv, v); }
    mxv = wave_max_u32(mxv);
    unsigned mn = tlo;
    if (tlo == 0u) {
        unsigned m = 0xFFFFFFFFu;
#pragma unroll
        for (int k = 0; k < 8; ++k) m = (k >= FULLROWS && e[k] == 0u) ? m : min(m, e[k]);
        mn = wave_min_u32(m);
    }
    const unsigned range = mxv - mn;
    const int hb = 31 - __builtin_clz(range | 1u);
    const int shift = hb > 7 ? hb - 7 : 0;
    *(LAS u32x4*)(H + 4 * lane) = (u32x4){0u, 0u, 0u, 0u};
#pragma unroll
    for (int k = 0; k < 8; ++k) if (k < FULLROWS || e[k] != 0u) (void)lds_atomic_inc(H + ((e[k] - mn) >> shift));
    const u32x4 c = *(LAS u32x4*)(H + 4 * lane);
    const unsigned T = c.x + c.y + c.z + c.w;
    const unsigned pin = wave_prefix_incl(T, lane);
    const unsigned tot = (unsigned)__builtin_amdgcn_readlane((int)pin, 63);
    const unsigned sufex = tot - pin;
    const unsigned suf = sufex + T;
    const bool found = (sufex < 256u) && (256u <= suf);
    unsigned run = sufex; int d = 0; bool got = false;
    if (!got && run + c.w >= 256u) { d = 4 * lane + 3; got = true; } run += c.w;
    if (!got && run + c.z >= 256u) { d = 4 * lane + 2; got = true; } run += c.z;
    if (!got && run + c.y >= 256u) { d = 4 * lane + 1; got = true; } run += c.y;
    if (!got && run + c.x >= 256u) { d = 4 * lane + 0; got = true; }
    const unsigned long long fm = __ballot(found);
    const int src = fm ? (__ffsll((long long)fm) - 1) : 0;
    d = __builtin_amdgcn_readlane(d, src);
    unsigned thr = mn + ((unsigned)d << shift);
    thr = thr ? thr : 1u;
    int newn = 0;
#pragma unroll
    for (int k = 0; k < 8; ++k) { const bool keep = e[k] >= thr;
        const unsigned long long mk = __ballot(keep);
        const int pos = newn + (int)__builtin_amdgcn_mbcnt_hi((unsigned)(mk >> 32), __builtin_amdgcn_mbcnt_lo((unsigned)mk, 0u));
        if (keep) L[pos] = e[k];
        newn += __popcll(mk); }
    if (lane == 0) { *cntp = (unsigned)newn; *thrp = thr - 1u; }
}

__device__ __forceinline__ void prune_excess(LAS unsigned* L, LAS unsigned* cntp, int lane) {
    const int n = __builtin_amdgcn_readfirstlane((int)*cntp);
    unsigned e[5];
#pragma unroll
    for (int k = 0; k < 5; ++k) { const int i = lane + 64 * k; const unsigned v = L[i]; e[k] = (i < n) ? v : 0xFFFFFFFFu; }
    for (int r = n - 256; r > 0; --r) {
        unsigned m = min(min(e[0], e[1]), min(min(e[2], e[3]), e[4]));
        m = wave_min_u32(m);
#pragma unroll
        for (int k = 0; k < 5; ++k) e[k] = (e[k] == m) ? 0xFFFFFFFFu : e[k];
    }
    int newn = 0;
#pragma unroll
    for (int k = 0; k < 5; ++k) { const bool keep = e[k] != 0xFFFFFFFFu;
        const unsigned long long mk = __ballot(keep);
        const int pos = newn + (int)__builtin_amdgcn_mbcnt_hi((unsigned)(mk >> 32), __builtin_amdgcn_mbcnt_lo((unsigned)mk, 0u));
        if (keep) L[pos] = e[k];
        newn += __popcll(mk); }
    if (lane == 0) *cntp = (unsigned)newn;
}

template <bool DIAG>
__device__ __forceinline__ void score_tile(LAS unsigned char* lds, const LAS unsigned char* kbuf, const bf16x8 (&afr)[2][4], const float (&wq)[2][16], unsigned (&cn)[2][2], const unsigned (&th)[2][2],
                                           int kt, int t0, int wave, int hf, int l31, unsigned lmask, unsigned trash) {
    bf16x8 bfr[2][4];
#pragma unroll
    for (int kh = 0; kh < 2; ++kh) { const int keyrow = kh * 32 + l31;
#pragma unroll
        for (int ks = 0; ks < 4; ++ks) bfr[kh][ks] = *(const LAS bf16x8*)(kbuf + keyrow * 128 + (((ks * 2 + hf) ^ ((keyrow >> 1) & 7)) * 16)); }
    f32x16 accs[2][2];
#pragma unroll
    for (int kh = 0; kh < 2; ++kh)
#pragma unroll
        for (int rt = 0; rt < 2; ++rt) {
#pragma unroll
            for (int j = 0; j < 16; ++j) accs[kh][rt][j] = 0.f;
#pragma unroll
            for (int ks = 0; ks < 4; ++ks) accs[kh][rt] = __builtin_amdgcn_mfma_f32_32x32x16_bf16(afr[rt][ks], bfr[kh][ks], accs[kh][rt], 0, 0, 0);
        }
#pragma unroll
    for (int kh = 0; kh < 2; ++kh) {
        const int keypos = kt * 64 + kh * 32 + l31;
        const unsigned idxbits = (unsigned)(16383 - keypos);
#pragma unroll
        for (int rt = 0; rt < 2; ++rt) {
#pragma unroll
            for (int ts = 0; ts < 2; ++ts) {
                float s = 0.f;
#pragma unroll
                for (int hd = 0; hd < 8; ++hd) s = fmaf(__builtin_amdgcn_fmed3f(accs[kh][rt][8 * ts + hd], 0.f, 3.0e38f), wq[rt][8 * ts + hd], s);
                const unsigned ub = __builtin_bit_cast(unsigned, s);
                const unsigned srt = ub ^ ((unsigned)((int)ub >> 31) | 0x80000000u);
                const unsigned packed = (srt & 0xFFFFC000u) | idxbits;
                const int tl = 4 * rt + 2 * hf + ts;
                bool pass = packed > th[rt][ts];
                if (DIAG) pass = pass && (keypos <= t0 + wave * 8 + tl);
                const unsigned long long mk = __builtin_amdgcn_ballot_w64(pass);
                const unsigned mine = hf ? (unsigned)(mk >> 32) : (unsigned)mk;
                const unsigned pre = __popc(mine & lmask);
                const unsigned addr = pass ? (unsigned)((wave * 8 + tl) * 2048) + (cn[rt][ts] + pre) * 4u : trash;
                *(LAS unsigned*)(lds + addr) = packed;
                cn[rt][ts] += __popc(mine);
            }
        }
    }
}

__device__ __forceinline__ void p4_attention(const unsigned char* pj, bf16_t* attn_out, unsigned* queue, int* seldbg, LAS unsigned char* lds, int wave, int lane) {
    const bf16_t* qb_ = (const bf16_t*)(pj + PJ_Q); const unsigned char* kv8 = pj + PJ_KV; const bf16_t* qib = (const bf16_t*)(pj + PJ_QI); const bf16_t* kwb = (const bf16_t*)(pj + PJ_KW);
    LAS unsigned* cnt_l = (LAS unsigned*)(lds + LDS_ATM);
    LAS unsigned* thr_l = cnt_l + 64;
    LAS unsigned* unit_l = cnt_l + 128;
    LAS unsigned* pflag = cnt_l + 132;
    LAS unsigned* wl_ctl = cnt_l + 136;
    LAS unsigned* cnt2 = cnt_l + 144;
    LAS unsigned* H = (LAS unsigned*)(lds + LDS_HIST) + wave * 256;
    const int tid = threadIdx.x, hf = lane >> 5, l31 = lane & 31;
    for (;;) {
        if (tid == 0) { const unsigned pref = xb_xcc_id() & 1u;
            unsigned uu = atomicAdd(queue + 64 * pref, 1u), bb = pref;
            if (uu >= 256u) { uu = atomicAdd(queue + 64 * (pref ^ 1u), 1u); bb = pref ^ 1u; }
            *unit_l = (uu >= 256u) ? 0xFFFFu : (uu * 2u + bb); pflag[0] = 0u; pflag[1] = 0u; wl_ctl[0] = 0u; wl_ctl[1] = 0u; }
        __syncthreads();
        const int u = __builtin_amdgcn_readfirstlane((int)*unit_l);
        __syncthreads();
        if (u >= 512) break;
        const int qb = 255 - (u >> 1), b = u & 1, t0 = qb * 64, rowbase = b * SEQ;
        if (lane < 8) { cnt_l[wave * 8 + lane] = 0u; thr_l[wave * 8 + lane] = 0u; }
        bf16x8 afr[2][4]; float wq[2][16];
#pragma unroll
        for (int rt = 0; rt < 2; ++rt) {
            const int m = l31, hd = (m & 3) + 4 * ((m >> 3) & 1), tl = 4 * rt + 2 * ((m >> 2) & 1) + (m >> 4);
            const bf16_t* qp = qib + (size_t)(rowbase + t0 + wave * 8 + tl) * 512 + hd * 64 + hf * 8;
#pragma unroll
            for (int ks = 0; ks < 4; ++ks) afr[rt][ks] = *(const bf16x8*)(qp + ks * 16);
#pragma unroll
            for (int ts = 0; ts < 2; ++ts) { const int tl2 = 4 * rt + 2 * hf + ts;
                const u32x4 wv = *(const u32x4*)(kwb + (size_t)(rowbase + t0 + wave * 8 + tl2) * 128 + 64);
                wq[rt][8 * ts + 0] = bf_lo(wv.x); wq[rt][8 * ts + 1] = bf_hi(wv.x); wq[rt][8 * ts + 2] = bf_lo(wv.y); wq[rt][8 * ts + 3] = bf_hi(wv.y);
                wq[rt][8 * ts + 4] = bf_lo(wv.z); wq[rt][8 * ts + 5] = bf_hi(wv.z); wq[rt][8 * ts + 6] = bf_lo(wv.w); wq[rt][8 * ts + 7] = bf_hi(wv.w); }
        }
#pragma unroll
        for (int rt = 0; rt < 2; ++rt) {
#pragma unroll
            for (int ks = 0; ks < 4; ++ks) asm volatile("" : "+v"(afr[rt][ks]));
#pragma unroll
            for (int j = 0; j < 16; ++j) asm volatile("" : "+v"(wq[rt][j]));
        }
        const int ntile = qb + 1;
        const int skey = tid >> 3, sch = tid & 7;
        const int sdst = skey * 128 + ((sch ^ ((skey >> 1) & 7)) * 16);
        u32x4 stg = *(const u32x4*)(kwb + (size_t)(rowbase + skey) * 128 + sch * 8);
        unsigned cn[2][2], th[2][2];
        const unsigned lmask = (1u << l31) - 1u, trash = (unsigned)(LDS_HIST + wave * 1024 + lane * 4);
#pragma unroll
        for (int rt = 0; rt < 2; ++rt)
#pragma unroll
            for (int ts = 0; ts < 2; ++ts) { cn[rt][ts] = 0u; th[rt][ts] = 0u; }
        for (int kt = 0; kt < ntile; ++kt) {
            LAS unsigned char* kbuf = lds + LDS_KT + (kt & 1) * 8192;
            *(LAS u32x4*)(kbuf + sdst) = stg;
            __syncthreads();
            if (kt + 1 < ntile) stg = *(const u32x4*)(kwb + (size_t)(rowbase + (kt + 1) * 64 + skey) * 128 + sch * 8);
            if (kt > 0 && __builtin_amdgcn_readfirstlane((int)pflag[(kt - 1) & 1]) == kt) {
                const unsigned long long jm = __ballot(cnt_l[lane] > 400u);
                { unsigned long long m = jm;
                  for (int ti = 0; m != 0ull; ++ti) { const int id = __ffsll((long long)m) - 1; m &= m - 1ull;
                    if ((ti & 7) == wave) {
                        prune_approx<6>((LAS unsigned*)(lds + id * 2048), H, cnt_l + id, cnt2 + id, thr_l + id, lane);
                        if (__builtin_amdgcn_readfirstlane((int)cnt2[id]) > 320) prune_token((LAS unsigned*)(lds + id * 2048), H, cnt2 + id, cnt2 + id, thr_l + id, lane);
                    } } }
                __syncthreads();
#pragma unroll
                for (int rt = 0; rt < 2; ++rt)
#pragma unroll
                    for (int ts = 0; ts < 2; ++ts) { const int tl = 4 * rt + 2 * hf + ts;
                        if ((jm >> (wave * 8 + tl)) & 1ull) { cn[rt][ts] = cnt2[wave * 8 + tl]; th[rt][ts] = thr_l[wave * 8 + tl]; } }
            }
            if (kt + 1 < ntile) score_tile<false>(lds, kbuf, afr, wq, cn, th, kt, t0, wave, hf, l31, lmask, trash);
            else                score_tile<true>(lds, kbuf, afr, wq, cn, th, kt, t0, wave, hf, l31, lmask, trash);
            bool need = false;
#pragma unroll
            for (int rt = 0; rt < 2; ++rt)
#pragma unroll
                for (int ts = 0; ts < 2; ++ts) { const int tl = 4 * rt + 2 * hf + ts; if (l31 == 0) cnt_l[wave * 8 + tl] = cn[rt][ts]; need |= cn[rt][ts] > 448u; }
            if (__ballot(need) != 0ull) { if (lane == 0) pflag[kt & 1] = (unsigned)(kt + 1); }
        }
        for (int tl = 0; tl < 8; ++tl) {
            const unsigned c = cnt_l[wave * 8 + tl];
            if (__builtin_amdgcn_readfirstlane((int)c) > 256) {
                LAS unsigned* Lt = (LAS unsigned*)(lds + (wave * 8 + tl) * 2048);
                prune_approx<4>(Lt, H, cnt_l + wave * 8 + tl, cnt_l + wave * 8 + tl, thr_l + wave * 8 + tl, lane);
                const int n2 = __builtin_amdgcn_readfirstlane((int)cnt_l[wave * 8 + tl]);
                if (n2 > 304) prune_token(Lt, H, cnt_l + wave * 8 + tl, cnt_l + wave * 8 + tl, thr_l + wave * 8 + tl, lane);
                else if (n2 > 256) prune_excess(Lt, cnt_l + wave * 8 + tl, lane);
            }
        }
        const int c15 = lane & 15, g4 = lane >> 4;
        for (int tl = 0; tl < 8; ++tl) {
            const int n = __builtin_amdgcn_readfirstlane((int)cnt_l[wave * 8 + tl]);
            const LAS unsigned* L = (const LAS unsigned*)(lds + (wave * 8 + tl) * 2048);
            const int tokrow = rowbase + t0 + wave * 8 + tl;
            const LAS unsigned* Lc = L + c15; const int nc = n - c15, n4 = n - 4 * g4;
#if DBG
            if (seldbg) for (int i = lane; i < 256; i += 64) seldbg[(size_t)tokrow * 256 + i] = (i < n) ? (int)(16383u - (L[i] & 16383u)) : -1;
#endif
            long bq[4];
#pragma unroll
            for (int ks = 0; ks < 4; ++ks) { const bool ok = (c15 < 8) && ((c15 >> 2) == (g4 >> 1));
                const u32x4 v = *(const u32x4*)(qb_ + (size_t)tokrow * 512 + (c15 & 7) * 64 + (g4 & 1) * 32 + ks * 8);
                const unsigned w0 = pk4_fp8(bf_lo(v.x), bf_hi(v.x), bf_lo(v.y), bf_hi(v.y)), w1 = pk4_fp8(bf_lo(v.z), bf_hi(v.z), bf_lo(v.w), bf_hi(v.w));
                bq[ks] = ok ? (long)(((unsigned long long)w1 << 32) | w0) : 0l; }
            f32x4 S[16];
            u32x4 kq[2][4][2];
#define LOAD_KGROUP(buf, grp) do { _Pragma("unroll") for (int tt = 0; tt < 4; ++tt) { const int T_ = (grp) * 4 + tt; const unsigned e_ = Lc[T_ * 16]; \
                const int kp_ = (T_ * 16 < nc) ? (int)(16383u - (e_ & 16383u)) : 0; \
                const unsigned char* kr_ = kv8 + (size_t)(rowbase + kp_) * 256 + g4 * 32;     \
                kq[buf][tt][0] = *(const u32x4*)kr_; kq[buf][tt][1] = *(const u32x4*)(kr_ + 16); } } while (0)
            LOAD_KGROUP(0, 0); LOAD_KGROUP(1, 1);
#pragma unroll
            for (int grp = 0; grp < 4; ++grp) {
#pragma unroll
                for (int tt = 0; tt < 4; ++tt) { const int T = grp * 4 + tt; const u32x4 k0 = kq[grp & 1][tt][0], k1 = kq[grp & 1][tt][1];
                    f32x4 sacc = (f32x4){0.f, 0.f, 0.f, 0.f};
                    sacc = __builtin_amdgcn_mfma_f32_16x16x32_fp8_fp8((long)(((unsigned long long)k0.y << 32) | k0.x), bq[0], sacc, 0, 0, 0);
                    sacc = __builtin_amdgcn_mfma_f32_16x16x32_fp8_fp8((long)(((unsigned long long)k0.w << 32) | k0.z), bq[1], sacc, 0, 0, 0);
                    sacc = __builtin_amdgcn_mfma_f32_16x16x32_fp8_fp8((long)(((unsigned long long)k1.y << 32) | k1.x), bq[2], sacc, 0, 0, 0);
                    sacc = __builtin_amdgcn_mfma_f32_16x16x32_fp8_fp8((long)(((unsigned long long)k1.w << 32) | k1.z), bq[3], sacc, 0, 0, 0);
                    if (n < 256) {
#pragma unroll
                        for (int j = 0; j < 4; ++j) if (T * 16 + j >= n4) sacc[j] = -1e30f; }
                    S[T] = sacc; }
                if (grp < 2) { if (grp == 0) LOAD_KGROUP(0, 2); else LOAD_KGROUP(1, 3); }
                asm volatile("" ::: "memory");
            }
#undef LOAD_KGROUP
            const LAS unsigned* Lh = L + (lane >> 3); const int nh = n - (lane >> 3);
            const int vwr = (wave * 8 + (lane >> 5)) * 2048 + 1024 + ((lane >> 3) & 3) * 160 + (lane >> 5) * 16 + (lane & 7) * 16;
            u32x4 vvA[4], vvB[4];
#pragma unroll
            for (int q = 0; q < 4; ++q) { const unsigned e = Lh[8 * q];
                const int kp = (8 * q < nh) ? (int)(16383u - (e & 16383u)) : 0;
                vvA[q] = *(const u32x4*)(kv8 + (size_t)(rowbase + kp) * 256 + 128 + (lane & 7) * 16); }
#pragma unroll
            for (int q = 0; q < 4; ++q) { const unsigned e = Lh[32 + 8 * q];
                const int kp = (32 + 8 * q < nh) ? (int)(16383u - (e & 16383u)) : 0;
                vvB[q] = *(const u32x4*)(kv8 + (size_t)(rowbase + kp) * 256 + 128 + (lane & 7) * 16); }
            float mx = -1e30f;
#pragma unroll
            for (int T = 0; T < 16; ++T)
#pragma unroll
                for (int j = 0; j < 4; ++j) mx = fmaxf(mx, S[T][j]);
            mx = fmaxf(mx, __shfl_xor(mx, 16)); mx = fmaxf(mx, __shfl_xor(mx, 32));
            float sum = 0.f; unsigned P8[16];
            const float mxl = (mx - 5.545177444f) * 1.44269504089f;
#pragma unroll
            for (int T = 0; T < 16; ++T) { f32x4 pv;
#pragma unroll
                for (int j = 0; j < 4; ++j) { pv[j] = __builtin_amdgcn_exp2f(fmaf(S[T][j], 1.44269504089f, -mxl)); sum += pv[j]; }
                int w = __builtin_amdgcn_cvt_pk_fp8_f32(pv[0], pv[1], 0, false); w = __builtin_amdgcn_cvt_pk_fp8_f32(pv[2], pv[3], w, true); P8[T] = (unsigned)w; }
            sum += __shfl_xor(sum, 16); sum += __shfl_xor(sum, 32);
            const float inv = 1.0f / sum;
            float invh[4];
#pragma unroll
            for (int j = 0; j < 4; ++j) invh[j] = __shfl(inv, 4 * (g4 & 1) + j);
            f32x4 O[8];
#pragma unroll
            for (int dt = 0; dt < 8; ++dt) O[dt] = (f32x4){0.f, 0.f, 0.f, 0.f};
            typedef int i2v __attribute__((ext_vector_type(2)));
            const LAS unsigned char* vtr = lds + (wave * 8 + g4 + 4 * ((lane & 15) >> 3)) * 2048 + 1024 + (((lane & 15) >> 1) & 3) * 160 + ((lane & 15) >> 3) * 128 + (g4 & 1) * 16 + (lane & 1) * 8;
#pragma unroll
            for (int ch = 0; ch < 8; ++ch) {
                u32x4 (&vv)[4] = (ch & 1) ? vvB : vvA;
#pragma unroll
                for (int q = 0; q < 4; ++q) *(LAS u32x4*)(lds + vwr + q * 4096 + (q >> 1) * 128) = vv[q];
                if (ch < 6) {
#pragma unroll
                    for (int q = 0; q < 4; ++q) { const unsigned e = Lh[(ch + 2) * 32 + 8 * q];
                        const int kp = ((ch + 2) * 32 + 8 * q < nh) ? (int)(16383u - (e & 16383u)) : 0;
                        vv[q] = *(const u32x4*)(kv8 + (size_t)(rowbase + kp) * 256 + 128 + (lane & 7) * 16); }
                }
                const long pf = (long)(((unsigned long long)P8[2 * ch + 1] << 32) | P8[2 * ch]);
#pragma unroll
                for (int dt = 0; dt < 8; ++dt) {
                    const i2v vt = __builtin_amdgcn_ds_read_tr8_b64_v2i32((LAS i2v*)(vtr + dt * 16));
                    O[dt] = __builtin_amdgcn_mfma_f32_16x16x32_fp8_fp8(pf, __builtin_bit_cast(long, vt), O[dt], 0, 0, 0);
                }
                asm volatile("" ::: "memory");
            }
            if (g4 < 2) {
#pragma unroll
                for (int j = 0; j < 4; ++j) {
                    const f32x4 o4 = g4 ? (f32x4){O[4][j], O[5][j], O[6][j], O[7][j]} : (f32x4){O[0][j], O[1][j], O[2][j], O[3][j]};
                    u32x2 w; w.x = pk2(o4[0] * invh[j], o4[1] * invh[j]); w.y = pk2(o4[2] * invh[j], o4[3] * invh[j]);
                    *(u32x2*)(attn_out + (size_t)tokrow * 1024 + (4 * g4 + j) * 64 + 4 * c15) = w;
                }
            }
        }
    }
}

__device__ __forceinline__ void p7_router(const Args& a, LAS unsigned char* lds, int wave, int lane, int G) {
    unsigned char* ws = a.ws;
    const bf16_t* x1b = (const bf16_t*)(ws + WS_X1B); const bf16_t* wr = (const bf16_t*)(ws + WS_WR);
    const float* ss2 = (const float*)(ws + CTLB_SS2); const float* rb = a.in[I_RB];
    int* topi = (int*)(ws + WS_TOPI); float* topg = (float*)(ws + WS_TOPG); int* lrank = (int*)(ws + WS_LRANK); int* cntwg = (int*)(ws + CTLB_CNTWG);
    LAS unsigned* wcnt = (LAS unsigned*)(lds + LDS_MISC + 64);
    if (threadIdx.x < 32) wcnt[threadIdx.x] = 0u;
    __syncthreads();
    LAS float* lg = (LAS float*)(lds + wave * 4096);
    const int c15 = lane & 15, g4 = lane >> 4;
    for (int tile = blockIdx.x * NWAVES + wave; tile < M / 16; tile += G * NWAVES) {
        const int tok0 = tile * 16;
        f32x4 a0 = (f32x4){0.f, 0.f, 0.f, 0.f}, a1 = a0;
        const bf16_t* ap = x1b + (size_t)(tok0 + c15) * D + g4 * 8; const bf16_t* bp0 = wr + (size_t)c15 * D + g4 * 8; const bf16_t* bp1 = bp0 + 16 * D;
#pragma unroll 8
        for (int ks = 0; ks < 32; ++ks) { const bf16x8 av = *(const bf16x8*)(ap + ks * 32), b0 = *(const bf16x8*)(bp0 + ks * 32), b1 = *(const bf16x8*)(bp1 + ks * 32);
            a0 = __builtin_amdgcn_mfma_f32_16x16x32_bf16(av, b0, a0, 0, 0, 0); a1 = __builtin_amdgcn_mfma_f32_16x16x32_bf16(av, b1, a1, 0, 0, 0); }
#pragma unroll
        for (int j = 0; j < 4; ++j) { lg[(4 * g4 + j) * 33 + c15] = a0[j]; lg[(4 * g4 + j) * 33 + 16 + c15] = a1[j]; }
        LDS_WAIT(); asm volatile("" ::: "memory");
        if (lane < 16) {
            const int tok = tok0 + lane; const float rs = rsqrtf(ss2[tok] * (1.0f / D) + RMS_EPS);
            float v[32];
#pragma unroll
            for (int e = 0; e < 32; ++e) v[e] = lg[lane * 33 + e] * rs + rb[e];
            int bi[4]; float bv[4];
#pragma unroll
            for (int r = 0; r < 4; ++r) { float best = -3.0e38f; int bidx = 0;
#pragma unroll
                for (int e = 0; e < 32; ++e) { bool used = false;
#pragma unroll
                    for (int q = 0; q < 4; ++q) if (q < r && bi[q] == e) used = true;
                    if (!used && v[e] > best) { best = v[e]; bidx = e; } }
                bi[r] = bidx; bv[r] = best; }
            float ex[4], se = 0.f;
#pragma unroll
            for (int r = 0; r < 4; ++r) { ex[r] = __expf(bv[r] - bv[0]); se += ex[r]; }
            const float inv = 1.0f / se;
#pragma unroll
            for (int r = 0; r < 4; ++r) { topi[tok * 4 + r] = bi[r]; topg[tok * 4 + r] = ex[r] * inv; lrank[tok * 4 + r] = (int)lds_atomic_inc(wcnt + bi[r]); }
        }
        LDS_WAIT(); asm volatile("" ::: "memory");
    }
    __syncthreads();
    if (threadIdx.x < 32) cntwg[blockIdx.x * 32 + threadIdx.x] = (int)wcnt[threadIdx.x];
}

__device__ __forceinline__ void p8_scatter(const Args& a, LAS unsigned char* lds, int wave, int lane, int G) {
    unsigned char* ws = a.ws;
    const int* cntwg = (const int*)(ws + CTLB_CNTWG); const int* topi = (const int*)(ws + WS_TOPI); const float* topg = (const float*)(ws + WS_TOPG);
    const int* lrank = (const int*)(ws + WS_LRANK); int* posof = (int*)(ws + WS_POSOF); int* rowmap = (int*)(ws + WS_ROWMAP); float* rowgate = (float*)(ws + WS_ROWGATE);
    int* tile_e = (int*)(ws + CTLB_TILEE); int* meta = (int*)(ws + CTLB_META); float* rowscale = (float*)(ws + WS_ROWSCALE);
    LAS int* part = (LAS int*)(lds);
    LAS int* tot = (LAS int*)(lds + 8192);
    LAS int* pre = tot + 32;
    LAS int* base = tot + 64;
    const int tid = threadIdx.x, e = tid & 31, pt = tid >> 5, myw = blockIdx.x;
    int sall = 0, spre = 0;
#pragma unroll 8
    for (int w = pt; w < G; w += 16) { const int v = cntwg[w * 32 + e]; sall += v; spre += (w < myw) ? v : 0; }
    part[pt * 32 + e] = sall; part[512 + pt * 32 + e] = spre;
    __syncthreads();
    if (tid < 32) { int s0 = 0, s1 = 0;
#pragma unroll
        for (int q = 0; q < 16; ++q) { s0 += part[q * 32 + tid]; s1 += part[512 + q * 32 + tid]; }
        tot[tid] = s0; pre[tid] = s1; }
    __syncthreads();
    if (tid == 0) { int bsum = 0; for (int q = 0; q < 32; ++q) { base[q] = bsum; bsum += (tot[q] + 255) & ~255; } base[32] = bsum; }
    __syncthreads();
    for (int tile = blockIdx.x * NWAVES + wave; tile < M / 16; tile += G * NWAVES) {
        const int idx = tile * 64 + lane; const int ex = topi[idx];
        const int pos = base[ex] + pre[ex] + lrank[idx];
        rowmap[pos] = idx >> 2; rowgate[pos] = topg[idx]; posof[idx] = pos;
        rowscale[pos] = rsqrtf(((const float*)(ws + CTLB_SS2))[idx >> 2] * (1.0f / D) + RMS_EPS);
    }
    for (int ex = blockIdx.x; ex < 32; ex += G) { const int t_ = tot[ex], pe = (t_ + 255) & ~255;
        for (int r = t_ + tid; r < pe; r += NTHREADS) { rowmap[base[ex] + r] = 0; rowgate[base[ex] + r] = 0.f; rowscale[base[ex] + r] = 0.f; } }
    if (blockIdx.x == 0) {
        const int ntl = base[32] >> 8;
        for (int t = tid; t < 544; t += NTHREADS) { int ex = 0;
            for (int q = 0; q < 32; ++q) if (base[q] <= t * 256) ex = q;
            tile_e[t] = (t < ntl) ? ex : 0; }
        if (tid == 0) meta[0] = ntl;
    }
}

__device__ __forceinline__ void p11_combine(const Args& a, int wave, int lane, int G) {
    unsigned char* ws = a.ws;
    const int* posof = (const int*)(ws + WS_POSOF); const unsigned char* Y = ws + WS_R2; const bf16_t* x1b = (const bf16_t*)(ws + WS_X1B); bf16_t* x2b = (bf16_t*)(ws + WS_R1); float* rs3 = (float*)(ws + WS_RS3);
    const int gw = blockIdx.x * NWAVES + wave, NGW = G * NWAVES;
    typedef int i4v __attribute__((ext_vector_type(4)));
    i4v pnx = (gw < M) ? *(const i4v*)(posof + (size_t)gw * 4) : (i4v){0, 0, 0, 0};
    for (int m = gw; m < M; m += NGW) {
        const i4v pcur = pnx;
        if (m + NGW < M) pnx = *(const i4v*)(posof + (size_t)(m + NGW) * 4);
        const u32x2* xr = (const u32x2*)(x1b + (size_t)m * D) + lane; f32x4 v[4]; u32x2 xw[4]; unsigned yw[4][4];
#pragma unroll
        for (int j = 0; j < 4; ++j) xw[j] = xr[64 * j];
#pragma unroll
        for (int s = 0; s < 4; ++s) { const unsigned* yr = (const unsigned*)(Y + (size_t)pcur[s] * D) + lane;
#pragma unroll
            for (int j = 0; j < 4; ++j) yw[s][j] = yr[64 * j]; }
#pragma unroll
        for (int j = 0; j < 4; ++j) { const u32x2 w = xw[j]; v[j] = (f32x4){bf_lo(w.x), bf_hi(w.x), bf_lo(w.y), bf_hi(w.y)}; }
#pragma unroll
        for (int s = 0; s < 4; ++s) {
#pragma unroll
            for (int j = 0; j < 4; ++j) { const f32x2_ lo = __builtin_amdgcn_cvt_pk_f32_fp8((int)yw[s][j], false), hi = __builtin_amdgcn_cvt_pk_f32_fp8((int)yw[s][j], true);
                v[j][0] += lo.x; v[j][1] += lo.y; v[j][2] += hi.x; v[j][3] += hi.y; } }
        float s = 0.f;
#pragma unroll
        for (int j = 0; j < 4; ++j) s += (v[j][0] * v[j][0] + v[j][1] * v[j][1]) + (v[j][2] * v[j][2] + v[j][3] * v[j][3]);
        s = wave_sum(s); if (lane == 0) rs3[m] = rsqrtf(s * (1.0f / D) + RMS_EPS);
        u32x2* o = (u32x2*)(x2b + (size_t)m * D) + lane;
#pragma unroll
        for (int j = 0; j < 4; ++j) { u32x2 w; w.x = pk2(v[j][0], v[j][1]); w.y = pk2(v[j][2], v[j][3]); o[64 * j] = w; }
    }
}
__device__ __forceinline__ void p13_final(const Args& a, int wave, int lane, int G) {
    const float* ss4 = (const float*)(a.ws + CTLB_SS4); const float* fg = a.in[I_FG]; const bf16_t* x3b = (const bf16_t*)(a.ws + WS_R1 + 128 * MiB);
    const int gw = blockIdx.x * NWAVES + wave, NGW = G * NWAVES;
    f32x4 gq[4];
#pragma unroll
    for (int j = 0; j < 4; ++j) gq[j] = ((const f32x4*)fg)[lane + 64 * j];
    for (int m0 = gw; m0 < M; m0 += 4 * NGW) { u32x2 xw[4][4]; float sv[4];
#pragma unroll
        for (int r = 0; r < 4; ++r) { const int m = m0 + r * NGW; if (m < M) { sv[r] = ss4[m]; const u32x2* xr = (const u32x2*)(x3b + (size_t)m * D) + lane;
#pragma unroll
            for (int j = 0; j < 4; ++j) xw[r][j] = xr[64 * j]; } }
#pragma unroll
        for (int r = 0; r < 4; ++r) { const int m = m0 + r * NGW; if (m < M) { const float rs = rsqrtf(sv[r] * (1.0f / D) + RMS_EPS); f32x4* orow = (f32x4*)(a.out + (size_t)m * D) + lane;
#pragma unroll
            for (int j = 0; j < 4; ++j) { const u32x2 w = xw[r][j]; orow[64 * j] = (f32x4){bf_lo(w.x), bf_hi(w.x), bf_lo(w.y), bf_hi(w.y)} * rs * gq[j]; } } } }
}

__global__ void __launch_bounds__(NTHREADS, 2) fwd(Args args) {
    extern __shared__ __attribute__((aligned(16))) unsigned char lds_raw[];
    LAS unsigned char* lds = (LAS unsigned char*)lds_raw;
    const int G = gridDim.x;
#define tid ((int)threadIdx.x)
#define lane ((int)(threadIdx.x & 63))
#define wave (__builtin_amdgcn_readfirstlane((int)(threadIdx.x >> 6)))
    unsigned char* ws = args.ws;
    volatile LAS unsigned* MISC = (volatile LAS unsigned*)(lds + LDS_MISC);
    if (tid < 64) MISC[tid] = 0u;
    __syncthreads();
    XcdBarrier bar = xcd_barrier_post((unsigned*)(ws + CTLB_BAR), MISC);
    const int lo = args.ph_lo, hi = args.ph_hi;
#define IN(k) (lo <= (k) && (k) < hi)
#define SEAM(k) do { if (IN(k) && IN((k) + 1)) xcd_barrier(bar); } while (0)
    unsigned char* pj = ws + WS_R1;
    bf16_t* xb = (bf16_t*)(ws + WS_R2); bf16_t* cat = (bf16_t*)(ws + WS_R2 + 64 * MiB);
    bf16_t* mixed = cat; bf16_t* attn = cat + 512; bf16_t* zb = (bf16_t*)(ws + WS_R2 + 192 * MiB);

    if (IN(PH_PRO)) { p0_prologue(args, lds, wave, lane, G); }
    SEAM(PH_PRO);
    if (IN(PH_INPROJ)) {
        pg8::Gemm g{xb, (const bf16_t*)(ws + WS_WIN), M, NP, D, 0, nullptr}; pg8::StaticOrder S; S.init(M, NP, G, (int)blockIdx.x);
        EpiProj E{pj, (const float*)(ws + WS_RS1)};
        pg8::gemm_phase<EpiProj, pg8::StaticOrder, false>(lds, g, S, E);
    }
    SEAM(PH_INPROJ);
    if (IN(PH_MIXED)) { p2_mixed((const bf16_t*)(pj + PJ_U), mixed, G); }
    if (IN(PH_ATT)) {
        __syncthreads();
        p4_attention(pj, attn, (unsigned*)(ws + CTLB_QUEUE), DBG ? (int*)(ws + WS_SEL) : nullptr, lds, wave, lane);
        for (;;) {
            __syncthreads();
            if (tid == 0) MISC[4] = atomicAdd((unsigned*)(ws + CTLB_QUEUE) + 128, 1u);
            __syncthreads();
            const int c = __builtin_amdgcn_readfirstlane((int)MISC[4]);
            if (c >= I_E1 / 8) break;
            deferred_chunk(args, lds, c, wave, lane);
        }
    }
    SEAM(PH_ATT);
    if (IN(PH_Z)) {
        pg8::Gemm g{cat, (const bf16_t*)(ws + WS_WPC), M, D, 1024, 0, nullptr}; pg8::StaticOrder S; S.init(M, D, G, (int)blockIdx.x);
        EpiGate<false, true> E{zb, (const bf16_t*)(pj + PJ_G) + 1024, nullptr};
        HookGateRatio Hk{(const bf16_t*)(pj + PJ_G)};
        pg8::gemm_phase<EpiGate<false, true>, pg8::StaticOrder, false, HookGateRatio>(lds, g, S, E, Hk);
    }
    SEAM(PH_Z);
    if (IN(PH_X1)) {
        pg8::Gemm g{zb, (const bf16_t*)(ws + WS_WOUT), M, D, D, 0, nullptr}; pg8::StaticOrder S; S.init(M, D, G, (int)blockIdx.x);
        EpiX1 E{args.in[I_X], (bf16_t*)(ws + WS_X1B), (float*)(ws + CTLB_SS2), ws + WS_R1 + 144 * MiB};
        pg8::gemm_phase<EpiX1, pg8::StaticOrder, false>(lds, g, S, E);
    }
    SEAM(PH_X1);
    if (IN(PH_ROUTER)) { p7_router(args, lds, wave, lane, G); }
    SEAM(PH_ROUTER);
    if (IN(PH_SCATTER)) { __syncthreads(); p8_scatter(args, lds, wave, lane, G); }
    SEAM(PH_SCATTER);
    if (IN(PH_MOE1)) {
        __syncthreads();
        pg8::Gemm g{(const bf16_t*)(ws + WS_R1 + 144 * MiB), (const bf16_t*)(ws + WS_W1), M, 2048, D / 2, (size_t)2048 * D, (const int*)(ws + WS_ROWMAP)};
        LAS int* te_l = (LAS int*)(lds + LDS_KT); for (int i = tid; i < 544; i += NTHREADS) te_l[i] = ((const int*)(ws + CTLB_TILEE))[i];
        __syncthreads();
        pg8::MoeOrder S{te_l, *(const int*)(ws + CTLB_META), 8, G, (int)blockIdx.x};
        EpiMoe1 E{ws + WS_R1, (const float*)(ws + WS_ROWSCALE), args.in[I_B1]};
        pg8::gemm_phase<EpiMoe1, pg8::MoeOrder, true, pg8::NoHook, 2>(lds, g, S, E);
        for (;;) {
            __syncthreads();
            if (tid == 0) MISC[4] = atomicAdd((unsigned*)(ws + CTLB_QUEUE) + 192, 1u);
            __syncthreads();
            const int c = I_E1 / 8 + __builtin_amdgcn_readfirstlane((int)MISC[4]);
            if (c >= DC_EXPERT) break;
            deferred_chunk(args, lds, c, wave, lane);
        }
    }
    SEAM(PH_MOE1);
    if (IN(PH_MOE2)) {
        pg8::Gemm g{(const bf16_t*)(ws + WS_R1), (const bf16_t*)(ws + WS_W2), MOE_ROWS, D, DFF / 2, (size_t)D * DFF, nullptr};
        LAS int* te_l = (LAS int*)(lds + LDS_KT); for (int i = tid; i < 544; i += NTHREADS) te_l[i] = ((const int*)(ws + CTLB_TILEE))[i];
        __syncthreads();
        pg8::MoeOrder S{te_l, *(const int*)(ws + CTLB_META), 4, G, (int)blockIdx.x};
        EpiMoe2 E{ws + WS_R2, (const float*)(ws + WS_ROWGATE), args.in[I_B2]};
        pg8::gemm_phase<EpiMoe2, pg8::MoeOrder, false, pg8::NoHook, 2>(lds, g, S, E);
        { const int nunits = S.ntiles * 4, rem = nunits % G, vwg = (G % 8 == 0) ? ((int)blockIdx.x % 8) * (G / 8) + (int)blockIdx.x / 8 : (int)blockIdx.x;
          pg8::PPOrder SP{rem ? G - rem : G, rem ? vwg - rem : vwg};
          pg8::Gemm gp{(const bf16_t*)(ws + WS_PB), (const bf16_t*)(ws + WS_WPP), M, D, PLE, 0, nullptr};
          EpiPP EP{(bf16_t*)(ws + WS_PP)};
          pg8::gemm_phase<EpiPP, pg8::PPOrder, false>(lds, gp, SP, EP); }
    }
    SEAM(PH_MOE2);
    if (IN(PH_COMBINE)) { p11_combine(args, wave, lane, G); }
    SEAM(PH_COMBINE);
    if (IN(PH_PLE)) {
        pg8::Gemm g{(const bf16_t*)(ws + WS_R1), (const bf16_t*)(ws + WS_WPG), M, D, D, 0, nullptr}; pg8::StaticOrder S; S.init(M, D, G, (int)blockIdx.x);
        EpiPleGX E{(bf16_t*)(ws + WS_R1 + 128 * MiB), (const bf16_t*)(ws + WS_R1), (const bf16_t*)(ws + WS_PP), (const float*)(ws + WS_RS3), (float*)(ws + CTLB_SS4)};
        pg8::gemm_phase<EpiPleGX, pg8::StaticOrder, false>(lds, g, S, E);
    }
    SEAM(PH_PLE);
    if (IN(PH_FINAL)) { p13_final(args, wave, lane, G); }
#undef IN
#undef SEAM
#undef tid
#undef lane
#undef wave
}

#if DBG
__device__ __forceinline__ unsigned hash_u(unsigned x) { x ^= x >> 16; x *= 0x7feb352dU; x ^= x >> 15; x *= 0x846ca68bU; x ^= x >> 16; return x; }
__device__ __forceinline__ bool closef(float got, float ref, float rtol, float atol) { return fabsf(got - ref) <= atol + rtol * fabsf(ref); }
__device__ float dotbf(const bf16_t* a, const bf16_t* b, int K) { float s = 0.f; for (int k = 0; k < K; ++k) s += bf1(a[k]) * bf1(b[k]); return s; }
__device__ __forceinline__ void dbg_fail(unsigned* dbg, int code) { atomicAdd(dbg + code, 1u); }
__device__ float f2bf_f(float v) { return __builtin_bit_cast(float, f2bf(v) << 16); }

__device__ float pjv(const unsigned char* pj, int m, int c) {
    const bf16_t* b; int ld, cc;
    if (c < 512) { b = (const bf16_t*)(pj + PJ_U); ld = 512; cc = c; }
    else if (c < 1024) { b = (const bf16_t*)(pj + PJ_Q); ld = 512; cc = c - 512; }
    else if (c < 1280) { const unsigned v = (pj + PJ_KV)[(size_t)m * 256 + (c - 1024)]; const int e = (v >> 3) & 15, mt = v & 7;
        const float mag = e ? ldexpf(1.0f + mt * 0.125f, e - 7) : ldexpf(mt * 0.125f, -6); return (v & 128) ? -mag : mag; }
    else if (c < 1792) { b = (const bf16_t*)(pj + PJ_QI); ld = 512; cc = c - 1280; }
    else if (c < 2048) { b = (const bf16_t*)(pj + PJ_KW); ld = 128; cc = c - 1792; if (cc >= 128) return 0.f; }
    else { b = (const bf16_t*)(pj + PJ_G); ld = 2048; cc = c - 2048; }
    return bf1(b[(size_t)m * ld + cc]);
}
__global__ void __launch_bounds__(256) chk(Args a, int phase) {
    unsigned char* ws = a.ws; unsigned* dbg = (unsigned*)(ws + CTLB_DBG);
    const unsigned s = blockIdx.x * 256 + threadIdx.x;
    const unsigned h = hash_u(s * 2654435761u + 12345u), h2 = hash_u(h + 777u);
    const unsigned char* pj = ws + WS_R1;
    const bf16_t* mixed = (const bf16_t*)(ws + WS_R2 + 64 * MiB); const bf16_t* attn = mixed + 512;
    const bf16_t* zb = (const bf16_t*)(ws + WS_R2 + 192 * MiB);
    if (phase == PH_PRO) {
        if (s == 0) {
            volatile unsigned* pv = dbg + 40; pv[0] = 0xC0484038u; pv[1] = 0x3F800000u; pv[2] = 0x40000000u; pv[3] = 0x40800000u; pv[4] = 0xC0000000u;
            const unsigned wrt = pv[0];
            const u32x2 r = fp8x4_to_bf16x4(wrt);
            if (!(r.x == 0x40003F80u && r.y == 0xC0004080u)) {
                if (r.x == 0x3F804000u) dbg_fail(dbg, 21); else if (r.x == 0xC0004080u) dbg_fail(dbg, 22); else if (r.x == 0x40003F80u) dbg_fail(dbg, 25); else if (r.y == 0xC0004080u) dbg_fail(dbg, 26); else dbg_fail(dbg, 23); }
            const unsigned enc = pk4_fp8(__builtin_bit_cast(float, (unsigned)pv[1]), __builtin_bit_cast(float, (unsigned)pv[2]), __builtin_bit_cast(float, (unsigned)pv[3]), __builtin_bit_cast(float, (unsigned)pv[4]));
            if (enc != 0xC0484038u) dbg_fail(dbg, 24);
        }
        {
          const int n = h % IN_COLS, k = h2 % D; int row = n < 1864 ? n : n + 184;
          if (n >= 1152 && n < 1280) { const int d = (n - 1152) & 63; row = 1152 + ((n - 1152) & 64) + 16 * (d & 3) + (d >> 2); }
          float sc = 1.f; if ((n >= 512 && n < 1024) || (n >= 1280 && n < 1792)) sc = 0.125f; if (n >= 1856 && n < 1864) sc = 0.35355339059327373f;
          const float ref = f2bf_f(a.in[I_WIN][(size_t)k * IN_COLS + n] * (sc * a.in[I_N1G][k]));
          const float got = bf1(((const bf16_t*)(ws + WS_WIN))[(size_t)row * D + k]);
          if (!closef(got, ref, 0.01f, 1e-6f)) dbg_fail(dbg, 1); }
        {
          const int m = h % M, k = h2 % D;
          if (!closef(bf1(((const bf16_t*)(ws + WS_R2))[(size_t)m * D + k]), f2bf_f(a.in[I_X][(size_t)m * D + k]), 0.01f, 1e-6f)) dbg_fail(dbg, 2);
          if (s < 512) { float q = 0.f; for (int i = 0; i < D; ++i) { const float v = a.in[I_X][(size_t)m * D + i]; q += v * v; }
            if (!closef(((const float*)(ws + WS_RS1))[m], rsqrtf(q / D + RMS_EPS), 0.001f, 0.f)) dbg_fail(dbg, 2); }
        }
    }
    if (phase == PH_INPROJ) {
        const int m = h % M; int c = h2 % NP; if (s & 1) c = (c & 255) | (7 << 8);
        float r = dotbf((const bf16_t*)(ws + WS_R2) + (size_t)m * D, (const bf16_t*)(ws + WS_WIN) + (size_t)c * D, D) * ((const float*)(ws + WS_RS1))[m];
        if (c >= 2048) r = 1.0f / (1.0f + expf(-r));
        if (c >= 1792 + 128 && c < 2048) r = 0.f;
        if (!closef(pjv(pj, m, c), r, (c >= 1024 && c < 1280) ? 0.08f : 0.02f, (c >= 1024 && c < 1280) ? 0.02f : 0.01f)) dbg_fail(dbg, 3);
    }
    if (phase == PH_MIXED) {
        int m = h % M; if (s < 64) m = (s & 31) + (s >> 5) * SEQ; const int c = h2 % 512, g = c >> 7, w = 2 << g, t = m & (SEQ - 1); const int nw = (t + 1) < w ? (t + 1) : w;
        float r = 0.f; for (int i = 0; i < nw; ++i) r += pjv(pj, m - i, c);
        r = r / nw - pjv(pj, m, c);
        if (!closef(bf1(mixed[(size_t)m * 1024 + c]), r, 0.02f, 0.01f)) dbg_fail(dbg, 4);
    }
    if (phase == PH_Z) {
        {
          const int e = h % 32, n = (h >> 5) % D, k = h2 % D;
          const int k2 = h2 % PLE;
          if (!closef(bf1(((const bf16_t*)(ws + WS_WPP))[(size_t)n * PLE + k2]), f2bf_f(a.in[I_PPW][(size_t)k2 * D + n]), 0.01f, 1e-6f)) dbg_fail(dbg, 1);
          if (!closef(bf1(((const bf16_t*)(ws + WS_WR))[(size_t)e * D + k]), f2bf_f(a.in[I_RW][(size_t)k * NE + e] * a.in[I_N2G][k]), 0.01f, 1e-6f)) dbg_fail(dbg, 1);
          if (!closef(bf1(((const bf16_t*)(ws + WS_WPG))[(size_t)n * D + k]), f2bf_f(a.in[I_PGW][(size_t)k * D + n] * a.in[I_PNG][k]), 0.01f, 1e-6f)) dbg_fail(dbg, 1);
          const int k5 = h2 % 512;
          if (!closef(bf1(((const bf16_t*)(ws + WS_WPC))[(size_t)n * 1024 + 512 + k5]), f2bf_f(a.in[I_WBA][(size_t)k5 * D + n]), 0.01f, 1e-6f)) dbg_fail(dbg, 1);
          { const int g = k5 >> 7; float r = 0.f; for (int d = 0; d < 128; ++d) r += a.in[I_POOLW][(size_t)k5 * 128 + d] * a.in[I_POOLS][g * 128 + d] * a.in[I_WBP][(size_t)(g * 128 + d) * D + n];
            if (!closef(bf1(((const bf16_t*)(ws + WS_WPC))[(size_t)n * 1024 + k5]), r, 0.01f, 1e-4f)) dbg_fail(dbg, 1); } }
        { const int m = h % M, k2 = h2 % PLE;
          if (!closef(bf1(((const bf16_t*)(ws + WS_PB))[(size_t)m * PLE + k2]), f2bf_f(a.in[I_P][(size_t)m * PLE + k2]), 0.01f, 1e-6f)) dbg_fail(dbg, 2); }
        {
          const int e = h % 32, n = (h >> 5) % 2048, k = h2 % D; const int row = n < 1024 ? (((n >> 7) << 8) + (n & 127)) : ((((n - 1024) >> 7) << 8) + 128 + ((n - 1024) & 127));
          const float ref = f2bf_f(a.in[I_W1][((size_t)e * D + k) * 2048 + n] * a.in[I_N2G][k]);
          const float got = bf1(((const bf16_t*)(ws + WS_W1))[((size_t)e * 2048 + row) * D + k]);
          if (!closef(got, ref, 0.01f, 1e-6f)) dbg_fail(dbg, 1); }
        { const int e = h % 32, n = (h >> 5) % D, k = h2 % D;
          if (!closef(bf1(((const bf16_t*)(ws + WS_W2))[((size_t)e * D + n) * DFF + k]), f2bf_f(a.in[I_W2][((size_t)e * DFF + k) * D + n]), 0.01f, 1e-6f)) dbg_fail(dbg, 1); }
        const int m = h % M, c = h2 % D; const bf16_t* wc_ = (const bf16_t*)(ws + WS_WPC) + (size_t)c * 1024;
        const float r = dotbf(mixed + (size_t)m * 1024, wc_, 512) * pjv(pj, m, C_GP + c) + dotbf(attn + (size_t)m * 1024, wc_ + 512, 512) * pjv(pj, m, C_GA + c);
        if (!closef(bf1(zb[(size_t)m * D + c]), r, 0.02f, 0.02f)) dbg_fail(dbg, 8);
    }
    if (phase == PH_X1) {
        const int m = h % M, c = h2 % D;
        const float r = a.in[I_X][(size_t)m * D + c] + dotbf(zb + (size_t)m * D, (const bf16_t*)(ws + WS_WOUT) + (size_t)c * D, D);
        if (!closef(bf1(((const bf16_t*)(ws + WS_X1B))[(size_t)m * D + c]), r, 0.01f, 0.01f)) dbg_fail(dbg, 9);
        if (s < 512) { float q = 0.f; for (int i = 0; i < D; ++i) { const float v = bf1(((const bf16_t*)(ws + WS_X1B))[(size_t)m * D + i]); q += v * v; }
            if (!closef(((const float*)(ws + CTLB_SS2))[m], q, 0.01f, 0.f)) dbg_fail(dbg, 9); }
    }
    if (phase == PH_ROUTER) {
        const int m = h % M; const float rs = rsqrtf(((const float*)(ws + CTLB_SS2))[m] / D + RMS_EPS);
        float v[32]; for (int e = 0; e < 32; ++e) v[e] = dotbf((const bf16_t*)(ws + WS_X1B) + (size_t)m * D, (const bf16_t*)(ws + WS_WR) + (size_t)e * D, D) * rs + a.in[I_RB][e];
        const int* ti = (const int*)(ws + WS_TOPI) + m * 4; const float* tg = (const float*)(ws + WS_TOPG) + m * 4;
        float mn = 1e30f, se = 0.f, gs = 0.f; bool ok = true;
        for (int r = 0; r < 4; ++r) { if (ti[r] < 0 || ti[r] >= 32) { ok = false; break; } mn = fminf(mn, v[ti[r]]); for (int q = 0; q < r; ++q) if (ti[q] == ti[r]) ok = false; }
        if (ok) { for (int r = 0; r < 4; ++r) se += expf(v[ti[r]] - v[ti[0]]);
            for (int r = 0; r < 4; ++r) { if (!closef(tg[r], expf(v[ti[r]] - v[ti[0]]) / se, 0.02f, 0.002f)) ok = false; gs += tg[r]; }
            int above = 0; for (int e = 0; e < 32; ++e) { bool sel = false; for (int r = 0; r < 4; ++r) sel |= (ti[r] == e); if (!sel && v[e] > mn + 1e-3f) ++above; }
            if (above) ok = false; }
        if (!ok) dbg_fail(dbg, 10);
    }
    if (phase == PH_SCATTER) {
        const int m = h % M; const int* ti = (const int*)(ws + WS_TOPI) + m * 4; const int* po = (const int*)(ws + WS_POSOF) + m * 4; const int* te = (const int*)(ws + CTLB_TILEE);
        const int ntl = *(const int*)(ws + CTLB_META); bool ok = ntl > 0 && ntl <= 544;
        for (int r = 0; r < 4 && ok; ++r) { const int p = po[r]; if (p < 0 || p >= ntl * 256) { ok = false; break; }
            if (((const int*)(ws + WS_ROWMAP))[p] != m) ok = false; if (te[p >> 8] != ti[r]) ok = false;
            if (!closef(((const float*)(ws + WS_ROWGATE))[p], ((const float*)(ws + WS_TOPG))[m * 4 + r], 1e-6f, 0.f)) ok = false; }
        if (!ok) dbg_fail(dbg, 11);
    }
    if (phase == PH_MOE1) {
        const int ntl = *(const int*)(ws + CTLB_META); if (ntl > 0 && ntl <= 544) {
        const int row = h % (ntl * 256), j = h2 % DFF; const int e = ((const int*)(ws + CTLB_TILEE))[row >> 8], tok = ((const int*)(ws + WS_ROWMAP))[row];
        const float rs = rsqrtf(((const float*)(ws + CTLB_SS2))[tok] / D + RMS_EPS);
        const bf16_t* w1t = (const bf16_t*)(ws + WS_W1) + (size_t)e * 2048 * D; const int rg = ((j >> 7) << 8) + (j & 127), ru = rg + 128;
        float gl = dotbf((const bf16_t*)(ws + WS_X1B) + (size_t)tok * D, w1t + (size_t)rg * D, D) * rs + a.in[I_B1][e * 2048 + j];
        float up = dotbf((const bf16_t*)(ws + WS_X1B) + (size_t)tok * D, w1t + (size_t)ru * D, D) * rs + a.in[I_B1][e * 2048 + 1024 + j];
        gl = fminf(gl, 7.f); up = fminf(fmaxf(up, -7.f), 7.f);
        const float r = (up + 1.f) * gl / (1.f + expf(-1.702f * gl));
        if (((const float*)(ws + WS_ROWGATE))[row] != 0.f && !closef(bf1(((const bf16_t*)(ws + WS_R1))[(size_t)row * DFF + j]), r, 0.03f, 0.02f)) dbg_fail(dbg, 12); } else dbg_fail(dbg, 12);
    }
    if (phase == PH_MOE2) {
        const int ntl = *(const int*)(ws + CTLB_META); if (ntl > 0 && ntl <= 544) {
        const int row = h % (ntl * 256), c = h2 % D; const int e = ((const int*)(ws + CTLB_TILEE))[row >> 8];
        const float r = (dotbf((const bf16_t*)(ws + WS_R1) + (size_t)row * DFF, (const bf16_t*)(ws + WS_W2) + ((size_t)e * D + c) * DFF, DFF) + a.in[I_B2][e * D + c]) * ((const float*)(ws + WS_ROWGATE))[row];
        if (!closef(bf1(((const bf16_t*)(ws + WS_R2))[(size_t)row * D + c]), r, 0.03f, 0.01f)) dbg_fail(dbg, 13); } else dbg_fail(dbg, 13);
    }
    if (phase == PH_COMBINE) {
        const int m = h % M, c = h2 % D;
        { float r2 = bf1(((const bf16_t*)(ws + WS_X1B))[(size_t)m * D + c]); for (int q = 0; q < 4; ++q) r2 += bf1(((const bf16_t*)(ws + WS_R2))[(size_t)((const int*)(ws + WS_POSOF))[m * 4 + q] * D + c]);
          if (!closef(bf1(((const bf16_t*)(ws + WS_R1))[(size_t)m * D + c]), r2, 0.01f, 0.01f)) dbg_fail(dbg, 14); }
        if (s < 512) { float q = 0.f; for (int i = 0; i < D; ++i) { const float v = bf1(((const bf16_t*)(ws + WS_R1))[(size_t)m * D + i]); q += v * v; }
            if (!closef(((const float*)(ws + WS_RS3))[m], rsqrtf(q / D + RMS_EPS), 0.01f, 0.f)) dbg_fail(dbg, 14); }
    }
    if (phase == PH_PLE) {
        const int m = h % M, c = h2 % D;
        const float pp = dotbf((const bf16_t*)(ws + WS_PB) + (size_t)m * PLE, (const bf16_t*)(ws + WS_WPP) + (size_t)c * PLE, PLE);
        const float ppk = bf1(((const bf16_t*)(ws + WS_PP))[(size_t)m * D + c]);
        if (!closef(ppk, pp, 0.02f, 0.01f)) dbg_fail(dbg, 16);
        const float gate = 1.f / (1.f + expf(-dotbf((const bf16_t*)(ws + WS_R1) + (size_t)m * D, (const bf16_t*)(ws + WS_WPG) + (size_t)c * D, D) * ((const float*)(ws + WS_RS3))[m]));
        const float r3 = bf1(((const bf16_t*)(ws + WS_R1))[(size_t)m * D + c]) + gate * ppk;
        if (!closef(bf1(((const bf16_t*)(ws + WS_R1 + 128 * MiB))[(size_t)m * D + c]), r3, 0.02f, 0.03f)) dbg_fail(dbg, 15);
    }
}
__global__ void __launch_bounds__(256) chk_att(Args a) {
    unsigned char* ws = a.ws; unsigned* dbg = (unsigned*)(ws + CTLB_DBG);
    const unsigned char* pj = ws + WS_R1; const bf16_t* attn = (const bf16_t*)(ws + WS_R2 + 64 * MiB) + 512; const int* sel = (const int*)(ws + WS_SEL);
    const int special[16] = {0, 5, 63, 64, 200, 255, 256, 257, 300, 449, 512, 1000, 2047, 4096, 9000, 16383};
    const int sb = blockIdx.x; int t = (sb < 16) ? special[sb] : (int)(hash_u(sb * 977u + 5u) % SEQ); const int b = sb & 1; const int row = b * SEQ + t;
    __shared__ unsigned bitmap[512]; __shared__ unsigned skey[256]; __shared__ int s_bad, s_viol; __shared__ unsigned s_min; __shared__ float sc[8][256];
    const int tid = threadIdx.x;
    for (int i = tid; i < 512; i += 256) bitmap[i] = 0u;
    if (tid == 0) { s_bad = 0; s_viol = 0; s_min = 0xFFFFFFFFu; }
    __syncthreads();
    const int nsel = (t + 1) < 256 ? (t + 1) : 256;
    auto score_key = [&](int kp) -> unsigned {
        float s = 0.f;
        for (int hd = 0; hd < 8; ++hd) { float l = 0.f; for (int d = 0; d < 64; ++d) l += pjv(pj, row, C_QI + hd * 64 + d) * pjv(pj, b * SEQ + kp, C_KI + d);
            s = fmaf(fmaxf(l, 0.f), pjv(pj, row, C_WI + hd), s); }
        const unsigned ub = __builtin_bit_cast(unsigned, s); const unsigned srt = ub ^ ((ub >> 31) ? 0xFFFFFFFFu : 0x80000000u);
        return (srt & 0xFFFFC000u) | (unsigned)(16383 - kp);
    };
    { const int kp = sel[(size_t)row * 256 + tid];
      if (tid < nsel) { if (kp < 0 || kp > t) atomicAdd(&s_bad, 1); else { const unsigned old = atomicOr(&bitmap[kp >> 5], 1u << (kp & 31)); if (old & (1u << (kp & 31))) atomicAdd(&s_bad, 1);
            const unsigned pk = score_key(kp); skey[tid] = pk; atomicMin(&s_min, pk); } }
      else if (kp != -1) atomicAdd(&s_bad, 1); }
    __syncthreads();
    if (s_bad == 0) {
        for (int kp = tid; kp <= t; kp += 256) { if (!((bitmap[kp >> 5] >> (kp & 31)) & 1u)) { if (score_key(kp) > s_min) atomicAdd(&s_viol, 1); } }
    }
    __syncthreads();
    if (tid == 0 && (s_bad != 0 || s_viol > 3)) dbg_fail(dbg, 6);
    if (s_bad != 0) return;
    for (int hd = 0; hd < 8; ++hd) { float l = -1e30f;
        if (tid < nsel) { const int kp = sel[(size_t)row * 256 + tid]; l = 0.f; for (int d = 0; d < 64; ++d) l += pjv(pj, row, C_Q + hd * 64 + d) * pjv(pj, b * SEQ + kp, C_K + (hd >> 2) * 64 + d); }
        sc[hd][tid] = l; }
    __syncthreads();
    for (int o = tid; o < 512; o += 256) { const int hd = o >> 6, d = o & 63; float mx = -1e30f; for (int i = 0; i < nsel; ++i) mx = fmaxf(mx, sc[hd][i]);
        float se = 0.f, ov = 0.f; for (int i = 0; i < nsel; ++i) { const float p = expf(sc[hd][i] - mx); se += p; ov += p * pjv(pj, b * SEQ + sel[(size_t)row * 256 + i], C_V + (hd >> 2) * 64 + 16 * (d & 3) + (d >> 2)); }
        if (!closef(bf1(attn[(size_t)row * 1024 + o]), ov / se, 0.03f, 0.01f)) dbg_fail(dbg, 7); }
}
__global__ void __launch_bounds__(256) chk_report(Args a) {
    const unsigned* dbg = (const unsigned*)(a.ws + CTLB_DBG);
    int code = 0; for (int c = 20; c < 32; ++c) if (dbg[c] != 0u) { code = c; break; }
    if (code == 0) for (int c = 1; c < 20; ++c) if (dbg[c] != 0u) { code = c; break; }
    if (code == 0) return;
    const float v = sqrtf((float)code);
    for (size_t i = (size_t)blockIdx.x * 256 + threadIdx.x; i < (size_t)M * D; i += (size_t)gridDim.x * 256) a.out[i] = v;
}
#endif

extern "C" void kernel_launch(void* const* d_in, const int* in_sizes, int n_in, void* d_out, int out_size, void* d_ws, size_t ws_size, hipStream_t stream) {
    static int grid = 0;
    if (grid == 0) {
        if (n_in != 20 || out_size != M * D || ws_size < WS_END) { fprintf(stderr, "kernel_launch: unexpected shapes (n_in %d out %d ws %zu)\n", n_in, out_size, ws_size); grid = -1; return; }
        int dev = 0, cus = 0, per_cu = 0;
        if (hipGetDevice(&dev) != hipSuccess || hipDeviceGetAttribute(&cus, hipDeviceAttributeMultiprocessorCount, dev) != hipSuccess) { grid = -1; return; }
        if (hipFuncSetAttribute((const void*)fwd, hipFuncAttributeMaxDynamicSharedMemorySize, LDS_BYTES) != hipSuccess) { fprintf(stderr, "kernel_launch: hipFuncSetAttribute failed\n"); grid = -1; return; }
        if (hipOccupancyMaxActiveBlocksPerMultiprocessor(&per_cu, (const void*)fwd, NTHREADS, LDS_BYTES) != hipSuccess || per_cu < 1) fprintf(stderr, "kernel_launch: occupancy query says %d\n", per_cu);
        (void)hipGetLastError();
        grid = cus;
    }
    if (grid < 0) return;
    (void)hipMemsetAsync((char*)d_ws + WS_CTL, 0, CTL_ZERO_BYTES, stream);
    Args a{};
    for (int i = 0; i < 20; ++i) a.in[i] = (const float*)d_in[i];
    a.out = (float*)d_out; a.ws = (unsigned char*)d_ws;
#if DBG
    for (int p = 0; p < NPH; ++p) {
        a.ph_lo = p; a.ph_hi = p + 1;
        hipLaunchKernelGGL(fwd, dim3(grid), dim3(NTHREADS), LDS_BYTES, stream, a);
        if (p == PH_ATT) hipLaunchKernelGGL(chk_att, dim3(48), dim3(256), 0, stream, a);
        else if (p != PH_FINAL && p != PH_POOL) hipLaunchKernelGGL(chk, dim3(32), dim3(256), 0, stream, a, p);
    }
    hipLaunchKernelGGL(chk_report, dim3(1024), dim3(256), 0, stream, a);
#else
    a.ph_lo = 0; a.ph_hi = NPH;
    hipLaunchKernelGGL(fwd, dim3(grid), dim3(NTHREADS), LDS_BYTES, stream, a);
#endif
}
```

```cpp
#include <hip/hip_runtime.h>
#include <cstdio>
#include <cstdint>

#ifndef DBG
#define DBG 0
#endif

#define LAS __attribute__((address_space(3)))
#define GAS __attribute__((address_space(1)))
typedef unsigned short bf16_t;
typedef short bf16x8 __attribute__((ext_vector_type(8)));
typedef float f32x4 __attribute__((ext_vector_type(4)));
typedef float f32x16 __attribute__((ext_vector_type(16)));
typedef unsigned u32x4 __attribute__((ext_vector_type(4)));
typedef unsigned u32x2 __attribute__((ext_vector_type(2)));

constexpr int M = 32768, SEQ = 16384, D = 1024, NP = 4096, NE = 32, DFF = 1024, PLE = 256;
constexpr int IN_COLS = 3912;
constexpr int C_U = 0, C_Q = 512, C_K = 1024, C_V = 1152, C_QI = 1280, C_KI = 1792, C_WI = 1856, C_GP = 2048, C_GA = 3072;
constexpr int MOE_ROWS = M * 4 + NE * 256;
constexpr float RMS_EPS = 1e-6f;
constexpr int NWAVES = 8, NTHREADS = 512;

constexpr size_t MiB = 1u << 20;
constexpr size_t WS_CTL = 0, CTL_ZERO_BYTES = 1 * MiB;
constexpr size_t CTLB_BAR = 16384;
constexpr size_t CTLB_QUEUE = 65536;
constexpr size_t CTLB_META = 65536 + 256;
constexpr size_t CTLB_DBG = 131072;
constexpr size_t CTLB_SS2 = 262144;
constexpr size_t CTLB_SS4 = 393216;
constexpr size_t CTLB_CNTWG = 524288;
constexpr size_t CTLB_TILEE = 589824;
constexpr size_t WS_WIN = 1 * MiB, WS_WPC = 9 * MiB, WS_WBA = 10 * MiB, WS_WOUT = 11 * MiB, WS_WR = 13 * MiB, WS_WPG = 14 * MiB, WS_WPP = 16 * MiB;
constexpr size_t WS_RS1 = 17 * MiB, WS_RS3 = 17 * MiB + 131072;
constexpr size_t WS_TOPI = 18 * MiB, WS_TOPG = 18 * MiB + 524288, WS_LRANK = 19 * MiB, WS_POSOF = 19 * MiB + 524288;
constexpr size_t WS_ROWMAP = 20 * MiB, WS_ROWGATE = 21 * MiB, WS_ROWSCALE = 17 * MiB + 262144;
constexpr size_t WS_W1 = 22 * MiB, WS_W2 = 150 * MiB, WS_PB = 214 * MiB, WS_X1B = 230 * MiB;
constexpr size_t WS_R1 = 294 * MiB;
constexpr size_t WS_R2 = 566 * MiB;
constexpr size_t PJ_U = 0, PJ_Q = 32 * MiB, PJ_KV = 64 * MiB, PJ_QI = 80 * MiB, PJ_KW = 112 * MiB, PJ_G = 120 * MiB;
constexpr size_t WS_SEL = 838 * MiB;
constexpr size_t WS_PP = 870 * MiB;
constexpr size_t WS_END = 934 * MiB;

constexpr int LDS_MAIN = 0;
constexpr int LDS_KT = 131072;
constexpr int LDS_HIST = 147456;
constexpr int LDS_ATM = 155648;
constexpr int LDS_MISC = 156672;
constexpr int LDS_BYTES = 157696;

__device__ __forceinline__ unsigned f2bf(float f) { unsigned u = __builtin_bit_cast(unsigned, f); return (u + 0x7fffu + ((u >> 16) & 1u)) >> 16; }
__device__ __forceinline__ unsigned pk2(float lo, float hi) { return f2bf(lo) | (f2bf(hi) << 16); }
__device__ __forceinline__ float bf_lo(unsigned w) { return __builtin_bit_cast(float, w << 16); }
__device__ __forceinline__ float bf_hi(unsigned w) { return __builtin_bit_cast(float, w & 0xffff0000u); }
__device__ __forceinline__ float bf1(bf16_t b) { return __builtin_bit_cast(float, ((unsigned)b) << 16); }
typedef float f32x2_ __attribute__((ext_vector_type(2)));
__device__ __forceinline__ u32x2 fp8x4_to_bf16x4(unsigned w) {
    const f32x2_ a = __builtin_amdgcn_cvt_pk_f32_fp8((int)w, false), b = __builtin_amdgcn_cvt_pk_f32_fp8((int)w, true);
    const float ax = a.x, ay = a.y, bx = b.x, by = b.y;
    u32x2 r; r.x = __builtin_amdgcn_perm(__float_as_uint(ay), __float_as_uint(ax), 0x07060302u);
    r.y = __builtin_amdgcn_perm(__float_as_uint(by), __float_as_uint(bx), 0x07060302u); return r;
}
__device__ __forceinline__ bf16x8 fp8x8_to_bf16x8(unsigned w0, unsigned w1) { const u32x2 a = fp8x4_to_bf16x4(w0), b = fp8x4_to_bf16x4(w1); return __builtin_bit_cast(bf16x8, (u32x4){a.x, a.y, b.x, b.y}); }
__device__ __forceinline__ float clamp_e4m3(float v) { return __builtin_amdgcn_fmed3f(v, -448.0f, 448.0f); }
__device__ __forceinline__ unsigned pk4_fp8(float a, float b, float c, float d) { int w = __builtin_amdgcn_cvt_pk_fp8_f32(clamp_e4m3(a), clamp_e4m3(b), 0, false); w = __builtin_amdgcn_cvt_pk_fp8_f32(clamp_e4m3(c), clamp_e4m3(d), w, true); return (unsigned)w; }
__device__ __forceinline__ float sigmoidf_(float x) { return __builtin_amdgcn_rcpf(1.0f + __expf(-x)); }
#define LDS_WAIT() asm volatile("s_waitcnt lgkmcnt(0)" ::: "memory")
#define VM_WAIT() asm volatile("s_waitcnt vmcnt(0)" ::: "memory")
__device__ __forceinline__ float wave_sum(float v) {
#pragma unroll
    for (int o = 1; o < 64; o <<= 1) v += __shfl_xor(v, o);
    return v;
}

#define XB_TMO      128
#define XB_XCNT(j)  (256  + 64 * (j))
#define XB_XSUB(j)  (1280 + 64 * (j))
#define XB_XGEN(j)  (2304 + 64 * (j))
#define XB_TOP      3328
#define XB_TOPGEN   3392
#define XCD_BAR_WORDS 3456
#define XB_SPIN_CAP (1u << 22)
__device__ __forceinline__ unsigned xb_ld(unsigned* p)              { return __hip_atomic_load(p, __ATOMIC_RELAXED, __HIP_MEMORY_SCOPE_AGENT); }
__device__ __forceinline__ unsigned xb_add(unsigned* p, unsigned v) { return __hip_atomic_fetch_add(p, v, __ATOMIC_RELAXED, __HIP_MEMORY_SCOPE_AGENT); }
__device__ __forceinline__ unsigned xb_xcc_id() { return (unsigned)__builtin_amdgcn_s_getreg((3 << 11) | 20) & 0xFu; }
#define XB_SPIN(cond, bar) do { unsigned _sp = 0; while (cond) { __builtin_amdgcn_s_sleep(1); \
    if ((++_sp & 255u) == 0u) { if (xb_ld(&(bar)[XB_TMO])) break; if (_sp > XB_SPIN_CAP) { atomicAdd(&(bar)[XB_TMO], 1u); break; } } } } while (0)
struct XcdBarrier { unsigned* bar; unsigned x; volatile LAS unsigned* st; };
__device__ __forceinline__ XcdBarrier xcd_barrier_post(unsigned* bar, volatile LAS unsigned* st) {
    XcdBarrier b; b.bar = bar; b.x = xb_xcc_id(); b.st = st;
    if (threadIdx.x == 0) (void)xb_add(&bar[XB_XCNT(b.x)], 1u);
    return b;
}
__device__ __forceinline__ void xcd_barrier_complete(unsigned* bar, unsigned x, unsigned& nloc, unsigned& nx) {
    const unsigned G = gridDim.x * gridDim.y * gridDim.z;
    unsigned sum, cnt, mine, sp = 0u;
    for (;;) {
        sum = 0u; cnt = 0u; mine = 0u;
#pragma unroll
        for (unsigned j = 0; j < 16; ++j) { const unsigned c = xb_ld(&bar[XB_XCNT(j)]); sum += c; cnt += (c > 0u) ? 1u : 0u; mine = (j == x) ? c : mine; }
        if (sum == G) break;
        __builtin_amdgcn_s_sleep(1);
        if ((++sp & 255u) == 0u) { if (xb_ld(&bar[XB_TMO])) break; if (sp > XB_SPIN_CAP) { atomicAdd(&bar[XB_TMO], 1u); break; } }
    }
    nloc = mine > 0u ? mine : 1u; nx = cnt > 0u ? cnt : 1u;
}
__device__ __forceinline__ void xcd_barrier(const XcdBarrier& b) {
    asm volatile("s_waitcnt vmcnt(0)" ::: "memory");
    __syncthreads();
    if (threadIdx.x == 0) {
        unsigned* bar = b.bar;
        __builtin_amdgcn_s_waitcnt(0);
        unsigned nloc = b.st[0], nx = b.st[1];
        if (nloc == 0u) { xcd_barrier_complete(bar, b.x, nloc, nx); b.st[0] = nloc; b.st[1] = nx; }
        const unsigned old = xb_add(&bar[XB_XSUB(b.x)], 1u);
        const unsigned gen = old / nloc;
        if (old + 1u == (gen + 1u) * nloc) {
            __builtin_amdgcn_fence(__ATOMIC_RELEASE, "agent");
            asm volatile("s_waitcnt vmcnt(0)" ::: "memory");
            const unsigned og = xb_add(&bar[XB_TOP], 1u);
            const unsigned tg = og / nx;
            if (og + 1u == (tg + 1u) * nx) xb_add(&bar[XB_TOPGEN], 1u);
            else XB_SPIN(xb_ld(&bar[XB_TOPGEN]) == tg, bar);
            __builtin_amdgcn_fence(__ATOMIC_ACQUIRE, "agent");
            xb_add(&bar[XB_XGEN(b.x)], 1u);
            asm volatile("s_waitcnt vmcnt(0)" ::: "memory");
        } else {
            XB_SPIN(xb_ld(&bar[XB_XGEN(b.x)]) == gen, bar);
            __builtin_amdgcn_fence(__ATOMIC_ACQUIRE, "agent");
            asm volatile("s_waitcnt vmcnt(0)" ::: "memory");
        }
    }
    __syncthreads();
}

namespace pg8 {
constexpr int BM = 256, BK = 64, HALF = 128, HTB = HALF * BK * 2, STAGE_BYTES = 8 * HTB, NXCD = 8, WGM = 8;
__host__ __device__ __forceinline__ int lds_byte(int r, int c) { const int st = (r >> 4) * 2 + (c >> 5), rr = r & 15, cc = c & 31, ob = rr * 64 + cc * 2; return st * 1024 + (ob ^ (((ob >> 9) & 1) << 5)); }
__host__ __device__ __forceinline__ void stage_rc(int b, int& R, int& C) { const int st = b / 1024, sb = b % 1024, swz = sb ^ (((sb >> 9) & 1) << 5); R = (st >> 1) * 16 + swz / 64; C = (st & 1) * 32 + (swz % 64) / 2; }
__host__ __device__ __forceinline__ int perm32(int rho) { const int n = rho >> 4, i = rho & 15; return 8 * (i >> 2) + 4 * n + (i & 3); }

struct Unit { int pm, pn, e; };
struct Gemm { const bf16_t* A; const bf16_t* Bt; int M, N, K; size_t bstride; const int* rowmap; };

struct StaticOrder {
    int nM, nN, nwg, G, c;
    __device__ void init(int M_, int N_, int G_, int c_) { nM = M_ / BM; nN = N_ / BM; nwg = nM * nN; G = G_; c = c_; }
    __device__ bool next(int i, Unit& u) const {
        const long L = (long)i * G + c; if (L >= nwg) return false;
        int wgid = (int)L; { const int q = nwg / NXCD, r = nwg % NXCD, xcd = wgid % NXCD, off = wgid / NXCD; wgid = (xcd < r ? xcd * (q + 1) : r * (q + 1) + (xcd - r) * q) + off; }
        const int nig = WGM * nN, gid = wgid / nig, fm = gid * WGM, gsz = (nM - fm) < WGM ? (nM - fm) : WGM;
        u.pm = fm + ((wgid % nig) % gsz); u.pn = (wgid % nig) / gsz; u.e = 0; return true;
    }
};
struct MoeOrder {
    const LAS int* tile_e; int ntiles, nct, G, c;
    __device__ bool next(int i, Unit& u) const {
        const int v = (G % 8 == 0) ? (c % 8) * (G / 8) + c / 8 : c;
        const long L = (long)i * G + v; if (L >= (long)ntiles * nct) return false;
        u.pm = (int)(L / nct); u.pn = (int)(L % nct); u.e = __builtin_amdgcn_readfirstlane(tile_e[u.pm]); return true;
    }
};

struct PPOrder {
    int S, r;
    __device__ __forceinline__ bool next(int i, Unit& u) const { if (r < 0) return false; const int L = r + i * S; if (L >= 512) return false; u.pm = L >> 2; u.pn = L & 3; u.e = 0; return true; }
};
__device__ __forceinline__ unsigned cvt_pk_bf16(float lo, float hi) { unsigned r; asm volatile("v_cvt_pk_bf16_f32 %0, %1, %2" : "=v"(r) : "v"(lo), "v"(hi)); return r; }

struct NoHook { static constexpr bool ACTIVE = false; };
typedef int v8i32 __attribute__((ext_vector_type(8)));
typedef long i64x2 __attribute__((ext_vector_type(2)));
template <class Epi, class Sched, bool GATHER, class Hook = NoHook, int FP8 = 0>
__device__ __forceinline__ void gemm_phase(LAS unsigned char* lds, const Gemm g, const Sched& S, const Epi& E, const Hook& Hk = Hook()) {
    int tid_ = (int)threadIdx.x; asm volatile("" : "+v"(tid_));
    const int tid = tid_, wid = __builtin_amdgcn_readfirstlane(tid >> 6), lane = tid & 63, wr = wid >> 2, wc = wid & 3, fr = lane & 15, fq = lane >> 4;
    const int K = g.K, nt = K / BK;
    unsigned voffA[2][2], nvoffA[2][2], voffB[2]; int RA[2], CA[2];
#pragma unroll
    for (int i = 0; i < 2; ++i) { int R, C; stage_rc(tid * 16 + i * 8192, R, C); const int Rb = Epi::PERM ? ((R & ~31) + perm32(R & 31)) : R;
        RA[i] = R; CA[i] = C; voffB[i] = (unsigned)(Rb * K + C) * 2u; }
    const size_t kstep = (size_t)(BK * 2);
    const size_t hstep = (size_t)HALF * K * 2;
    const size_t tstep = 2 * hstep;
    const unsigned ldsw = (unsigned)wid * 1024u;
    const int aoff = lds_byte(wr * 64 + fr, fq * 8), boff = lds_byte(wc * 32 + fr, fq * 8);
#define PG8_SA(b, h) (((b) * 2 + (h)) * HTB)
#define PG8_SB(b, h) ((4 + (b) * 2 + (h)) * HTB)
      \
    const __amdgpu_buffer_rsrc_t rsA = __builtin_amdgcn_make_buffer_rsrc((void*)g.A, 0, 0x7FFFFFFF, 0x00020000), rsB = __builtin_amdgcn_make_buffer_rsrc((void*)g.Bt, 0, 0x7FFFFFFF, 0x00020000);
#define PG8_STAGE2(bufoff, gbase, v0, v1) do { \
        if constexpr (true) { if ((bufoff) < 4 * HTB) { const int so_ = (int)((const char*)(gbase) - (const char*)g.A); \
                __builtin_amdgcn_raw_ptr_buffer_load_lds(rsA, (LAS void*)(lds + (bufoff) + ldsw), 16, (int)(v0), so_, 0, 0); __builtin_amdgcn_raw_ptr_buffer_load_lds(rsA, (LAS void*)(lds + (bufoff) + ldsw + 8192), 16, (int)(v1), so_, 0, 0); } \
            else { const int so_ = (int)((const char*)(gbase) - (const char*)g.Bt); \
                __builtin_amdgcn_raw_ptr_buffer_load_lds(rsB, (LAS void*)(lds + (bufoff) + ldsw), 16, (int)(v0), so_, 0, 0); __builtin_amdgcn_raw_ptr_buffer_load_lds(rsB, (LAS void*)(lds + (bufoff) + ldsw + 8192), 16, (int)(v1), so_, 0, 0); } } \
        else { \
        __builtin_amdgcn_global_load_lds((const unsigned*)((const char*)(gbase) + (v0)), (LAS unsigned*)(lds + (bufoff) + ldsw), 16, 0, 0); \
        __builtin_amdgcn_global_load_lds((const unsigned*)((const char*)(gbase) + (v1)), (LAS unsigned*)(lds + (bufoff) + ldsw + 8192), 16, 0, 0); } } while (0)
#define PG8_STAGEB(bufoff, gbase) PG8_STAGE2(bufoff, gbase, voffB[0], voffB[1])
#define PG8_LDA(dst, b, h) do { _Pragma("unroll") for (int m = 0; m < 4; ++m) _Pragma("unroll") for (int k = 0; k < 2; ++k) dst[m][k] = *(const LAS bf16x8*)(lds + PG8_SA(b, h) + aoff + m * 2048 + k * 1024); } while (0)
#define PG8_LDB(dst, b, h) do { _Pragma("unroll") for (int n = 0; n < 2; ++n) _Pragma("unroll") for (int k = 0; k < 2; ++k) dst[n][k] = *(const LAS bf16x8*)(lds + PG8_SB(b, h) + boff + n * 2048 + k * 1024); } while (0)
#define PG8_MMA(ai, bj, At, Bt) do { __builtin_amdgcn_s_setprio(1); \
        if constexpr (FP8 == 2) { _Pragma("unroll") for (int m = 0; m < 4; ++m) _Pragma("unroll") for (int n = 0; n < 2; ++n) { \
            const v8i32 b_ = __builtin_bit_cast(v8i32, __builtin_shufflevector(Bt[n][0], Bt[n][1], 0, 1, 2, 3, 4, 5, 6, 7, 8, 9, 10, 11, 12, 13, 14, 15)); \
            const v8i32 a_ = __builtin_bit_cast(v8i32, __builtin_shufflevector(At[m][0], At[m][1], 0, 1, 2, 3, 4, 5, 6, 7, 8, 9, 10, 11, 12, 13, 14, 15)); \
            asm volatile("v_mfma_scale_f32_16x16x128_f8f6f4 %0, %1, %2, %0, %3, %3 op_sel_hi:[0,0,0]" : "+v"(acc[ai][bj][m][n]) : "v"(b_), "v"(a_), "v"(sc1_)); } } \
        else if constexpr (FP8 == 1) { _Pragma("unroll") for (int m = 0; m < 4; ++m) _Pragma("unroll") for (int n = 0; n < 2; ++n) _Pragma("unroll") for (int k = 0; k < 2; ++k) { \
            const i64x2 b_ = __builtin_bit_cast(i64x2, Bt[n][k]), a_ = __builtin_bit_cast(i64x2, At[m][k]); \
            acc[ai][bj][m][n] = __builtin_amdgcn_mfma_f32_16x16x32_fp8_fp8(b_.x, a_.x, acc[ai][bj][m][n], 0, 0, 0); acc[ai][bj][m][n] = __builtin_amdgcn_mfma_f32_16x16x32_fp8_fp8(b_.y, a_.y, acc[ai][bj][m][n], 0, 0, 0); } } \
        else { _Pragma("unroll") for (int m = 0; m < 4; ++m) _Pragma("unroll") for (int n = 0; n < 2; ++n) _Pragma("unroll") for (int k = 0; k < 2; ++k) \
            acc[ai][bj][m][n] = __builtin_amdgcn_mfma_f32_16x16x32_bf16(Bt[n][k], At[m][k], acc[ai][bj][m][n], 0, 0, 0); } \
        __builtin_amdgcn_s_setprio(0); } while (0)
#define PG8_WAIT_V(n) asm volatile("s_waitcnt vmcnt(" #n ")" ::: "memory")
#define PG8_WAIT_L(n) asm volatile("s_waitcnt lgkmcnt(" #n ")" ::: "memory")
#define PG8_BAR __builtin_amdgcn_s_barrier()
#define PG8_SCHED __builtin_amdgcn_sched_barrier(0)
    Unit cur, nxt; int ui = 0;
    if (!S.next(0, cur)) return;
    int sc1_ = 0x7F7F7F7F; if constexpr (FP8 == 2) asm volatile("" : "+v"(sc1_));
    f32x4 acc[2][2][4][2];
#pragma unroll
    for (int a = 0; a < 2; ++a)
#pragma unroll
        for (int b = 0; b < 2; ++b)
#pragma unroll
            for (int m = 0; m < 4; ++m)
#pragma unroll
                for (int n = 0; n < 2; ++n) acc[a][b][m][n] = (f32x4){0.f, 0.f, 0.f, 0.f};
    bf16x8 At[4][2], B0[2][2], B1[2][2];
#pragma unroll
    for (int h = 0; h < 2; ++h)
#pragma unroll
        for (int i = 0; i < 2; ++i) {
            if constexpr (GATHER) voffA[h][i] = ((unsigned)g.rowmap[cur.pm * BM + h * HALF + RA[i]] * (unsigned)K + (unsigned)CA[i]) * 2u;
            else voffA[h][i] = (unsigned)((h * HALF + RA[i]) * K + CA[i]) * 2u;
            if constexpr (GATHER) nvoffA[h][i] = voffA[h][i];
        }
    const char* cA = GATHER ? (const char*)g.A : (const char*)g.A + (size_t)cur.pm * tstep;
    const char* cB = (const char*)g.Bt + (size_t)cur.e * g.bstride + (size_t)cur.pn * tstep;
    PG8_STAGEB(PG8_SB(0, 0), cB); PG8_STAGE2(PG8_SA(0, 0), cA, voffA[0][0], voffA[0][1]); PG8_STAGEB(PG8_SB(0, 1), cB + hstep); PG8_STAGE2(PG8_SA(0, 1), cA, voffA[1][0], voffA[1][1]);
    if (wr == 1) PG8_BAR;
    PG8_WAIT_V(4); PG8_BAR;
    PG8_STAGEB(PG8_SB(1, 0), cB + kstep); PG8_STAGE2(PG8_SA(1, 0), cA + kstep, voffA[0][0], voffA[0][1]); PG8_STAGEB(PG8_SB(1, 1), cB + hstep + kstep);
    PG8_WAIT_V(6); PG8_BAR;
    for (;;) {
        const bool has_next = S.next(ui + 1, nxt);
        const char* nA = has_next ? (GATHER ? (const char*)g.A : (const char*)g.A + (size_t)nxt.pm * tstep) : cA;
        const char* nB = has_next ? (const char*)g.Bt + (size_t)nxt.e * g.bstride + (size_t)nxt.pn * tstep : cB;
        if constexpr (GATHER) {
            if (has_next) {
#pragma unroll
                for (int h = 0; h < 2; ++h)
#pragma unroll
                    for (int i = 0; i < 2; ++i) nvoffA[h][i] = ((unsigned)g.rowmap[nxt.pm * BM + h * HALF + RA[i]] * (unsigned)K + (unsigned)CA[i]) * 2u;
            }
        }
        for (int t = 0; t < nt; t += 2) {
            const bool last = (t == nt - 2);
            if constexpr (Hook::ACTIVE) { if (t == nt / 2) Hk.mid(acc, cur); }
            const char* a1 = cA + (size_t)(t + 1) * kstep;
            const char* a2 = last ? nA : cA + (size_t)(t + 2) * kstep; const char* b2 = last ? nB : cB + (size_t)(t + 2) * kstep;
            const char* a3 = a2 + kstep; const char* b3 = b2 + kstep;
            unsigned w00 = voffA[0][0], w01 = voffA[0][1], w10 = voffA[1][0], w11 = voffA[1][1];
            if constexpr (GATHER) { if (last) { w00 = nvoffA[0][0]; w01 = nvoffA[0][1]; w10 = nvoffA[1][0]; w11 = nvoffA[1][1]; } }
            PG8_LDB(B0, 0, 0); PG8_SCHED; PG8_LDA(At, 0, 0); PG8_STAGE2(PG8_SA(1, 1), a1, voffA[1][0], voffA[1][1]);
            PG8_WAIT_L(8); PG8_BAR; PG8_WAIT_L(0); PG8_MMA(0, 0, At, B0); PG8_BAR; PG8_SCHED;
            PG8_LDB(B1, 0, 1); PG8_STAGEB(PG8_SB(0, 0), b2);
            PG8_BAR; PG8_WAIT_L(0); PG8_MMA(0, 1, At, B1); PG8_BAR;
            PG8_LDA(At, 0, 1); PG8_STAGE2(PG8_SA(0, 0), a2, w00, w01);
            PG8_BAR; PG8_WAIT_L(0); PG8_MMA(1, 0, At, B0); PG8_BAR; PG8_SCHED;
            PG8_STAGEB(PG8_SB(0, 1), b2 + hstep);
            PG8_WAIT_V(6); PG8_BAR; PG8_MMA(1, 1, At, B1); PG8_BAR;
            PG8_LDB(B0, 1, 0); PG8_SCHED; PG8_LDA(At, 1, 0); PG8_STAGE2(PG8_SA(0, 1), a2, w10, w11);
            PG8_WAIT_L(8); PG8_BAR; PG8_WAIT_L(0); PG8_MMA(0, 0, At, B0); PG8_BAR; PG8_SCHED;
            PG8_LDB(B1, 1, 1); PG8_STAGEB(PG8_SB(1, 0), b3);
            PG8_BAR; PG8_WAIT_L(0); PG8_MMA(0, 1, At, B1); PG8_BAR;
            PG8_LDA(At, 1, 1); PG8_STAGE2(PG8_SA(1, 0), a3, w00, w01);
            PG8_BAR; PG8_WAIT_L(0); PG8_MMA(1, 0, At, B0); PG8_BAR; PG8_SCHED;
            PG8_STAGEB(PG8_SB(1, 1), b3 + hstep);
            PG8_WAIT_V(6); PG8_BAR; PG8_MMA(1, 1, At, B1); PG8_BAR;
        }
        if constexpr (FP8 == 2) asm volatile("s_nop 15\n\ts_nop 15" ::: "memory");
        E(acc, cur, wr, wc, fr, fq);
        if (!has_next) break;
#pragma unroll
        for (int a = 0; a < 2; ++a)
#pragma unroll
            for (int b = 0; b < 2; ++b)
#pragma unroll
                for (int m = 0; m < 4; ++m)
#pragma unroll
                    for (int n = 0; n < 2; ++n) acc[a][b][m][n] = (f32x4){0.f, 0.f, 0.f, 0.f};
        cur = nxt; cA = nA; cB = nB; ++ui;
        if constexpr (GATHER) {
#pragma unroll
            for (int h = 0; h < 2; ++h)
#pragma unroll
                for (int i = 0; i < 2; ++i) voffA[h][i] = nvoffA[h][i];
        }
    }
    PG8_WAIT_V(0);
    if (wr == 0) PG8_BAR;
    PG8_BAR;
#undef PG8_SA
#undef PG8_SB
#undef PG8_STAGE2
#undef PG8_STAGEB
#undef PG8_LDA
#undef PG8_LDB
#undef PG8_MMA
#undef PG8_WAIT_V
#undef PG8_WAIT_L
#undef PG8_BAR
#undef PG8_SCHED
}
}
using pg8::Unit;

typedef f32x4 AccT[2][2][4][2];
struct EpiProj {
    static constexpr bool PERM = true;
    unsigned char* pj; const float* rs;
    __device__ __forceinline__ void operator()(const AccT& acc, const Unit& u, int wr, int wc, int fr, int fq) const {
        const int pn = u.pn; const bool sig = pn >= 8;
        bf16_t* base; int ld, nbj = 2;
        if (pn < 2)       { base = (bf16_t*)(pj + PJ_U) + pn * 256; ld = 512; }
        else if (pn < 4) {
            unsigned char* q8 = pj + PJ_Q + (pn - 2) * 256; const int row0 = u.pm * 256 + wr * 64 + fr, cb = wc * 32 + 8 * fq;
            float sv[8];
#pragma unroll
            for (int g = 0; g < 8; ++g) sv[g] = rs[row0 + (g >> 2) * 128 + (g & 3) * 16];
#pragma unroll
            for (int ai = 0; ai < 2; ++ai)
#pragma unroll
                for (int m = 0; m < 4; ++m) { const int row = row0 + ai * 128 + m * 16; const float s = sv[ai * 4 + m];
#pragma unroll
                    for (int bj = 0; bj < 2; ++bj) { const f32x4 v0 = acc[ai][bj][m][0] * s, v1 = acc[ai][bj][m][1] * s;
                        u32x2 w; w.x = pk4_fp8(v0[0], v0[1], v0[2], v0[3]); w.y = pk4_fp8(v1[0], v1[1], v1[2], v1[3]);
                        *(u32x2*)(q8 + (size_t)row * 512 + bj * 128 + cb) = w; } }
            return; }
        else if (pn == 4) {
            unsigned char* kv8 = pj + PJ_KV; const int row0 = u.pm * 256 + wr * 64 + fr, cb = wc * 32 + 8 * fq;
            float sv[8];
#pragma unroll
            for (int g = 0; g < 8; ++g) sv[g] = rs[row0 + (g >> 2) * 128 + (g & 3) * 16];
#pragma unroll
            for (int ai = 0; ai < 2; ++ai)
#pragma unroll
                for (int m = 0; m < 4; ++m) { const int row = row0 + ai * 128 + m * 16; const float s = sv[ai * 4 + m];
#pragma unroll
                    for (int bj = 0; bj < 2; ++bj) { const f32x4 v0 = acc[ai][bj][m][0] * s, v1 = acc[ai][bj][m][1] * s;
                        u32x2 w; w.x = pk4_fp8(v0[0], v0[1], v0[2], v0[3]); w.y = pk4_fp8(v1[0], v1[1], v1[2], v1[3]);
                        *(u32x2*)(kv8 + (size_t)row * 256 + bj * 128 + cb) = w; } }
            return; }
        else if (pn < 7)  { base = (bf16_t*)(pj + PJ_QI) + (pn - 5) * 256; ld = 512; }
        else if (pn == 7) { base = (bf16_t*)(pj + PJ_KW); ld = 128; nbj = 1; }
        else              { base = (bf16_t*)(pj + PJ_G) + (pn - 8) * 256; ld = 2048; }
        const int row0 = u.pm * 256 + wr * 64 + fr, col0 = wc * 32 + 8 * fq;
        float sv[8];
#pragma unroll
        for (int g = 0; g < 8; ++g) sv[g] = rs[row0 + (g >> 2) * 128 + (g & 3) * 16];
#pragma unroll
        for (int ai = 0; ai < 2; ++ai)
#pragma unroll
            for (int m = 0; m < 4; ++m) { const int row = row0 + ai * 128 + m * 16; const float s = sv[ai * 4 + m]; bf16_t* rowp = base + (size_t)row * ld + col0;
#pragma unroll
                for (int bj = 0; bj < 2; ++bj) { if (bj < nbj) { f32x4 v0 = acc[ai][bj][m][0] * s, v1 = acc[ai][bj][m][1] * s;
                    if (sig) {
#pragma unroll
                        for (int j = 0; j < 4; ++j) { v0[j] = sigmoidf_(v0[j]); v1[j] = sigmoidf_(v1[j]); } }
                    u32x4 w; w.x = pk2(v0[0], v0[1]); w.y = pk2(v0[2], v0[3]); w.z = pk2(v1[0], v1[1]); w.w = pk2(v1[2], v1[3]);
                    *(u32x4*)(rowp + bj * 128) = w; } } }
    }
};
__device__ __forceinline__ void fp8x8_to_f32(u32x2 w, float (&f)[8]) {
    const f32x2_ a = __builtin_amdgcn_cvt_pk_f32_fp8((int)w.x, false), b = __builtin_amdgcn_cvt_pk_f32_fp8((int)w.x, true), c = __builtin_amdgcn_cvt_pk_f32_fp8((int)w.y, false), d = __builtin_amdgcn_cvt_pk_f32_fp8((int)w.y, true);
    f[0] = a.x; f[1] = a.y; f[2] = b.x; f[3] = b.y; f[4] = c.x; f[5] = c.y; f[6] = d.x; f[7] = d.y; }
__device__ __forceinline__ float ga_clamp(float g) { return fmaxf(g, 8.67361738e-19f); }
struct HookGateRatio {
    static constexpr bool ACTIVE = true;
    const bf16_t* gates;
    __device__ __forceinline__ void mid(AccT& acc, const Unit& u) const {
        int tz = threadIdx.x; asm volatile("" : "+v"(tz));
        const int wid = tz >> 6, ln = tz & 63, wr = wid >> 2, wc = wid & 3, fr = ln & 15, fq = ln >> 4;
        const int row0 = u.pm * 256 + wr * 64 + fr, col0 = u.pn * 256 + wc * 32 + 8 * fq;
        u32x4 gpv[2][2], gav[2][2];
#pragma unroll
        for (int bj = 0; bj < 2; ++bj) { gpv[0][bj] = *(const u32x4*)(gates + (size_t)row0 * 2048 + col0 + bj * 128); gav[0][bj] = *(const u32x4*)(gates + (size_t)row0 * 2048 + 1024 + col0 + bj * 128); }
#pragma unroll
        for (int ai = 0; ai < 2; ++ai)
#pragma unroll
            for (int m = 0; m < 4; ++m) { const int g1 = ai * 4 + m + 1;
                if (g1 < 8) { const int rown = row0 + (g1 >> 2) * 128 + (g1 & 3) * 16;
#pragma unroll
                    for (int bj = 0; bj < 2; ++bj) { gpv[g1 & 1][bj] = *(const u32x4*)(gates + (size_t)rown * 2048 + col0 + bj * 128); gav[g1 & 1][bj] = *(const u32x4*)(gates + (size_t)rown * 2048 + 1024 + col0 + bj * 128); } }
#pragma unroll
                for (int bj = 0; bj < 2; ++bj) {
                    const u32x4 gp = gpv[m & 1][bj], ga = gav[m & 1][bj];
                    acc[ai][bj][m][0][0] *= bf_lo(gp.x) * __builtin_amdgcn_rcpf(ga_clamp(bf_lo(ga.x))); acc[ai][bj][m][0][1] *= bf_hi(gp.x) * __builtin_amdgcn_rcpf(ga_clamp(bf_hi(ga.x)));
                    acc[ai][bj][m][0][2] *= bf_lo(gp.y) * __builtin_amdgcn_rcpf(ga_clamp(bf_lo(ga.y))); acc[ai][bj][m][0][3] *= bf_hi(gp.y) * __builtin_amdgcn_rcpf(ga_clamp(bf_hi(ga.y)));
                    acc[ai][bj][m][1][0] *= bf_lo(gp.z) * __builtin_amdgcn_rcpf(ga_clamp(bf_lo(ga.z))); acc[ai][bj][m][1][1] *= bf_hi(gp.z) * __builtin_amdgcn_rcpf(ga_clamp(bf_hi(ga.z)));
                    acc[ai][bj][m][1][2] *= bf_lo(gp.w) * __builtin_amdgcn_rcpf(ga_clamp(bf_lo(ga.w))); acc[ai][bj][m][1][3] *= bf_hi(gp.w) * __builtin_amdgcn_rcpf(ga_clamp(bf_hi(ga.w)));
                    }
                asm volatile("" ::: "memory"); }
    }
};
template <bool ADD, bool CLAMP = false> struct EpiGate {
    static constexpr bool PERM = true;
    bf16_t* O; const bf16_t* gate; const bf16_t* addsrc;
    __device__ __forceinline__ void operator()(const AccT& acc, const Unit& u, int wr, int wc, int fr, int fq) const {
        const int row0 = u.pm * 256 + wr * 64 + fr, col0 = u.pn * 256 + wc * 32 + 8 * fq;
        u32x4 gb[4][2];
#pragma unroll
        for (int g = 0; g < 4; ++g)
#pragma unroll
            for (int bj = 0; bj < 2; ++bj) gb[g][bj] = *(const u32x4*)(gate + (size_t)(row0 + g * 16) * 2048 + col0 + bj * 128);
#pragma unroll
        for (int ai = 0; ai < 2; ++ai)
#pragma unroll
            for (int m = 0; m < 4; ++m) { const int row = row0 + ai * 128 + m * 16;
#pragma unroll
                for (int bj = 0; bj < 2; ++bj) { const int col = col0 + bj * 128;
                    const u32x4 gw = gb[m][bj];
                    if (ai == 0) gb[m][bj] = *(const u32x4*)(gate + (size_t)(row + 128) * 2048 + col);
                    f32x4 v0 = acc[ai][bj][m][0], v1 = acc[ai][bj][m][1];
                    if (CLAMP) {
                        v0[0] *= ga_clamp(bf_lo(gw.x)); v0[1] *= ga_clamp(bf_hi(gw.x)); v0[2] *= ga_clamp(bf_lo(gw.y)); v0[3] *= ga_clamp(bf_hi(gw.y));
                        v1[0] *= ga_clamp(bf_lo(gw.z)); v1[1] *= ga_clamp(bf_hi(gw.z)); v1[2] *= ga_clamp(bf_lo(gw.w)); v1[3] *= ga_clamp(bf_hi(gw.w));
                    } else {
                    v0[0] *= bf_lo(gw.x); v0[1] *= bf_hi(gw.x); v0[2] *= bf_lo(gw.y); v0[3] *= bf_hi(gw.y);
                    v1[0] *= bf_lo(gw.z); v1[1] *= bf_hi(gw.z); v1[2] *= bf_lo(gw.w); v1[3] *= bf_hi(gw.w); }
                    if (ADD) { const u32x4 aw = *(const u32x4*)(addsrc + (size_t)row * D + col);
                        v0[0] += bf_lo(aw.x); v0[1] += bf_hi(aw.x); v0[2] += bf_lo(aw.y); v0[3] += bf_hi(aw.y);
                        v1[0] += bf_lo(aw.z); v1[1] += bf_hi(aw.z); v1[2] += bf_lo(aw.w); v1[3] += bf_hi(aw.w); }
                    u32x4 w; w.x = pk2(v0[0], v0[1]); w.y = pk2(v0[2], v0[3]); w.z = pk2(v1[0], v1[1]); w.w = pk2(v1[2], v1[3]);
                    *(u32x4*)(O + (size_t)row * D + col) = w; } }
    }
};
struct EpiX1 {
    static constexpr bool PERM = false;
    const float* x; bf16_t* xb; float* ss; unsigned char* x8;
    __device__ __forceinline__ void operator()(const AccT& acc, const Unit& u, int wr, int wc, int fr, int fq) const {
        const int row0 = u.pm * 256 + wr * 64 + fr, col0 = u.pn * 256 + wc * 32 + 4 * fq;
        f32x4 xv[2][4];
#pragma unroll
        for (int g = 0; g < 2; ++g)
#pragma unroll
            for (int q = 0; q < 4; ++q) xv[g][q] = *(const f32x4*)(x + (size_t)(row0 + g * 16) * D + col0 + (q >> 1) * 128 + (q & 1) * 16);
#pragma unroll
        for (int ai = 0; ai < 2; ++ai)
#pragma unroll
            for (int m = 0; m < 4; ++m) { const int row = row0 + ai * 128 + m * 16; float s = 0.f;
                const int g2 = ai * 4 + m + 2, rown = row0 + (g2 >> 2) * 128 + (g2 & 3) * 16;
#pragma unroll
                for (int bj = 0; bj < 2; ++bj)
#pragma unroll
                    for (int n = 0; n < 2; ++n) { const size_t o = (size_t)row * D + col0 + bj * 128 + n * 16;
                        const f32x4 xin = xv[m & 1][bj * 2 + n];
                        if (g2 < 8) xv[m & 1][bj * 2 + n] = *(const f32x4*)(x + (size_t)rown * D + col0 + bj * 128 + n * 16);
                        const f32x4 v = xin + acc[ai][bj][m][n];
                        u32x2 w; w.x = pk2(v[0], v[1]); w.y = pk2(v[2], v[3]); *(u32x2*)(xb + o) = w;
                        *(unsigned*)(x8 + o) = pk4_fp8(v[0], v[1], v[2], v[3]);
                        s += (v[0] * v[0] + v[1] * v[1]) + (v[2] * v[2] + v[3] * v[3]); }
                s += __shfl_xor(s, 16); s += __shfl_xor(s, 32);
                if (fq == 0) atomicAdd(ss + row, s); }
    }
};
struct EpiMoe1 {
    static constexpr bool PERM = true;
    unsigned char* act; const float* rowscale; const float* b1;
    __device__ __forceinline__ void operator()(const AccT& acc, const Unit& u, int wr, int wc, int fr, int fq) const {
        const int row0 = u.pm * 256 + wr * 64 + fr, colj = u.pn * 128 + wc * 32 + 8 * fq;
        const float* bg = b1 + (size_t)u.e * 2048 + colj; const float* bu = bg + 1024;
        const f32x4 bg0 = *(const f32x4*)bg, bg1 = *(const f32x4*)(bg + 4), bu0 = *(const f32x4*)bu, bu1 = *(const f32x4*)(bu + 4);
        float sv[8];
#pragma unroll
        for (int g = 0; g < 8; ++g) sv[g] = rowscale[row0 + (g >> 2) * 128 + (g & 3) * 16] * (1.0f / 64.0f);
#pragma unroll
        for (int ai = 0; ai < 2; ++ai)
#pragma unroll
            for (int m = 0; m < 4; ++m) { const int row = row0 + ai * 128 + m * 16;
                const float rs = sv[ai * 4 + m];
                float r[8];
#pragma unroll
                for (int n = 0; n < 2; ++n)
#pragma unroll
                    for (int j = 0; j < 4; ++j) { float gl = acc[ai][0][m][n][j] * rs + (n ? bg1[j] : bg0[j]); float up = acc[ai][1][m][n][j] * rs + (n ? bu1[j] : bu0[j]);
                        gl = fminf(gl, 7.0f); up = fminf(fmaxf(up, -7.0f), 7.0f);
                        r[n * 4 + j] = 8.0f * ((up + 1.0f) * (gl * sigmoidf_(1.702f * gl))); }
                u32x2 w; w.x = pk4_fp8(r[0], r[1], r[2], r[3]); w.y = pk4_fp8(r[4], r[5], r[6], r[7]);
                *(u32x2*)(act + (size_t)row * DFF + colj) = w; }
    }
};
struct EpiMoe2 {
    static constexpr bool PERM = true;
    unsigned char* Y; const float* rowgate; const float* b2;
    __device__ __forceinline__ void operator()(const AccT& acc, const Unit& u, int wr, int wc, int fr, int fq) const {
        const int row0 = u.pm * 256 + wr * 64 + fr, col0 = u.pn * 256 + wc * 32 + 8 * fq;
        f32x4 cb[2][2]; float sv[8];
#pragma unroll
        for (int bj = 0; bj < 2; ++bj) { const float* bb = b2 + (size_t)u.e * D + col0 + bj * 128; cb[bj][0] = *(const f32x4*)bb; cb[bj][1] = *(const f32x4*)(bb + 4); }
#pragma unroll
        for (int g = 0; g < 8; ++g) sv[g] = rowgate[row0 + (g >> 2) * 128 + (g & 3) * 16];
#pragma unroll
        for (int ai = 0; ai < 2; ++ai)
#pragma unroll
            for (int m = 0; m < 4; ++m) { const int row = row0 + ai * 128 + m * 16; const float gt = sv[ai * 4 + m];
#pragma unroll
                for (int bj = 0; bj < 2; ++bj) { const int col = col0 + bj * 128;
                    const f32x4 c0 = cb[bj][0], c1 = cb[bj][1];
                    const f32x4 v0 = (acc[ai][bj][m][0] * (1.0f / 512.0f) + c0) * gt, v1 = (acc[ai][bj][m][1] * (1.0f / 512.0f) + c1) * gt;
                    u32x2 w; w.x = pk4_fp8(v0[0], v0[1], v0[2], v0[3]); w.y = pk4_fp8(v1[0], v1[1], v1[2], v1[3]);
                    *(u32x2*)(Y + (size_t)row * D + col) = w; } }
    }
};
struct EpiPP {
    static constexpr bool PERM = true;
    unsigned char* PP;
    __device__ __forceinline__ void operator()(const AccT& acc, const Unit& u, int wr, int wc, int fr, int fq) const {
        const int row0 = u.pm * 256 + wr * 64 + fr, col0 = u.pn * 256 + wc * 32 + 8 * fq;
#pragma unroll
        for (int ai = 0; ai < 2; ++ai)
#pragma unroll
            for (int m = 0; m < 4; ++m) { const int row = row0 + ai * 128 + m * 16;
#pragma unroll
                for (int bj = 0; bj < 2; ++bj) { const f32x4 v0 = acc[ai][bj][m][0], v1 = acc[ai][bj][m][1];
                    u32x2 w; w.x = pk4_fp8(v0[0], v0[1], v0[2], v0[3]); w.y = pk4_fp8(v1[0], v1[1], v1[2], v1[3]);
                    *(u32x2*)(PP + (size_t)row * D + col0 + bj * 128) = w; } }
    }
};
struct EpiPleGX {
    static constexpr bool PERM = true;
    bf16_t* x3b; const bf16_t* x2b; const unsigned char* PP; const float* rs; float* ss;
    __device__ __forceinline__ void operator()(const AccT& acc, const Unit& u, int wr, int wc, int fr, int fq) const {
        const int row0 = u.pm * 256 + wr * 64 + fr, col0 = u.pn * 256 + wc * 32 + 8 * fq;
        float sv[8]; u32x2 pb[2][2]; u32x4 xq[2][2];
#pragma unroll
        for (int g = 0; g < 8; ++g) sv[g] = rs[row0 + (g >> 2) * 128 + (g & 3) * 16];
#pragma unroll
        for (int g = 0; g < 2; ++g)
#pragma unroll
            for (int bj = 0; bj < 2; ++bj) { const size_t o = (size_t)(row0 + g * 16) * D + col0 + bj * 128; pb[g][bj] = *(const u32x2*)(PP + o); xq[g][bj] = *(const u32x4*)(x2b + o); }
#pragma unroll
        for (int ai = 0; ai < 2; ++ai)
#pragma unroll
            for (int m = 0; m < 4; ++m) { const int row = row0 + ai * 128 + m * 16; const float rsv = sv[ai * 4 + m]; float s = 0.f;
                const int g2 = ai * 4 + m + 2, rown = row0 + (g2 >> 2) * 128 + (g2 & 3) * 16;
#pragma unroll
                for (int bj = 0; bj < 2; ++bj) { const size_t o = (size_t)row * D + col0 + bj * 128;
                    const u32x4 xw = xq[m & 1][bj]; float pf[8]; fp8x8_to_f32(pb[m & 1][bj], pf);
                    if (g2 < 8) { const size_t on = (size_t)rown * D + col0 + bj * 128; pb[m & 1][bj] = *(const u32x2*)(PP + on); xq[m & 1][bj] = *(const u32x4*)(x2b + on); }
                    const f32x4 a0 = acc[ai][bj][m][0] * rsv, a1 = acc[ai][bj][m][1] * rsv;
                    f32x4 x0, x1;
                    x0[0] = bf_lo(xw.x) + sigmoidf_(a0[0]) * pf[0]; x0[1] = bf_hi(xw.x) + sigmoidf_(a0[1]) * pf[1];
                    x0[2] = bf_lo(xw.y) + sigmoidf_(a0[2]) * pf[2]; x0[3] = bf_hi(xw.y) + sigmoidf_(a0[3]) * pf[3];
                    x1[0] = bf_lo(xw.z) + sigmoidf_(a1[0]) * pf[4]; x1[1] = bf_hi(xw.z) + sigmoidf_(a1[1]) * pf[5];
                    x1[2] = bf_lo(xw.w) + sigmoidf_(a1[2]) * pf[6]; x1[3] = bf_hi(xw.w) + sigmoidf_(a1[3]) * pf[7];
                    { u32x4 w; w.x = pk2(x0[0], x0[1]); w.y = pk2(x0[2], x0[3]); w.z = pk2(x1[0], x1[1]); w.w = pk2(x1[2], x1[3]); *(u32x4*)(x3b + o) = w; }
                    s += (x0[0] * x0[0] + x0[1] * x0[1]) + (x0[2] * x0[2] + x0[3] * x0[3]) + (x1[0] * x1[0] + x1[1] * x1[1]) + (x1[2] * x1[2] + x1[3] * x1[3]); }
                s += __shfl_xor(s, 16); s += __shfl_xor(s, 32);
                if (fq == 0) atomicAdd(ss + row, s); }
    }
};

struct Args { const float* in[20]; float* out; unsigned char* ws; int ph_lo, ph_hi; };
enum { I_X = 0, I_P, I_N1G, I_WIN, I_POOLW, I_POOLS, I_WBP, I_WBA, I_WOUT, I_N2G, I_RW, I_RB, I_W1, I_B1, I_W2, I_B2, I_PNG, I_PGW, I_PPW, I_FG };
enum { PH_PRO = 0, PH_INPROJ, PH_MIXED, PH_POOL, PH_ATT, PH_Z, PH_X1, PH_ROUTER, PH_SCATTER, PH_MOE1, PH_MOE2, PH_COMBINE, PH_PLE, PH_FINAL, NPH };

__device__ __forceinline__ int tr_dst_row(int mode, int n) {
    if (mode == 1) { if (n >= 1152 && n < 1280) { const int d = (n - 1152) & 63; return 1152 + ((n - 1152) & 64) + 16 * (d & 3) + (d >> 2); }
                     return n < 1864 ? n : n + 184; }
    if (mode == 2) return n < 1024 ? (((n >> 7) << 8) + (n & 127)) : ((((n - 1024) >> 7) << 8) + 128 + ((n - 1024) & 127));
    return n;
}
__device__ __forceinline__ float tr_col_scale(int mode, int n) {
    if (mode == 1) { if ((n >= 512 && n < 1024) || (n >= 1280 && n < 1792)) return 0.125f; if (n >= 1856 && n < 1864) return 0.35355339059327373f; }
    return 1.0f;
}
__device__ __forceinline__ void transpose_item(const float* W, int ldw, int Nvalid, int K, bf16_t* WT, const float* kgain, int mode, LAS float* scr, int kb, int nb, int lane, int ldt = 0, float f8scale = 0.f) {
    if (ldt == 0) ldt = K;
    const int k0 = 64 * kb, n0 = 64 * nb, c4 = lane & 15, kr = lane >> 4, nl = n0 + 4 * c4; const bool nok = nl < Nvalid;
    const f32x4 cs = (f32x4){tr_col_scale(mode, nl), tr_col_scale(mode, nl + 1), tr_col_scale(mode, nl + 2), tr_col_scale(mode, nl + 3)};
    f32x4 v[16];
#pragma unroll
    for (int i = 0; i < 16; ++i) { const int kk = 4 * i + kr; v[i] = nok ? *(const f32x4*)(W + (size_t)(k0 + kk) * ldw + nl) : (f32x4){0.f, 0.f, 0.f, 0.f}; }
    float kgv[16];
#pragma unroll
    for (int i = 0; i < 16; ++i) kgv[i] = kgain ? kgain[k0 + 4 * i + kr] : 1.0f;
#pragma unroll
    for (int i = 0; i < 16; ++i) asm volatile("" : "+v"(kgv[i]));
#pragma unroll
    for (int i = 0; i < 16; ++i) { const int kk = 4 * i + kr; *(LAS f32x4*)(scr + kk * 68 + 4 * c4) = v[i] * cs * kgv[i]; }
    LDS_WAIT(); asm volatile("" ::: "memory");
    const int c = lane & 7;
#pragma unroll
    for (int j = 0; j < 8; ++j) { const int n = (lane >> 3) + 8 * j; const LAS float* s = scr + (8 * c) * 68 + n;
        if (f8scale != 0.f) {
            u32x2 o8; o8.x = pk4_fp8(s[0 * 68] * f8scale, s[1 * 68] * f8scale, s[2 * 68] * f8scale, s[3 * 68] * f8scale); o8.y = pk4_fp8(s[4 * 68] * f8scale, s[5 * 68] * f8scale, s[6 * 68] * f8scale, s[7 * 68] * f8scale);
            if (n0 + n < Nvalid) *(u32x2*)((unsigned char*)WT + (size_t)tr_dst_row(mode, n0 + n) * ldt + k0 + 8 * c) = o8;
        } else {
        u32x4 o; o.x = pk2(s[0 * 68], s[1 * 68]); o.y = pk2(s[2 * 68], s[3 * 68]); o.z = pk2(s[4 * 68], s[5 * 68]); o.w = pk2(s[6 * 68], s[7 * 68]);
        if (n0 + n < Nvalid) *(u32x4*)(WT + (size_t)tr_dst_row(mode, n0 + n) * ldt + k0 + 8 * c) = o; } }
    LDS_WAIT(); asm volatile("" ::: "memory");
}
constexpr int I_E1 = 32 * 16 * 32, I_E2 = 32 * 16 * 16, N_EXPERT_ITEMS = I_E1 + I_E2;
constexpr int I_BA = 8 * 16, I_OUT = 16 * 16, I_R = 16, I_PG = 16 * 16, I_PP = 4 * 16, N_SMALL_ITEMS = I_BA + I_OUT + I_R + I_PG + I_PP;
constexpr int DC_EXPERT = N_EXPERT_ITEMS / 8, DC_SMALL = N_SMALL_ITEMS / 8, DC_WPC = 2048 / 8, DC_PB = M * PLE / 8 / 4096, DC_TOTAL = DC_EXPERT + DC_SMALL + DC_WPC + DC_PB;
__device__ __forceinline__ void deferred_chunk(const Args& a, LAS unsigned char* lds, int c, int wave, int lane) {
    unsigned char* ws = a.ws; LAS float* scr = (LAS float*)(lds + wave * 17408);
    if (c < DC_EXPERT) { int r = c * 8 + wave;
        if (r < I_E1) { const int e = r / (16 * 32), q = r % (16 * 32);
            transpose_item(a.in[I_W1] + (size_t)e * D * 2048, 2048, 2048, D, (bf16_t*)(ws + WS_W1 + (size_t)e * 2048 * D), a.in[I_N2G], 2, scr, q / 32, q % 32, lane, D, 64.0f); return; }
        r -= I_E1; { const int e = r / (16 * 16), q = r % (16 * 16);
            transpose_item(a.in[I_W2] + (size_t)e * DFF * D, D, D, DFF, (bf16_t*)(ws + WS_W2 + (size_t)e * D * DFF), nullptr, 0, scr, q / 16, q % 16, lane, DFF, 64.0f); }
        return; }
    c -= DC_EXPERT;
    if (c < DC_SMALL) { int r = c * 8 + wave;
        if (r < I_BA) { transpose_item(a.in[I_WBA], D, D, 512, (bf16_t*)(ws + WS_WPC) + 512, nullptr, 0, scr, r / 16, r % 16, lane, 1024); return; } r -= I_BA;
        if (r < I_OUT) { transpose_item(a.in[I_WOUT], D, D, D, (bf16_t*)(ws + WS_WOUT), nullptr, 0, scr, r / 16, r % 16, lane); return; } r -= I_OUT;
        if (r < I_R) { transpose_item(a.in[I_RW], NE, NE, D, (bf16_t*)(ws + WS_WR), a.in[I_N2G], 0, scr, r, 0, lane); return; } r -= I_R;
        if (r < I_PG) { transpose_item(a.in[I_PGW], D, D, D, (bf16_t*)(ws + WS_WPG), a.in[I_PNG], 0, scr, r / 16, r % 16, lane); return; } r -= I_PG;
        transpose_item(a.in[I_PPW], D, D, PLE, (bf16_t*)(ws + WS_WPP), nullptr, 0, scr, r / 16, r % 16, lane); return; }
    c -= DC_SMALL;
    if (c < DC_WPC) {
        const float* pw = a.in[I_POOLW]; const float* ps = a.in[I_POOLS]; const float* wbp = a.in[I_WBP]; bf16_t* wpc = (bf16_t*)(ws + WS_WPC);
        const int it = c * 8 + wave, gc = it >> 2, n0 = (it & 3) * 256 + lane * 4, g = gc >> 7;
        f32x4 acc = (f32x4){0.f, 0.f, 0.f, 0.f};
        const float* pwr = pw + (size_t)gc * 128; const float* psr = ps + g * 128; const float* wr_ = wbp + (size_t)(g * 128) * D + n0;
#pragma unroll 8
        for (int d = 0; d < 128; ++d) { const float av = pwr[d] * psr[d]; const f32x4 wv = *(const f32x4*)(wr_ + (size_t)d * D); acc += wv * av; }
#pragma unroll
        for (int j = 0; j < 4; ++j) wpc[(size_t)(n0 + j) * 1024 + gc] = (bf16_t)f2bf(acc[j]);
        return; }
    c -= DC_WPC;
    {
        const f32x4* p = (const f32x4*)a.in[I_P]; u32x4* pb = (u32x4*)(ws + WS_PB);
        f32x4 pv[8][2];
#pragma unroll
        for (int k = 0; k < 8; ++k) { const int i = c * 4096 + k * 512 + (int)threadIdx.x; pv[k][0] = p[2 * i]; pv[k][1] = p[2 * i + 1]; }
#pragma unroll
        for (int k = 0; k < 8; ++k) { const int i = c * 4096 + k * 512 + (int)threadIdx.x; const f32x4 v0 = pv[k][0], v1 = pv[k][1];
            u32x4 w; w.x = pk2(v0[0], v0[1]); w.y = pk2(v0[2], v0[3]); w.z = pk2(v1[0], v1[1]); w.w = pk2(v1[2], v1[3]); pb[i] = w; } }
}
__device__ __forceinline__ void p0_prologue(const Args& a, LAS unsigned char* lds, int wave, int lane, int G) {
    unsigned char* ws = a.ws;
    LAS float* scr = (LAS float*)(lds + wave * 17408);
    const int gw = blockIdx.x * NWAVES + wave, NGW = G * NWAVES;
    for (int it = gw; it < 16 * 62; it += NGW) transpose_item(a.in[I_WIN], IN_COLS, IN_COLS, D, (bf16_t*)(ws + WS_WIN), a.in[I_N1G], 1, scr, it / 62, it % 62, lane);
    for (int c = DC_EXPERT + (int)blockIdx.x; c < DC_TOTAL; c += G) { deferred_chunk(a, lds, c, wave, lane); __syncthreads(); }
    { const int gt = blockIdx.x * NTHREADS + threadIdx.x, NT = G * NTHREADS; u32x4* z = (u32x4*)((bf16_t*)(ws + WS_WIN) + (size_t)1864 * D);
      for (int i = gt; i < 184 * D * 2 / 16; i += NT) z[i] = (u32x4){0u, 0u, 0u, 0u}; }
    { const float* x = a.in[I_X]; bf16_t* xb = (bf16_t*)(ws + WS_R2); float* rs1 = (float*)(ws + WS_RS1);
      for (int m0 = gw; m0 < M; m0 += 2 * NGW) { f32x4 v[2][4];
#pragma unroll
        for (int r = 0; r < 2; ++r) { const int m = m0 + r * NGW; if (m < M) { const f32x4* xr = (const f32x4*)(x + (size_t)m * D) + lane;
#pragma unroll
            for (int j = 0; j < 4; ++j) v[r][j] = xr[64 * j]; } }
#pragma unroll
        for (int r = 0; r < 2; ++r) { const int m = m0 + r * NGW; if (m < M) { float s = 0.f;
#pragma unroll
            for (int j = 0; j < 4; ++j) s += (v[r][j][0] * v[r][j][0] + v[r][j][1] * v[r][j][1]) + (v[r][j][2] * v[r][j][2] + v[r][j][3] * v[r][j][3]);
            s = wave_sum(s); if (lane == 0) rs1[m] = rsqrtf(s * (1.0f / D) + RMS_EPS);
            u32x2* o = (u32x2*)(xb + (size_t)m * D) + lane;
#pragma unroll
            for (int j = 0; j < 4; ++j) { u32x2 w; w.x = pk2(v[r][j][0], v[r][j][1]); w.y = pk2(v[r][j][2], v[r][j][3]); o[64 * j] = w; } } } } }
}

template <int W>
__device__ __forceinline__ void mixed_item(const bf16_t* ub, bf16_t* mixed, int tok, int c8) {
    const int t = tok & (SEQ - 1); const int nw = (t + 1) < W ? (t + 1) : W;
    u32x4 v[W];
#pragma unroll
    for (int i = 0; i < W; ++i) { const int ii = i < nw ? i : 0; v[i] = *(const u32x4*)(ub + (size_t)(tok - ii) * 512 + c8 * 8); }
    float s[8], cur[8];
#pragma unroll
    for (int j = 0; j < 8; ++j) { s[j] = 0.f; cur[j] = 0.f; }
#pragma unroll
    for (int i = 0; i < W; ++i) { const float mk = i < nw ? 1.0f : 0.0f;
        const float f[8] = {bf_lo(v[i].x), bf_hi(v[i].x), bf_lo(v[i].y), bf_hi(v[i].y), bf_lo(v[i].z), bf_hi(v[i].z), bf_lo(v[i].w), bf_hi(v[i].w)};
#pragma unroll
        for (int j = 0; j < 8; ++j) { s[j] = fmaf(f[j], mk, s[j]); if (i == 0) cur[j] = f[j]; } }
    const float inv = 1.0f / (float)nw;
    u32x4 o; o.x = pk2(s[0] * inv - cur[0], s[1] * inv - cur[1]); o.y = pk2(s[2] * inv - cur[2], s[3] * inv - cur[3]);
    o.z = pk2(s[4] * inv - cur[4], s[5] * inv - cur[5]); o.w = pk2(s[6] * inv - cur[6], s[7] * inv - cur[7]);
    *(u32x4*)(mixed + (size_t)tok * 1024 + c8 * 8) = o;
}
__device__ __forceinline__ void p2_mixed(const bf16_t* ub, bf16_t* mixed, int G) {
    const int ln = threadIdx.x & 63, gw = blockIdx.x * NWAVES + (int)(threadIdx.x >> 6), NGW = G * NWAVES;
    int k = 0;
    for (int P = gw; P < M; P += NGW, ++k) {
        const int g = __builtin_amdgcn_readfirstlane((P + k) & 3), tok = (P >> 2) * 4 + (ln >> 4), c8 = g * 16 + (ln & 15);
        if (g == 0) mixed_item<2>(ub, mixed, tok, c8); else if (g == 1) mixed_item<4>(ub, mixed, tok, c8); else if (g == 2) mixed_item<8>(ub, mixed, tok, c8); else mixed_item<16>(ub, mixed, tok, c8);
    }
}

__device__ __forceinline__ unsigned lds_atomic_inc(LAS unsigned* p) { return __hip_atomic_fetch_add(p, 1u, __ATOMIC_RELAXED, __HIP_MEMORY_SCOPE_WORKGROUP); }
__device__ __forceinline__ void prune_token(LAS unsigned* L, LAS unsigned* H, const LAS unsigned* cntin, LAS unsigned* cntp, LAS unsigned* thrp, int lane) {
    const int n = __builtin_amdgcn_readfirstlane((int)*cntin);
    unsigned prefix = 0u; unsigned want = 256u;
#pragma unroll
    for (int p = 0; p < 4; ++p) {
        const int shift = 24 - 8 * p;
        *(LAS u32x4*)(H + 4 * lane) = (u32x4){0u, 0u, 0u, 0u};
        for (int i = lane; i < n; i += 64) { const unsigned e = L[i];
            bool match = true; if (p > 0) match = ((e ^ prefix) >> ((shift + 8) & 31)) == 0u;
            if (match) (void)lds_atomic_inc(H + ((e >> shift) & 255u)); }
        const u32x4 c = *(LAS u32x4*)(H + 4 * lane);
        const unsigned T = c.x + c.y + c.z + c.w; unsigned suf = T;
#pragma unroll
        for (int off = 1; off < 64; off <<= 1) { const unsigned v = (unsigned)__shfl_down((int)suf, off); if (lane + off < 64) suf += v; }
        const unsigned sufex = suf - T;
        const bool found = (sufex < want) && (want <= suf);
        unsigned run = sufex; int d = 0; unsigned nw = 0u; bool got = false;
        if (!got && run + c.w >= want) { d = 4 * lane + 3; nw = want - run; got = true; } run += c.w;
        if (!got && run + c.z >= want) { d = 4 * lane + 2; nw = want - run; got = true; } run += c.z;
        if (!got && run + c.y >= want) { d = 4 * lane + 1; nw = want - run; got = true; } run += c.y;
        if (!got && run + c.x >= want) { d = 4 * lane + 0; nw = want - run; got = true; }
        const unsigned long long fm = __ballot(found);
        const int src = fm ? (__ffsll((long long)fm) - 1) : 0;
        d = __shfl(d, src); want = (unsigned)__shfl((int)nw, src);
        prefix |= (unsigned)d << shift;
    }
    int newn = 0;
    for (int base = 0; base < n; base += 64) { const int i = base + lane; const unsigned e = (i < n) ? L[i] : 0u; const bool keep = (i < n) && (e >= prefix);
        const unsigned long long mk = __ballot(keep);
        const int pos = newn + (int)__builtin_amdgcn_mbcnt_hi((unsigned)(mk >> 32), __builtin_amdgcn_mbcnt_lo((unsigned)mk, 0u));
        if (keep) L[pos] = e;
        newn += __popcll(mk); }
    if (lane == 0) { *cntp = (unsigned)newn; *thrp = prefix; }
}

template <int CTRL> __device__ __forceinline__ unsigned dpp0(unsigned v) { return (unsigned)__builtin_amdgcn_update_dpp(0, (int)v, CTRL, 0xf, 0xf, true); }
__device__ __forceinline__ unsigned wave_min_u32(unsigned v) {
    v = min(v, (unsigned)__builtin_amdgcn_update_dpp((int)v, (int)v, 0x128, 0xf, 0xf, false)); v = min(v, (unsigned)__builtin_amdgcn_update_dpp((int)v, (int)v, 0x124, 0xf, 0xf, false));
    v = min(v, (unsigned)__builtin_amdgcn_update_dpp((int)v, (int)v, 0x122, 0xf, 0xf, false)); v = min(v, (unsigned)__builtin_amdgcn_update_dpp((int)v, (int)v, 0x121, 0xf, 0xf, false));
    const unsigned a = __builtin_amdgcn_readlane((int)v, 0), b = __builtin_amdgcn_readlane((int)v, 16), c = __builtin_amdgcn_readlane((int)v, 32), d = __builtin_amdgcn_readlane((int)v, 48);
    return min(min(a, b), min(c, d));
}
__device__ __forceinline__ unsigned wave_max_u32(unsigned v) { return ~wave_min_u32(~v); }
__device__ __forceinline__ unsigned wave_prefix_incl(unsigned v, int lane) {
    v += dpp0<0x111>(v); v += dpp0<0x112>(v); v += dpp0<0x114>(v); v += dpp0<0x118>(v);
    const unsigned r0 = __builtin_amdgcn_readlane((int)v, 15), r1 = __builtin_amdgcn_readlane((int)v, 31), r2 = __builtin_amdgcn_readlane((int)v, 47);
    const int row = lane >> 4;
    return v + (row >= 1 ? r0 : 0u) + (row >= 2 ? r1 : 0u) + (row >= 3 ? r2 : 0u);
}
template <int FULLROWS>
__device__ __forceinline__ void prune_approx(LAS unsigned* L, LAS unsigned* H, const LAS unsigned* cntin, LAS unsigned* cntp, LAS unsigned* thrp, int lane) {
    const int n = __builtin_amdgcn_readfirstlane((int)*cntin);
    const unsigned tlo = (unsigned)__builtin_amdgcn_readfirstlane((int)*thrp);
    unsigned e[8]; unsigned mxv = 0u;
#pragma unroll
    for (int k = 0; k < 8; ++k) { unsigned v = L[lane + 64 * k]; if (k >= FULLROWS) v = (lane + 64 * k < n) ? v : 0u; e[k] = v; mxv = max(mxv, v); }
    mxv = wave_max_u32(mxv);
    unsigned mn = tlo;
    if (tlo == 0u) {
        unsigned m = 0xFFFFFFFFu;
#pragma unroll
        for (int k = 0; k < 8; ++k) m = (k >= FULLROWS && e[k] == 0u) ? m : min(m, e[k]);
        mn = wave_min_u32(m);
    }
    const unsigned range = mxv - mn;
    const int hb = 31 - __builtin_clz(range | 1u);
    const int shift = hb > 7 ? hb - 7 : 0;
    *(LAS u32x4*)(H + 4 * lane) = (u32x4){0u, 0u, 0u, 0u};
#pragma unroll
    for (int k = 0; k < 8; ++k) if (k < FULLROWS || e[k] != 0u) (void)lds_atomic_inc(H + ((e[k] - mn) >> shift));
    const u32x4 c = *(LAS u32x4*)(H + 4 * lane);
    const unsigned T = c.x + c.y + c.z + c.w;
    const unsigned pin = wave_prefix_incl(T, lane);
    const unsigned tot = (unsigned)__builtin_amdgcn_readlane((int)pin, 63);
    const unsigned sufex = tot - pin;
    const unsigned suf = sufex + T;
    const bool found = (sufex < 256u) && (256u <= suf);
    unsigned run = sufex; int d = 0; bool got = false;
    if (!got && run + c.w >= 256u) { d = 4 * lane + 3; got = true; } run += c.w;
    if (!got && run + c.z >= 256u) { d = 4 * lane + 2; got = true; } run += c.z;
    if (!got && run + c.y >= 256u) { d = 4 * lane + 1; got = true; } run += c.y;
    if (!got && run + c.x >= 256u) { d = 4 * lane + 0; got = true; }
    const unsigned long long fm = __ballot(found);
    const int src = fm ? (__ffsll((long long)fm) - 1) : 0;
    d = __builtin_amdgcn_readlane(d, src);
    unsigned thr = mn + ((unsigned)d << shift);
    thr = thr ? thr : 1u;
    int newn = 0;
#pragma unroll
    for (int k = 0; k < 8; ++k) { const bool keep = e[k] >= thr;
        const unsigned long long mk = __ballot(keep);
        const int pos = newn + (int)__builtin_amdgcn_mbcnt_hi((unsigned)(mk >> 32), __builtin_amdgcn_mbcnt_lo((unsigned)mk, 0u));
        if (keep) L[pos] = e[k];
        newn += __popcll(mk); }
    if (lane == 0) { *cntp = (unsigned)newn; *thrp = thr - 1u; }
}

__device__ __forceinline__ void prune_excess(LAS unsigned* L, LAS unsigned* cntp, int lane) {
    const int n = __builtin_amdgcn_readfirstlane((int)*cntp);
    unsigned e[5];
#pragma unroll
    for (int k = 0; k < 5; ++k) { const int i = lane + 64 * k; const unsigned v = L[i]; e[k] = (i < n) ? v : 0xFFFFFFFFu; }
    for (int r = n - 256; r > 0; --r) {
        unsigned m = min(min(e[0], e[1]), min(min(e[2], e[3]), e[4]));
        m = wave_min_u32(m);
#pragma unroll
        for (int k = 0; k < 5; ++k) e[k] = (e[k] == m) ? 0xFFFFFFFFu : e[k];
    }
    int newn = 0;
#pragma unroll
    for (int k = 0; k < 5; ++k) { const bool keep = e[k] != 0xFFFFFFFFu;
        const unsigned long long mk = __ballot(keep);
        const int pos = newn + (int)__builtin_amdgcn_mbcnt_hi((unsigned)(mk >> 32), __builtin_amdgcn_mbcnt_lo((unsigned)mk, 0u));
        if (keep) L[pos] = e[k];
        newn += __popcll(mk); }
    if (lane == 0) *cntp = (unsigned)newn;
}

template <bool DIAG>
__device__ __forceinline__ void score_tile(LAS unsigned char* lds, const LAS unsigned char* kbuf, const bf16x8 (&afr)[2][4], const float (&wq)[2][16], unsigned (&cn)[2][2], const unsigned (&th)[2][2],
                                           int kt, int t0, int wave, int hf, int l31, unsigned lmask, unsigned trash) {
    bf16x8 bfr[2][4];
#pragma unroll
    for (int kh = 0; kh < 2; ++kh) { const int keyrow = kh * 32 + l31;
#pragma unroll
        for (int ks = 0; ks < 4; ++ks) bfr[kh][ks] = *(const LAS bf16x8*)(kbuf + keyrow * 128 + (((ks * 2 + hf) ^ ((keyrow >> 1) & 7)) * 16)); }
    f32x16 accs[2][2];
#pragma unroll
    for (int kh = 0; kh < 2; ++kh)
#pragma unroll
        for (int rt = 0; rt < 2; ++rt) {
#pragma unroll
            for (int j = 0; j < 16; ++j) accs[kh][rt][j] = 0.f;
#pragma unroll
            for (int ks = 0; ks < 4; ++ks) accs[kh][rt] = __builtin_amdgcn_mfma_f32_32x32x16_bf16(afr[rt][ks], bfr[kh][ks], accs[kh][rt], 0, 0, 0);
        }
#pragma unroll
    for (int kh = 0; kh < 2; ++kh) {
        const int keypos = kt * 64 + kh * 32 + l31;
        const unsigned idxbits = (unsigned)(16383 - keypos);
#pragma unroll
        for (int rt = 0; rt < 2; ++rt) {
#pragma unroll
            for (int ts = 0; ts < 2; ++ts) {
                float s = 0.f;
#pragma unroll
                for (int hd = 0; hd < 8; ++hd) s = fmaf(__builtin_amdgcn_fmed3f(accs[kh][rt][8 * ts + hd], 0.f, 3.0e38f), wq[rt][8 * ts + hd], s);
                const unsigned ub = __builtin_bit_cast(unsigned, s);
                const unsigned srt = ub ^ ((unsigned)((int)ub >> 31) | 0x80000000u);
                const unsigned packed = (srt & 0xFFFFC000u) | idxbits;
                const int tl = 4 * rt + 2 * hf + ts;
                bool pass = packed > th[rt][ts];
                if (DIAG) pass = pass && (keypos <= t0 + wave * 8 + tl);
                const unsigned long long mk = __builtin_amdgcn_ballot_w64(pass);
                const unsigned mine = hf ? (unsigned)(mk >> 32) : (unsigned)mk;
                const unsigned pre = __popc(mine & lmask);
                const unsigned addr = pass ? (unsigned)((wave * 8 + tl) * 2048) + (cn[rt][ts] + pre) * 4u : trash;
                *(LAS unsigned*)(lds + addr) = packed;
                cn[rt][ts] += __popc(mine);
            }
        }
    }
}

__device__ __forceinline__ void p4_attention(const unsigned char* pj, bf16_t* attn_out, unsigned* queue, int* seldbg, LAS unsigned char* lds, int wave, int lane) {
    const unsigned char* qb_ = pj + PJ_Q;   const unsigned char* kv8 = pj + PJ_KV; const bf16_t* qib = (const bf16_t*)(pj + PJ_QI); const bf16_t* kwb = (const bf16_t*)(pj + PJ_KW);
    LAS unsigned* cnt_l = (LAS unsigned*)(lds + LDS_ATM);
    LAS unsigned* thr_l = cnt_l + 64;
    LAS unsigned* unit_l = cnt_l + 128;
    LAS unsigned* pflag = cnt_l + 132;
    LAS unsigned* wl_ctl = cnt_l + 136;
    LAS unsigned* cnt2 = cnt_l + 144;
    LAS unsigned* H = (LAS unsigned*)(lds + LDS_HIST) + wave * 256;
    const int tid = threadIdx.x, hf = lane >> 5, l31 = lane & 31;
    for (;;) {
        if (tid == 0) { const unsigned pref = xb_xcc_id() & 1u;
            unsigned uu = atomicAdd(queue + 64 * pref, 1u), bb = pref;
            if (uu >= 256u) { uu = atomicAdd(queue + 64 * (pref ^ 1u), 1u); bb = pref ^ 1u; }
            *unit_l = (uu >= 256u) ? 0xFFFFu : (uu * 2u + bb); pflag[0] = 0u; pflag[1] = 0u; wl_ctl[0] = 0u; wl_ctl[1] = 0u; }
        __syncthreads();
        const int u = __builtin_amdgcn_readfirstlane((int)*unit_l);
        __syncthreads();
        if (u >= 512) break;
        const int qb = 255 - (u >> 1), b = u & 1, t0 = qb * 64, rowbase = b * SEQ;
        if (lane < 8) { cnt_l[wave * 8 + lane] = 0u; thr_l[wave * 8 + lane] = 0u; }
        bf16x8 afr[2][4]; float wq[2][16];
#pragma unroll
        for (int rt = 0; rt < 2; ++rt) {
            const int m = l31, hd = (m & 3) + 4 * ((m >> 3) & 1), tl = 4 * rt + 2 * ((m >> 2) & 1) + (m >> 4);
            const bf16_t* qp = qib + (size_t)(rowbase + t0 + wave * 8 + tl) * 512 + hd * 64 + hf * 8;
#pragma unroll
            for (int ks = 0; ks < 4; ++ks) afr[rt][ks] = *(const bf16x8*)(qp + ks * 16);
#pragma unroll
            for (int ts = 0; ts < 2; ++ts) { const int tl2 = 4 * rt + 2 * hf + ts;
                const u32x4 wv = *(const u32x4*)(kwb + (size_t)(rowbase + t0 + wave * 8 + tl2) * 128 + 64);
                wq[rt][8 * ts + 0] = bf_lo(wv.x); wq[rt][8 * ts + 1] = bf_hi(wv.x); wq[rt][8 * ts + 2] = bf_lo(wv.y); wq[rt][8 * ts + 3] = bf_hi(wv.y);
                wq[rt][8 * ts + 4] = bf_lo(wv.z); wq[rt][8 * ts + 5] = bf_hi(wv.z); wq[rt][8 * ts + 6] = bf_lo(wv.w); wq[rt][8 * ts + 7] = bf_hi(wv.w); }
        }
#pragma unroll
        for (int rt = 0; rt < 2; ++rt) {
#pragma unroll
            for (int ks = 0; ks < 4; ++ks) asm volatile("" : "+v"(afr[rt][ks]));
#pragma unroll
            for (int j = 0; j < 16; ++j) asm volatile("" : "+v"(wq[rt][j]));
        }
        const int ntile = qb + 1;
        const int skey = tid >> 3, sch = tid & 7;
        const int sdst = skey * 128 + ((sch ^ ((skey >> 1) & 7)) * 16);
        u32x4 stg = *(const u32x4*)(kwb + (size_t)(rowbase + skey) * 128 + sch * 8);
        unsigned cn[2][2], th[2][2];
        const unsigned lmask = (1u << l31) - 1u, trash = (unsigned)(LDS_HIST + wave * 1024 + lane * 4);
#pragma unroll
        for (int rt = 0; rt < 2; ++rt)
#pragma unroll
            for (int ts = 0; ts < 2; ++ts) { cn[rt][ts] = 0u; th[rt][ts] = 0u; }
        for (int kt = 0; kt < ntile; ++kt) {
            LAS unsigned char* kbuf = lds + LDS_KT + (kt & 1) * 8192;
            *(LAS u32x4*)(kbuf + sdst) = stg;
            __syncthreads();
            if (kt + 1 < ntile) stg = *(const u32x4*)(kwb + (size_t)(rowbase + (kt + 1) * 64 + skey) * 128 + sch * 8);
            if (kt > 0 && __builtin_amdgcn_readfirstlane((int)pflag[(kt - 1) & 1]) == kt) {
                const unsigned long long jm = __ballot(cnt_l[lane] > 400u);
                { unsigned long long m = jm;
                  for (int ti = 0; m != 0ull; ++ti) { const int id = __ffsll((long long)m) - 1; m &= m - 1ull;
                    if ((ti & 7) == wave) {
                        prune_approx<6>((LAS unsigned*)(lds + id * 2048), H, cnt_l + id, cnt2 + id, thr_l + id, lane);
                        if (__builtin_amdgcn_readfirstlane((int)cnt2[id]) > 320) prune_token((LAS unsigned*)(lds + id * 2048), H, cnt2 + id, cnt2 + id, thr_l + id, lane);
                    } } }
                __syncthreads();
#pragma unroll
                for (int rt = 0; rt < 2; ++rt)
#pragma unroll
                    for (int ts = 0; ts < 2; ++ts) { const int tl = 4 * rt + 2 * hf + ts;
                        if ((jm >> (wave * 8 + tl)) & 1ull) { cn[rt][ts] = cnt2[wave * 8 + tl]; th[rt][ts] = thr_l[wave * 8 + tl]; } }
            }
            if (kt + 1 < ntile) score_tile<false>(lds, kbuf, afr, wq, cn, th, kt, t0, wave, hf, l31, lmask, trash);
            else                score_tile<true>(lds, kbuf, afr, wq, cn, th, kt, t0, wave, hf, l31, lmask, trash);
            bool need = false;
#pragma unroll
            for (int rt = 0; rt < 2; ++rt)
#pragma unroll
                for (int ts = 0; ts < 2; ++ts) { const int tl = 4 * rt + 2 * hf + ts; if (l31 == 0) cnt_l[wave * 8 + tl] = cn[rt][ts]; need |= cn[rt][ts] > 448u; }
            if (__ballot(need) != 0ull) { if (lane == 0) pflag[kt & 1] = (unsigned)(kt + 1); }
        }
        for (int tl = 0; tl < 8; ++tl) {
            const unsigned c = cnt_l[wave * 8 + tl];
            if (__builtin_amdgcn_readfirstlane((int)c) > 256) {
                LAS unsigned* Lt = (LAS unsigned*)(lds + (wave * 8 + tl) * 2048);
                prune_approx<4>(Lt, H, cnt_l + wave * 8 + tl, cnt_l + wave * 8 + tl, thr_l + wave * 8 + tl, lane);
                const int n2 = __builtin_amdgcn_readfirstlane((int)cnt_l[wave * 8 + tl]);
                if (n2 > 304) prune_token(Lt, H, cnt_l + wave * 8 + tl, cnt_l + wave * 8 + tl, thr_l + wave * 8 + tl, lane);
                else if (n2 > 256) prune_excess(Lt, cnt_l + wave * 8 + tl, lane);
            }
        }
        const int c15 = lane & 15, g4 = lane >> 4;
        for (int tl = 0; tl < 8; ++tl) {
            const int n = __builtin_amdgcn_readfirstlane((int)cnt_l[wave * 8 + tl]);
            const LAS unsigned* L = (const LAS unsigned*)(lds + (wave * 8 + tl) * 2048);
            const int tokrow = rowbase + t0 + wave * 8 + tl;
            const LAS unsigned* Lc = L + c15; const int nc = n - c15, n4 = n - 4 * g4;
#if DBG
            if (seldbg) for (int i = lane; i < 256; i += 64) seldbg[(size_t)tokrow * 256 + i] = (i < n) ? (int)(16383u - (L[i] & 16383u)) : -1;
#endif
            long bq[4];
#pragma unroll
            for (int ks = 0; ks < 4; ++ks) { const bool ok = (c15 < 8) && ((c15 >> 2) == (g4 >> 1));
                const u32x2 v = *(const u32x2*)(qb_ + (size_t)tokrow * 512 + (c15 & 7) * 64 + (g4 & 1) * 32 + ks * 8);
                bq[ks] = ok ? (long)(((unsigned long long)v.y << 32) | v.x) : 0l; }
            f32x4 S[16];
            u32x4 kq[2][4][2];
#define LOAD_KGROUP(buf, grp) do { _Pragma("unroll") for (int tt = 0; tt < 4; ++tt) { const int T_ = (grp) * 4 + tt; const unsigned e_ = Lc[T_ * 16]; \
                const int kp_ = (T_ * 16 < nc) ? (int)(16383u - (e_ & 16383u)) : 0; \
                const unsigned char* kr_ = kv8 + (size_t)(rowbase + kp_) * 256 + g4 * 32;     \
                kq[buf][tt][0] = *(const u32x4*)kr_; kq[buf][tt][1] = *(const u32x4*)(kr_ + 16); } } while (0)
            LOAD_KGROUP(0, 0); LOAD_KGROUP(1, 1);
#pragma unroll
            for (int grp = 0; grp < 4; ++grp) {
#pragma unroll
                for (int tt = 0; tt < 4; ++tt) { const int T = grp * 4 + tt; const u32x4 k0 = kq[grp & 1][tt][0], k1 = kq[grp & 1][tt][1];
                    f32x4 sacc = (f32x4){0.f, 0.f, 0.f, 0.f};
                    sacc = __builtin_amdgcn_mfma_f32_16x16x32_fp8_fp8((long)(((unsigned long long)k0.y << 32) | k0.x), bq[0], sacc, 0, 0, 0);
                    sacc = __builtin_amdgcn_mfma_f32_16x16x32_fp8_fp8((long)(((unsigned long long)k0.w << 32) | k0.z), bq[1], sacc, 0, 0, 0);
                    sacc = __builtin_amdgcn_mfma_f32_16x16x32_fp8_fp8((long)(((unsigned long long)k1.y << 32) | k1.x), bq[2], sacc, 0, 0, 0);
                    sacc = __builtin_amdgcn_mfma_f32_16x16x32_fp8_fp8((long)(((unsigned long long)k1.w << 32) | k1.z), bq[3], sacc, 0, 0, 0);
                    if (n < 256) {
#pragma unroll
                        for (int j = 0; j < 4; ++j) if (T * 16 + j >= n4) sacc[j] = -1e30f; }
                    S[T] = sacc; }
                if (grp < 2) { if (grp == 0) LOAD_KGROUP(0, 2); else LOAD_KGROUP(1, 3); }
                asm volatile("" ::: "memory");
            }
#undef LOAD_KGROUP
            const LAS unsigned* Lh = L + (lane >> 3); const int nh = n - (lane >> 3);
            const int vwr = (wave * 8 + (lane >> 5)) * 2048 + 1024 + ((lane >> 3) & 3) * 160 + (lane >> 5) * 16 + (lane & 7) * 16;
            u32x4 vvA[4], vvB[4];
#pragma unroll
            for (int q = 0; q < 4; ++q) { const unsigned e = Lh[8 * q];
                const int kp = (8 * q < nh) ? (int)(16383u - (e & 16383u)) : 0;
                vvA[q] = *(const u32x4*)(kv8 + (size_t)(rowbase + kp) * 256 + 128 + (lane & 7) * 16); }
#pragma unroll
            for (int q = 0; q < 4; ++q) { const unsigned e = Lh[32 + 8 * q];
                const int kp = (32 + 8 * q < nh) ? (int)(16383u - (e & 16383u)) : 0;
                vvB[q] = *(const u32x4*)(kv8 + (size_t)(rowbase + kp) * 256 + 128 + (lane & 7) * 16); }
            float mx = -1e30f;
#pragma unroll
            for (int T = 0; T < 16; ++T)
#pragma unroll
                for (int j = 0; j < 4; ++j) mx = fmaxf(mx, S[T][j]);
            mx = fmaxf(mx, __shfl_xor(mx, 16)); mx = fmaxf(mx, __shfl_xor(mx, 32));
            float sum = 0.f; unsigned P8[16];
            const float mxl = (mx - 5.545177444f) * 1.44269504089f;
#pragma unroll
            for (int T = 0; T < 16; ++T) { f32x4 pv;
#pragma unroll
                for (int j = 0; j < 4; ++j) { pv[j] = __builtin_amdgcn_exp2f(fmaf(S[T][j], 1.44269504089f, -mxl)); sum += pv[j]; }
                int w = __builtin_amdgcn_cvt_pk_fp8_f32(pv[0], pv[1], 0, false); w = __builtin_amdgcn_cvt_pk_fp8_f32(pv[2], pv[3], w, true); P8[T] = (unsigned)w; }
            sum += __shfl_xor(sum, 16); sum += __shfl_xor(sum, 32);
            const float inv = 1.0f / sum;
            float invh[4];
#pragma unroll
            for (int j = 0; j < 4; ++j) invh[j] = __shfl(inv, 4 * (g4 & 1) + j);
            f32x4 O[8];
#pragma unroll
            for (int dt = 0; dt < 8; ++dt) O[dt] = (f32x4){0.f, 0.f, 0.f, 0.f};
            typedef int i2v __attribute__((ext_vector_type(2)));
            const LAS unsigned char* vtr = lds + (wave * 8 + g4 + 4 * ((lane & 15) >> 3)) * 2048 + 1024 + (((lane & 15) >> 1) & 3) * 160 + ((lane & 15) >> 3) * 128 + (g4 & 1) * 16 + (lane & 1) * 8;
#pragma unroll
            for (int ch = 0; ch < 8; ++ch) {
                u32x4 (&vv)[4] = (ch & 1) ? vvB : vvA;
#pragma unroll
                for (int q = 0; q < 4; ++q) *(LAS u32x4*)(lds + vwr + q * 4096 + (q >> 1) * 128) = vv[q];
                if (ch < 6) {
#pragma unroll
                    for (int q = 0; q < 4; ++q) { const unsigned e = Lh[(ch + 2) * 32 + 8 * q];
                        const int kp = ((ch + 2) * 32 + 8 * q < nh) ? (int)(16383u - (e & 16383u)) : 0;
                        vv[q] = *(const u32x4*)(kv8 + (size_t)(rowbase + kp) * 256 + 128 + (lane & 7) * 16); }
                }
                const long pf = (long)(((unsigned long long)P8[2 * ch + 1] << 32) | P8[2 * ch]);
#pragma unroll
                for (int dt = 0; dt < 8; ++dt) {
                    const i2v vt = __builtin_amdgcn_ds_read_tr8_b64_v2i32((LAS i2v*)(vtr + dt * 16));
                    O[dt] = __builtin_amdgcn_mfma_f32_16x16x32_fp8_fp8(pf, __builtin_bit_cast(long, vt), O[dt], 0, 0, 0);
                }
                asm volatile("" ::: "memory");
            }
            if (g4 < 2) {
#pragma unroll
                for (int j = 0; j < 4; ++j) {
                    const f32x4 o4 = g4 ? (f32x4){O[4][j], O[5][j], O[6][j], O[7][j]} : (f32x4){O[0][j], O[1][j], O[2][j], O[3][j]};
                    u32x2 w; w.x = pk2(o4[0] * invh[j], o4[1] * invh[j]); w.y = pk2(o4[2] * invh[j], o4[3] * invh[j]);
                    *(u32x2*)(attn_out + (size_t)tokrow * 1024 + (4 * g4 + j) * 64 + 4 * c15) = w;
                }
            }
        }
    }
}

__device__ __forceinline__ void p7_router(const Args& a, LAS unsigned char* lds, int wave, int lane, int G) {
    unsigned char* ws = a.ws;
    const bf16_t* x1b = (const bf16_t*)(ws + WS_X1B); const bf16_t* wr = (const bf16_t*)(ws + WS_WR);
    const float* ss2 = (const float*)(ws + CTLB_SS2); const float* rb = a.in[I_RB];
    int* topi = (int*)(ws + WS_TOPI); float* topg = (float*)(ws + WS_TOPG); int* lrank = (int*)(ws + WS_LRANK); int* cntwg = (int*)(ws + CTLB_CNTWG);
    LAS unsigned* wcnt = (LAS unsigned*)(lds + LDS_MISC + 64);
    if (threadIdx.x < 32) wcnt[threadIdx.x] = 0u;
    __syncthreads();
    LAS float* lg = (LAS float*)(lds + wave * 4096);
    const int c15 = lane & 15, g4 = lane >> 4;
    for (int tile = blockIdx.x * NWAVES + wave; tile < M / 16; tile += G * NWAVES) {
        const int tok0 = tile * 16;
        f32x4 a0 = (f32x4){0.f, 0.f, 0.f, 0.f}, a1 = a0;
        const bf16_t* ap = x1b + (size_t)(tok0 + c15) * D + g4 * 8; const bf16_t* bp0 = wr + (size_t)c15 * D + g4 * 8; const bf16_t* bp1 = bp0 + 16 * D;
#pragma unroll 8
        for (int ks = 0; ks < 32; ++ks) { const bf16x8 av = *(const bf16x8*)(ap + ks * 32), b0 = *(const bf16x8*)(bp0 + ks * 32), b1 = *(const bf16x8*)(bp1 + ks * 32);
            a0 = __builtin_amdgcn_mfma_f32_16x16x32_bf16(av, b0, a0, 0, 0, 0); a1 = __builtin_amdgcn_mfma_f32_16x16x32_bf16(av, b1, a1, 0, 0, 0); }
#pragma unroll
        for (int j = 0; j < 4; ++j) { lg[(4 * g4 + j) * 33 + c15] = a0[j]; lg[(4 * g4 + j) * 33 + 16 + c15] = a1[j]; }
        LDS_WAIT(); asm volatile("" ::: "memory");
        if (lane < 16) {
            const int tok = tok0 + lane; const float rs = rsqrtf(ss2[tok] * (1.0f / D) + RMS_EPS);
            float v[32];
#pragma unroll
            for (int e = 0; e < 32; ++e) v[e] = lg[lane * 33 + e] * rs + rb[e];
            int bi[4]; float bv[4];
#pragma unroll
            for (int r = 0; r < 4; ++r) { float best = -3.0e38f; int bidx = 0;
#pragma unroll
                for (int e = 0; e < 32; ++e) { bool used = false;
#pragma unroll
                    for (int q = 0; q < 4; ++q) if (q < r && bi[q] == e) used = true;
                    if (!used && v[e] > best) { best = v[e]; bidx = e; } }
                bi[r] = bidx; bv[r] = best; }
            float ex[4], se = 0.f;
#pragma unroll
            for (int r = 0; r < 4; ++r) { ex[r] = __expf(bv[r] - bv[0]); se += ex[r]; }
            const float inv = 1.0f / se;
#pragma unroll
            for (int r = 0; r < 4; ++r) { topi[tok * 4 + r] = bi[r]; topg[tok * 4 + r] = ex[r] * inv; lrank[tok * 4 + r] = (int)lds_atomic_inc(wcnt + bi[r]); }
        }
        LDS_WAIT(); asm volatile("" ::: "memory");
    }
    __syncthreads();
    if (threadIdx.x < 32) cntwg[blockIdx.x * 32 + threadIdx.x] = (int)wcnt[threadIdx.x];
}

__device__ __forceinline__ void p8_scatter(const Args& a, LAS unsigned char* lds, int wave, int lane, int G) {
    unsigned char* ws = a.ws;
    const int* cntwg = (const int*)(ws + CTLB_CNTWG); const int* topi = (const int*)(ws + WS_TOPI); const float* topg = (const float*)(ws + WS_TOPG);
    const int* lrank = (const int*)(ws + WS_LRANK); int* posof = (int*)(ws + WS_POSOF); int* rowmap = (int*)(ws + WS_ROWMAP); float* rowgate = (float*)(ws + WS_ROWGATE);
    int* tile_e = (int*)(ws + CTLB_TILEE); int* meta = (int*)(ws + CTLB_META); float* rowscale = (float*)(ws + WS_ROWSCALE);
    LAS int* part = (LAS int*)(lds);
    LAS int* tot = (LAS int*)(lds + 8192);
    LAS int* pre = tot + 32;
    LAS int* base = tot + 64;
    const int tid = threadIdx.x, e = tid & 31, pt = tid >> 5, myw = blockIdx.x;
    int sall = 0, spre = 0;
#pragma unroll 8
    for (int w = pt; w < G; w += 16) { const int v = cntwg[w * 32 + e]; sall += v; spre += (w < myw) ? v : 0; }
    part[pt * 32 + e] = sall; part[512 + pt * 32 + e] = spre;
    __syncthreads();
    if (tid < 32) { int s0 = 0, s1 = 0;
#pragma unroll
        for (int q = 0; q < 16; ++q) { s0 += part[q * 32 + tid]; s1 += part[512 + q * 32 + tid]; }
        tot[tid] = s0; pre[tid] = s1; }
    __syncthreads();
    if (tid == 0) { int bsum = 0; for (int q = 0; q < 32; ++q) { base[q] = bsum; bsum += (tot[q] + 255) & ~255; } base[32] = bsum; }
    __syncthreads();
    for (int tile = blockIdx.x * NWAVES + wave; tile < M / 16; tile += G * NWAVES) {
        const int idx = tile * 64 + lane; const int ex = topi[idx];
        const int pos = base[ex] + pre[ex] + lrank[idx];
        rowmap[pos] = idx >> 2; rowgate[pos] = topg[idx]; posof[idx] = pos;
        rowscale[pos] = rsqrtf(((const float*)(ws + CTLB_SS2))[idx >> 2] * (1.0f / D) + RMS_EPS);
    }
    for (int ex = blockIdx.x; ex < 32; ex += G) { const int t_ = tot[ex], pe = (t_ + 255) & ~255;
        for (int r = t_ + tid; r < pe; r += NTHREADS) { rowmap[base[ex] + r] = 0; rowgate[base[ex] + r] = 0.f; rowscale[base[ex] + r] = 0.f; } }
    if (blockIdx.x == 0) {
        const int ntl = base[32] >> 8;
        for (int t = tid; t < 544; t += NTHREADS) { int ex = 0;
            for (int q = 0; q < 32; ++q) if (base[q] <= t * 256) ex = q;
            tile_e[t] = (t < ntl) ? ex : 0; }
        if (tid == 0) meta[0] = ntl;
    }
}

__device__ __forceinline__ void p11_combine(const Args& a, int wave, int lane, int G) {
    unsigned char* ws = a.ws;
    const int* posof = (const int*)(ws + WS_POSOF); const unsigned char* Y = ws + WS_R2; const bf16_t* x1b = (const bf16_t*)(ws + WS_X1B); bf16_t* x2b = (bf16_t*)(ws + WS_R1); float* rs3 = (float*)(ws + WS_RS3);
    const int gw = blockIdx.x * NWAVES + wave, NGW = G * NWAVES;
    typedef int i4v __attribute__((ext_vector_type(4)));
    i4v pnx = (gw < M) ? *(const i4v*)(posof + (size_t)gw * 4) : (i4v){0, 0, 0, 0};
    for (int m = gw; m < M; m += NGW) {
        const i4v pcur = pnx;
        if (m + NGW < M) pnx = *(const i4v*)(posof + (size_t)(m + NGW) * 4);
        const u32x2* xr = (const u32x2*)(x1b + (size_t)m * D) + lane; f32x4 v[4]; u32x2 xw[4]; unsigned yw[4][4];
#pragma unroll
        for (int j = 0; j < 4; ++j) xw[j] = xr[64 * j];
#pragma unroll
        for (int s = 0; s < 4; ++s) { const unsigned* yr = (const unsigned*)(Y + (size_t)pcur[s] * D) + lane;
#pragma unroll
            for (int j = 0; j < 4; ++j) yw[s][j] = yr[64 * j]; }
#pragma unroll
        for (int j = 0; j < 4; ++j) { const u32x2 w = xw[j]; v[j] = (f32x4){bf_lo(w.x), bf_hi(w.x), bf_lo(w.y), bf_hi(w.y)}; }
#pragma unroll
        for (int s = 0; s < 4; ++s) {
#pragma unroll
            for (int j = 0; j < 4; ++j) { const f32x2_ lo = __builtin_amdgcn_cvt_pk_f32_fp8((int)yw[s][j], false), hi = __builtin_amdgcn_cvt_pk_f32_fp8((int)yw[s][j], true);
                v[j][0] += lo.x; v[j][1] += lo.y; v[j][2] += hi.x; v[j][3] += hi.y; } }
        float s = 0.f;
#pragma unroll
        for (int j = 0; j < 4; ++j) s += (v[j][0] * v[j][0] + v[j][1] * v[j][1]) + (v[j][2] * v[j][2] + v[j][3] * v[j][3]);
        s = wave_sum(s); if (lane == 0) rs3[m] = rsqrtf(s * (1.0f / D) + RMS_EPS);
        u32x2* o = (u32x2*)(x2b + (size_t)m * D) + lane;
#pragma unroll
        for (int j = 0; j < 4; ++j) { u32x2 w; w.x = pk2(v[j][0], v[j][1]); w.y = pk2(v[j][2], v[j][3]); o[64 * j] = w; }
    }
}
__device__ __forceinline__ void p13_final(const Args& a, int wave, int lane, int G) {
    const float* ss4 = (const float*)(a.ws + CTLB_SS4); const float* fg = a.in[I_FG]; const bf16_t* x3b = (const bf16_t*)(a.ws + WS_R1 + 128 * MiB);
    const int gw = blockIdx.x * NWAVES + wave, NGW = G * NWAVES;
    f32x4 gq[4];
#pragma unroll
    for (int j = 0; j < 4; ++j) gq[j] = ((const f32x4*)fg)[lane + 64 * j];
    for (int m0 = gw; m0 < M; m0 += 4 * NGW) { u32x2 xw[4][4]; float sv[4];
#pragma unroll
        for (int r = 0; r < 4; ++r) { const int m = m0 + r * NGW; if (m < M) { sv[r] = ss4[m]; const u32x2* xr = (const u32x2*)(x3b + (size_t)m * D) + lane;
#pragma unroll
            for (int j = 0; j < 4; ++j) xw[r][j] = xr[64 * j]; } }
#pragma unroll
        for (int r = 0; r < 4; ++r) { const int m = m0 + r * NGW; if (m < M) { const float rs = rsqrtf(sv[r] * (1.0f / D) + RMS_EPS); f32x4* orow = (f32x4*)(a.out + (size_t)m * D) + lane;
#pragma unroll
            for (int j = 0; j < 4; ++j) { const u32x2 w = xw[r][j]; orow[64 * j] = (f32x4){bf_lo(w.x), bf_hi(w.x), bf_lo(w.y), bf_hi(w.y)} * rs * gq[j]; } } } }
}

__global__ void __launch_bounds__(NTHREADS, 2) fwd(Args args) {
    extern __shared__ __attribute__((aligned(16))) unsigned char lds_raw[];
    LAS unsigned char* lds = (LAS unsigned char*)lds_raw;
    const int G = gridDim.x;
#define tid ((int)threadIdx.x)
#define lane ((int)(threadIdx.x & 63))
#define wave (__builtin_amdgcn_readfirstlane((int)(threadIdx.x >> 6)))
    unsigned char* ws = args.ws;
    volatile LAS unsigned* MISC = (volatile LAS unsigned*)(lds + LDS_MISC);
    if (tid < 64) MISC[tid] = 0u;
    __syncthreads();
    XcdBarrier bar = xcd_barrier_post((unsigned*)(ws + CTLB_BAR), MISC);
    const int lo = args.ph_lo, hi = args.ph_hi;
#define IN(k) (lo <= (k) && (k) < hi)
#define SEAM(k) do { if (IN(k) && IN((k) + 1)) xcd_barrier(bar); } while (0)
    unsigned char* pj = ws + WS_R1;
    bf16_t* xb = (bf16_t*)(ws + WS_R2); bf16_t* cat = (bf16_t*)(ws + WS_R2 + 64 * MiB);
    bf16_t* mixed = cat; bf16_t* attn = cat + 512; bf16_t* zb = (bf16_t*)(ws + WS_R2 + 192 * MiB);

    if (IN(PH_PRO)) { p0_prologue(args, lds, wave, lane, G); }
    SEAM(PH_PRO);
    if (IN(PH_INPROJ)) {
        pg8::Gemm g{xb, (const bf16_t*)(ws + WS_WIN), M, NP, D, 0, nullptr}; pg8::StaticOrder S; S.init(M, NP, G, (int)blockIdx.x);
        EpiProj E{pj, (const float*)(ws + WS_RS1)};
        pg8::gemm_phase<EpiProj, pg8::StaticOrder, false>(lds, g, S, E);
    }
    SEAM(PH_INPROJ);
    if (IN(PH_MIXED)) { p2_mixed((const bf16_t*)(pj + PJ_U), mixed, G); }
    if (IN(PH_ATT)) {
        __syncthreads();
        p4_attention(pj, attn, (unsigned*)(ws + CTLB_QUEUE), DBG ? (int*)(ws + WS_SEL) : nullptr, lds, wave, lane);
        for (;;) {
            __syncthreads();
            if (tid == 0) MISC[4] = atomicAdd((unsigned*)(ws + CTLB_QUEUE) + 128, 1u);
            __syncthreads();
            const int c = __builtin_amdgcn_readfirstlane((int)MISC[4]);
            if (c >= I_E1 / 8) break;
            deferred_chunk(args, lds, c, wave, lane);
        }
    }
    SEAM(PH_ATT);
    if (IN(PH_Z)) {
        pg8::Gemm g{cat, (const bf16_t*)(ws + WS_WPC), M, D, 1024, 0, nullptr}; pg8::StaticOrder S; S.init(M, D, G, (int)blockIdx.x);
        EpiGate<false, true> E{zb, (const bf16_t*)(pj + PJ_G) + 1024, nullptr};
        HookGateRatio Hk{(const bf16_t*)(pj + PJ_G)};
        pg8::gemm_phase<EpiGate<false, true>, pg8::StaticOrder, false, HookGateRatio>(lds, g, S, E, Hk);
    }
    SEAM(PH_Z);
    if (IN(PH_X1)) {
        pg8::Gemm g{zb, (const bf16_t*)(ws + WS_WOUT), M, D, D, 0, nullptr}; pg8::StaticOrder S; S.init(M, D, G, (int)blockIdx.x);
        EpiX1 E{args.in[I_X], (bf16_t*)(ws + WS_X1B), (float*)(ws + CTLB_SS2), ws + WS_R1 + 144 * MiB};
        pg8::gemm_phase<EpiX1, pg8::StaticOrder, false>(lds, g, S, E);
    }
    SEAM(PH_X1);
    if (IN(PH_ROUTER)) { p7_router(args, lds, wave, lane, G); }
    SEAM(PH_ROUTER);
    if (IN(PH_SCATTER)) { __syncthreads(); p8_scatter(args, lds, wave, lane, G); }
    SEAM(PH_SCATTER);
    if (IN(PH_MOE1)) {
        __syncthreads();
        pg8::Gemm g{(const bf16_t*)(ws + WS_R1 + 144 * MiB), (const bf16_t*)(ws + WS_W1), M, 2048, D / 2, (size_t)2048 * D, (const int*)(ws + WS_ROWMAP)};
        LAS int* te_l = (LAS int*)(lds + LDS_KT); for (int i = tid; i < 544; i += NTHREADS) te_l[i] = ((const int*)(ws + CTLB_TILEE))[i];
        __syncthreads();
        pg8::MoeOrder S{te_l, *(const int*)(ws + CTLB_META), 8, G, (int)blockIdx.x};
        EpiMoe1 E{ws + WS_R1, (const float*)(ws + WS_ROWSCALE), args.in[I_B1]};
        pg8::gemm_phase<EpiMoe1, pg8::MoeOrder, true, pg8::NoHook, 2>(lds, g, S, E);
        for (;;) {
            __syncthreads();
            if (tid == 0) MISC[4] = atomicAdd((unsigned*)(ws + CTLB_QUEUE) + 192, 1u);
            __syncthreads();
            const int c = I_E1 / 8 + __builtin_amdgcn_readfirstlane((int)MISC[4]);
            if (c >= DC_EXPERT) break;
            deferred_chunk(args, lds, c, wave, lane);
        }
    }
    SEAM(PH_MOE1);
    if (IN(PH_MOE2)) {
        pg8::Gemm g{(const bf16_t*)(ws + WS_R1), (const bf16_t*)(ws + WS_W2), MOE_ROWS, D, DFF / 2, (size_t)D * DFF, nullptr};
        LAS int* te_l = (LAS int*)(lds + LDS_KT); for (int i = tid; i < 544; i += NTHREADS) te_l[i] = ((const int*)(ws + CTLB_TILEE))[i];
        __syncthreads();
        pg8::MoeOrder S{te_l, *(const int*)(ws + CTLB_META), 4, G, (int)blockIdx.x};
        EpiMoe2 E{ws + WS_R2, (const float*)(ws + WS_ROWGATE), args.in[I_B2]};
        pg8::gemm_phase<EpiMoe2, pg8::MoeOrder, false, pg8::NoHook, 2>(lds, g, S, E);
        { const int nunits = S.ntiles * 4, rem = nunits % G, vwg = (G % 8 == 0) ? ((int)blockIdx.x % 8) * (G / 8) + (int)blockIdx.x / 8 : (int)blockIdx.x;
          pg8::PPOrder SP{rem ? G - rem : G, rem ? vwg - rem : vwg};
          pg8::Gemm gp{(const bf16_t*)(ws + WS_PB), (const bf16_t*)(ws + WS_WPP), M, D, PLE, 0, nullptr};
          EpiPP EP{ws + WS_PP};
          pg8::gemm_phase<EpiPP, pg8::PPOrder, false>(lds, gp, SP, EP); }
    }
    SEAM(PH_MOE2);
    if (IN(PH_COMBINE)) { p11_combine(args, wave, lane, G); }
    SEAM(PH_COMBINE);
    if (IN(PH_PLE)) {
        pg8::Gemm g{(const bf16_t*)(ws + WS_R1), (const bf16_t*)(ws + WS_WPG), M, D, D, 0, nullptr}; pg8::StaticOrder S; S.init(M, D, G, (int)blockIdx.x);
        EpiPleGX E{(bf16_t*)(ws + WS_R1 + 128 * MiB), (const bf16_t*)(ws + WS_R1), ws + WS_PP, (const float*)(ws + WS_RS3), (float*)(ws + CTLB_SS4)};
        pg8::gemm_phase<EpiPleGX, pg8::StaticOrder, false>(lds, g, S, E);
    }
    SEAM(PH_PLE);
    if (IN(PH_FINAL)) { p13_final(args, wave, lane, G); }
#undef IN
#undef SEAM
#undef tid
#undef lane
#undef wave
}

#if DBG
__device__ __forceinline__ unsigned hash_u(unsigned x) { x ^= x >> 16; x *= 0x7feb352dU; x ^= x >> 15; x *= 0x846ca68bU; x ^= x >> 16; return x; }
__device__ __forceinline__ bool closef(float got, float ref, float rtol, float atol) { return fabsf(got - ref) <= atol + rtol * fabsf(ref); }
__device__ float dotbf(const bf16_t* a, const bf16_t* b, int K) { float s = 0.f; for (int k = 0; k < K; ++k) s += bf1(a[k]) * bf1(b[k]); return s; }
__device__ __forceinline__ void dbg_fail(unsigned* dbg, int code) { atomicAdd(dbg + code, 1u); }
__device__ float f2bf_f(float v) { return __builtin_bit_cast(float, f2bf(v) << 16); }

__device__ float pjv(const unsigned char* pj, int m, int c) {
    const bf16_t* b; int ld, cc;
    if (c < 512) { b = (const bf16_t*)(pj + PJ_U); ld = 512; cc = c; }
    else if (c < 1024) { b = (const bf16_t*)(pj + PJ_Q); ld = 512; cc = c - 512; }
    else if (c < 1280) { const unsigned v = (pj + PJ_KV)[(size_t)m * 256 + (c - 1024)]; const int e = (v >> 3) & 15, mt = v & 7;
        const float mag = e ? ldexpf(1.0f + mt * 0.125f, e - 7) : ldexpf(mt * 0.125f, -6); return (v & 128) ? -mag : mag; }
    else if (c < 1792) { b = (const bf16_t*)(pj + PJ_QI); ld = 512; cc = c - 1280; }
    else if (c < 2048) { b = (const bf16_t*)(pj + PJ_KW); ld = 128; cc = c - 1792; if (cc >= 128) return 0.f; }
    else { b = (const bf16_t*)(pj + PJ_G); ld = 2048; cc = c - 2048; }
    return bf1(b[(size_t)m * ld + cc]);
}
__global__ void __launch_bounds__(256) chk(Args a, int phase) {
    unsigned char* ws = a.ws; unsigned* dbg = (unsigned*)(ws + CTLB_DBG);
    const unsigned s = blockIdx.x * 256 + threadIdx.x;
    const unsigned h = hash_u(s * 2654435761u + 12345u), h2 = hash_u(h + 777u);
    const unsigned char* pj = ws + WS_R1;
    const bf16_t* mixed = (const bf16_t*)(ws + WS_R2 + 64 * MiB); const bf16_t* attn = mixed + 512;
    const bf16_t* zb = (const bf16_t*)(ws + WS_R2 + 192 * MiB);
    if (phase == PH_PRO) {
        if (s == 0) {
            volatile unsigned* pv = dbg + 40; pv[0] = 0xC0484038u; pv[1] = 0x3F800000u; pv[2] = 0x40000000u; pv[3] = 0x40800000u; pv[4] = 0xC0000000u;
            const unsigned wrt = pv[0];
            const u32x2 r = fp8x4_to_bf16x4(wrt);
            if (!(r.x == 0x40003F80u && r.y == 0xC0004080u)) {
                if (r.x == 0x3F804000u) dbg_fail(dbg, 21); else if (r.x == 0xC0004080u) dbg_fail(dbg, 22); else if (r.x == 0x40003F80u) dbg_fail(dbg, 25); else if (r.y == 0xC0004080u) dbg_fail(dbg, 26); else dbg_fail(dbg, 23); }
            const unsigned enc = pk4_fp8(__builtin_bit_cast(float, (unsigned)pv[1]), __builtin_bit_cast(float, (unsigned)pv[2]), __builtin_bit_cast(float, (unsigned)pv[3]), __builtin_bit_cast(float, (unsigned)pv[4]));
            if (enc != 0xC0484038u) dbg_fail(dbg, 24);
        }
        {
          const int n = h % IN_COLS, k = h2 % D; int row = n < 1864 ? n : n + 184;
          if (n >= 1152 && n < 1280) { const int d = (n - 1152) & 63; row = 1152 + ((n - 1152) & 64) + 16 * (d & 3) + (d >> 2); }
          float sc = 1.f; if ((n >= 512 && n < 1024) || (n >= 1280 && n < 1792)) sc = 0.125f; if (n >= 1856 && n < 1864) sc = 0.35355339059327373f;
          const float ref = f2bf_f(a.in[I_WIN][(size_t)k * IN_COLS + n] * (sc * a.in[I_N1G][k]));
          const float got = bf1(((const bf16_t*)(ws + WS_WIN))[(size_t)row * D + k]);
          if (!closef(got, ref, 0.01f, 1e-6f)) dbg_fail(dbg, 1); }
        {
          const int m = h % M, k = h2 % D;
          if (!closef(bf1(((const bf16_t*)(ws + WS_R2))[(size_t)m * D + k]), f2bf_f(a.in[I_X][(size_t)m * D + k]), 0.01f, 1e-6f)) dbg_fail(dbg, 2);
          if (s < 512) { float q = 0.f; for (int i = 0; i < D; ++i) { const float v = a.in[I_X][(size_t)m * D + i]; q += v * v; }
            if (!closef(((const float*)(ws + WS_RS1))[m], rsqrtf(q / D + RMS_EPS), 0.001f, 0.f)) dbg_fail(dbg, 2); }
        }
    }
    if (phase == PH_INPROJ) {
        const int m = h % M; int c = h2 % NP; if (s & 1) c = (c & 255) | (7 << 8);
        float r = dotbf((const bf16_t*)(ws + WS_R2) + (size_t)m * D, (const bf16_t*)(ws + WS_WIN) + (size_t)c * D, D) * ((const float*)(ws + WS_RS1))[m];
        if (c >= 2048) r = 1.0f / (1.0f + expf(-r));
        if (c >= 1792 + 128 && c < 2048) r = 0.f;
        if (!closef(pjv(pj, m, c), r, (c >= 1024 && c < 1280) ? 0.08f : 0.02f, (c >= 1024 && c < 1280) ? 0.02f : 0.01f)) dbg_fail(dbg, 3);
    }
    if (phase == PH_MIXED) {
        int m = h % M; if (s < 64) m = (s & 31) + (s >> 5) * SEQ; const int c = h2 % 512, g = c >> 7, w = 2 << g, t = m & (SEQ - 1); const int nw = (t + 1) < w ? (t + 1) : w;
        float r = 0.f; for (int i = 0; i < nw; ++i) r += pjv(pj, m - i, c);
        r = r / nw - pjv(pj, m, c);
        if (!closef(bf1(mixed[(size_t)m * 1024 + c]), r, 0.02f, 0.01f)) dbg_fail(dbg, 4);
    }
    if (phase == PH_Z) {
        {
          const int e = h % 32, n = (h >> 5) % D, k = h2 % D;
          const int k2 = h2 % PLE;
          if (!closef(bf1(((const bf16_t*)(ws + WS_WPP))[(size_t)n * PLE + k2]), f2bf_f(a.in[I_PPW][(size_t)k2 * D + n]), 0.01f, 1e-6f)) dbg_fail(dbg, 1);
          if (!closef(bf1(((const bf16_t*)(ws + WS_WR))[(size_t)e * D + k]), f2bf_f(a.in[I_RW][(size_t)k * NE + e] * a.in[I_N2G][k]), 0.01f, 1e-6f)) dbg_fail(dbg, 1);
          if (!closef(bf1(((const bf16_t*)(ws + WS_WPG))[(size_t)n * D + k]), f2bf_f(a.in[I_PGW][(size_t)k * D + n] * a.in[I_PNG][k]), 0.01f, 1e-6f)) dbg_fail(dbg, 1);
          const int k5 = h2 % 512;
          if (!closef(bf1(((const bf16_t*)(ws + WS_WPC))[(size_t)n * 1024 + 512 + k5]), f2bf_f(a.in[I_WBA][(size_t)k5 * D + n]), 0.01f, 1e-6f)) dbg_fail(dbg, 1);
          { const int g = k5 >> 7; float r = 0.f; for (int d = 0; d < 128; ++d) r += a.in[I_POOLW][(size_t)k5 * 128 + d] * a.in[I_POOLS][g * 128 + d] * a.in[I_WBP][(size_t)(g * 128 + d) * D + n];
            if (!closef(bf1(((const bf16_t*)(ws + WS_WPC))[(size_t)n * 1024 + k5]), r, 0.01f, 1e-4f)) dbg_fail(dbg, 1); } }
        { const int m = h % M, k2 = h2 % PLE;
          if (!closef(bf1(((const bf16_t*)(ws + WS_PB))[(size_t)m * PLE + k2]), f2bf_f(a.in[I_P][(size_t)m * PLE + k2]), 0.01f, 1e-6f)) dbg_fail(dbg, 2); }
        {
          const int e = h % 32, n = (h >> 5) % 2048, k = h2 % D; const int row = n < 1024 ? (((n >> 7) << 8) + (n & 127)) : ((((n - 1024) >> 7) << 8) + 128 + ((n - 1024) & 127));
          const float ref = f2bf_f(a.in[I_W1][((size_t)e * D + k) * 2048 + n] * a.in[I_N2G][k]);
          const float got = bf1(((const bf16_t*)(ws + WS_W1))[((size_t)e * 2048 + row) * D + k]);
          if (!closef(got, ref, 0.01f, 1e-6f)) dbg_fail(dbg, 1); }
        { const int e = h % 32, n = (h >> 5) % D, k = h2 % D;
          if (!closef(bf1(((const bf16_t*)(ws + WS_W2))[((size_t)e * D + n) * DFF + k]), f2bf_f(a.in[I_W2][((size_t)e * DFF + k) * D + n]), 0.01f, 1e-6f)) dbg_fail(dbg, 1); }
        const int m = h % M, c = h2 % D; const bf16_t* wc_ = (const bf16_t*)(ws + WS_WPC) + (size_t)c * 1024;
        const float r = dotbf(mixed + (size_t)m * 1024, wc_, 512) * pjv(pj, m, C_GP + c) + dotbf(attn + (size_t)m * 1024, wc_ + 512, 512) * pjv(pj, m, C_GA + c);
        if (!closef(bf1(zb[(size_t)m * D + c]), r, 0.02f, 0.02f)) dbg_fail(dbg, 8);
    }
    if (phase == PH_X1) {
        const int m = h % M, c = h2 % D;
        const float r = a.in[I_X][(size_t)m * D + c] + dotbf(zb + (size_t)m * D, (const bf16_t*)(ws + WS_WOUT) + (size_t)c * D, D);
        if (!closef(bf1(((const bf16_t*)(ws + WS_X1B))[(size_t)m * D + c]), r, 0.01f, 0.01f)) dbg_fail(dbg, 9);
        if (s < 512) { float q = 0.f; for (int i = 0; i < D; ++i) { const float v = bf1(((const bf16_t*)(ws + WS_X1B))[(size_t)m * D + i]); q += v * v; }
            if (!closef(((const float*)(ws + CTLB_SS2))[m], q, 0.01f, 0.f)) dbg_fail(dbg, 9); }
    }
    if (phase == PH_ROUTER) {
        const int m = h % M; const float rs = rsqrtf(((const float*)(ws + CTLB_SS2))[m] / D + RMS_EPS);
        float v[32]; for (int e = 0; e < 32; ++e) v[e] = dotbf((const bf16_t*)(ws + WS_X1B) + (size_t)m * D, (const bf16_t*)(ws + WS_WR) + (size_t)e * D, D) * rs + a.in[I_RB][e];
        const int* ti = (const int*)(ws + WS_TOPI) + m * 4; const float* tg = (const float*)(ws + WS_TOPG) + m * 4;
        float mn = 1e30f, se = 0.f, gs = 0.f; bool ok = true;
        for (int r = 0; r < 4; ++r) { if (ti[r] < 0 || ti[r] >= 32) { ok = false; break; } mn = fminf(mn, v[ti[r]]); for (int q = 0; q < r; ++q) if (ti[q] == ti[r]) ok = false; }
        if (ok) { for (int r = 0; r < 4; ++r) se += expf(v[ti[r]] - v[ti[0]]);
            for (int r = 0; r < 4; ++r) { if (!closef(tg[r], expf(v[ti[r]] - v[ti[0]]) / se, 0.02f, 0.002f)) ok = false; gs += tg[r]; }
            int above = 0; for (int e = 0; e < 32; ++e) { bool sel = false; for (int r = 0; r < 4; ++r) sel |= (ti[r] == e); if (!sel && v[e] > mn + 1e-3f) ++above; }
            if (above) ok = false; }
        if (!ok) dbg_fail(dbg, 10);
    }
    if (phase == PH_SCATTER) {
        const int m = h % M; const int* ti = (const int*)(ws + WS_TOPI) + m * 4; const int* po = (const int*)(ws + WS_POSOF) + m * 4; const int* te = (const int*)(ws + CTLB_TILEE);
        const int ntl = *(const int*)(ws + CTLB_META); bool ok = ntl > 0 && ntl <= 544;
        for (int r = 0; r < 4 && ok; ++r) { const int p = po[r]; if (p < 0 || p >= ntl * 256) { ok = false; break; }
            if (((const int*)(ws + WS_ROWMAP))[p] != m) ok = false; if (te[p >> 8] != ti[r]) ok = false;
            if (!closef(((const float*)(ws + WS_ROWGATE))[p], ((const float*)(ws + WS_TOPG))[m * 4 + r], 1e-6f, 0.f)) ok = false; }
        if (!ok) dbg_fail(dbg, 11);
    }
    if (phase == PH_MOE1) {
        const int ntl = *(const int*)(ws + CTLB_META); if (ntl > 0 && ntl <= 544) {
        const int row = h % (ntl * 256), j = h2 % DFF; const int e = ((const int*)(ws + CTLB_TILEE))[row >> 8], tok = ((const int*)(ws + WS_ROWMAP))[row];
        const float rs = rsqrtf(((const float*)(ws + CTLB_SS2))[tok] / D + RMS_EPS);
        const bf16_t* w1t = (const bf16_t*)(ws + WS_W1) + (size_t)e * 2048 * D; const int rg = ((j >> 7) << 8) + (j & 127), ru = rg + 128;
        float gl = dotbf((const bf16_t*)(ws + WS_X1B) + (size_t)tok * D, w1t + (size_t)rg * D, D) * rs + a.in[I_B1][e * 2048 + j];
        float up = dotbf((const bf16_t*)(ws + WS_X1B) + (size_t)tok * D, w1t + (size_t)ru * D, D) * rs + a.in[I_B1][e * 2048 + 1024 + j];
        gl = fminf(gl, 7.f); up = fminf(fmaxf(up, -7.f), 7.f);
        const float r = (up + 1.f) * gl / (1.f + expf(-1.702f * gl));
        if (((const float*)(ws + WS_ROWGATE))[row] != 0.f && !closef(bf1(((const bf16_t*)(ws + WS_R1))[(size_t)row * DFF + j]), r, 0.03f, 0.02f)) dbg_fail(dbg, 12); } else dbg_fail(dbg, 12);
    }
    if (phase == PH_MOE2) {
        const int ntl = *(const int*)(ws + CTLB_META); if (ntl > 0 && ntl <= 544) {
        const int row = h % (ntl * 256), c = h2 % D; const int e = ((const int*)(ws + CTLB_TILEE))[row >> 8];
        const float r = (dotbf((const bf16_t*)(ws + WS_R1) + (size_t)row * DFF, (const bf16_t*)(ws + WS_W2) + ((size_t)e * D + c) * DFF, DFF) + a.in[I_B2][e * D + c]) * ((const float*)(ws + WS_ROWGATE))[row];
        if (!closef(bf1(((const bf16_t*)(ws + WS_R2))[(size_t)row * D + c]), r, 0.03f, 0.01f)) dbg_fail(dbg, 13); } else dbg_fail(dbg, 13);
    }
    if (phase == PH_COMBINE) {
        const int m = h % M, c = h2 % D;
        { float r2 = bf1(((const bf16_t*)(ws + WS_X1B))[(size_t)m * D + c]); for (int q = 0; q < 4; ++q) r2 += bf1(((const bf16_t*)(ws + WS_R2))[(size_t)((const int*)(ws + WS_POSOF))[m * 4 + q] * D + c]);
          if (!closef(bf1(((const bf16_t*)(ws + WS_R1))[(size_t)m * D + c]), r2, 0.01f, 0.01f)) dbg_fail(dbg, 14); }
        if (s < 512) { float q = 0.f; for (int i = 0; i < D; ++i) { const float v = bf1(((const bf16_t*)(ws + WS_R1))[(size_t)m * D + i]); q += v * v; }
            if (!closef(((const float*)(ws + WS_RS3))[m], rsqrtf(q / D + RMS_EPS), 0.01f, 0.f)) dbg_fail(dbg, 14); }
    }
    if (phase == PH_PLE) {
        const int m = h % M, c = h2 % D;
        const float pp = dotbf((const bf16_t*)(ws + WS_PB) + (size_t)m * PLE, (const bf16_t*)(ws + WS_WPP) + (size_t)c * PLE, PLE);
        const float ppk = bf1(((const bf16_t*)(ws + WS_PP))[(size_t)m * D + c]);
        if (!closef(ppk, pp, 0.02f, 0.01f)) dbg_fail(dbg, 16);
        const float gate = 1.f / (1.f + expf(-dotbf((const bf16_t*)(ws + WS_R1) + (size_t)m * D, (const bf16_t*)(ws + WS_WPG) + (size_t)c * D, D) * ((const float*)(ws + WS_RS3))[m]));
        const float r3 = bf1(((const bf16_t*)(ws + WS_R1))[(size_t)m * D + c]) + gate * ppk;
        if (!closef(bf1(((const bf16_t*)(ws + WS_R1 + 128 * MiB))[(size_t)m * D + c]), r3, 0.02f, 0.03f)) dbg_fail(dbg, 15);
    }
}
__global__ void __launch_bounds__(256) chk_att(Args a) {
    unsigned char* ws = a.ws; unsigned* dbg = (unsigned*)(ws + CTLB_DBG);
    const unsigned char* pj = ws + WS_R1; const bf16_t* attn = (const bf16_t*)(ws + WS_R2 + 64 * MiB) + 512; const int* sel = (const int*)(ws + WS_SEL);
    const int special[16] = {0, 5, 63, 64, 200, 255, 256, 257, 300, 449, 512, 1000, 2047, 4096, 9000, 16383};
    const int sb = blockIdx.x; int t = (sb < 16) ? special[sb] : (int)(hash_u(sb * 977u + 5u) % SEQ); const int b = sb & 1; const int row = b * SEQ + t;
    __shared__ unsigned bitmap[512]; __shared__ unsigned skey[256]; __shared__ int s_bad, s_viol; __shared__ unsigned s_min; __shared__ float sc[8][256];
    const int tid = threadIdx.x;
    for (int i = tid; i < 512; i += 256) bitmap[i] = 0u;
    if (tid == 0) { s_bad = 0; s_viol = 0; s_min = 0xFFFFFFFFu; }
    __syncthreads();
    const int nsel = (t + 1) < 256 ? (t + 1) : 256;
    auto score_key = [&](int kp) -> unsigned {
        float s = 0.f;
        for (int hd = 0; hd < 8; ++hd) { float l = 0.f; for (int d = 0; d < 64; ++d) l += pjv(pj, row, C_QI + hd * 64 + d) * pjv(pj, b * SEQ + kp, C_KI + d);
            s = fmaf(fmaxf(l, 0.f), pjv(pj, row, C_WI + hd), s); }
        const unsigned ub = __builtin_bit_cast(unsigned, s); const unsigned srt = ub ^ ((ub >> 31) ? 0xFFFFFFFFu : 0x80000000u);
        return (srt & 0xFFFFC000u) | (unsigned)(16383 - kp);
    };
    { const int kp = sel[(size_t)row * 256 + tid];
      if (tid < nsel) { if (kp < 0 || kp > t) atomicAdd(&s_bad, 1); else { const unsigned old = atomicOr(&bitmap[kp >> 5], 1u << (kp & 31)); if (old & (1u << (kp & 31))) atomicAdd(&s_bad, 1);
            const unsigned pk = score_key(kp); skey[tid] = pk; atomicMin(&s_min, pk); } }
      else if (kp != -1) atomicAdd(&s_bad, 1); }
    __syncthreads();
    if (s_bad == 0) {
        for (int kp = tid; kp <= t; kp += 256) { if (!((bitmap[kp >> 5] >> (kp & 31)) & 1u)) { if (score_key(kp) > s_min) atomicAdd(&s_viol, 1); } }
    }
    __syncthreads();
    if (tid == 0 && (s_bad != 0 || s_viol > 3)) dbg_fail(dbg, 6);
    if (s_bad != 0) return;
    for (int hd = 0; hd < 8; ++hd) { float l = -1e30f;
        if (tid < nsel) { const int kp = sel[(size_t)row * 256 + tid]; l = 0.f; for (int d = 0; d < 64; ++d) l += pjv(pj, row, C_Q + hd * 64 + d) * pjv(pj, b * SEQ + kp, C_K + (hd >> 2) * 64 + d); }
        sc[hd][tid] = l; }
    __syncthreads();
    for (int o = tid; o < 512; o += 256) { const int hd = o >> 6, d = o & 63; float mx = -1e30f; for (int i = 0; i < nsel; ++i) mx = fmaxf(mx, sc[hd][i]);
        float se = 0.f, ov = 0.f; for (int i = 0; i < nsel; ++i) { const float p = expf(sc[hd][i] - mx); se += p; ov += p * pjv(pj, b * SEQ + sel[(size_t)row * 256 + i], C_V + (hd >> 2) * 64 + 16 * (d & 3) + (d >> 2)); }
        if (!closef(bf1(attn[(size_t)row * 1024 + o]), ov / se, 0.03f, 0.01f)) dbg_fail(dbg, 7); }
}
__global__ void __launch_bounds__(256) chk_report(Args a) {
    const unsigned* dbg = (const unsigned*)(a.ws + CTLB_DBG);
    int code = 0; for (int c = 20; c < 32; ++c) if (dbg[c] != 0u) { code = c; break; }
    if (code == 0) for (int c = 1; c < 20; ++c) if (dbg[c] != 0u) { code = c; break; }
    if (code == 0) return;
    const float v = sqrtf((float)code);
    for (size_t i = (size_t)blockIdx.x * 256 + threadIdx.x; i < (size_t)M * D; i += (size_t)gridDim.x * 256) a.out[i] = v;
}
#endif

extern "C" void kernel_launch(void* const* d_in, const int* in_sizes, int n_in, void* d_out, int out_size, void* d_ws, size_t ws_size, hipStream_t stream) {
    static int grid = 0;
    if (grid == 0) {
        if (n_in != 20 || out_size != M * D || ws_size < WS_END) { fprintf(stderr, "kernel_launch: unexpected shapes (n_in %d out %d ws %zu)\n", n_in, out_size, ws_size); grid = -1; return; }
        int dev = 0, cus = 0, per_cu = 0;
        if (hipGetDevice(&dev) != hipSuccess || hipDeviceGetAttribute(&cus, hipDeviceAttributeMultiprocessorCount, dev) != hipSuccess) { grid = -1; return; }
        if (hipFuncSetAttribute((const void*)fwd, hipFuncAttributeMaxDynamicSharedMemorySize, LDS_BYTES) != hipSuccess) { fprintf(stderr, "kernel_launch: hipFuncSetAttribute failed\n"); grid = -1; return; }
        if (hipOccupancyMaxActiveBlocksPerMultiprocessor(&per_cu, (const void*)fwd, NTHREADS, LDS_BYTES) != hipSuccess || per_cu < 1) fprintf(stderr, "kernel_launch: occupancy query says %d\n", per_cu);
        (void)hipGetLastError();
        grid = cus;
    }
    if (grid < 0) return;
    (void)hipMemsetAsync((char*)d_ws + WS_CTL, 0, CTL_ZERO_BYTES, stream);
    Args a{};
    for (int i = 0; i < 20; ++i) a.in[i] = (const float*)d_in[i];
    a.out = (float*)d_out; a.ws = (unsigned char*)d_ws;
#if DBG
    for (int p = 0; p < NPH; ++p) {
        a.ph_lo = p; a.ph_hi = p + 1;
        hipLaunchKernelGGL(fwd, dim3(grid), dim3(NTHREADS), LDS_BYTES, stream, a);
        if (p == PH_ATT) hipLaunchKernelGGL(chk_att, dim3(48), dim3(256), 0, stream, a);
        else if (p != PH_FINAL && p != PH_POOL) hipLaunchKernelGGL(chk, dim3(32), dim3(256), 0, stream, a, p);
    }
    hipLaunchKernelGGL(chk_report, dim3(1024), dim3(256), 0, stream, a);
#else
    a.ph_lo = 0; a.ph_hi = NPH;
    hipLaunchKernelGGL(fwd, dim3(grid), dim3(NTHREADS), LDS_BYTES, stream, a);
#endif
}
```

```cpp
#include <hip/hip_runtime.h>
#include <cstdio>
#include <cstdint>

#ifndef DBG
#define DBG 0
#endif

#define LAS __attribute__((address_space(3)))
#define GAS __attribute__((address_space(1)))
typedef unsigned short bf16_t;
typedef short bf16x8 __attribute__((ext_vector_type(8)));
typedef float f32x4 __attribute__((ext_vector_type(4)));
typedef float f32x16 __attribute__((ext_vector_type(16)));
typedef unsigned u32x4 __attribute__((ext_vector_type(4)));
typedef unsigned u32x2 __attribute__((ext_vector_type(2)));

constexpr int M = 32768, SEQ = 16384, D = 1024, NP = 4096, NE = 32, DFF = 1024, PLE = 256;
constexpr int IN_COLS = 3912;
constexpr int C_U = 0, C_Q = 512, C_K = 1024, C_V = 1152, C_QI = 1280, C_KI = 1792, C_WI = 1856, C_GP = 2048, C_GA = 3072;
constexpr int MOE_ROWS = M * 4 + NE * 256;
constexpr float RMS_EPS = 1e-6f;
constexpr int NWAVES = 8, NTHREADS = 512;

constexpr size_t MiB = 1u << 20;
constexpr size_t WS_CTL = 0, CTL_ZERO_BYTES = 1 * MiB;
constexpr size_t CTLB_BAR = 16384;
constexpr size_t CTLB_QUEUE = 65536;
constexpr size_t CTLB_META = 65536 + 256;
constexpr size_t CTLB_DBG = 131072;
constexpr size_t CTLB_SS2 = 262144;
constexpr size_t CTLB_SS4 = 393216;
constexpr size_t CTLB_CNTWG = 524288;
constexpr size_t CTLB_TILEE = 589824;
constexpr size_t WS_WIN = 1 * MiB, WS_WPC = 9 * MiB, WS_WBA = 10 * MiB, WS_WOUT = 11 * MiB, WS_WR = 13 * MiB, WS_WPG = 14 * MiB, WS_WPP = 16 * MiB;
constexpr size_t WS_RS1 = 17 * MiB, WS_RS3 = 17 * MiB + 131072;
constexpr size_t WS_TOPI = 18 * MiB, WS_TOPG = 18 * MiB + 524288, WS_LRANK = 19 * MiB, WS_POSOF = 19 * MiB + 524288;
constexpr size_t WS_ROWMAP = 20 * MiB, WS_ROWGATE = 21 * MiB, WS_ROWSCALE = 17 * MiB + 262144;
constexpr size_t WS_W1 = 22 * MiB, WS_W2 = 150 * MiB, WS_PB = 214 * MiB, WS_X1B = 230 * MiB;
constexpr size_t WS_R1 = 294 * MiB;
constexpr size_t WS_R2 = 566 * MiB;
constexpr size_t PJ_U = 0, PJ_Q = 32 * MiB, PJ_KV = 64 * MiB, PJ_QI = 80 * MiB, PJ_KW = 112 * MiB, PJ_G = 120 * MiB;
constexpr size_t WS_SEL = 838 * MiB;
constexpr size_t WS_PP = 870 * MiB;
constexpr size_t WS_END = 934 * MiB;

constexpr int LDS_MAIN = 0;
constexpr int LDS_KT = 131072;
constexpr int LDS_HIST = 147456;
constexpr int LDS_ATM = 155648;
constexpr int LDS_MISC = 156672;
constexpr int LDS_BYTES = 157696;

__device__ __forceinline__ unsigned f2bf(float f) { unsigned u = __builtin_bit_cast(unsigned, f); return (u + 0x7fffu + ((u >> 16) & 1u)) >> 16; }
__device__ __forceinline__ unsigned pk2(float lo, float hi) { return f2bf(lo) | (f2bf(hi) << 16); }
__device__ __forceinline__ float bf_lo(unsigned w) { return __builtin_bit_cast(float, w << 16); }
__device__ __forceinline__ float bf_hi(unsigned w) { return __builtin_bit_cast(float, w & 0xffff0000u); }
__device__ __forceinline__ float bf1(bf16_t b) { return __builtin_bit_cast(float, ((unsigned)b) << 16); }
typedef float f32x2_ __attribute__((ext_vector_type(2)));
__device__ __forceinline__ u32x2 fp8x4_to_bf16x4(unsigned w) {
    const f32x2_ a = __builtin_amdgcn_cvt_pk_f32_fp8((int)w, false), b = __builtin_amdgcn_cvt_pk_f32_fp8((int)w, true);
    const float ax = a.x, ay = a.y, bx = b.x, by = b.y;
    u32x2 r; r.x = __builtin_amdgcn_perm(__float_as_uint(ay), __float_as_uint(ax), 0x07060302u);
    r.y = __builtin_amdgcn_perm(__float_as_uint(by), __float_as_uint(bx), 0x07060302u); return r;
}
__device__ __forceinline__ bf16x8 fp8x8_to_bf16x8(unsigned w0, unsigned w1) { const u32x2 a = fp8x4_to_bf16x4(w0), b = fp8x4_to_bf16x4(w1); return __builtin_bit_cast(bf16x8, (u32x4){a.x, a.y, b.x, b.y}); }
__device__ __forceinline__ float clamp_e4m3(float v) { return __builtin_amdgcn_fmed3f(v, -448.0f, 448.0f); }
__device__ __forceinline__ unsigned pk4_fp8(float a, float b, float c, float d) { int w = __builtin_amdgcn_cvt_pk_fp8_f32(clamp_e4m3(a), clamp_e4m3(b), 0, false); w = __builtin_amdgcn_cvt_pk_fp8_f32(clamp_e4m3(c), clamp_e4m3(d), w, true); return (unsigned)w; }
__device__ __forceinline__ float sigmoidf_(float x) { return __builtin_amdgcn_rcpf(1.0f + __expf(-x)); }
#define LDS_WAIT() asm volatile("s_waitcnt lgkmcnt(0)" ::: "memory")
#define VM_WAIT() asm volatile("s_waitcnt vmcnt(0)" ::: "memory")
__device__ __forceinline__ float wave_sum(float v) {
#pragma unroll
    for (int o = 1; o < 64; o <<= 1) v += __shfl_xor(v, o);
    return v;
}

#define XB_TMO      128
#define XB_XCNT(j)  (256  + 64 * (j))
#define XB_XSUB(j)  (1280 + 64 * (j))
#define XB_XGEN(j)  (2304 + 64 * (j))
#define XB_TOP      3328
#define XB_TOPGEN   3392
#define XCD_BAR_WORDS 3456
#define XB_SPIN_CAP (1u << 22)
__device__ __forceinline__ unsigned xb_ld(unsigned* p)              { return __hip_atomic_load(p, __ATOMIC_RELAXED, __HIP_MEMORY_SCOPE_AGENT); }
__device__ __forceinline__ unsigned xb_add(unsigned* p, unsigned v) { return __hip_atomic_fetch_add(p, v, __ATOMIC_RELAXED, __HIP_MEMORY_SCOPE_AGENT); }
__device__ __forceinline__ unsigned xb_xcc_id() { return (unsigned)__builtin_amdgcn_s_getreg((3 << 11) | 20) & 0xFu; }
#define XB_SPIN(cond, bar) do { unsigned _sp = 0; while (cond) { __builtin_amdgcn_s_sleep(1); \
    if ((++_sp & 255u) == 0u) { if (xb_ld(&(bar)[XB_TMO])) break; if (_sp > XB_SPIN_CAP) { atomicAdd(&(bar)[XB_TMO], 1u); break; } } } } while (0)
struct XcdBarrier { unsigned* bar; unsigned x; volatile LAS unsigned* st; };
__device__ __forceinline__ XcdBarrier xcd_barrier_post(unsigned* bar, volatile LAS unsigned* st) {
    XcdBarrier b; b.bar = bar; b.x = xb_xcc_id(); b.st = st;
    if (threadIdx.x == 0) (void)xb_add(&bar[XB_XCNT(b.x)], 1u);
    return b;
}
__device__ __forceinline__ void xcd_barrier_complete(unsigned* bar, unsigned x, unsigned& nloc, unsigned& nx) {
    const unsigned G = gridDim.x * gridDim.y * gridDim.z;
    unsigned sum, cnt, mine, sp = 0u;
    for (;;) {
        sum = 0u; cnt = 0u; mine = 0u;
#pragma unroll
        for (unsigned j = 0; j < 16; ++j) { const unsigned c = xb_ld(&bar[XB_XCNT(j)]); sum += c; cnt += (c > 0u) ? 1u : 0u; mine = (j == x) ? c : mine; }
        if (sum == G) break;
        __builtin_amdgcn_s_sleep(1);
        if ((++sp & 255u) == 0u) { if (xb_ld(&bar[XB_TMO])) break; if (sp > XB_SPIN_CAP) { atomicAdd(&bar[XB_TMO], 1u); break; } }
    }
    nloc = mine > 0u ? mine : 1u; nx = cnt > 0u ? cnt : 1u;
}
__device__ __forceinline__ void xcd_barrier(const XcdBarrier& b) {
    asm volatile("s_waitcnt vmcnt(0)" ::: "memory");
    __syncthreads();
    if (threadIdx.x == 0) {
        unsigned* bar = b.bar;
        __builtin_amdgcn_s_waitcnt(0);
        unsigned nloc = b.st[0], nx = b.st[1];
        if (nloc == 0u) { xcd_barrier_complete(bar, b.x, nloc, nx); b.st[0] = nloc; b.st[1] = nx; }
        const unsigned old = xb_add(&bar[XB_XSUB(b.x)], 1u);
        const unsigned gen = old / nloc;
        if (old + 1u == (gen + 1u) * nloc) {
            __builtin_amdgcn_fence(__ATOMIC_RELEASE, "agent");
            asm volatile("s_waitcnt vmcnt(0)" ::: "memory");
            const unsigned og = xb_add(&bar[XB_TOP], 1u);
            const unsigned tg = og / nx;
            if (og + 1u == (tg + 1u) * nx) xb_add(&bar[XB_TOPGEN], 1u);
            else XB_SPIN(xb_ld(&bar[XB_TOPGEN]) == tg, bar);
            __builtin_amdgcn_fence(__ATOMIC_ACQUIRE, "agent");
            xb_add(&bar[XB_XGEN(b.x)], 1u);
            asm volatile("s_waitcnt vmcnt(0)" ::: "memory");
        } else {
            XB_SPIN(xb_ld(&bar[XB_XGEN(b.x)]) == gen, bar);
            __builtin_amdgcn_fence(__ATOMIC_ACQUIRE, "agent");
            asm volatile("s_waitcnt vmcnt(0)" ::: "memory");
        }
    }
    __syncthreads();
}

namespace pg8 {
constexpr int BM = 256, BK = 64, HALF = 128, HTB = HALF * BK * 2, STAGE_BYTES = 8 * HTB, NXCD = 8, WGM = 8;
__host__ __device__ __forceinline__ int lds_byte(int r, int c) { const int st = (r >> 4) * 2 + (c >> 5), rr = r & 15, cc = c & 31, ob = rr * 64 + cc * 2; return st * 1024 + (ob ^ (((ob >> 9) & 1) << 5)); }
__host__ __device__ __forceinline__ void stage_rc(int b, int& R, int& C) { const int st = b / 1024, sb = b % 1024, swz = sb ^ (((sb >> 9) & 1) << 5); R = (st >> 1) * 16 + swz / 64; C = (st & 1) * 32 + (swz % 64) / 2; }
__host__ __device__ __forceinline__ int perm32(int rho) { const int n = rho >> 4, i = rho & 15; return 8 * (i >> 2) + 4 * n + (i & 3); }

struct Unit { int pm, pn, e; };
struct Gemm { const bf16_t* A; const bf16_t* Bt; int M, N, K; size_t bstride; const int* rowmap; };

struct StaticOrder {
    int nM, nN, nwg, G, c;
    __device__ void init(int M_, int N_, int G_, int c_) { nM = M_ / BM; nN = N_ / BM; nwg = nM * nN; G = G_; c = c_; }
    __device__ bool next(int i, Unit& u) const {
        const long L = (long)i * G + c; if (L >= nwg) return false;
        int wgid = (int)L; { const int q = nwg / NXCD, r = nwg % NXCD, xcd = wgid % NXCD, off = wgid / NXCD; wgid = (xcd < r ? xcd * (q + 1) : r * (q + 1) + (xcd - r) * q) + off; }
        const int nig = WGM * nN, gid = wgid / nig, fm = gid * WGM, gsz = (nM - fm) < WGM ? (nM - fm) : WGM;
        u.pm = fm + ((wgid % nig) % gsz); u.pn = (wgid % nig) / gsz; u.e = 0; return true;
    }
};
struct MoeOrder {
    const LAS int* tile_e; int ntiles, nct, G, c;
    __device__ bool next(int i, Unit& u) const {
        const int v = (G % 8 == 0) ? (c % 8) * (G / 8) + c / 8 : c;
        const long L = (long)i * G + v; if (L >= (long)ntiles * nct) return false;
        u.pm = (int)(L / nct); u.pn = (int)(L % nct); u.e = __builtin_amdgcn_readfirstlane(tile_e[u.pm]); return true;
    }
};

struct PPOrder {
    int S, r;
    __device__ __forceinline__ bool next(int i, Unit& u) const { if (r < 0) return false; const int L = r + i * S; if (L >= 512) return false; u.pm = L >> 2; u.pn = L & 3; u.e = 0; return true; }
};
__device__ __forceinline__ unsigned cvt_pk_bf16(float lo, float hi) { unsigned r; asm volatile("v_cvt_pk_bf16_f32 %0, %1, %2" : "=v"(r) : "v"(lo), "v"(hi)); return r; }

struct NoHook { static constexpr bool ACTIVE = false; };
typedef int v8i32 __attribute__((ext_vector_type(8)));
typedef long i64x2 __attribute__((ext_vector_type(2)));
template <class Epi, class Sched, bool GATHER, class Hook = NoHook, int FP8 = 0>
__device__ __forceinline__ void gemm_phase(LAS unsigned char* lds, const Gemm g, const Sched& S, const Epi& E, const Hook& Hk = Hook()) {
    int tid_ = (int)threadIdx.x; asm volatile("" : "+v"(tid_));
    const int tid = tid_, wid = __builtin_amdgcn_readfirstlane(tid >> 6), lane = tid & 63, wr = wid >> 2, wc = wid & 3, fr = lane & 15, fq = lane >> 4;
    const int K = g.K, nt = K / BK;
    unsigned voffA[2][2], nvoffA[2][2], voffB[2]; int RA[2], CA[2];
#pragma unroll
    for (int i = 0; i < 2; ++i) { int R, C; stage_rc(tid * 16 + i * 8192, R, C); const int Rb = Epi::PERM ? ((R & ~31) + perm32(R & 31)) : R;
        RA[i] = R; CA[i] = C; voffB[i] = (unsigned)(Rb * K + C) * 2u; }
    const size_t kstep = (size_t)(BK * 2);
    const size_t hstep = (size_t)HALF * K * 2;
    const size_t tstep = 2 * hstep;
    const unsigned ldsw = (unsigned)wid * 1024u;
    const int aoff = lds_byte(wr * 64 + fr, fq * 8), boff = lds_byte(wc * 32 + fr, fq * 8);
#define PG8_SA(b, h) (((b) * 2 + (h)) * HTB)
#define PG8_SB(b, h) ((4 + (b) * 2 + (h)) * HTB)
      \
    const __amdgpu_buffer_rsrc_t rsA = __builtin_amdgcn_make_buffer_rsrc((void*)g.A, 0, 0x7FFFFFFF, 0x00020000), rsB = __builtin_amdgcn_make_buffer_rsrc((void*)g.Bt, 0, 0x7FFFFFFF, 0x00020000);
#define PG8_STAGE2(bufoff, gbase, v0, v1) do { \
        if constexpr (true) { if ((bufoff) < 4 * HTB) { const int so_ = (int)((const char*)(gbase) - (const char*)g.A); \
                __builtin_amdgcn_raw_ptr_buffer_load_lds(rsA, (LAS void*)(lds + (bufoff) + ldsw), 16, (int)(v0), so_, 0, 0); __builtin_amdgcn_raw_ptr_buffer_load_lds(rsA, (LAS void*)(lds + (bufoff) + ldsw + 8192), 16, (int)(v1), so_, 0, 0); } \
            else { const int so_ = (int)((const char*)(gbase) - (const char*)g.Bt); \
                __builtin_amdgcn_raw_ptr_buffer_load_lds(rsB, (LAS void*)(lds + (bufoff) + ldsw), 16, (int)(v0), so_, 0, 0); __builtin_amdgcn_raw_ptr_buffer_load_lds(rsB, (LAS void*)(lds + (bufoff) + ldsw + 8192), 16, (int)(v1), so_, 0, 0); } } \
        else { \
        __builtin_amdgcn_global_load_lds((const unsigned*)((const char*)(gbase) + (v0)), (LAS unsigned*)(lds + (bufoff) + ldsw), 16, 0, 0); \
        __builtin_amdgcn_global_load_lds((const unsigned*)((const char*)(gbase) + (v1)), (LAS unsigned*)(lds + (bufoff) + ldsw + 8192), 16, 0, 0); } } while (0)
#define PG8_STAGEB(bufoff, gbase) PG8_STAGE2(bufoff, gbase, voffB[0], voffB[1])
#define PG8_LDA(dst, b, h) do { _Pragma("unroll") for (int m = 0; m < 4; ++m) _Pragma("unroll") for (int k = 0; k < 2; ++k) dst[m][k] = *(const LAS bf16x8*)(lds + PG8_SA(b, h) + aoff + m * 2048 + k * 1024); } while (0)
#define PG8_LDB(dst, b, h) do { _Pragma("unroll") for (int n = 0; n < 2; ++n) _Pragma("unroll") for (int k = 0; k < 2; ++k) dst[n][k] = *(const LAS bf16x8*)(lds + PG8_SB(b, h) + boff + n * 2048 + k * 1024); } while (0)
#define PG8_MMA(ai, bj, At, Bt) do { __builtin_amdgcn_s_setprio(1); \
        if constexpr (FP8 == 2) { _Pragma("unroll") for (int m = 0; m < 4; ++m) _Pragma("unroll") for (int n = 0; n < 2; ++n) { \
            const v8i32 b_ = __builtin_bit_cast(v8i32, __builtin_shufflevector(Bt[n][0], Bt[n][1], 0, 1, 2, 3, 4, 5, 6, 7, 8, 9, 10, 11, 12, 13, 14, 15)); \
            const v8i32 a_ = __builtin_bit_cast(v8i32, __builtin_shufflevector(At[m][0], At[m][1], 0, 1, 2, 3, 4, 5, 6, 7, 8, 9, 10, 11, 12, 13, 14, 15)); \
            asm volatile("v_mfma_scale_f32_16x16x128_f8f6f4 %0, %1, %2, %0, %3, %3 op_sel_hi:[0,0,0]" : "+v"(acc[ai][bj][m][n]) : "v"(b_), "v"(a_), "v"(sc1_)); } } \
        else if constexpr (FP8 == 1) { _Pragma("unroll") for (int m = 0; m < 4; ++m) _Pragma("unroll") for (int n = 0; n < 2; ++n) _Pragma("unroll") for (int k = 0; k < 2; ++k) { \
            const i64x2 b_ = __builtin_bit_cast(i64x2, Bt[n][k]), a_ = __builtin_bit_cast(i64x2, At[m][k]); \
            acc[ai][bj][m][n] = __builtin_amdgcn_mfma_f32_16x16x32_fp8_fp8(b_.x, a_.x, acc[ai][bj][m][n], 0, 0, 0); acc[ai][bj][m][n] = __builtin_amdgcn_mfma_f32_16x16x32_fp8_fp8(b_.y, a_.y, acc[ai][bj][m][n], 0, 0, 0); } } \
        else { _Pragma("unroll") for (int m = 0; m < 4; ++m) _Pragma("unroll") for (int n = 0; n < 2; ++n) _Pragma("unroll") for (int k = 0; k < 2; ++k) \
            acc[ai][bj][m][n] = __builtin_amdgcn_mfma_f32_16x16x32_bf16(Bt[n][k], At[m][k], acc[ai][bj][m][n], 0, 0, 0); } \
        __builtin_amdgcn_s_setprio(0); } while (0)
#define PG8_WAIT_V(n) asm volatile("s_waitcnt vmcnt(" #n ")" ::: "memory")
#define PG8_WAIT_L(n) asm volatile("s_waitcnt lgkmcnt(" #n ")" ::: "memory")
#define PG8_BAR __builtin_amdgcn_s_barrier()
#define PG8_SCHED __builtin_amdgcn_sched_barrier(0)
    Unit cur, nxt; int ui = 0;
    if (!S.next(0, cur)) return;
    int sc1_ = 0x7F7F7F7F; if constexpr (FP8 == 2) asm volatile("" : "+v"(sc1_));
    f32x4 acc[2][2][4][2];
#pragma unroll
    for (int a = 0; a < 2; ++a)
#pragma unroll
        for (int b = 0; b < 2; ++b)
#pragma unroll
            for (int m = 0; m < 4; ++m)
#pragma unroll
                for (int n = 0; n < 2; ++n) acc[a][b][m][n] = (f32x4){0.f, 0.f, 0.f, 0.f};
    bf16x8 At[4][2], B0[2][2], B1[2][2];
#pragma unroll
    for (int h = 0; h < 2; ++h)
#pragma unroll
        for (int i = 0; i < 2; ++i) {
            if constexpr (GATHER) voffA[h][i] = ((unsigned)g.rowmap[cur.pm * BM + h * HALF + RA[i]] * (unsigned)K + (unsigned)CA[i]) * 2u;
            else voffA[h][i] = (unsigned)((h * HALF + RA[i]) * K + CA[i]) * 2u;
            if constexpr (GATHER) nvoffA[h][i] = voffA[h][i];
        }
    const char* cA = GATHER ? (const char*)g.A : (const char*)g.A + (size_t)cur.pm * tstep;
    const char* cB = (const char*)g.Bt + (size_t)cur.e * g.bstride + (size_t)cur.pn * tstep;
    PG8_STAGEB(PG8_SB(0, 0), cB); PG8_STAGE2(PG8_SA(0, 0), cA, voffA[0][0], voffA[0][1]); PG8_STAGEB(PG8_SB(0, 1), cB + hstep); PG8_STAGE2(PG8_SA(0, 1), cA, voffA[1][0], voffA[1][1]);
    if (wr == 1) PG8_BAR;
    PG8_WAIT_V(4); PG8_BAR;
    PG8_STAGEB(PG8_SB(1, 0), cB + kstep); PG8_STAGE2(PG8_SA(1, 0), cA + kstep, voffA[0][0], voffA[0][1]); PG8_STAGEB(PG8_SB(1, 1), cB + hstep + kstep);
    PG8_WAIT_V(6); PG8_BAR;
    for (;;) {
        const bool has_next = S.next(ui + 1, nxt);
        const char* nA = has_next ? (GATHER ? (const char*)g.A : (const char*)g.A + (size_t)nxt.pm * tstep) : cA;
        const char* nB = has_next ? (const char*)g.Bt + (size_t)nxt.e * g.bstride + (size_t)nxt.pn * tstep : cB;
        if constexpr (GATHER) {
            if (has_next) {
#pragma unroll
                for (int h = 0; h < 2; ++h)
#pragma unroll
                    for (int i = 0; i < 2; ++i) nvoffA[h][i] = ((unsigned)g.rowmap[nxt.pm * BM + h * HALF + RA[i]] * (unsigned)K + (unsigned)CA[i]) * 2u;
            }
        }
        for (int t = 0; t < nt; t += 2) {
            const bool last = (t == nt - 2);
            if constexpr (Hook::ACTIVE) { if (t == nt / 2) Hk.mid(acc, cur); }
            const char* a1 = cA + (size_t)(t + 1) * kstep;
            const char* a2 = last ? nA : cA + (size_t)(t + 2) * kstep; const char* b2 = last ? nB : cB + (size_t)(t + 2) * kstep;
            const char* a3 = a2 + kstep; const char* b3 = b2 + kstep;
            unsigned w00 = voffA[0][0], w01 = voffA[0][1], w10 = voffA[1][0], w11 = voffA[1][1];
            if constexpr (GATHER) { if (last) { w00 = nvoffA[0][0]; w01 = nvoffA[0][1]; w10 = nvoffA[1][0]; w11 = nvoffA[1][1]; } }
            PG8_LDB(B0, 0, 0); PG8_SCHED; PG8_LDA(At, 0, 0); PG8_STAGE2(PG8_SA(1, 1), a1, voffA[1][0], voffA[1][1]);
            PG8_WAIT_L(8); PG8_BAR; PG8_WAIT_L(0); PG8_MMA(0, 0, At, B0); PG8_BAR; PG8_SCHED;
            PG8_LDB(B1, 0, 1); PG8_STAGEB(PG8_SB(0, 0), b2);
            PG8_BAR; PG8_WAIT_L(0); PG8_MMA(0, 1, At, B1); PG8_BAR;
            PG8_LDA(At, 0, 1); PG8_STAGE2(PG8_SA(0, 0), a2, w00, w01);
            PG8_BAR; PG8_WAIT_L(0); PG8_MMA(1, 0, At, B0); PG8_BAR; PG8_SCHED;
            PG8_STAGEB(PG8_SB(0, 1), b2 + hstep);
            PG8_WAIT_V(6); PG8_BAR; PG8_MMA(1, 1, At, B1); PG8_BAR;
            PG8_LDB(B0, 1, 0); PG8_SCHED; PG8_LDA(At, 1, 0); PG8_STAGE2(PG8_SA(0, 1), a2, w10, w11);
            PG8_WAIT_L(8); PG8_BAR; PG8_WAIT_L(0); PG8_MMA(0, 0, At, B0); PG8_BAR; PG8_SCHED;
            PG8_LDB(B1, 1, 1); PG8_STAGEB(PG8_SB(1, 0), b3);
            PG8_BAR; PG8_WAIT_L(0); PG8_MMA(0, 1, At, B1); PG8_BAR;
            PG8_LDA(At, 1, 1); PG8_STAGE2(PG8_SA(1, 0), a3, w00, w01);
            PG8_BAR; PG8_WAIT_L(0); PG8_MMA(1, 0, At, B0); PG8_BAR; PG8_SCHED;
            PG8_STAGEB(PG8_SB(1, 1), b3 + hstep);
            PG8_WAIT_V(6); PG8_BAR; PG8_MMA(1, 1, At, B1); PG8_BAR;
        }
        if constexpr (FP8 == 2) asm volatile("s_nop 15\n\ts_nop 15" ::: "memory");
        E(acc, cur, wr, wc, fr, fq);
        if (!has_next) break;
#pragma unroll
        for (int a = 0; a < 2; ++a)
#pragma unroll
            for (int b = 0; b < 2; ++b)
#pragma unroll
                for (int m = 0; m < 4; ++m)
#pragma unroll
                    for (int n = 0; n < 2; ++n) acc[a][b][m][n] = (f32x4){0.f, 0.f, 0.f, 0.f};
        cur = nxt; cA = nA; cB = nB; ++ui;
        if constexpr (GATHER) {
#pragma unroll
            for (int h = 0; h < 2; ++h)
#pragma unroll
                for (int i = 0; i < 2; ++i) voffA[h][i] = nvoffA[h][i];
        }
    }
    PG8_WAIT_V(0);
    if (wr == 0) PG8_BAR;
    PG8_BAR;
#undef PG8_SA
#undef PG8_SB
#undef PG8_STAGE2
#undef PG8_STAGEB
#undef PG8_LDA
#undef PG8_LDB
#undef PG8_MMA
#undef PG8_WAIT_V
#undef PG8_WAIT_L
#undef PG8_BAR
#undef PG8_SCHED
}
}
using pg8::Unit;

typedef f32x4 AccT[2][2][4][2];
struct EpiProj {
    static constexpr bool PERM = true;
    unsigned char* pj; const float* rs;
    __device__ __forceinline__ void operator()(const AccT& acc, const Unit& u, int wr, int wc, int fr, int fq) const {
        const int pn = u.pn; const bool sig = pn >= 8;
        bf16_t* base; int ld, nbj = 2;
        if (pn < 2)       { base = (bf16_t*)(pj + PJ_U) + pn * 256; ld = 512; }
        else if (pn < 4) {
            unsigned char* q8 = pj + PJ_Q + (pn - 2) * 256; const int row0 = u.pm * 256 + wr * 64 + fr, cb = wc * 32 + 8 * fq;
            float sv[8];
#pragma unroll
            for (int g = 0; g < 8; ++g) sv[g] = rs[row0 + (g >> 2) * 128 + (g & 3) * 16];
#pragma unroll
            for (int ai = 0; ai < 2; ++ai)
#pragma unroll
                for (int m = 0; m < 4; ++m) { const int row = row0 + ai * 128 + m * 16; const float s = sv[ai * 4 + m];
#pragma unroll
                    for (int bj = 0; bj < 2; ++bj) { const f32x4 v0 = acc[ai][bj][m][0] * s, v1 = acc[ai][bj][m][1] * s;
                        u32x2 w; w.x = pk4_fp8(v0[0], v0[1], v0[2], v0[3]); w.y = pk4_fp8(v1[0], v1[1], v1[2], v1[3]);
                        *(u32x2*)(q8 + (size_t)row * 512 + bj * 128 + cb) = w; } }
            return; }
        else if (pn == 4) {
            unsigned char* kv8 = pj + PJ_KV; const int row0 = u.pm * 256 + wr * 64 + fr, cb = wc * 32 + 8 * fq;
            float sv[8];
#pragma unroll
            for (int g = 0; g < 8; ++g) sv[g] = rs[row0 + (g >> 2) * 128 + (g & 3) * 16];
#pragma unroll
            for (int ai = 0; ai < 2; ++ai)
#pragma unroll
                for (int m = 0; m < 4; ++m) { const int row = row0 + ai * 128 + m * 16; const float s = sv[ai * 4 + m];
#pragma unroll
                    for (int bj = 0; bj < 2; ++bj) { const f32x4 v0 = acc[ai][bj][m][0] * s, v1 = acc[ai][bj][m][1] * s;
                        u32x2 w; w.x = pk4_fp8(v0[0], v0[1], v0[2], v0[3]); w.y = pk4_fp8(v1[0], v1[1], v1[2], v1[3]);
                        *(u32x2*)(kv8 + (size_t)row * 256 + bj * 128 + cb) = w; } }
            return; }
        else if (pn < 7)  { base = (bf16_t*)(pj + PJ_QI) + (pn - 5) * 256; ld = 512; }
        else if (pn == 7) { base = (bf16_t*)(pj + PJ_KW); ld = 128; nbj = 1; }
        else              { base = (bf16_t*)(pj + PJ_G) + (pn - 8) * 256; ld = 2048; }
        const int row0 = u.pm * 256 + wr * 64 + fr, col0 = wc * 32 + 8 * fq;
        float sv[8];
#pragma unroll
        for (int g = 0; g < 8; ++g) sv[g] = rs[row0 + (g >> 2) * 128 + (g & 3) * 16];
#pragma unroll
        for (int ai = 0; ai < 2; ++ai)
#pragma unroll
            for (int m = 0; m < 4; ++m) { const int row = row0 + ai * 128 + m * 16; const float s = sv[ai * 4 + m]; bf16_t* rowp = base + (size_t)row * ld + col0;
#pragma unroll
                for (int bj = 0; bj < 2; ++bj) { if (bj < nbj) { f32x4 v0 = acc[ai][bj][m][0] * s, v1 = acc[ai][bj][m][1] * s;
                    if (sig) {
#pragma unroll
                        for (int j = 0; j < 4; ++j) { v0[j] = sigmoidf_(v0[j]); v1[j] = sigmoidf_(v1[j]); } }
                    u32x4 w; w.x = pk2(v0[0], v0[1]); w.y = pk2(v0[2], v0[3]); w.z = pk2(v1[0], v1[1]); w.w = pk2(v1[2], v1[3]);
                    *(u32x4*)(rowp + bj * 128) = w; } } }
    }
};
__device__ __forceinline__ void fp8x8_to_f32(u32x2 w, float (&f)[8]) {
    const f32x2_ a = __builtin_amdgcn_cvt_pk_f32_fp8((int)w.x, false), b = __builtin_amdgcn_cvt_pk_f32_fp8((int)w.x, true), c = __builtin_amdgcn_cvt_pk_f32_fp8((int)w.y, false), d = __builtin_amdgcn_cvt_pk_f32_fp8((int)w.y, true);
    f[0] = a.x; f[1] = a.y; f[2] = b.x; f[3] = b.y; f[4] = c.x; f[5] = c.y; f[6] = d.x; f[7] = d.y; }
__device__ __forceinline__ float ga_clamp(float g) { return fmaxf(g, 8.67361738e-19f); }
struct HookGateRatio {
    static constexpr bool ACTIVE = true;
    const bf16_t* gates;
    __device__ __forceinline__ void mid(AccT& acc, const Unit& u) const {
        int tz = threadIdx.x; asm volatile("" : "+v"(tz));
        const int wid = tz >> 6, ln = tz & 63, wr = wid >> 2, wc = wid & 3, fr = ln & 15, fq = ln >> 4;
        const int row0 = u.pm * 256 + wr * 64 + fr, col0 = u.pn * 256 + wc * 32 + 8 * fq;
        u32x4 gpv[2][2], gav[2][2];
#pragma unroll
        for (int bj = 0; bj < 2; ++bj) { gpv[0][bj] = *(const u32x4*)(gates + (size_t)row0 * 2048 + col0 + bj * 128); gav[0][bj] = *(const u32x4*)(gates + (size_t)row0 * 2048 + 1024 + col0 + bj * 128); }
#pragma unroll
        for (int ai = 0; ai < 2; ++ai)
#pragma unroll
            for (int m = 0; m < 4; ++m) { const int g1 = ai * 4 + m + 1;
                if (g1 < 8) { const int rown = row0 + (g1 >> 2) * 128 + (g1 & 3) * 16;
#pragma unroll
                    for (int bj = 0; bj < 2; ++bj) { gpv[g1 & 1][bj] = *(const u32x4*)(gates + (size_t)rown * 2048 + col0 + bj * 128); gav[g1 & 1][bj] = *(const u32x4*)(gates + (size_t)rown * 2048 + 1024 + col0 + bj * 128); } }
#pragma unroll
                for (int bj = 0; bj < 2; ++bj) {
                    const u32x4 gp = gpv[m & 1][bj], ga = gav[m & 1][bj];
                    acc[ai][bj][m][0][0] *= bf_lo(gp.x) * __builtin_amdgcn_rcpf(ga_clamp(bf_lo(ga.x))); acc[ai][bj][m][0][1] *= bf_hi(gp.x) * __builtin_amdgcn_rcpf(ga_clamp(bf_hi(ga.x)));
                    acc[ai][bj][m][0][2] *= bf_lo(gp.y) * __builtin_amdgcn_rcpf(ga_clamp(bf_lo(ga.y))); acc[ai][bj][m][0][3] *= bf_hi(gp.y) * __builtin_amdgcn_rcpf(ga_clamp(bf_hi(ga.y)));
                    acc[ai][bj][m][1][0] *= bf_lo(gp.z) * __builtin_amdgcn_rcpf(ga_clamp(bf_lo(ga.z))); acc[ai][bj][m][1][1] *= bf_hi(gp.z) * __builtin_amdgcn_rcpf(ga_clamp(bf_hi(ga.z)));
                    acc[ai][bj][m][1][2] *= bf_lo(gp.w) * __builtin_amdgcn_rcpf(ga_clamp(bf_lo(ga.w))); acc[ai][bj][m][1][3] *= bf_hi(gp.w) * __builtin_amdgcn_rcpf(ga_clamp(bf_hi(ga.w)));
                    }
                asm volatile("" ::: "memory"); }
    }
};
template <bool ADD, bool CLAMP = false> struct EpiGate {
    static constexpr bool PERM = true;
    bf16_t* O; const bf16_t* gate; const bf16_t* addsrc;
    __device__ __forceinline__ void operator()(const AccT& acc, const Unit& u, int wr, int wc, int fr, int fq) const {
        const int row0 = u.pm * 256 + wr * 64 + fr, col0 = u.pn * 256 + wc * 32 + 8 * fq;
        u32x4 gb[4][2];
#pragma unroll
        for (int g = 0; g < 4; ++g)
#pragma unroll
            for (int bj = 0; bj < 2; ++bj) gb[g][bj] = *(const u32x4*)(gate + (size_t)(row0 + g * 16) * 2048 + col0 + bj * 128);
#pragma unroll
        for (int ai = 0; ai < 2; ++ai)
#pragma unroll
            for (int m = 0; m < 4; ++m) { const int row = row0 + ai * 128 + m * 16;
#pragma unroll
                for (int bj = 0; bj < 2; ++bj) { const int col = col0 + bj * 128;
                    const u32x4 gw = gb[m][bj];
                    if (ai == 0) gb[m][bj] = *(const u32x4*)(gate + (size_t)(row + 128) * 2048 + col);
                    f32x4 v0 = acc[ai][bj][m][0], v1 = acc[ai][bj][m][1];
                    if (CLAMP) {
                        v0[0] *= ga_clamp(bf_lo(gw.x)); v0[1] *= ga_clamp(bf_hi(gw.x)); v0[2] *= ga_clamp(bf_lo(gw.y)); v0[3] *= ga_clamp(bf_hi(gw.y));
                        v1[0] *= ga_clamp(bf_lo(gw.z)); v1[1] *= ga_clamp(bf_hi(gw.z)); v1[2] *= ga_clamp(bf_lo(gw.w)); v1[3] *= ga_clamp(bf_hi(gw.w));
                    } else {
                    v0[0] *= bf_lo(gw.x); v0[1] *= bf_hi(gw.x); v0[2] *= bf_lo(gw.y); v0[3] *= bf_hi(gw.y);
                    v1[0] *= bf_lo(gw.z); v1[1] *= bf_hi(gw.z); v1[2] *= bf_lo(gw.w); v1[3] *= bf_hi(gw.w); }
                    if (ADD) { const u32x4 aw = *(const u32x4*)(addsrc + (size_t)row * D + col);
                        v0[0] += bf_lo(aw.x); v0[1] += bf_hi(aw.x); v0[2] += bf_lo(aw.y); v0[3] += bf_hi(aw.y);
                        v1[0] += bf_lo(aw.z); v1[1] += bf_hi(aw.z); v1[2] += bf_lo(aw.w); v1[3] += bf_hi(aw.w); }
                    u32x4 w; w.x = pk2(v0[0], v0[1]); w.y = pk2(v0[2], v0[3]); w.z = pk2(v1[0], v1[1]); w.w = pk2(v1[2], v1[3]);
                    *(u32x4*)(O + (size_t)row * D + col) = w; } }
    }
};
struct EpiX1 {
    static constexpr bool PERM = false;
    const float* x; bf16_t* xb; float* ss; unsigned char* x8;
    __device__ __forceinline__ void operator()(const AccT& acc, const Unit& u, int wr, int wc, int fr, int fq) const {
        const int row0 = u.pm * 256 + wr * 64 + fr, col0 = u.pn * 256 + wc * 32 + 4 * fq;
        f32x4 xv[2][4];
#pragma unroll
        for (int g = 0; g < 2; ++g)
#pragma unroll
            for (int q = 0; q < 4; ++q) xv[g][q] = *(const f32x4*)(x + (size_t)(row0 + g * 16) * D + col0 + (q >> 1) * 128 + (q & 1) * 16);
#pragma unroll
        for (int ai = 0; ai < 2; ++ai)
#pragma unroll
            for (int m = 0; m < 4; ++m) { const int row = row0 + ai * 128 + m * 16; float s = 0.f;
                const int g2 = ai * 4 + m + 2, rown = row0 + (g2 >> 2) * 128 + (g2 & 3) * 16;
#pragma unroll
                for (int bj = 0; bj < 2; ++bj)
#pragma unroll
                    for (int n = 0; n < 2; ++n) { const size_t o = (size_t)row * D + col0 + bj * 128 + n * 16;
                        const f32x4 xin = xv[m & 1][bj * 2 + n];
                        if (g2 < 8) xv[m & 1][bj * 2 + n] = *(const f32x4*)(x + (size_t)rown * D + col0 + bj * 128 + n * 16);
                        const f32x4 v = xin + acc[ai][bj][m][n];
                        u32x2 w; w.x = pk2(v[0], v[1]); w.y = pk2(v[2], v[3]); *(u32x2*)(xb + o) = w;
                        *(unsigned*)(x8 + o) = pk4_fp8(v[0], v[1], v[2], v[3]);
                        s += (v[0] * v[0] + v[1] * v[1]) + (v[2] * v[2] + v[3] * v[3]); }
                s += __shfl_xor(s, 16); s += __shfl_xor(s, 32);
                if (fq == 0) atomicAdd(ss + row, s); }
    }
};
struct EpiMoe1 {
    static constexpr bool PERM = true;
    unsigned char* act; const float* rowscale; const float* b1;
    __device__ __forceinline__ void operator()(const AccT& acc, const Unit& u, int wr, int wc, int fr, int fq) const {
        const int row0 = u.pm * 256 + wr * 64 + fr, colj = u.pn * 128 + wc * 32 + 8 * fq;
        const float* bg = b1 + (size_t)u.e * 2048 + colj; const float* bu = bg + 1024;
        const f32x4 bg0 = *(const f32x4*)bg, bg1 = *(const f32x4*)(bg + 4), bu0 = *(const f32x4*)bu, bu1 = *(const f32x4*)(bu + 4);
        float sv[8];
#pragma unroll
        for (int g = 0; g < 8; ++g) sv[g] = rowscale[row0 + (g >> 2) * 128 + (g & 3) * 16] * (1.0f / 64.0f);
#pragma unroll
        for (int ai = 0; ai < 2; ++ai)
#pragma unroll
            for (int m = 0; m < 4; ++m) { const int row = row0 + ai * 128 + m * 16;
                const float rs = sv[ai * 4 + m];
                float r[8];
#pragma unroll
                for (int n = 0; n < 2; ++n)
#pragma unroll
                    for (int j = 0; j < 4; ++j) { float gl = acc[ai][0][m][n][j] * rs + (n ? bg1[j] : bg0[j]); float up = acc[ai][1][m][n][j] * rs + (n ? bu1[j] : bu0[j]);
                        gl = fminf(gl, 7.0f); up = fminf(fmaxf(up, -7.0f), 7.0f);
                        r[n * 4 + j] = 8.0f * ((up + 1.0f) * (gl * sigmoidf_(1.702f * gl))); }
                u32x2 w; w.x = pk4_fp8(r[0], r[1], r[2], r[3]); w.y = pk4_fp8(r[4], r[5], r[6], r[7]);
                *(u32x2*)(act + (size_t)row * DFF + colj) = w; }
    }
};
struct EpiMoe2 {
    static constexpr bool PERM = true;
    unsigned char* Y; const float* rowgate; const float* b2;
    __device__ __forceinline__ void operator()(const AccT& acc, const Unit& u, int wr, int wc, int fr, int fq) const {
        const int row0 = u.pm * 256 + wr * 64 + fr, col0 = u.pn * 256 + wc * 32 + 8 * fq;
        f32x4 cb[2][2]; float sv[8];
#pragma unroll
        for (int bj = 0; bj < 2; ++bj) { const float* bb = b2 + (size_t)u.e * D + col0 + bj * 128; cb[bj][0] = *(const f32x4*)bb; cb[bj][1] = *(const f32x4*)(bb + 4); }
#pragma unroll
        for (int g = 0; g < 8; ++g) sv[g] = rowgate[row0 + (g >> 2) * 128 + (g & 3) * 16];
#pragma unroll
        for (int ai = 0; ai < 2; ++ai)
#pragma unroll
            for (int m = 0; m < 4; ++m) { const int row = row0 + ai * 128 + m * 16; const float gt = sv[ai * 4 + m];
#pragma unroll
                for (int bj = 0; bj < 2; ++bj) { const int col = col0 + bj * 128;
                    const f32x4 c0 = cb[bj][0], c1 = cb[bj][1];
                    const f32x4 v0 = (acc[ai][bj][m][0] * (1.0f / 512.0f) + c0) * gt, v1 = (acc[ai][bj][m][1] * (1.0f / 512.0f) + c1) * gt;
                    u32x2 w; w.x = pk4_fp8(v0[0], v0[1], v0[2], v0[3]); w.y = pk4_fp8(v1[0], v1[1], v1[2], v1[3]);
                    *(u32x2*)(Y + (size_t)row * D + col) = w; } }
    }
};
struct EpiPP {
    static constexpr bool PERM = true;
    unsigned char* PP;
    __device__ __forceinline__ void operator()(const AccT& acc, const Unit& u, int wr, int wc, int fr, int fq) const {
        const int row0 = u.pm * 256 + wr * 64 + fr, col0 = u.pn * 256 + wc * 32 + 8 * fq;
#pragma unroll
        for (int ai = 0; ai < 2; ++ai)
#pragma unroll
            for (int m = 0; m < 4; ++m) { const int row = row0 + ai * 128 + m * 16;
#pragma unroll
                for (int bj = 0; bj < 2; ++bj) { const f32x4 v0 = acc[ai][bj][m][0], v1 = acc[ai][bj][m][1];
                    u32x2 w; w.x = pk4_fp8(v0[0], v0[1], v0[2], v0[3]); w.y = pk4_fp8(v1[0], v1[1], v1[2], v1[3]);
                    *(u32x2*)(PP + (size_t)row * D + col0 + bj * 128) = w; } }
    }
};
struct EpiPleGX {
    static constexpr bool PERM = true;
    bf16_t* x3b; const bf16_t* x2b; const unsigned char* PP; const float* rs; float* ss;
    __device__ __forceinline__ void operator()(const AccT& acc, const Unit& u, int wr, int wc, int fr, int fq) const {
        const int row0 = u.pm * 256 + wr * 64 + fr, col0 = u.pn * 256 + wc * 32 + 8 * fq;
        float sv[8]; u32x2 pb[2][2]; u32x4 xq[2][2];
#pragma unroll
        for (int g = 0; g < 8; ++g) sv[g] = rs[row0 + (g >> 2) * 128 + (g & 3) * 16] * (1.0f / 64.0f);
#pragma unroll
        for (int g = 0; g < 2; ++g)
#pragma unroll
            for (int bj = 0; bj < 2; ++bj) { const size_t o = (size_t)(row0 + g * 16) * D + col0 + bj * 128; pb[g][bj] = *(const u32x2*)(PP + o); xq[g][bj] = *(const u32x4*)(x2b + o); }
#pragma unroll
        for (int ai = 0; ai < 2; ++ai)
#pragma unroll
            for (int m = 0; m < 4; ++m) { const int row = row0 + ai * 128 + m * 16; const float rsv = sv[ai * 4 + m]; float s = 0.f;
                const int g2 = ai * 4 + m + 2, rown = row0 + (g2 >> 2) * 128 + (g2 & 3) * 16;
#pragma unroll
                for (int bj = 0; bj < 2; ++bj) { const size_t o = (size_t)row * D + col0 + bj * 128;
                    const u32x4 xw = xq[m & 1][bj]; float pf[8]; fp8x8_to_f32(pb[m & 1][bj], pf);
                    if (g2 < 8) { const size_t on = (size_t)rown * D + col0 + bj * 128; pb[m & 1][bj] = *(const u32x2*)(PP + on); xq[m & 1][bj] = *(const u32x4*)(x2b + on); }
                    const f32x4 a0 = acc[ai][bj][m][0] * rsv, a1 = acc[ai][bj][m][1] * rsv;
                    f32x4 x0, x1;
                    x0[0] = bf_lo(xw.x) + sigmoidf_(a0[0]) * pf[0]; x0[1] = bf_hi(xw.x) + sigmoidf_(a0[1]) * pf[1];
                    x0[2] = bf_lo(xw.y) + sigmoidf_(a0[2]) * pf[2]; x0[3] = bf_hi(xw.y) + sigmoidf_(a0[3]) * pf[3];
                    x1[0] = bf_lo(xw.z) + sigmoidf_(a1[0]) * pf[4]; x1[1] = bf_hi(xw.z) + sigmoidf_(a1[1]) * pf[5];
                    x1[2] = bf_lo(xw.w) + sigmoidf_(a1[2]) * pf[6]; x1[3] = bf_hi(xw.w) + sigmoidf_(a1[3]) * pf[7];
                    { u32x4 w; w.x = pk2(x0[0], x0[1]); w.y = pk2(x0[2], x0[3]); w.z = pk2(x1[0], x1[1]); w.w = pk2(x1[2], x1[3]); *(u32x4*)(x3b + o) = w; }
                    s += (x0[0] * x0[0] + x0[1] * x0[1]) + (x0[2] * x0[2] + x0[3] * x0[3]) + (x1[0] * x1[0] + x1[1] * x1[1]) + (x1[2] * x1[2] + x1[3] * x1[3]); }
                s += __shfl_xor(s, 16); s += __shfl_xor(s, 32);
                if (fq == 0) atomicAdd(ss + row, s); }
    }
};

struct Args { const float* in[20]; float* out; unsigned char* ws; int ph_lo, ph_hi; };
enum { I_X = 0, I_P, I_N1G, I_WIN, I_POOLW, I_POOLS, I_WBP, I_WBA, I_WOUT, I_N2G, I_RW, I_RB, I_W1, I_B1, I_W2, I_B2, I_PNG, I_PGW, I_PPW, I_FG };
enum { PH_PRO = 0, PH_INPROJ, PH_MIXED, PH_POOL, PH_ATT, PH_Z, PH_X1, PH_ROUTER, PH_SCATTER, PH_MOE1, PH_MOE2, PH_COMBINE, PH_PLE, PH_FINAL, NPH };

__device__ __forceinline__ int tr_dst_row(int mode, int n) {
    if (mode == 1) { if (n >= 1152 && n < 1280) { const int d = (n - 1152) & 63; return 1152 + ((n - 1152) & 64) + 16 * (d & 3) + (d >> 2); }
                     return n < 1864 ? n : n + 184; }
    if (mode == 2) return n < 1024 ? (((n >> 7) << 8) + (n & 127)) : ((((n - 1024) >> 7) << 8) + 128 + ((n - 1024) & 127));
    return n;
}
__device__ __forceinline__ float tr_col_scale(int mode, int n) {
    if (mode == 1) { if ((n >= 512 && n < 1024) || (n >= 1280 && n < 1792)) return 0.125f; if (n >= 1856 && n < 1864) return 0.35355339059327373f; }
    return 1.0f;
}
__device__ __forceinline__ void transpose_item(const float* W, int ldw, int Nvalid, int K, bf16_t* WT, const float* kgain, int mode, LAS float* scr, int kb, int nb, int lane, int ldt = 0, float f8scale = 0.f) {
    if (ldt == 0) ldt = K;
    const int k0 = 64 * kb, n0 = 64 * nb, c4 = lane & 15, kr = lane >> 4, nl = n0 + 4 * c4; const bool nok = nl < Nvalid;
    const f32x4 cs = (f32x4){tr_col_scale(mode, nl), tr_col_scale(mode, nl + 1), tr_col_scale(mode, nl + 2), tr_col_scale(mode, nl + 3)};
    f32x4 v[16];
#pragma unroll
    for (int i = 0; i < 16; ++i) { const int kk = 4 * i + kr; v[i] = nok ? *(const f32x4*)(W + (size_t)(k0 + kk) * ldw + nl) : (f32x4){0.f, 0.f, 0.f, 0.f}; }
    float kgv[16];
#pragma unroll
    for (int i = 0; i < 16; ++i) kgv[i] = kgain ? kgain[k0 + 4 * i + kr] : 1.0f;
#pragma unroll
    for (int i = 0; i < 16; ++i) asm volatile("" : "+v"(kgv[i]));
#pragma unroll
    for (int i = 0; i < 16; ++i) { const int kk = 4 * i + kr; *(LAS f32x4*)(scr + kk * 68 + 4 * c4) = v[i] * cs * kgv[i]; }
    LDS_WAIT(); asm volatile("" ::: "memory");
    const int c = lane & 7;
#pragma unroll
    for (int j = 0; j < 8; ++j) { const int n = (lane >> 3) + 8 * j; const LAS float* s = scr + (8 * c) * 68 + n;
        if (f8scale != 0.f) {
            u32x2 o8; o8.x = pk4_fp8(s[0 * 68] * f8scale, s[1 * 68] * f8scale, s[2 * 68] * f8scale, s[3 * 68] * f8scale); o8.y = pk4_fp8(s[4 * 68] * f8scale, s[5 * 68] * f8scale, s[6 * 68] * f8scale, s[7 * 68] * f8scale);
            if (n0 + n < Nvalid) *(u32x2*)((unsigned char*)WT + (size_t)tr_dst_row(mode, n0 + n) * ldt + k0 + 8 * c) = o8;
        } else {
        u32x4 o; o.x = pk2(s[0 * 68], s[1 * 68]); o.y = pk2(s[2 * 68], s[3 * 68]); o.z = pk2(s[4 * 68], s[5 * 68]); o.w = pk2(s[6 * 68], s[7 * 68]);
        if (n0 + n < Nvalid) *(u32x4*)(WT + (size_t)tr_dst_row(mode, n0 + n) * ldt + k0 + 8 * c) = o; } }
    LDS_WAIT(); asm volatile("" ::: "memory");
}
constexpr int I_E1 = 32 * 16 * 32, I_E2 = 32 * 16 * 16, N_EXPERT_ITEMS = I_E1 + I_E2;
constexpr int I_BA = 8 * 16, I_OUT = 16 * 16, I_R = 16, I_PG = 16 * 16, I_PP = 4 * 16, N_SMALL_ITEMS = I_BA + I_OUT + I_R + I_PG + I_PP;
constexpr int DC_EXPERT = N_EXPERT_ITEMS / 8, DC_SMALL = N_SMALL_ITEMS / 8, DC_WPC = 2048 / 8, DC_PB = M * PLE / 8 / 4096, DC_TOTAL = DC_EXPERT + DC_SMALL + DC_WPC + DC_PB;
__device__ __forceinline__ void deferred_chunk(const Args& a, LAS unsigned char* lds, int c, int wave, int lane) {
    unsigned char* ws = a.ws; LAS float* scr = (LAS float*)(lds + wave * 17408);
    if (c < DC_EXPERT) { int r = c * 8 + wave;
        if (r < I_E1) { const int e = r / (16 * 32), q = r % (16 * 32);
            transpose_item(a.in[I_W1] + (size_t)e * D * 2048, 2048, 2048, D, (bf16_t*)(ws + WS_W1 + (size_t)e * 2048 * D), a.in[I_N2G], 2, scr, q / 32, q % 32, lane, D, 64.0f); return; }
        r -= I_E1; { const int e = r / (16 * 16), q = r % (16 * 16);
            transpose_item(a.in[I_W2] + (size_t)e * DFF * D, D, D, DFF, (bf16_t*)(ws + WS_W2 + (size_t)e * D * DFF), nullptr, 0, scr, q / 16, q % 16, lane, DFF, 64.0f); }
        return; }
    c -= DC_EXPERT;
    if (c < DC_SMALL) { int r = c * 8 + wave;
        if (r < I_BA) { transpose_item(a.in[I_WBA], D, D, 512, (bf16_t*)(ws + WS_WPC) + 512, nullptr, 0, scr, r / 16, r % 16, lane, 1024); return; } r -= I_BA;
        if (r < I_OUT) { transpose_item(a.in[I_WOUT], D, D, D, (bf16_t*)(ws + WS_WOUT), nullptr, 0, scr, r / 16, r % 16, lane); return; } r -= I_OUT;
        if (r < I_R) { transpose_item(a.in[I_RW], NE, NE, D, (bf16_t*)(ws + WS_WR), a.in[I_N2G], 0, scr, r, 0, lane); return; } r -= I_R;
        if (r < I_PG) { transpose_item(a.in[I_PGW], D, D, D, (bf16_t*)(ws + WS_WPG), a.in[I_PNG], 0, scr, r / 16, r % 16, lane, D, 64.0f); return; } r -= I_PG;
        transpose_item(a.in[I_PPW], D, D, PLE, (bf16_t*)(ws + WS_WPP), nullptr, 0, scr, r / 16, r % 16, lane); return; }
    c -= DC_SMALL;
    if (c < DC_WPC) {
        const float* pw = a.in[I_POOLW]; const float* ps = a.in[I_POOLS]; const float* wbp = a.in[I_WBP]; bf16_t* wpc = (bf16_t*)(ws + WS_WPC);
        const int it = c * 8 + wave, gc = it >> 2, n0 = (it & 3) * 256 + lane * 4, g = gc >> 7;
        f32x4 acc = (f32x4){0.f, 0.f, 0.f, 0.f};
        const float* pwr = pw + (size_t)gc * 128; const float* psr = ps + g * 128; const float* wr_ = wbp + (size_t)(g * 128) * D + n0;
#pragma unroll 8
        for (int d = 0; d < 128; ++d) { const float av = pwr[d] * psr[d]; const f32x4 wv = *(const f32x4*)(wr_ + (size_t)d * D); acc += wv * av; }
#pragma unroll
        for (int j = 0; j < 4; ++j) wpc[(size_t)(n0 + j) * 1024 + gc] = (bf16_t)f2bf(acc[j]);
        return; }
    c -= DC_WPC;
    {
        const f32x4* p = (const f32x4*)a.in[I_P]; u32x4* pb = (u32x4*)(ws + WS_PB);
        f32x4 pv[8][2];
#pragma unroll
        for (int k = 0; k < 8; ++k) { const int i = c * 4096 + k * 512 + (int)threadIdx.x; pv[k][0] = p[2 * i]; pv[k][1] = p[2 * i + 1]; }
#pragma unroll
        for (int k = 0; k < 8; ++k) { const int i = c * 4096 + k * 512 + (int)threadIdx.x; const f32x4 v0 = pv[k][0], v1 = pv[k][1];
            u32x4 w; w.x = pk2(v0[0], v0[1]); w.y = pk2(v0[2], v0[3]); w.z = pk2(v1[0], v1[1]); w.w = pk2(v1[2], v1[3]); pb[i] = w; } }
}
__device__ __forceinline__ void p0_prologue(const Args& a, LAS unsigned char* lds, int wave, int lane, int G) {
    unsigned char* ws = a.ws;
    LAS float* scr = (LAS float*)(lds + wave * 17408);
    const int gw = blockIdx.x * NWAVES + wave, NGW = G * NWAVES;
    for (int it = gw; it < 16 * 62; it += NGW) transpose_item(a.in[I_WIN], IN_COLS, IN_COLS, D, (bf16_t*)(ws + WS_WIN), a.in[I_N1G], 1, scr, it / 62, it % 62, lane);
    for (int c = DC_EXPERT + (int)blockIdx.x; c < DC_TOTAL; c += G) { deferred_chunk(a, lds, c, wave, lane); __syncthreads(); }
    { const int gt = blockIdx.x * NTHREADS + threadIdx.x, NT = G * NTHREADS; u32x4* z = (u32x4*)((bf16_t*)(ws + WS_WIN) + (size_t)1864 * D);
      for (int i = gt; i < 184 * D * 2 / 16; i += NT) z[i] = (u32x4){0u, 0u, 0u, 0u}; }
    { const float* x = a.in[I_X]; bf16_t* xb = (bf16_t*)(ws + WS_R2); float* rs1 = (float*)(ws + WS_RS1);
      for (int m0 = gw; m0 < M; m0 += 2 * NGW) { f32x4 v[2][4];
#pragma unroll
        for (int r = 0; r < 2; ++r) { const int m = m0 + r * NGW; if (m < M) { const f32x4* xr = (const f32x4*)(x + (size_t)m * D) + lane;
#pragma unroll
            for (int j = 0; j < 4; ++j) v[r][j] = xr[64 * j]; } }
#pragma unroll
        for (int r = 0; r < 2; ++r) { const int m = m0 + r * NGW; if (m < M) { float s = 0.f;
#pragma unroll
            for (int j = 0; j < 4; ++j) s += (v[r][j][0] * v[r][j][0] + v[r][j][1] * v[r][j][1]) + (v[r][j][2] * v[r][j][2] + v[r][j][3] * v[r][j][3]);
            s = wave_sum(s); if (lane == 0) rs1[m] = rsqrtf(s * (1.0f / D) + RMS_EPS);
            u32x2* o = (u32x2*)(xb + (size_t)m * D) + lane;
#pragma unroll
            for (int j = 0; j < 4; ++j) { u32x2 w; w.x = pk2(v[r][j][0], v[r][j][1]); w.y = pk2(v[r][j][2], v[r][j][3]); o[64 * j] = w; } } } } }
}

template <int W>
__device__ __forceinline__ void mixed_item(const bf16_t* ub, bf16_t* mixed, int tok, int c8) {
    const int t = tok & (SEQ - 1); const int nw = (t + 1) < W ? (t + 1) : W;
    u32x4 v[W];
#pragma unroll
    for (int i = 0; i < W; ++i) { const int ii = i < nw ? i : 0; v[i] = *(const u32x4*)(ub + (size_t)(tok - ii) * 512 + c8 * 8); }
    float s[8], cur[8];
#pragma unroll
    for (int j = 0; j < 8; ++j) { s[j] = 0.f; cur[j] = 0.f; }
#pragma unroll
    for (int i = 0; i < W; ++i) { const float mk = i < nw ? 1.0f : 0.0f;
        const float f[8] = {bf_lo(v[i].x), bf_hi(v[i].x), bf_lo(v[i].y), bf_hi(v[i].y), bf_lo(v[i].z), bf_hi(v[i].z), bf_lo(v[i].w), bf_hi(v[i].w)};
#pragma unroll
        for (int j = 0; j < 8; ++j) { s[j] = fmaf(f[j], mk, s[j]); if (i == 0) cur[j] = f[j]; } }
    const float inv = 1.0f / (float)nw;
    u32x4 o; o.x = pk2(s[0] * inv - cur[0], s[1] * inv - cur[1]); o.y = pk2(s[2] * inv - cur[2], s[3] * inv - cur[3]);
    o.z = pk2(s[4] * inv - cur[4], s[5] * inv - cur[5]); o.w = pk2(s[6] * inv - cur[6], s[7] * inv - cur[7]);
    *(u32x4*)(mixed + (size_t)tok * 1024 + c8 * 8) = o;
}
__device__ __forceinline__ void p2_mixed(const bf16_t* ub, bf16_t* mixed, int G) {
    const int ln = threadIdx.x & 63, gw = blockIdx.x * NWAVES + (int)(threadIdx.x >> 6), NGW = G * NWAVES;
    int k = 0;
    for (int P = gw; P < M; P += NGW, ++k) {
        const int g = __builtin_amdgcn_readfirstlane((P + k) & 3), tok = (P >> 2) * 4 + (ln >> 4), c8 = g * 16 + (ln & 15);
        if (g == 0) mixed_item<2>(ub, mixed, tok, c8); else if (g == 1) mixed_item<4>(ub, mixed, tok, c8); else if (g == 2) mixed_item<8>(ub, mixed, tok, c8); else mixed_item<16>(ub, mixed, tok, c8);
    }
}

__device__ __forceinline__ unsigned lds_atomic_inc(LAS unsigned* p) { return __hip_atomic_fetch_add(p, 1u, __ATOMIC_RELAXED, __HIP_MEMORY_SCOPE_WORKGROUP); }
__device__ __forceinline__ void prune_token(LAS unsigned* L, LAS unsigned* H, const LAS unsigned* cntin, LAS unsigned* cntp, LAS unsigned* thrp, int lane) {
    const int n = __builtin_amdgcn_readfirstlane((int)*cntin);
    unsigned prefix = 0u; unsigned want = 256u;
#pragma unroll
    for (int p = 0; p < 4; ++p) {
        const int shift = 24 - 8 * p;
        *(LAS u32x4*)(H + 4 * lane) = (u32x4){0u, 0u, 0u, 0u};
        for (int i = lane; i < n; i += 64) { const unsigned e = L[i];
            bool match = true; if (p > 0) match = ((e ^ prefix) >> ((shift + 8) & 31)) == 0u;
            if (match) (void)lds_atomic_inc(H + ((e >> shift) & 255u)); }
        const u32x4 c = *(LAS u32x4*)(H + 4 * lane);
        const unsigned T = c.x + c.y + c.z + c.w; unsigned suf = T;
#pragma unroll
        for (int off = 1; off < 64; off <<= 1) { const unsigned v = (unsigned)__shfl_down((int)suf, off); if (lane + off < 64) suf += v; }
        const unsigned sufex = suf - T;
        const bool found = (sufex < want) && (want <= suf);
        unsigned run = sufex; int d = 0; unsigned nw = 0u; bool got = false;
        if (!got && run + c.w >= want) { d = 4 * lane + 3; nw = want - run; got = true; } run += c.w;
        if (!got && run + c.z >= want) { d = 4 * lane + 2; nw = want - run; got = true; } run += c.z;
        if (!got && run + c.y >= want) { d = 4 * lane + 1; nw = want - run; got = true; } run += c.y;
        if (!got && run + c.x >= want) { d = 4 * lane + 0; nw = want - run; got = true; }
        const unsigned long long fm = __ballot(found);
        const int src = fm ? (__ffsll((long long)fm) - 1) : 0;
        d = __shfl(d, src); want = (unsigned)__shfl((int)nw, src);
        prefix |= (unsigned)d << shift;
    }
    int newn = 0;
    for (int base = 0; base < n; base += 64) { const int i = base + lane; const unsigned e = (i < n) ? L[i] : 0u; const bool keep = (i < n) && (e >= prefix);
        const unsigned long long mk = __ballot(keep);
        const int pos = newn + (int)__builtin_amdgcn_mbcnt_hi((unsigned)(mk >> 32), __builtin_amdgcn_mbcnt_lo((unsigned)mk, 0u));
        if (keep) L[pos] = e;
        newn += __popcll(mk); }
    if (lane == 0) { *cntp = (unsigned)newn; *thrp = prefix; }
}

template <int CTRL> __device__ __forceinline__ unsigned dpp0(unsigned v) { return (unsigned)__builtin_amdgcn_update_dpp(0, (int)v, CTRL, 0xf, 0xf, true); }
__device__ __forceinline__ unsigned wave_min_u32(unsigned v) {
    v = min(v, (unsigned)__builtin_amdgcn_update_dpp((int)v, (int)v, 0x128, 0xf, 0xf, false)); v = min(v, (unsigned)__builtin_amdgcn_update_dpp((int)v, (int)v, 0x124, 0xf, 0xf, false));
    v = min(v, (unsigned)__builtin_amdgcn_update_dpp((int)v, (int)v, 0x122, 0xf, 0xf, false)); v = min(v, (unsigned)__builtin_amdgcn_update_dpp((int)v, (int)v, 0x121, 0xf, 0xf, false));
    const unsigned a = __builtin_amdgcn_readlane((int)v, 0), b = __builtin_amdgcn_readlane((int)v, 16), c = __builtin_amdgcn_readlane((int)v, 32), d = __builtin_amdgcn_readlane((int)v, 48);
    return min(min(a, b), min(c, d));
}
__device__ __forceinline__ unsigned wave_max_u32(unsigned v) { return ~wave_min_u32(~v); }
__device__ __forceinline__ unsigned wave_prefix_incl(unsigned v, int lane) {
    v += dpp0<0x111>(v); v += dpp0<0x112>(v); v += dpp0<0x114>(v); v += dpp0<0x118>(v);
    const unsigned r0 = __builtin_amdgcn_readlane((int)v, 15), r1 = __builtin_amdgcn_readlane((int)v, 31), r2 = __builtin_amdgcn_readlane((int)v, 47);
    const int row = lane >> 4;
    return v + (row >= 1 ? r0 : 0u) + (row >= 2 ? r1 : 0u) + (row >= 3 ? r2 : 0u);
}
template <int FULLROWS>
__device__ __forceinline__ void prune_approx(LAS unsigned* L, LAS unsigned* H, const LAS unsigned* cntin, LAS unsigned* cntp, LAS unsigned* thrp, int lane) {
    const int n = __builtin_amdgcn_readfirstlane((int)*cntin);
    const unsigned tlo = (unsigned)__builtin_amdgcn_readfirstlane((int)*thrp);
    unsigned e[8]; unsigned mxv = 0u;
#pragma unroll
    for (int k = 0; k < 8; ++k) { unsigned v = L[lane + 64 * k]; if (k >= FULLROWS) v = (lane + 64 * k < n) ? v : 0u; e[k] = v; mxv = max(mxv, v); }
    mxv = wave_max_u32(mxv);
    unsigned mn = tlo;
    if (tlo == 0u) {
        unsigned m = 0xFFFFFFFFu;
#pragma unroll
        for (int k = 0; k < 8; ++k) m = (k >= FULLROWS && e[k] == 0u) ? m : min(m, e[k]);
        mn = wave_min_u32(m);
    }
    const unsigned range = mxv - mn;
    const int hb = 31 - __builtin_clz(range | 1u);
    const int shift = hb > 7 ? hb - 7 : 0;
    *(LAS u32x4*)(H + 4 * lane) = (u32x4){0u, 0u, 0u, 0u};
#pragma unroll
    for (int k = 0; k < 8; ++k) if (k < FULLROWS || e[k] != 0u) (void)lds_atomic_inc(H + ((e[k] - mn) >> shift));
    const u32x4 c = *(LAS u32x4*)(H + 4 * lane);
    const unsigned T = c.x + c.y + c.z + c.w;
    const unsigned pin = wave_prefix_incl(T, lane);
    const unsigned tot = (unsigned)__builtin_amdgcn_readlane((int)pin, 63);
    const unsigned sufex = tot - pin;
    const unsigned suf = sufex + T;
    const bool found = (sufex < 256u) && (256u <= suf);
    unsigned run = sufex; int d = 0; bool got = false;
    if (!got && run + c.w >= 256u) { d = 4 * lane + 3; got = true; } run += c.w;
    if (!got && run + c.z >= 256u) { d = 4 * lane + 2; got = true; } run += c.z;
    if (!got && run + c.y >= 256u) { d = 4 * lane + 1; got = true; } run += c.y;
    if (!got && run + c.x >= 256u) { d = 4 * lane + 0; got = true; }
    const unsigned long long fm = __ballot(found);
    const int src = fm ? (__ffsll((long long)fm) - 1) : 0;
    d = __builtin_amdgcn_readlane(d, src);
    unsigned thr = mn + ((unsigned)d << shift);
    thr = thr ? thr : 1u;
    int newn = 0;
#pragma unroll
    for (int k = 0; k < 8; ++k) { const bool keep = e[k] >= thr;
        const unsigned long long mk = __ballot(keep);
        const int pos = newn + (int)__builtin_amdgcn_mbcnt_hi((unsigned)(mk >> 32), __builtin_amdgcn_mbcnt_lo((unsigned)mk, 0u));
        if (keep) L[pos] = e[k];
        newn += __popcll(mk); }
    if (lane == 0) { *cntp = (unsigned)newn; *thrp = thr - 1u; }
}

__device__ __forceinline__ void prune_excess(LAS unsigned* L, LAS unsigned* cntp, int lane) {
    const int n = __builtin_amdgcn_readfirstlane((int)*cntp);
    unsigned e[5];
#pragma unroll
    for (int k = 0; k < 5; ++k) { const int i = lane + 64 * k; const unsigned v = L[i]; e[k] = (i < n) ? v : 0xFFFFFFFFu; }
    for (int r = n - 256; r > 0; --r) {
        unsigned m = min(min(e[0], e[1]), min(min(e[2], e[3]), e[4]));
        m = wave_min_u32(m);
#pragma unroll
        for (int k = 0; k < 5; ++k) e[k] = (e[k] == m) ? 0xFFFFFFFFu : e[k];
    }
    int newn = 0;
#pragma unroll
    for (int k = 0; k < 5; ++k) { const bool keep = e[k] != 0xFFFFFFFFu;
        const unsigned long long mk = __ballot(keep);
        const int pos = newn + (int)__builtin_amdgcn_mbcnt_hi((unsigned)(mk >> 32), __builtin_amdgcn_mbcnt_lo((unsigned)mk, 0u));
        if (keep) L[pos] = e[k];
        newn += __popcll(mk); }
    if (lane == 0) *cntp = (unsigned)newn;
}

template <bool DIAG>
__device__ __forceinline__ void score_tile(LAS unsigned char* lds, const LAS unsigned char* kbuf, const bf16x8 (&afr)[2][4], const float (&wq)[2][16], unsigned (&cn)[2][2], const unsigned (&th)[2][2],
                                           int kt, int t0, int wave, int hf, int l31, unsigned lmask, unsigned trash) {
    bf16x8 bfr[2][4];
#pragma unroll
    for (int kh = 0; kh < 2; ++kh) { const int keyrow = kh * 32 + l31;
#pragma unroll
        for (int ks = 0; ks < 4; ++ks) bfr[kh][ks] = *(const LAS bf16x8*)(kbuf + keyrow * 128 + (((ks * 2 + hf) ^ ((keyrow >> 1) & 7)) * 16)); }
    f32x16 accs[2][2];
#pragma unroll
    for (int kh = 0; kh < 2; ++kh)
#pragma unroll
        for (int rt = 0; rt < 2; ++rt) {
#pragma unroll
            for (int j = 0; j < 16; ++j) accs[kh][rt][j] = 0.f;
#pragma unroll
            for (int ks = 0; ks < 4; ++ks) accs[kh][rt] = __builtin_amdgcn_mfma_f32_32x32x16_bf16(afr[rt][ks], bfr[kh][ks], accs[kh][rt], 0, 0, 0);
        }
#pragma unroll
    for (int kh = 0; kh < 2; ++kh) {
        const int keypos = kt * 64 + kh * 32 + l31;
        const unsigned idxbits = (unsigned)(16383 - keypos);
#pragma unroll
        for (int rt = 0; rt < 2; ++rt) {
#pragma unroll
            for (int ts = 0; ts < 2; ++ts) {
                float s = 0.f;
#pragma unroll
                for (int hd = 0; hd < 8; ++hd) s = fmaf(__builtin_amdgcn_fmed3f(accs[kh][rt][8 * ts + hd], 0.f, 3.0e38f), wq[rt][8 * ts + hd], s);
                const unsigned ub = __builtin_bit_cast(unsigned, s);
                const unsigned srt = ub ^ ((unsigned)((int)ub >> 31) | 0x80000000u);
                const unsigned packed = (srt & 0xFFFFC000u) | idxbits;
                const int tl = 4 * rt + 2 * hf + ts;
                bool pass = packed > th[rt][ts];
                if (DIAG) pass = pass && (keypos <= t0 + wave * 8 + tl);
                const unsigned long long mk = __builtin_amdgcn_ballot_w64(pass);
                const unsigned mine = hf ? (unsigned)(mk >> 32) : (unsigned)mk;
                const unsigned pre = __popc(mine & lmask);
                const unsigned addr = pass ? (unsigned)((wave * 8 + tl) * 2048) + (cn[rt][ts] + pre) * 4u : trash;
                *(LAS unsigned*)(lds + addr) = packed;
                cn[rt][ts] += __popc(mine);
            }
        }
    }
}

__device__ __forceinline__ void p4_attention(const unsigned char* pj, bf16_t* attn_out, unsigned* queue, int* seldbg, LAS unsigned char* lds, int wave, int lane) {
    const unsigned char* qb_ = pj + PJ_Q;   const unsigned char* kv8 = pj + PJ_KV; const bf16_t* qib = (const bf16_t*)(pj + PJ_QI); const bf16_t* kwb = (const bf16_t*)(pj + PJ_KW);
    LAS unsigned* cnt_l = (LAS unsigned*)(lds + LDS_ATM);
    LAS unsigned* thr_l = cnt_l + 64;
    LAS unsigned* unit_l = cnt_l + 128;
    LAS unsigned* pflag = cnt_l + 132;
    LAS unsigned* wl_ctl = cnt_l + 136;
    LAS unsigned* cnt2 = cnt_l + 144;
    LAS unsigned* H = (LAS unsigned*)(lds + LDS_HIST) + wave * 256;
    const int tid = threadIdx.x, hf = lane >> 5, l31 = lane & 31;
    for (;;) {
        if (tid == 0) { const unsigned pref = xb_xcc_id() & 1u;
            unsigned uu = atomicAdd(queue + 64 * pref, 1u), bb = pref;
            if (uu >= 256u) { uu = atomicAdd(queue + 64 * (pref ^ 1u), 1u); bb = pref ^ 1u; }
            *unit_l = (uu >= 256u) ? 0xFFFFu : (uu * 2u + bb); pflag[0] = 0u; pflag[1] = 0u; wl_ctl[0] = 0u; wl_ctl[1] = 0u; }
        __syncthreads();
        const int u = __builtin_amdgcn_readfirstlane((int)*unit_l);
        __syncthreads();
        if (u >= 512) break;
        const int qb = 255 - (u >> 1), b = u & 1, t0 = qb * 64, rowbase = b * SEQ;
        if (lane < 8) { cnt_l[wave * 8 + lane] = 0u; thr_l[wave * 8 + lane] = 0u; }
        bf16x8 afr[2][4]; float wq[2][16];
#pragma unroll
        for (int rt = 0; rt < 2; ++rt) {
            const int m = l31, hd = (m & 3) + 4 * ((m >> 3) & 1), tl = 4 * rt + 2 * ((m >> 2) & 1) + (m >> 4);
            const bf16_t* qp = qib + (size_t)(rowbase + t0 + wave * 8 + tl) * 512 + hd * 64 + hf * 8;
#pragma unroll
            for (int ks = 0; ks < 4; ++ks) afr[rt][ks] = *(const bf16x8*)(qp + ks * 16);
#pragma unroll
            for (int ts = 0; ts < 2; ++ts) { const int tl2 = 4 * rt + 2 * hf + ts;
                const u32x4 wv = *(const u32x4*)(kwb + (size_t)(rowbase + t0 + wave * 8 + tl2) * 128 + 64);
                wq[rt][8 * ts + 0] = bf_lo(wv.x); wq[rt][8 * ts + 1] = bf_hi(wv.x); wq[rt][8 * ts + 2] = bf_lo(wv.y); wq[rt][8 * ts + 3] = bf_hi(wv.y);
                wq[rt][8 * ts + 4] = bf_lo(wv.z); wq[rt][8 * ts + 5] = bf_hi(wv.z); wq[rt][8 * ts + 6] = bf_lo(wv.w); wq[rt][8 * ts + 7] = bf_hi(wv.w); }
        }
#pragma unroll
        for (int rt = 0; rt < 2; ++rt) {
#pragma unroll
            for (int ks = 0; ks < 4; ++ks) asm volatile("" : "+v"(afr[rt][ks]));
#pragma unroll
            for (int j = 0; j < 16; ++j) asm volatile("" : "+v"(wq[rt][j]));
        }
        const int ntile = qb + 1;
        const int skey = tid >> 3, sch = tid & 7;
        const int sdst = skey * 128 + ((sch ^ ((skey >> 1) & 7)) * 16);
        u32x4 stg = *(const u32x4*)(kwb + (size_t)(rowbase + skey) * 128 + sch * 8);
        unsigned cn[2][2], th[2][2];
        const unsigned lmask = (1u << l31) - 1u, trash = (unsigned)(LDS_HIST + wave * 1024 + lane * 4);
#pragma unroll
        for (int rt = 0; rt < 2; ++rt)
#pragma unroll
            for (int ts = 0; ts < 2; ++ts) { cn[rt][ts] = 0u; th[rt][ts] = 0u; }
        for (int kt = 0; kt < ntile; ++kt) {
            LAS unsigned char* kbuf = lds + LDS_KT + (kt & 1) * 8192;
            *(LAS u32x4*)(kbuf + sdst) = stg;
            __syncthreads();
            if (kt + 1 < ntile) stg = *(const u32x4*)(kwb + (size_t)(rowbase + (kt + 1) * 64 + skey) * 128 + sch * 8);
            if (kt > 0 && __builtin_amdgcn_readfirstlane((int)pflag[(kt - 1) & 1]) == kt) {
                const unsigned long long jm = __ballot(cnt_l[lane] > 400u);
                { unsigned long long m = jm;
                  for (int ti = 0; m != 0ull; ++ti) { const int id = __ffsll((long long)m) - 1; m &= m - 1ull;
                    if ((ti & 7) == wave) {
                        prune_approx<6>((LAS unsigned*)(lds + id * 2048), H, cnt_l + id, cnt2 + id, thr_l + id, lane);
                        if (__builtin_amdgcn_readfirstlane((int)cnt2[id]) > 320) prune_token((LAS unsigned*)(lds + id * 2048), H, cnt2 + id, cnt2 + id, thr_l + id, lane);
                    } } }
                __syncthreads();
#pragma unroll
                for (int rt = 0; rt < 2; ++rt)
#pragma unroll
                    for (int ts = 0; ts < 2; ++ts) { const int tl = 4 * rt + 2 * hf + ts;
                        if ((jm >> (wave * 8 + tl)) & 1ull) { cn[rt][ts] = cnt2[wave * 8 + tl]; th[rt][ts] = thr_l[wave * 8 + tl]; } }
            }
            if (kt + 1 < ntile) score_tile<false>(lds, kbuf, afr, wq, cn, th, kt, t0, wave, hf, l31, lmask, trash);
            else                score_tile<true>(lds, kbuf, afr, wq, cn, th, kt, t0, wave, hf, l31, lmask, trash);
            bool need = false;
#pragma unroll
            for (int rt = 0; rt < 2; ++rt)
#pragma unroll
                for (int ts = 0; ts < 2; ++ts) { const int tl = 4 * rt + 2 * hf + ts; if (l31 == 0) cnt_l[wave * 8 + tl] = cn[rt][ts]; need |= cn[rt][ts] > 448u; }
            if (__ballot(need) != 0ull) { if (lane == 0) pflag[kt & 1] = (unsigned)(kt + 1); }
        }
        for (int tl = 0; tl < 8; ++tl) {
            const unsigned c = cnt_l[wave * 8 + tl];
            if (__builtin_amdgcn_readfirstlane((int)c) > 256) {
                LAS unsigned* Lt = (LAS unsigned*)(lds + (wave * 8 + tl) * 2048);
                prune_approx<4>(Lt, H, cnt_l + wave * 8 + tl, cnt_l + wave * 8 + tl, thr_l + wave * 8 + tl, lane);
                const int n2 = __builtin_amdgcn_readfirstlane((int)cnt_l[wave * 8 + tl]);
                if (n2 > 304) prune_token(Lt, H, cnt_l + wave * 8 + tl, cnt_l + wave * 8 + tl, thr_l + wave * 8 + tl, lane);
                else if (n2 > 256) prune_excess(Lt, cnt_l + wave * 8 + tl, lane);
            }
        }
        const int c15 = lane & 15, g4 = lane >> 4;
        for (int tl = 0; tl < 8; ++tl) {
            const int n = __builtin_amdgcn_readfirstlane((int)cnt_l[wave * 8 + tl]);
            const LAS unsigned* L = (const LAS unsigned*)(lds + (wave * 8 + tl) * 2048);
            const int tokrow = rowbase + t0 + wave * 8 + tl;
            const LAS unsigned* Lc = L + c15; const int nc = n - c15, n4 = n - 4 * g4;
#if DBG
            if (seldbg) for (int i = lane; i < 256; i += 64) seldbg[(size_t)tokrow * 256 + i] = (i < n) ? (int)(16383u - (L[i] & 16383u)) : -1;
#endif
            long bq[4];
#pragma unroll
            for (int ks = 0; ks < 4; ++ks) { const bool ok = (c15 < 8) && ((c15 >> 2) == (g4 >> 1));
                const u32x2 v = *(const u32x2*)(qb_ + (size_t)tokrow * 512 + (c15 & 7) * 64 + (g4 & 1) * 32 + ks * 8);
                bq[ks] = ok ? (long)(((unsigned long long)v.y << 32) | v.x) : 0l; }
            f32x4 S[16];
            u32x4 kq[2][4][2];
#define LOAD_KGROUP(buf, grp) do { _Pragma("unroll") for (int tt = 0; tt < 4; ++tt) { const int T_ = (grp) * 4 + tt; const unsigned e_ = Lc[T_ * 16]; \
                const int kp_ = (T_ * 16 < nc) ? (int)(16383u - (e_ & 16383u)) : 0; \
                const unsigned char* kr_ = kv8 + (size_t)(rowbase + kp_) * 256 + g4 * 32;     \
                kq[buf][tt][0] = *(const u32x4*)kr_; kq[buf][tt][1] = *(const u32x4*)(kr_ + 16); } } while (0)
            LOAD_KGROUP(0, 0); LOAD_KGROUP(1, 1);
#pragma unroll
            for (int grp = 0; grp < 4; ++grp) {
#pragma unroll
                for (int tt = 0; tt < 4; ++tt) { const int T = grp * 4 + tt; const u32x4 k0 = kq[grp & 1][tt][0], k1 = kq[grp & 1][tt][1];
                    f32x4 sacc = (f32x4){0.f, 0.f, 0.f, 0.f};
                    sacc = __builtin_amdgcn_mfma_f32_16x16x32_fp8_fp8((long)(((unsigned long long)k0.y << 32) | k0.x), bq[0], sacc, 0, 0, 0);
                    sacc = __builtin_amdgcn_mfma_f32_16x16x32_fp8_fp8((long)(((unsigned long long)k0.w << 32) | k0.z), bq[1], sacc, 0, 0, 0);
                    sacc = __builtin_amdgcn_mfma_f32_16x16x32_fp8_fp8((long)(((unsigned long long)k1.y << 32) | k1.x), bq[2], sacc, 0, 0, 0);
                    sacc = __builtin_amdgcn_mfma_f32_16x16x32_fp8_fp8((long)(((unsigned long long)k1.w << 32) | k1.z), bq[3], sacc, 0, 0, 0);
                    if (n < 256) {
#pragma unroll
                        for (int j = 0; j < 4; ++j) if (T * 16 + j >= n4) sacc[j] = -1e30f; }
                    S[T] = sacc; }
                if (grp < 2) { if (grp == 0) LOAD_KGROUP(0, 2); else LOAD_KGROUP(1, 3); }
                asm volatile("" ::: "memory");
            }
#undef LOAD_KGROUP
            const LAS unsigned* Lh = L + (lane >> 3); const int nh = n - (lane >> 3);
            const int vwr = (wave * 8 + (lane >> 5)) * 2048 + 1024 + ((lane >> 3) & 3) * 160 + (lane >> 5) * 16 + (lane & 7) * 16;
            u32x4 vvA[4], vvB[4];
#pragma unroll
            for (int q = 0; q < 4; ++q) { const unsigned e = Lh[8 * q];
                const int kp = (8 * q < nh) ? (int)(16383u - (e & 16383u)) : 0;
                vvA[q] = *(const u32x4*)(kv8 + (size_t)(rowbase + kp) * 256 + 128 + (lane & 7) * 16); }
#pragma unroll
            for (int q = 0; q < 4; ++q) { const unsigned e = Lh[32 + 8 * q];
                const int kp = (32 + 8 * q < nh) ? (int)(16383u - (e & 16383u)) : 0;
                vvB[q] = *(const u32x4*)(kv8 + (size_t)(rowbase + kp) * 256 + 128 + (lane & 7) * 16); }
            float mx = -1e30f;
#pragma unroll
            for (int T = 0; T < 16; ++T)
#pragma unroll
                for (int j = 0; j < 4; ++j) mx = fmaxf(mx, S[T][j]);
            mx = fmaxf(mx, __shfl_xor(mx, 16)); mx = fmaxf(mx, __shfl_xor(mx, 32));
            float sum = 0.f; unsigned P8[16];
            const float mxl = (mx - 5.545177444f) * 1.44269504089f;
#pragma unroll
            for (int T = 0; T < 16; ++T) { f32x4 pv;
#pragma unroll
                for (int j = 0; j < 4; ++j) { pv[j] = __builtin_amdgcn_exp2f(fmaf(S[T][j], 1.44269504089f, -mxl)); sum += pv[j]; }
                int w = __builtin_amdgcn_cvt_pk_fp8_f32(pv[0], pv[1], 0, false); w = __builtin_amdgcn_cvt_pk_fp8_f32(pv[2], pv[3], w, true); P8[T] = (unsigned)w; }
            sum += __shfl_xor(sum, 16); sum += __shfl_xor(sum, 32);
            const float inv = 1.0f / sum;
            float invh[4];
#pragma unroll
            for (int j = 0; j < 4; ++j) invh[j] = __shfl(inv, 4 * (g4 & 1) + j);
            f32x4 O[8];
#pragma unroll
            for (int dt = 0; dt < 8; ++dt) O[dt] = (f32x4){0.f, 0.f, 0.f, 0.f};
            typedef int i2v __attribute__((ext_vector_type(2)));
            const LAS unsigned char* vtr = lds + (wave * 8 + g4 + 4 * ((lane & 15) >> 3)) * 2048 + 1024 + (((lane & 15) >> 1) & 3) * 160 + ((lane & 15) >> 3) * 128 + (g4 & 1) * 16 + (lane & 1) * 8;
#pragma unroll
            for (int ch = 0; ch < 8; ++ch) {
                u32x4 (&vv)[4] = (ch & 1) ? vvB : vvA;
#pragma unroll
                for (int q = 0; q < 4; ++q) *(LAS u32x4*)(lds + vwr + q * 4096 + (q >> 1) * 128) = vv[q];
                if (ch < 6) {
#pragma unroll
                    for (int q = 0; q < 4; ++q) { const unsigned e = Lh[(ch + 2) * 32 + 8 * q];
                        const int kp = ((ch + 2) * 32 + 8 * q < nh) ? (int)(16383u - (e & 16383u)) : 0;
                        vv[q] = *(const u32x4*)(kv8 + (size_t)(rowbase + kp) * 256 + 128 + (lane & 7) * 16); }
                }
                const long pf = (long)(((unsigned long long)P8[2 * ch + 1] << 32) | P8[2 * ch]);
#pragma unroll
                for (int dt = 0; dt < 8; ++dt) {
                    const i2v vt = __builtin_amdgcn_ds_read_tr8_b64_v2i32((LAS i2v*)(vtr + dt * 16));
                    O[dt] = __builtin_amdgcn_mfma_f32_16x16x32_fp8_fp8(pf, __builtin_bit_cast(long, vt), O[dt], 0, 0, 0);
                }
                asm volatile("" ::: "memory");
            }
            if (g4 < 2) {
#pragma unroll
                for (int j = 0; j < 4; ++j) {
                    const f32x4 o4 = g4 ? (f32x4){O[4][j], O[5][j], O[6][j], O[7][j]} : (f32x4){O[0][j], O[1][j], O[2][j], O[3][j]};
                    u32x2 w; w.x = pk2(o4[0] * invh[j], o4[1] * invh[j]); w.y = pk2(o4[2] * invh[j], o4[3] * invh[j]);
                    *(u32x2*)(attn_out + (size_t)tokrow * 1024 + (4 * g4 + j) * 64 + 4 * c15) = w;
                }
            }
        }
    }
}

__device__ __forceinline__ void p7_router(const Args& a, LAS unsigned char* lds, int wave, int lane, int G) {
    unsigned char* ws = a.ws;
    const bf16_t* x1b = (const bf16_t*)(ws + WS_X1B); const bf16_t* wr = (const bf16_t*)(ws + WS_WR);
    const float* ss2 = (const float*)(ws + CTLB_SS2); const float* rb = a.in[I_RB];
    int* topi = (int*)(ws + WS_TOPI); float* topg = (float*)(ws + WS_TOPG); int* lrank = (int*)(ws + WS_LRANK); int* cntwg = (int*)(ws + CTLB_CNTWG);
    LAS unsigned* wcnt = (LAS unsigned*)(lds + LDS_MISC + 64);
    if (threadIdx.x < 32) wcnt[threadIdx.x] = 0u;
    __syncthreads();
    LAS float* lg = (LAS float*)(lds + wave * 4096);
    const int c15 = lane & 15, g4 = lane >> 4;
    for (int tile = blockIdx.x * NWAVES + wave; tile < M / 16; tile += G * NWAVES) {
        const int tok0 = tile * 16;
        f32x4 a0 = (f32x4){0.f, 0.f, 0.f, 0.f}, a1 = a0;
        const bf16_t* ap = x1b + (size_t)(tok0 + c15) * D + g4 * 8; const bf16_t* bp0 = wr + (size_t)c15 * D + g4 * 8; const bf16_t* bp1 = bp0 + 16 * D;
#pragma unroll 8
        for (int ks = 0; ks < 32; ++ks) { const bf16x8 av = *(const bf16x8*)(ap + ks * 32), b0 = *(const bf16x8*)(bp0 + ks * 32), b1 = *(const bf16x8*)(bp1 + ks * 32);
            a0 = __builtin_amdgcn_mfma_f32_16x16x32_bf16(av, b0, a0, 0, 0, 0); a1 = __builtin_amdgcn_mfma_f32_16x16x32_bf16(av, b1, a1, 0, 0, 0); }
#pragma unroll
        for (int j = 0; j < 4; ++j) { lg[(4 * g4 + j) * 33 + c15] = a0[j]; lg[(4 * g4 + j) * 33 + 16 + c15] = a1[j]; }
        LDS_WAIT(); asm volatile("" ::: "memory");
        if (lane < 16) {
            const int tok = tok0 + lane; const float rs = rsqrtf(ss2[tok] * (1.0f / D) + RMS_EPS);
            float v[32];
#pragma unroll
            for (int e = 0; e < 32; ++e) v[e] = lg[lane * 33 + e] * rs + rb[e];
            int bi[4]; float bv[4];
#pragma unroll
            for (int r = 0; r < 4; ++r) { float best = -3.0e38f; int bidx = 0;
#pragma unroll
                for (int e = 0; e < 32; ++e) { bool used = false;
#pragma unroll
                    for (int q = 0; q < 4; ++q) if (q < r && bi[q] == e) used = true;
                    if (!used && v[e] > best) { best = v[e]; bidx = e; } }
                bi[r] = bidx; bv[r] = best; }
            float ex[4], se = 0.f;
#pragma unroll
            for (int r = 0; r < 4; ++r) { ex[r] = __expf(bv[r] - bv[0]); se += ex[r]; }
            const float inv = 1.0f / se;
#pragma unroll
            for (int r = 0; r < 4; ++r) { topi[tok * 4 + r] = bi[r]; topg[tok * 4 + r] = ex[r] * inv; lrank[tok * 4 + r] = (int)lds_atomic_inc(wcnt + bi[r]); }
        }
        LDS_WAIT(); asm volatile("" ::: "memory");
    }
    __syncthreads();
    if (threadIdx.x < 32) cntwg[blockIdx.x * 32 + threadIdx.x] = (int)wcnt[threadIdx.x];
}

__device__ __forceinline__ void p8_scatter(const Args& a, LAS unsigned char* lds, int wave, int lane, int G) {
    unsigned char* ws = a.ws;
    const int* cntwg = (const int*)(ws + CTLB_CNTWG); const int* topi = (const int*)(ws + WS_TOPI); const float* topg = (const float*)(ws + WS_TOPG);
    const int* lrank = (const int*)(ws + WS_LRANK); int* posof = (int*)(ws + WS_POSOF); int* rowmap = (int*)(ws + WS_ROWMAP); float* rowgate = (float*)(ws + WS_ROWGATE);
    int* tile_e = (int*)(ws + CTLB_TILEE); int* meta = (int*)(ws + CTLB_META); float* rowscale = (float*)(ws + WS_ROWSCALE);
    LAS int* part = (LAS int*)(lds);
    LAS int* tot = (LAS int*)(lds + 8192);
    LAS int* pre = tot + 32;
    LAS int* base = tot + 64;
    const int tid = threadIdx.x, e = tid & 31, pt = tid >> 5, myw = blockIdx.x;
    int sall = 0, spre = 0;
#pragma unroll 8
    for (int w = pt; w < G; w += 16) { const int v = cntwg[w * 32 + e]; sall += v; spre += (w < myw) ? v : 0; }
    part[pt * 32 + e] = sall; part[512 + pt * 32 + e] = spre;
    __syncthreads();
    if (tid < 32) { int s0 = 0, s1 = 0;
#pragma unroll
        for (int q = 0; q < 16; ++q) { s0 += part[q * 32 + tid]; s1 += part[512 + q * 32 + tid]; }
        tot[tid] = s0; pre[tid] = s1; }
    __syncthreads();
    if (tid == 0) { int bsum = 0; for (int q = 0; q < 32; ++q) { base[q] = bsum; bsum += (tot[q] + 255) & ~255; } base[32] = bsum; }
    __syncthreads();
    for (int tile = blockIdx.x * NWAVES + wave; tile < M / 16; tile += G * NWAVES) {
        const int idx = tile * 64 + lane; const int ex = topi[idx];
        const int pos = base[ex] + pre[ex] + lrank[idx];
        rowmap[pos] = idx >> 2; rowgate[pos] = topg[idx]; posof[idx] = pos;
        rowscale[pos] = rsqrtf(((const float*)(ws + CTLB_SS2))[idx >> 2] * (1.0f / D) + RMS_EPS);
    }
    for (int ex = blockIdx.x; ex < 32; ex += G) { const int t_ = tot[ex], pe = (t_ + 255) & ~255;
        for (int r = t_ + tid; r < pe; r += NTHREADS) { rowmap[base[ex] + r] = 0; rowgate[base[ex] + r] = 0.f; rowscale[base[ex] + r] = 0.f; } }
    if (blockIdx.x == 0) {
        const int ntl = base[32] >> 8;
        for (int t = tid; t < 544; t += NTHREADS) { int ex = 0;
            for (int q = 0; q < 32; ++q) if (base[q] <= t * 256) ex = q;
            tile_e[t] = (t < ntl) ? ex : 0; }
        if (tid == 0) meta[0] = ntl;
    }
}

__device__ __forceinline__ void p11_combine(const Args& a, int wave, int lane, int G) {
    unsigned char* ws = a.ws;
    const int* posof = (const int*)(ws + WS_POSOF); const unsigned char* Y = ws + WS_R2; const bf16_t* x1b = (const bf16_t*)(ws + WS_X1B); bf16_t* x2b = (bf16_t*)(ws + WS_R1); float* rs3 = (float*)(ws + WS_RS3);
    const int gw = blockIdx.x * NWAVES + wave, NGW = G * NWAVES;
    typedef int i4v __attribute__((ext_vector_type(4)));
    i4v pnx = (gw < M) ? *(const i4v*)(posof + (size_t)gw * 4) : (i4v){0, 0, 0, 0};
    for (int m = gw; m < M; m += NGW) {
        const i4v pcur = pnx;
        if (m + NGW < M) pnx = *(const i4v*)(posof + (size_t)(m + NGW) * 4);
        const u32x2* xr = (const u32x2*)(x1b + (size_t)m * D) + lane; f32x4 v[4]; u32x2 xw[4]; unsigned yw[4][4];
#pragma unroll
        for (int j = 0; j < 4; ++j) xw[j] = xr[64 * j];
#pragma unroll
        for (int s = 0; s < 4; ++s) { const unsigned* yr = (const unsigned*)(Y + (size_t)pcur[s] * D) + lane;
#pragma unroll
            for (int j = 0; j < 4; ++j) yw[s][j] = yr[64 * j]; }
#pragma unroll
        for (int j = 0; j < 4; ++j) { const u32x2 w = xw[j]; v[j] = (f32x4){bf_lo(w.x), bf_hi(w.x), bf_lo(w.y), bf_hi(w.y)}; }
#pragma unroll
        for (int s = 0; s < 4; ++s) {
#pragma unroll
            for (int j = 0; j < 4; ++j) { const f32x2_ lo = __builtin_amdgcn_cvt_pk_f32_fp8((int)yw[s][j], false), hi = __builtin_amdgcn_cvt_pk_f32_fp8((int)yw[s][j], true);
                v[j][0] += lo.x; v[j][1] += lo.y; v[j][2] += hi.x; v[j][3] += hi.y; } }
        float s = 0.f;
#pragma unroll
        for (int j = 0; j < 4; ++j) s += (v[j][0] * v[j][0] + v[j][1] * v[j][1]) + (v[j][2] * v[j][2] + v[j][3] * v[j][3]);
        s = wave_sum(s); if (lane == 0) rs3[m] = rsqrtf(s * (1.0f / D) + RMS_EPS);
        u32x2* o = (u32x2*)(x2b + (size_t)m * D) + lane;
#pragma unroll
        for (int j = 0; j < 4; ++j) { u32x2 w; w.x = pk2(v[j][0], v[j][1]); w.y = pk2(v[j][2], v[j][3]); o[64 * j] = w; }
        unsigned* o8 = (unsigned*)(ws + WS_R1 + 192 * MiB + (size_t)m * D) + lane;
#pragma unroll
        for (int j = 0; j < 4; ++j) o8[64 * j] = pk4_fp8(v[j][0], v[j][1], v[j][2], v[j][3]);
    }
}
__device__ __forceinline__ void p13_final(const Args& a, int wave, int lane, int G) {
    const float* ss4 = (const float*)(a.ws + CTLB_SS4); const float* fg = a.in[I_FG]; const bf16_t* x3b = (const bf16_t*)(a.ws + WS_R1 + 128 * MiB);
    const int gw = blockIdx.x * NWAVES + wave, NGW = G * NWAVES;
    f32x4 gq[4];
#pragma unroll
    for (int j = 0; j < 4; ++j) gq[j] = ((const f32x4*)fg)[lane + 64 * j];
    for (int m0 = gw; m0 < M; m0 += 4 * NGW) { u32x2 xw[4][4]; float sv[4];
#pragma unroll
        for (int r = 0; r < 4; ++r) { const int m = m0 + r * NGW; if (m < M) { sv[r] = ss4[m]; const u32x2* xr = (const u32x2*)(x3b + (size_t)m * D) + lane;
#pragma unroll
            for (int j = 0; j < 4; ++j) xw[r][j] = xr[64 * j]; } }
#pragma unroll
        for (int r = 0; r < 4; ++r) { const int m = m0 + r * NGW; if (m < M) { const float rs = rsqrtf(sv[r] * (1.0f / D) + RMS_EPS); f32x4* orow = (f32x4*)(a.out + (size_t)m * D) + lane;
#pragma unroll
            for (int j = 0; j < 4; ++j) { const u32x2 w = xw[r][j]; orow[64 * j] = (f32x4){bf_lo(w.x), bf_hi(w.x), bf_lo(w.y), bf_hi(w.y)} * rs * gq[j]; } } } }
}

__global__ void __launch_bounds__(NTHREADS, 2) fwd(Args args) {
    extern __shared__ __attribute__((aligned(16))) unsigned char lds_raw[];
    LAS unsigned char* lds = (LAS unsigned char*)lds_raw;
    const int G = gridDim.x;
#define tid ((int)threadIdx.x)
#define lane ((int)(threadIdx.x & 63))
#define wave (__builtin_amdgcn_readfirstlane((int)(threadIdx.x >> 6)))
    unsigned char* ws = args.ws;
    volatile LAS unsigned* MISC = (volatile LAS unsigned*)(lds + LDS_MISC);
    if (tid < 64) MISC[tid] = 0u;
    __syncthreads();
    XcdBarrier bar = xcd_barrier_post((unsigned*)(ws + CTLB_BAR), MISC);
    const int lo = args.ph_lo, hi = args.ph_hi;
#define IN(k) (lo <= (k) && (k) < hi)
#define SEAM(k) do { if (IN(k) && IN((k) + 1)) xcd_barrier(bar); } while (0)
    unsigned char* pj = ws + WS_R1;
    bf16_t* xb = (bf16_t*)(ws + WS_R2); bf16_t* cat = (bf16_t*)(ws + WS_R2 + 64 * MiB);
    bf16_t* mixed = cat; bf16_t* attn = cat + 512; bf16_t* zb = (bf16_t*)(ws + WS_R2 + 192 * MiB);

    if (IN(PH_PRO)) { p0_prologue(args, lds, wave, lane, G); }
    SEAM(PH_PRO);
    if (IN(PH_INPROJ)) {
        pg8::Gemm g{xb, (const bf16_t*)(ws + WS_WIN), M, NP, D, 0, nullptr}; pg8::StaticOrder S; S.init(M, NP, G, (int)blockIdx.x);
        EpiProj E{pj, (const float*)(ws + WS_RS1)};
        pg8::gemm_phase<EpiProj, pg8::StaticOrder, false>(lds, g, S, E);
    }
    SEAM(PH_INPROJ);
    if (IN(PH_MIXED)) { p2_mixed((const bf16_t*)(pj + PJ_U), mixed, G); }
    if (IN(PH_ATT)) {
        __syncthreads();
        p4_attention(pj, attn, (unsigned*)(ws + CTLB_QUEUE), DBG ? (int*)(ws + WS_SEL) : nullptr, lds, wave, lane);
        for (;;) {
            __syncthreads();
            if (tid == 0) MISC[4] = atomicAdd((unsigned*)(ws + CTLB_QUEUE) + 128, 1u);
            __syncthreads();
            const int c = __builtin_amdgcn_readfirstlane((int)MISC[4]);
            if (c >= I_E1 / 8) break;
            deferred_chunk(args, lds, c, wave, lane);
        }
    }
    SEAM(PH_ATT);
    if (IN(PH_Z)) {
        pg8::Gemm g{cat, (const bf16_t*)(ws + WS_WPC), M, D, 1024, 0, nullptr}; pg8::StaticOrder S; S.init(M, D, G, (int)blockIdx.x);
        EpiGate<false, true> E{zb, (const bf16_t*)(pj + PJ_G) + 1024, nullptr};
        HookGateRatio Hk{(const bf16_t*)(pj + PJ_G)};
        pg8::gemm_phase<EpiGate<false, true>, pg8::StaticOrder, false, HookGateRatio>(lds, g, S, E, Hk);
    }
    SEAM(PH_Z);
    if (IN(PH_X1)) {
        pg8::Gemm g{zb, (const bf16_t*)(ws + WS_WOUT), M, D, D, 0, nullptr}; pg8::StaticOrder S; S.init(M, D, G, (int)blockIdx.x);
        EpiX1 E{args.in[I_X], (bf16_t*)(ws + WS_X1B), (float*)(ws + CTLB_SS2), ws + WS_R1 + 144 * MiB};
        pg8::gemm_phase<EpiX1, pg8::StaticOrder, false>(lds, g, S, E);
    }
    SEAM(PH_X1);
    if (IN(PH_ROUTER)) { p7_router(args, lds, wave, lane, G); }
    SEAM(PH_ROUTER);
    if (IN(PH_SCATTER)) { __syncthreads(); p8_scatter(args, lds, wave, lane, G); }
    SEAM(PH_SCATTER);
    if (IN(PH_MOE1)) {
        __syncthreads();
        pg8::Gemm g{(const bf16_t*)(ws + WS_R1 + 144 * MiB), (const bf16_t*)(ws + WS_W1), M, 2048, D / 2, (size_t)2048 * D, (const int*)(ws + WS_ROWMAP)};
        LAS int* te_l = (LAS int*)(lds + LDS_KT); for (int i = tid; i < 544; i += NTHREADS) te_l[i] = ((const int*)(ws + CTLB_TILEE))[i];
        __syncthreads();
        pg8::MoeOrder S{te_l, *(const int*)(ws + CTLB_META), 8, G, (int)blockIdx.x};
        EpiMoe1 E{ws + WS_R1, (const float*)(ws + WS_ROWSCALE), args.in[I_B1]};
        pg8::gemm_phase<EpiMoe1, pg8::MoeOrder, true, pg8::NoHook, 2>(lds, g, S, E);
        for (;;) {
            __syncthreads();
            if (tid == 0) MISC[4] = atomicAdd((unsigned*)(ws + CTLB_QUEUE) + 192, 1u);
            __syncthreads();
            const int c = I_E1 / 8 + __builtin_amdgcn_readfirstlane((int)MISC[4]);
            if (c >= DC_EXPERT) break;
            deferred_chunk(args, lds, c, wave, lane);
        }
    }
    SEAM(PH_MOE1);
    if (IN(PH_MOE2)) {
        pg8::Gemm g{(const bf16_t*)(ws + WS_R1), (const bf16_t*)(ws + WS_W2), MOE_ROWS, D, DFF / 2, (size_t)D * DFF, nullptr};
        LAS int* te_l = (LAS int*)(lds + LDS_KT); for (int i = tid; i < 544; i += NTHREADS) te_l[i] = ((const int*)(ws + CTLB_TILEE))[i];
        __syncthreads();
        pg8::MoeOrder S{te_l, *(const int*)(ws + CTLB_META), 4, G, (int)blockIdx.x};
        EpiMoe2 E{ws + WS_R2, (const float*)(ws + WS_ROWGATE), args.in[I_B2]};
        pg8::gemm_phase<EpiMoe2, pg8::MoeOrder, false, pg8::NoHook, 2>(lds, g, S, E);
        { const int nunits = S.ntiles * 4, rem = nunits % G, vwg = (G % 8 == 0) ? ((int)blockIdx.x % 8) * (G / 8) + (int)blockIdx.x / 8 : (int)blockIdx.x;
          pg8::PPOrder SP{rem ? G - rem : G, rem ? vwg - rem : vwg};
          pg8::Gemm gp{(const bf16_t*)(ws + WS_PB), (const bf16_t*)(ws + WS_WPP), M, D, PLE, 0, nullptr};
          EpiPP EP{ws + WS_PP};
          pg8::gemm_phase<EpiPP, pg8::PPOrder, false>(lds, gp, SP, EP); }
    }
    SEAM(PH_MOE2);
    if (IN(PH_COMBINE)) { p11_combine(args, wave, lane, G); }
    SEAM(PH_COMBINE);
    if (IN(PH_PLE)) {
        pg8::Gemm g{(const bf16_t*)(ws + WS_R1 + 192 * MiB), (const bf16_t*)(ws + WS_WPG), M, D, D / 2, 0, nullptr}; pg8::StaticOrder S; S.init(M, D, G, (int)blockIdx.x);
        EpiPleGX E{(bf16_t*)(ws + WS_R1 + 128 * MiB), (const bf16_t*)(ws + WS_R1), ws + WS_PP, (const float*)(ws + WS_RS3), (float*)(ws + CTLB_SS4)};
        pg8::gemm_phase<EpiPleGX, pg8::StaticOrder, false, pg8::NoHook, 2>(lds, g, S, E);
    }
    SEAM(PH_PLE);
    if (IN(PH_FINAL)) { p13_final(args, wave, lane, G); }
#undef IN
#undef SEAM
#undef tid
#undef lane
#undef wave
}

#if DBG
__device__ __forceinline__ unsigned hash_u(unsigned x) { x ^= x >> 16; x *= 0x7feb352dU; x ^= x >> 15; x *= 0x846ca68bU; x ^= x >> 16; return x; }
__device__ __forceinline__ bool closef(float got, float ref, float rtol, float atol) { return fabsf(got - ref) <= atol + rtol * fabsf(ref); }
__device__ float dotbf(const bf16_t* a, const bf16_t* b, int K) { float s = 0.f; for (int k = 0; k < K; ++k) s += bf1(a[k]) * bf1(b[k]); return s; }
__device__ __forceinline__ void dbg_fail(unsigned* dbg, int code) { atomicAdd(dbg + code, 1u); }
__device__ float f2bf_f(float v) { return __builtin_bit_cast(float, f2bf(v) << 16); }

__device__ float pjv(const unsigned char* pj, int m, int c) {
    const bf16_t* b; int ld, cc;
    if (c < 512) { b = (const bf16_t*)(pj + PJ_U); ld = 512; cc = c; }
    else if (c < 1024) { b = (const bf16_t*)(pj + PJ_Q); ld = 512; cc = c - 512; }
    else if (c < 1280) { const unsigned v = (pj + PJ_KV)[(size_t)m * 256 + (c - 1024)]; const int e = (v >> 3) & 15, mt = v & 7;
        const float mag = e ? ldexpf(1.0f + mt * 0.125f, e - 7) : ldexpf(mt * 0.125f, -6); return (v & 128) ? -mag : mag; }
    else if (c < 1792) { b = (const bf16_t*)(pj + PJ_QI); ld = 512; cc = c - 1280; }
    else if (c < 2048) { b = (const bf16_t*)(pj + PJ_KW); ld = 128; cc = c - 1792; if (cc >= 128) return 0.f; }
    else { b = (const bf16_t*)(pj + PJ_G); ld = 2048; cc = c - 2048; }
    return bf1(b[(size_t)m * ld + cc]);
}
__global__ void __launch_bounds__(256) chk(Args a, int phase) {
    unsigned char* ws = a.ws; unsigned* dbg = (unsigned*)(ws + CTLB_DBG);
    const unsigned s = blockIdx.x * 256 + threadIdx.x;
    const unsigned h = hash_u(s * 2654435761u + 12345u), h2 = hash_u(h + 777u);
    const unsigned char* pj = ws + WS_R1;
    const bf16_t* mixed = (const bf16_t*)(ws + WS_R2 + 64 * MiB); const bf16_t* attn = mixed + 512;
    const bf16_t* zb = (const bf16_t*)(ws + WS_R2 + 192 * MiB);
    if (phase == PH_PRO) {
        if (s == 0) {
            volatile unsigned* pv = dbg + 40; pv[0] = 0xC0484038u; pv[1] = 0x3F800000u; pv[2] = 0x40000000u; pv[3] = 0x40800000u; pv[4] = 0xC0000000u;
            const unsigned wrt = pv[0];
            const u32x2 r = fp8x4_to_bf16x4(wrt);
            if (!(r.x == 0x40003F80u && r.y == 0xC0004080u)) {
                if (r.x == 0x3F804000u) dbg_fail(dbg, 21); else if (r.x == 0xC0004080u) dbg_fail(dbg, 22); else if (r.x == 0x40003F80u) dbg_fail(dbg, 25); else if (r.y == 0xC0004080u) dbg_fail(dbg, 26); else dbg_fail(dbg, 23); }
            const unsigned enc = pk4_fp8(__builtin_bit_cast(float, (unsigned)pv[1]), __builtin_bit_cast(float, (unsigned)pv[2]), __builtin_bit_cast(float, (unsigned)pv[3]), __builtin_bit_cast(float, (unsigned)pv[4]));
            if (enc != 0xC0484038u) dbg_fail(dbg, 24);
        }
        {
          const int n = h % IN_COLS, k = h2 % D; int row = n < 1864 ? n : n + 184;
          if (n >= 1152 && n < 1280) { const int d = (n - 1152) & 63; row = 1152 + ((n - 1152) & 64) + 16 * (d & 3) + (d >> 2); }
          float sc = 1.f; if ((n >= 512 && n < 1024) || (n >= 1280 && n < 1792)) sc = 0.125f; if (n >= 1856 && n < 1864) sc = 0.35355339059327373f;
          const float ref = f2bf_f(a.in[I_WIN][(size_t)k * IN_COLS + n] * (sc * a.in[I_N1G][k]));
          const float got = bf1(((const bf16_t*)(ws + WS_WIN))[(size_t)row * D + k]);
          if (!closef(got, ref, 0.01f, 1e-6f)) dbg_fail(dbg, 1); }
        {
          const int m = h % M, k = h2 % D;
          if (!closef(bf1(((const bf16_t*)(ws + WS_R2))[(size_t)m * D + k]), f2bf_f(a.in[I_X][(size_t)m * D + k]), 0.01f, 1e-6f)) dbg_fail(dbg, 2);
          if (s < 512) { float q = 0.f; for (int i = 0; i < D; ++i) { const float v = a.in[I_X][(size_t)m * D + i]; q += v * v; }
            if (!closef(((const float*)(ws + WS_RS1))[m], rsqrtf(q / D + RMS_EPS), 0.001f, 0.f)) dbg_fail(dbg, 2); }
        }
    }
    if (phase == PH_INPROJ) {
        const int m = h % M; int c = h2 % NP; if (s & 1) c = (c & 255) | (7 << 8);
        float r = dotbf((const bf16_t*)(ws + WS_R2) + (size_t)m * D, (const bf16_t*)(ws + WS_WIN) + (size_t)c * D, D) * ((const float*)(ws + WS_RS1))[m];
        if (c >= 2048) r = 1.0f / (1.0f + expf(-r));
        if (c >= 1792 + 128 && c < 2048) r = 0.f;
        if (!closef(pjv(pj, m, c), r, (c >= 1024 && c < 1280) ? 0.08f : 0.02f, (c >= 1024 && c < 1280) ? 0.02f : 0.01f)) dbg_fail(dbg, 3);
    }
    if (phase == PH_MIXED) {
        int m = h % M; if (s < 64) m = (s & 31) + (s >> 5) * SEQ; const int c = h2 % 512, g = c >> 7, w = 2 << g, t = m & (SEQ - 1); const int nw = (t + 1) < w ? (t + 1) : w;
        float r = 0.f; for (int i = 0; i < nw; ++i) r += pjv(pj, m - i, c);
        r = r / nw - pjv(pj, m, c);
        if (!closef(bf1(mixed[(size_t)m * 1024 + c]), r, 0.02f, 0.01f)) dbg_fail(dbg, 4);
    }
    if (phase == PH_Z) {
        {
          const int e = h % 32, n = (h >> 5) % D, k = h2 % D;
          const int k2 = h2 % PLE;
          if (!closef(bf1(((const bf16_t*)(ws + WS_WPP))[(size_t)n * PLE + k2]), f2bf_f(a.in[I_PPW][(size_t)k2 * D + n]), 0.01f, 1e-6f)) dbg_fail(dbg, 1);
          if (!closef(bf1(((const bf16_t*)(ws + WS_WR))[(size_t)e * D + k]), f2bf_f(a.in[I_RW][(size_t)k * NE + e] * a.in[I_N2G][k]), 0.01f, 1e-6f)) dbg_fail(dbg, 1);
          if (!closef(bf1(((const bf16_t*)(ws + WS_WPG))[(size_t)n * D + k]), f2bf_f(a.in[I_PGW][(size_t)k * D + n] * a.in[I_PNG][k]), 0.01f, 1e-6f)) dbg_fail(dbg, 1);
          const int k5 = h2 % 512;
          if (!closef(bf1(((const bf16_t*)(ws + WS_WPC))[(size_t)n * 1024 + 512 + k5]), f2bf_f(a.in[I_WBA][(size_t)k5 * D + n]), 0.01f, 1e-6f)) dbg_fail(dbg, 1);
          { const int g = k5 >> 7; float r = 0.f; for (int d = 0; d < 128; ++d) r += a.in[I_POOLW][(size_t)k5 * 128 + d] * a.in[I_POOLS][g * 128 + d] * a.in[I_WBP][(size_t)(g * 128 + d) * D + n];
            if (!closef(bf1(((const bf16_t*)(ws + WS_WPC))[(size_t)n * 1024 + k5]), r, 0.01f, 1e-4f)) dbg_fail(dbg, 1); } }
        { const int m = h % M, k2 = h2 % PLE;
          if (!closef(bf1(((const bf16_t*)(ws + WS_PB))[(size_t)m * PLE + k2]), f2bf_f(a.in[I_P][(size_t)m * PLE + k2]), 0.01f, 1e-6f)) dbg_fail(dbg, 2); }
        {
          const int e = h % 32, n = (h >> 5) % 2048, k = h2 % D; const int row = n < 1024 ? (((n >> 7) << 8) + (n & 127)) : ((((n - 1024) >> 7) << 8) + 128 + ((n - 1024) & 127));
          const float ref = f2bf_f(a.in[I_W1][((size_t)e * D + k) * 2048 + n] * a.in[I_N2G][k]);
          const float got = bf1(((const bf16_t*)(ws + WS_W1))[((size_t)e * 2048 + row) * D + k]);
          if (!closef(got, ref, 0.01f, 1e-6f)) dbg_fail(dbg, 1); }
        { const int e = h % 32, n = (h >> 5) % D, k = h2 % D;
          if (!closef(bf1(((const bf16_t*)(ws + WS_W2))[((size_t)e * D + n) * DFF + k]), f2bf_f(a.in[I_W2][((size_t)e * DFF + k) * D + n]), 0.01f, 1e-6f)) dbg_fail(dbg, 1); }
        const int m = h % M, c = h2 % D; const bf16_t* wc_ = (const bf16_t*)(ws + WS_WPC) + (size_t)c * 1024;
        const float r = dotbf(mixed + (size_t)m * 1024, wc_, 512) * pjv(pj, m, C_GP + c) + dotbf(attn + (size_t)m * 1024, wc_ + 512, 512) * pjv(pj, m, C_GA + c);
        if (!closef(bf1(zb[(size_t)m * D + c]), r, 0.02f, 0.02f)) dbg_fail(dbg, 8);
    }
    if (phase == PH_X1) {
        const int m = h % M, c = h2 % D;
        const float r = a.in[I_X][(size_t)m * D + c] + dotbf(zb + (size_t)m * D, (const bf16_t*)(ws + WS_WOUT) + (size_t)c * D, D);
        if (!closef(bf1(((const bf16_t*)(ws + WS_X1B))[(size_t)m * D + c]), r, 0.01f, 0.01f)) dbg_fail(dbg, 9);
        if (s < 512) { float q = 0.f; for (int i = 0; i < D; ++i) { const float v = bf1(((const bf16_t*)(ws + WS_X1B))[(size_t)m * D + i]); q += v * v; }
            if (!closef(((const float*)(ws + CTLB_SS2))[m], q, 0.01f, 0.f)) dbg_fail(dbg, 9); }
    }
    if (phase == PH_ROUTER) {
        const int m = h % M; const float rs = rsqrtf(((const float*)(ws + CTLB_SS2))[m] / D + RMS_EPS);
        float v[32]; for (int e = 0; e < 32; ++e) v[e] = dotbf((const bf16_t*)(ws + WS_X1B) + (size_t)m * D, (const bf16_t*)(ws + WS_WR) + (size_t)e * D, D) * rs + a.in[I_RB][e];
        const int* ti = (const int*)(ws + WS_TOPI) + m * 4; const float* tg = (const float*)(ws + WS_TOPG) + m * 4;
        float mn = 1e30f, se = 0.f, gs = 0.f; bool ok = true;
        for (int r = 0; r < 4; ++r) { if (ti[r] < 0 || ti[r] >= 32) { ok = false; break; } mn = fminf(mn, v[ti[r]]); for (int q = 0; q < r; ++q) if (ti[q] == ti[r]) ok = false; }
        if (ok) { for (int r = 0; r < 4; ++r) se += expf(v[ti[r]] - v[ti[0]]);
            for (int r = 0; r < 4; ++r) { if (!closef(tg[r], expf(v[ti[r]] - v[ti[0]]) / se, 0.02f, 0.002f)) ok = false; gs += tg[r]; }
            int above = 0; for (int e = 0; e < 32; ++e) { bool sel = false; for (int r = 0; r < 4; ++r) sel |= (ti[r] == e); if (!sel && v[e] > mn + 1e-3f) ++above; }
            if (above) ok = false; }
        if (!ok) dbg_fail(dbg, 10);
    }
    if (phase == PH_SCATTER) {
        const int m = h % M; const int* ti = (const int*)(ws + WS_TOPI) + m * 4; const int* po = (const int*)(ws + WS_POSOF) + m * 4; const int* te = (const int*)(ws + CTLB_TILEE);
        const int ntl = *(const int*)(ws + CTLB_META); bool ok = ntl > 0 && ntl <= 544;
        for (int r = 0; r < 4 && ok; ++r) { const int p = po[r]; if (p < 0 || p >= ntl * 256) { ok = false; break; }
            if (((const int*)(ws + WS_ROWMAP))[p] != m) ok = false; if (te[p >> 8] != ti[r]) ok = false;
            if (!closef(((const float*)(ws + WS_ROWGATE))[p], ((const float*)(ws + WS_TOPG))[m * 4 + r], 1e-6f, 0.f)) ok = false; }
        if (!ok) dbg_fail(dbg, 11);
    }
    if (phase == PH_MOE1) {
        const int ntl = *(const int*)(ws + CTLB_META); if (ntl > 0 && ntl <= 544) {
        const int row = h % (ntl * 256), j = h2 % DFF; const int e = ((const int*)(ws + CTLB_TILEE))[row >> 8], tok = ((const int*)(ws + WS_ROWMAP))[row];
        const float rs = rsqrtf(((const float*)(ws + CTLB_SS2))[tok] / D + RMS_EPS);
        const bf16_t* w1t = (const bf16_t*)(ws + WS_W1) + (size_t)e * 2048 * D; const int rg = ((j >> 7) << 8) + (j & 127), ru = rg + 128;
        float gl = dotbf((const bf16_t*)(ws + WS_X1B) + (size_t)tok * D, w1t + (size_t)rg * D, D) * rs + a.in[I_B1][e * 2048 + j];
        float up = dotbf((const bf16_t*)(ws + WS_X1B) + (size_t)tok * D, w1t + (size_t)ru * D, D) * rs + a.in[I_B1][e * 2048 + 1024 + j];
        gl = fminf(gl, 7.f); up = fminf(fmaxf(up, -7.f), 7.f);
        const float r = (up + 1.f) * gl / (1.f + expf(-1.702f * gl));
        if (((const float*)(ws + WS_ROWGATE))[row] != 0.f && !closef(bf1(((const bf16_t*)(ws + WS_R1))[(size_t)row * DFF + j]), r, 0.03f, 0.02f)) dbg_fail(dbg, 12); } else dbg_fail(dbg, 12);
    }
    if (phase == PH_MOE2) {
        const int ntl = *(const int*)(ws + CTLB_META); if (ntl > 0 && ntl <= 544) {
        const int row = h % (ntl * 256), c = h2 % D; const int e = ((const int*)(ws + CTLB_TILEE))[row >> 8];
        const float r = (dotbf((const bf16_t*)(ws + WS_R1) + (size_t)row * DFF, (const bf16_t*)(ws + WS_W2) + ((size_t)e * D + c) * DFF, DFF) + a.in[I_B2][e * D + c]) * ((const float*)(ws + WS_ROWGATE))[row];
        if (!closef(bf1(((const bf16_t*)(ws + WS_R2))[(size_t)row * D + c]), r, 0.03f, 0.01f)) dbg_fail(dbg, 13); } else dbg_fail(dbg, 13);
    }
    if (phase == PH_COMBINE) {
        const int m = h % M, c = h2 % D;
        { float r2 = bf1(((const bf16_t*)(ws + WS_X1B))[(size_t)m * D + c]); for (int q = 0; q < 4; ++q) r2 += bf1(((const bf16_t*)(ws + WS_R2))[(size_t)((const int*)(ws + WS_POSOF))[m * 4 + q] * D + c]);
          if (!closef(bf1(((const bf16_t*)(ws + WS_R1))[(size_t)m * D + c]), r2, 0.01f, 0.01f)) dbg_fail(dbg, 14); }
        if (s < 512) { float q = 0.f; for (int i = 0; i < D; ++i) { const float v = bf1(((const bf16_t*)(ws + WS_R1))[(size_t)m * D + i]); q += v * v; }
            if (!closef(((const float*)(ws + WS_RS3))[m], rsqrtf(q / D + RMS_EPS), 0.01f, 0.f)) dbg_fail(dbg, 14); }
    }
    if (phase == PH_PLE) {
        const int m = h % M, c = h2 % D;
        const float pp = dotbf((const bf16_t*)(ws + WS_PB) + (size_t)m * PLE, (const bf16_t*)(ws + WS_WPP) + (size_t)c * PLE, PLE);
        const float ppk = bf1(((const bf16_t*)(ws + WS_PP))[(size_t)m * D + c]);
        if (!closef(ppk, pp, 0.02f, 0.01f)) dbg_fail(dbg, 16);
        const float gate = 1.f / (1.f + expf(-dotbf((const bf16_t*)(ws + WS_R1) + (size_t)m * D, (const bf16_t*)(ws + WS_WPG) + (size_t)c * D, D) * ((const float*)(ws + WS_RS3))[m]));
        const float r3 = bf1(((const bf16_t*)(ws + WS_R1))[(size_t)m * D + c]) + gate * ppk;
        if (!closef(bf1(((const bf16_t*)(ws + WS_R1 + 128 * MiB))[(size_t)m * D + c]), r3, 0.02f, 0.03f)) dbg_fail(dbg, 15);
    }
}
__global__ void __launch_bounds__(256) chk_att(Args a) {
    unsigned char* ws = a.ws; unsigned* dbg = (unsigned*)(ws + CTLB_DBG);
    const unsigned char* pj = ws + WS_R1; const bf16_t* attn = (const bf16_t*)(ws + WS_R2 + 64 * MiB) + 512; const int* sel = (const int*)(ws + WS_SEL);
    const int special[16] = {0, 5, 63, 64, 200, 255, 256, 257, 300, 449, 512, 1000, 2047, 4096, 9000, 16383};
    const int sb = blockIdx.x; int t = (sb < 16) ? special[sb] : (int)(hash_u(sb * 977u + 5u) % SEQ); const int b = sb & 1; const int row = b * SEQ + t;
    __shared__ unsigned bitmap[512]; __shared__ unsigned skey[256]; __shared__ int s_bad, s_viol; __shared__ unsigned s_min; __shared__ float sc[8][256];
    const int tid = threadIdx.x;
    for (int i = tid; i < 512; i += 256) bitmap[i] = 0u;
    if (tid == 0) { s_bad = 0; s_viol = 0; s_min = 0xFFFFFFFFu; }
    __syncthreads();
    const int nsel = (t + 1) < 256 ? (t + 1) : 256;
    auto score_key = [&](int kp) -> unsigned {
        float s = 0.f;
        for (int hd = 0; hd < 8; ++hd) { float l = 0.f; for (int d = 0; d < 64; ++d) l += pjv(pj, row, C_QI + hd * 64 + d) * pjv(pj, b * SEQ + kp, C_KI + d);
            s = fmaf(fmaxf(l, 0.f), pjv(pj, row, C_WI + hd), s); }
        const unsigned ub = __builtin_bit_cast(unsigned, s); const unsigned srt = ub ^ ((ub >> 31) ? 0xFFFFFFFFu : 0x80000000u);
        return (srt & 0xFFFFC000u) | (unsigned)(16383 - kp);
    };
    { const int kp = sel[(size_t)row * 256 + tid];
      if (tid < nsel) { if (kp < 0 || kp > t) atomicAdd(&s_bad, 1); else { const unsigned old = atomicOr(&bitmap[kp >> 5], 1u << (kp & 31)); if (old & (1u << (kp & 31))) atomicAdd(&s_bad, 1);
            const unsigned pk = score_key(kp); skey[tid] = pk; atomicMin(&s_min, pk); } }
      else if (kp != -1) atomicAdd(&s_bad, 1); }
    __syncthreads();
    if (s_bad == 0) {
        for (int kp = tid; kp <= t; kp += 256) { if (!((bitmap[kp >> 5] >> (kp & 31)) & 1u)) { if (score_key(kp) > s_min) atomicAdd(&s_viol, 1); } }
    }
    __syncthreads();
    if (tid == 0 && (s_bad != 0 || s_viol > 3)) dbg_fail(dbg, 6);
    if (s_bad != 0) return;
    for (int hd = 0; hd < 8; ++hd) { float l = -1e30f;
        if (tid < nsel) { const int kp = sel[(size_t)row * 256 + tid]; l = 0.f; for (int d = 0; d < 64; ++d) l += pjv(pj, row, C_Q + hd * 64 + d) * pjv(pj, b * SEQ + kp, C_K + (hd >> 2) * 64 + d); }
        sc[hd][tid] = l; }
    __syncthreads();
    for (int o = tid; o < 512; o += 256) { const int hd = o >> 6, d = o & 63; float mx = -1e30f; for (int i = 0; i < nsel; ++i) mx = fmaxf(mx, sc[hd][i]);
        float se = 0.f, ov = 0.f; for (int i = 0; i < nsel; ++i) { const float p = expf(sc[hd][i] - mx); se += p; ov += p * pjv(pj, b * SEQ + sel[(size_t)row * 256 + i], C_V + (hd >> 2) * 64 + 16 * (d & 3) + (d >> 2)); }
        if (!closef(bf1(attn[(size_t)row * 1024 + o]), ov / se, 0.03f, 0.01f)) dbg_fail(dbg, 7); }
}
__global__ void __launch_bounds__(256) chk_report(Args a) {
    const unsigned* dbg = (const unsigned*)(a.ws + CTLB_DBG);
    int code = 0; for (int c = 20; c < 32; ++c) if (dbg[c] != 0u) { code = c; break; }
    if (code == 0) for (int c = 1; c < 20; ++c) if (dbg[c] != 0u) { code = c; break; }
    if (code == 0) return;
    const float v = sqrtf((float)code);
    for (size_t i = (size_t)blockIdx.x * 256 + threadIdx.x; i < (size_t)M * D; i += (size_t)gridDim.x * 256) a.out[i] = v;
}
#endif

extern "C" void kernel_launch(void* const* d_in, const int* in_sizes, int n_in, void* d_out, int out_size, void* d_ws, size_t ws_size, hipStream_t stream) {
    static int grid = 0;
    if (grid == 0) {
        if (n_in != 20 || out_size != M * D || ws_size < WS_END) { fprintf(stderr, "kernel_launch: unexpected shapes (n_in %d out %d ws %zu)\n", n_in, out_size, ws_size); grid = -1; return; }
        int dev = 0, cus = 0, per_cu = 0;
        if (hipGetDevice(&dev) != hipSuccess || hipDeviceGetAttribute(&cus, hipDeviceAttributeMultiprocessorCount, dev) != hipSuccess) { grid = -1; return; }
        if (hipFuncSetAttribute((const void*)fwd, hipFuncAttributeMaxDynamicSharedMemorySize, LDS_BYTES) != hipSuccess) { fprintf(stderr, "kernel_launch: hipFuncSetAttribute failed\n"); grid = -1; return; }
        if (hipOccupancyMaxActiveBlocksPerMultiprocessor(&per_cu, (const void*)fwd, NTHREADS, LDS_BYTES) != hipSuccess || per_cu < 1) fprintf(stderr, "kernel_launch: occupancy query says %d\n", per_cu);
        (void)hipGetLastError();
        grid = cus;
    }
    if (grid < 0) return;
    (void)hipMemsetAsync((char*)d_ws + WS_CTL, 0, CTL_ZERO_BYTES, stream);
    Args a{};
    for (int i = 0; i < 20; ++i) a.in[i] = (const float*)d_in[i];
    a.out = (float*)d_out; a.ws = (unsigned char*)d_ws;
#if DBG
    for (int p = 0; p < NPH; ++p) {
        a.ph_lo = p; a.ph_hi = p + 1;
        hipLaunchKernelGGL(fwd, dim3(grid), dim3(NTHREADS), LDS_BYTES, stream, a);
        if (p == PH_ATT) hipLaunchKernelGGL(chk_att, dim3(48), dim3(256), 0, stream, a);
        else if (p != PH_FINAL && p != PH_POOL) hipLaunchKernelGGL(chk, dim3(32), dim3(256), 0, stream, a, p);
    }
    hipLaunchKernelGGL(chk_report, dim3(1024), dim3(256), 0, stream, a);
#else
    a.ph_lo = 0; a.ph_hi = NPH;
    hipLaunchKernelGGL(fwd, dim3(grid), dim3(NTHREADS), LDS_BYTES, stream, a);
#endif
}
```
